# Optimizing an MI355X kernel written in HIP

```python
import numpy as np
import jax
import jax.numpy as jnp
from jax import lax

D_MODEL = 1024
BATCH = 32
SEQ = 2048
DEPTH = 4

N_MIXERS = 4
PLE_DIM = 256
D_FF = 4 * D_MODEL
NORM_EPS = 1e-6

A_HEADS = 8
A_DV = D_MODEL // A_HEADS
A_DQK = A_DV // 2
A_CHUNK = 128
A_SPLITS = (A_HEADS * A_DQK, A_HEADS * A_DQK, D_MODEL, D_MODEL, A_HEADS, A_HEADS)

B_HEADS = 8
B_DK = 128
B_DV = D_MODEL // B_HEADS
B_FDIM = B_HEADS * B_DK
B_CHUNK = 16
B_SPLITS = (B_FDIM, B_FDIM, D_MODEL, D_MODEL)

C_HALF = 2 * D_MODEL
C_GROUPS = 8
C_GROUP_W = C_HALF // C_GROUPS
C_CHUNK = 128

D_RNN = D_MODEL
D_BLOCK_W = 256
D_BLOCKS = D_RNN // D_BLOCK_W
D_CONV = 4
RG_C = 8.0

kernel_name = 'hybrid_mlstm_hgrn2_gmlp_rglru_trunk'


def _rmsnorm(x, gain):
    x32 = x.astype(jnp.float32)
    y = x32 * lax.rsqrt(jnp.mean(x32 * x32, axis=-1, keepdims=True) + NORM_EPS)
    return (y * gain.astype(jnp.float32)).astype(x.dtype)


def _split(z, sizes):
    idx = np.cumsum(sizes)[:-1].tolist()
    return jnp.split(z, idx, axis=-1)


def _to_chunks(t, size):
    b, s, h = t.shape[:3]
    t = t.reshape((b, s // size, size, h) + t.shape[3:])
    return jnp.transpose(t, (1, 0, 3, 2) + tuple(range(4, t.ndim)))


def _from_chunks(t):
    t = jnp.transpose(t, (1, 0, 3, 2) + tuple(range(4, t.ndim)))
    b, nc, size, h = t.shape[:4]
    return t.reshape((b, nc * size, h) + t.shape[4:])


def _mlstm_chunkwise(q, k, v, log_i, log_f):
    bsz, _, nh, dk = q.shape
    dv = v.shape[-1]
    L = A_CHUNK
    mask = jnp.tril(jnp.ones((L, L), dtype=bool))

    def step(carry, inp):
        c_st, n_st, m_st = carry
        qc, kc, vc, ic, fc = inp
        b = jnp.cumsum(fc, axis=-1)
        inter = b + m_st[..., None]
        dmat = jnp.where(mask, b[..., :, None] - b[..., None, :] + ic[..., None, :], -jnp.inf)
        m_t = jnp.maximum(inter, jnp.max(dmat, axis=-1))
        s = jnp.einsum('bhtd,bhsd->bhts', qc, kc) * jnp.exp(dmat - m_t[..., None])
        w_inter = jnp.exp(inter - m_t)
        num = jnp.einsum('bhts,bhsv->bhtv', s, vc) + w_inter[..., None] * jnp.einsum('bhtd,bhdv->bhtv', qc, c_st)
        den = jnp.sum(s, axis=-1) + w_inter * jnp.einsum('bhtd,bhd->bht', qc, n_st)
        out = num / jnp.maximum(jnp.abs(den), jnp.exp(-m_t))[..., None]
        b_last = b[..., -1]
        tail = b_last[..., None] - b + ic
        m_new = jnp.maximum(b_last + m_st, jnp.max(tail, axis=-1))
        decay = jnp.exp(b_last + m_st - m_new)
        wk = jnp.exp(tail - m_new[..., None])
        c_new = decay[..., None, None] * c_st + jnp.einsum('bhs,bhsd,bhsv->bhdv', wk, kc, vc)
        n_new = decay[..., None] * n_st + jnp.einsum('bhs,bhsd->bhd', wk, kc)
        return (c_new, n_new, m_new), out

    init = (jnp.zeros((bsz, nh, dk, dv), jnp.float32),
            jnp.zeros((bsz, nh, dk), jnp.float32),
            jnp.zeros((bsz, nh), jnp.float32))
    xs = (_to_chunks(q, L), _to_chunks(k, L), _to_chunks(v, L), _to_chunks(log_i, L), _to_chunks(log_f, L))
    _, out = lax.scan(step, init, xs)
    return _from_chunks(out)


def _mlstm_mixer(x, w_in, ig_bias, fg_bias, head_gain, w_out):
    bsz, s, _ = x.shape
    f32 = jnp.float32
    q, k, v, o, ig, fg = _split(x @ w_in, A_SPLITS)
    q = q.reshape(bsz, s, A_HEADS, A_DQK).astype(f32) * (A_DQK ** -0.5)
    k = k.reshape(bsz, s, A_HEADS, A_DQK).astype(f32)
    v = v.reshape(bsz, s, A_HEADS, A_DV).astype(f32)
    log_i = ig.astype(f32) + ig_bias.astype(f32)
    log_f = jax.nn.log_sigmoid(fg.astype(f32) + fg_bias.astype(f32))
    hcell = _rmsnorm(_mlstm_chunkwise(q, k, v, log_i, log_f), head_gain)
    y = jax.nn.sigmoid(o.astype(f32)) * hcell.reshape(bsz, s, D_MODEL)
    return y.astype(x.dtype) @ w_out


def _hgrn2_chunkwise(q, k, v, log_f):
    bsz, _, nh, dk = q.shape
    dv = v.shape[-1]
    L = B_CHUNK
    mask = jnp.tril(jnp.ones((L, L), dtype=bool))[:, :, None]

    def step(s_st, inp):
        qc, kc, vc, gc = inp
        g = jnp.cumsum(gc, axis=-2)
        decay = jnp.exp(jnp.where(mask, g[..., :, None, :] - g[..., None, :, :], -jnp.inf))
        attn = jnp.einsum('bhtc,bhsc,bhtsc->bhts', qc, kc, decay)
        out = jnp.einsum('bhts,bhsv->bhtv', attn, vc) + jnp.einsum('bhtc,bhcv->bhtv', qc * jnp.exp(g), s_st)
        g_last = g[..., -1:, :]
        s_new = (jnp.exp(g_last[..., 0, :])[..., None] * s_st
                 + jnp.einsum('bhsc,bhsv->bhcv', kc * jnp.exp(g_last - g), vc))
        return s_new, out

    init = jnp.zeros((bsz, nh, dk, dv), jnp.float32)
    xs = (_to_chunks(q, L), _to_chunks(k, L), _to_chunks(v, L), _to_chunks(log_f, L))
    _, out = lax.scan(step, init, xs)
    return _from_chunks(out)


def _hgrn2_mixer(x, w_in, lower_bound, head_gain, w_out):
    bsz, s, _ = x.shape
    f32 = jnp.float32
    q, fz, i_in, g = _split(x @ w_in, B_SPLITS)
    fz = fz.astype(f32)
    lb = lower_bound.astype(f32)
    log_f = jnp.logaddexp(jnp.log(lb), jnp.log1p(-lb) + jax.nn.log_sigmoid(fz))
    key = (1.0 - lb) * jax.nn.sigmoid(-fz)
    shp = (bsz, s, B_HEADS, B_DK)
    o = _hgrn2_chunkwise(q.astype(f32).reshape(shp), key.reshape(shp),
                         i_in.astype(f32).reshape(bsz, s, B_HEADS, B_DV), log_f.reshape(shp))
    o = _rmsnorm(o, head_gain).reshape(bsz, s, D_MODEL) * jax.nn.silu(g.astype(f32))
    return o.astype(x.dtype) @ w_out


def _gmlp_mixer(x, w_in, ln_gain, ln_bias, w_s, b_s, w_out):
    bsz, s, _ = x.shape
    f32 = jnp.float32
    u, v = jnp.split(jax.nn.gelu(x @ w_in), 2, axis=-1)
    v32 = v.astype(f32)
    mu = jnp.mean(v32, axis=-1, keepdims=True)
    var = jnp.mean(jnp.square(v32 - mu), axis=-1, keepdims=True)
    v32 = (v32 - mu) * lax.rsqrt(var + NORM_EPS) * ln_gain.astype(f32) + ln_bias.astype(f32)
    vc = v32.reshape(bsz, s // C_CHUNK, C_CHUNK, C_GROUPS, C_GROUP_W)
    w_causal = jnp.tril(w_s.astype(f32))
    vm = jnp.einsum('gts,bnsgc->bntgc', w_causal, vc) + b_s.astype(f32).T[:, :, None]
    y = u.astype(f32) * vm.reshape(bsz, s, C_HALF)
    return y.astype(x.dtype) @ w_out


def _linrec_combine(e1, e2):
    a1, b1 = e1
    a2, b2 = e2
    return a1 * a2, a2 * b1 + b2


def _rglru_mixer(x, w_in, conv_w, conv_b, w_a, b_a, w_x, b_x, lam, w_out):
    bsz, s, _ = x.shape
    f32 = jnp.float32
    gate_br, xb = jnp.split(x @ w_in, 2, axis=-1)
    xb = lax.conv_general_dilated(xb, conv_w[:, None, :], window_strides=(1,), padding=[(D_CONV - 1, 0)],
                                  dimension_numbers=('NWC', 'WIO', 'NWC'), feature_group_count=D_RNN) + conv_b
    xg = xb.astype(f32).reshape(bsz, s, D_BLOCKS, D_BLOCK_W)
    r = jax.nn.sigmoid(jnp.einsum('bsnc,ncd->bsnd', xg, w_a.astype(f32)).reshape(bsz, s, D_RNN) + b_a.astype(f32))
    ig = jax.nn.sigmoid(jnp.einsum('bsnc,ncd->bsnd', xg, w_x.astype(f32)).reshape(bsz, s, D_RNN) + b_x.astype(f32))
    log_a = -RG_C * r * jax.nn.softplus(-lam.astype(f32))
    a = jnp.exp(log_a)
    beta = jnp.sqrt(-jnp.expm1(2.0 * log_a)) * (ig * xg.reshape(bsz, s, D_RNN))
    _, hseq = lax.associative_scan(_linrec_combine, (a, beta), axis=1)
    y = hseq * jax.nn.gelu(gate_br.astype(f32))
    return y.astype(x.dtype) @ w_out


def _sqrelu_mlp(x, w_up, w_down):
    return jnp.square(jax.nn.relu(x @ w_up)) @ w_down


def setup_inputs(seed: int = 0) -> dict:
    key = jax.random.key(seed)
    keys = iter(jax.random.split(key, 48))

    def nrm(shape, scale):
        return scale * jax.random.normal(next(keys), shape, jnp.float32)

    def gain(shape):
        return 1.0 + nrm(shape, 0.05)

    n_a, n_b, n_c, n_d = [len(range(m, DEPTH, N_MIXERS)) for m in range(N_MIXERS)]
    d = D_MODEL
    u = jax.random.uniform(next(keys), (n_d, D_RNN), jnp.float32, 0.9, 0.999)
    a0 = u ** (1.0 / RG_C)
    return {
        'x': nrm((BATCH, SEQ, d), 1.0),
        'p': nrm((DEPTH, BATCH, SEQ, PLE_DIM), 1.0),
        'norm_gains': gain((DEPTH, 5, d)),
        'mlp_w_up': nrm((DEPTH, d, D_FF), d ** -0.5),
        'mlp_w_down': nrm((DEPTH, D_FF, d), D_FF ** -0.5),
        'ple_w_up': nrm((DEPTH, PLE_DIM, d), PLE_DIM ** -0.5),
        'ple_w_gate': nrm((DEPTH, d, d), d ** -0.5),
        'a_w_in': nrm((n_a, d, sum(A_SPLITS)), d ** -0.5),
        'a_ig_bias': nrm((n_a, A_HEADS), 0.1),
        'a_fg_bias': jnp.linspace(3.0, 6.0, A_HEADS, dtype=jnp.float32) + nrm((n_a, A_HEADS), 0.1),
        'a_head_gain': gain((n_a, A_HEADS, A_DV)),
        'a_w_out': nrm((n_a, A_HEADS * A_DV, d), (A_HEADS * A_DV) ** -0.5),
        'b_w_in': nrm((n_b, d, sum(B_SPLITS)), d ** -0.5),
        'b_lower_bound': 1.0 + nrm((DEPTH, B_FDIM), 0.1),
        'b_head_gain': gain((n_b, B_HEADS, B_DV)),
        'b_w_out': nrm((n_b, B_HEADS * B_DV, d), (B_HEADS * B_DV) ** -0.5),
        'c_w_in': nrm((n_c, d, 2 * C_HALF), d ** -0.5),
        'c_ln_gain': gain((n_c, C_HALF)),
        'c_ln_bias': nrm((n_c, C_HALF), 0.02),
        'c_spatial_w': nrm((n_c, C_GROUPS, C_CHUNK, C_CHUNK), C_CHUNK ** -0.5),
        'c_spatial_b': 1.0 + nrm((n_c, C_GROUPS, C_CHUNK), 0.02),
        'c_w_out': nrm((n_c, C_HALF, d), C_HALF ** -0.5),
        'd_w_in': nrm((n_d, d, 2 * D_RNN), d ** -0.5),
        'd_conv_w': nrm((n_d, D_CONV, D_RNN), D_CONV ** -0.5),
        'd_conv_b': nrm((n_d, D_RNN), 0.02),
        'd_w_a': nrm((n_d, D_BLOCKS, D_BLOCK_W, D_BLOCK_W), D_BLOCK_W ** -0.5),
        'd_b_a': nrm((n_d, D_RNN), 0.02),
        'd_w_x': nrm((n_d, D_BLOCKS, D_BLOCK_W, D_BLOCK_W), D_BLOCK_W ** -0.5),
        'd_b_x': nrm((n_d, D_RNN), 0.02),
        'd_lambda': jnp.log(a0) - jnp.log1p(-a0),
        'd_w_out': nrm((n_d, D_RNN, d), D_RNN ** -0.5),
    }


def reference(x, p, norm_gains, mlp_w_up, mlp_w_down, ple_w_up, ple_w_gate,
              a_w_in, a_ig_bias, a_fg_bias, a_head_gain, a_w_out,
              b_w_in, b_lower_bound, b_head_gain, b_w_out,
              c_w_in, c_ln_gain, c_ln_bias, c_spatial_w, c_spatial_b, c_w_out,
              d_w_in, d_conv_w, d_conv_b, d_w_a, d_b_a, d_w_x, d_b_x, d_lambda, d_w_out):
    lb = jnp.cumsum(jax.nn.softmax(b_lower_bound.astype(jnp.float32), axis=0), axis=0)
    lb = lb - lb[0]
    h = x
    for i in range(DEPTH):
        kind, j = i % N_MIXERS, i // N_MIXERS
        hn = _rmsnorm(h, norm_gains[i, 0])
        if kind == 0:
            y = _mlstm_mixer(hn, a_w_in[j], a_ig_bias[j], a_fg_bias[j], a_head_gain[j], a_w_out[j])
        elif kind == 1:
            y = _hgrn2_mixer(hn, b_w_in[j], lb[i], b_head_gain[j], b_w_out[j])
        elif kind == 2:
            y = _gmlp_mixer(hn, c_w_in[j], c_ln_gain[j], c_ln_bias[j], c_spatial_w[j], c_spatial_b[j], c_w_out[j])
        else:
            y = _rglru_mixer(hn, d_w_in[j], d_conv_w[j], d_conv_b[j], d_w_a[j], d_b_a[j],
                             d_w_x[j], d_b_x[j], d_lambda[j], d_w_out[j])
        h = h + _rmsnorm(y, norm_gains[i, 1])
        y = _sqrelu_mlp(_rmsnorm(h, norm_gains[i, 2]), mlp_w_up[i], mlp_w_down[i])
        h = h + _rmsnorm(y, norm_gains[i, 3])
        gate = jax.nn.sigmoid(h @ ple_w_gate[i])
        h = h + _rmsnorm(gate * (p[i] @ ple_w_up[i]), norm_gains[i, 4])
    return h
```

```cpp
#include <hip/hip_runtime.h>
#include <hip/hip_cooperative_groups.h>
#include <cstdio>
namespace cg = cooperative_groups;

#ifndef ONE_LAUNCH
#define ONE_LAUNCH 1
#endif

#define LAS __attribute__((address_space(3)))
typedef unsigned short bf16_t;
typedef short bf16x8 __attribute__((ext_vector_type(8)));
typedef short s16x4 __attribute__((ext_vector_type(4)));
typedef float f32x4 __attribute__((ext_vector_type(4)));
typedef float f32x2 __attribute__((ext_vector_type(2)));
typedef unsigned u32x4 __attribute__((ext_vector_type(4)));
typedef unsigned u32x2 __attribute__((ext_vector_type(2)));

constexpr int MTOK = 65536, DM = 1024, SEQL = 2048;
constexpr float EPS = 1e-6f;
constexpr int NTHREADS = 512;
constexpr int LDS_BYTES = 147456;

constexpr size_t W_UP = 4096ull * 1024, W_DN = 1024ull * 4096, W_G = 1024ull * 1024, W_PU = 1024ull * 256;
constexpr size_t LW = W_UP + W_DN + W_G + W_PU;
constexpr size_t OFF_A_IN = 4 * LW;
constexpr size_t OFF_A_OUT = OFF_A_IN + 3328ull * 1024;
constexpr size_t OFF_B_IN = OFF_A_OUT + 1024ull * 1024;
constexpr size_t OFF_B_OUT = OFF_B_IN + 4096ull * 1024;
constexpr size_t OFF_C_IN = OFF_B_OUT + 1024ull * 1024;
constexpr size_t OFF_C_OUT = OFF_C_IN + 4096ull * 1024;
constexpr size_t OFF_C_WS = OFF_C_OUT + 1024ull * 2048;
constexpr size_t OFF_D_IN = OFF_C_WS + 8ull * 128 * 128;
constexpr size_t OFF_D_G = OFF_D_IN + 2048ull * 1024;
constexpr size_t OFF_D_OUT = OFF_D_G + 4ull * 512 * 256;
constexpr size_t W_TOTAL = OFF_D_OUT + 1024ull * 1024;
constexpr size_t MiB = 1024ull * 1024;
static_assert(W_TOTAL * 2 <= 112 * MiB, "weights region");
constexpr size_t WS_W = 0, WS_HN = 112 * MiB, WS_Z = 240 * MiB, WS_YP = 752 * MiB, WS_PB = 880 * MiB, WS_GATE = 912 * MiB, WS_LB = 916 * MiB, WS_BAR = 917 * MiB, WS_END = 918 * MiB;

struct Params {
    const float* in[31];
    float* out;
    unsigned char* ws;
    int ph_lo, ph_hi;
};
typedef const __attribute__((address_space(4))) Params* KP;
enum { I_X = 0, I_P, I_NG, I_WUP, I_WDN, I_PUP, I_PG, I_AIN, I_AIB, I_AFB, I_AHG, I_AOUT, I_BIN, I_BLB, I_BHG, I_BOUT, I_CIN, I_CLG, I_CLB, I_CSW, I_CSB, I_COUT,
       I_DIN, I_DCW, I_DCB, I_DWA, I_DBA, I_DWX, I_DBX, I_DLAM, I_DOUT };

__device__ __forceinline__ float bf2f(bf16_t b) { return __uint_as_float(((unsigned)b) << 16); }
__device__ __forceinline__ float bflo(unsigned u) { return __uint_as_float(u << 16); }
__device__ __forceinline__ float bfhi(unsigned u) { return __uint_as_float(u & 0xffff0000u); }
__device__ __forceinline__ unsigned pk2(float lo, float hi) { unsigned r; asm("v_cvt_pk_bf16_f32 %0, %1, %2" : "=v"(r) : "v"(lo), "v"(hi)); return r; }
__device__ __forceinline__ bf16_t f2bf(float f) { return (bf16_t)(pk2(f, 0.f) & 0xffffu); }
__device__ __forceinline__ float fast_rcp(float x) { return __builtin_amdgcn_rcpf(x); }
__device__ __forceinline__ float sigmoidf_(float x) { return fast_rcp(1.0f + __expf(-x)); }
__device__ __forceinline__ float gelu_tanh(float x) { const float t = 1.5957691216057308f * (x + 0.044715f * x * x * x); return x * fast_rcp(1.0f + __expf(-t)); }
__device__ __forceinline__ float wave_sum(float v) {
#pragma unroll
    for (int o = 32; o >= 1; o >>= 1) v += __shfl_xor(v, o);
    return v;
}
__device__ __forceinline__ bf16x8 as_bf16x8(u32x4 v) { union { u32x4 u; bf16x8 b; } x; x.u = v; return x.b; }
__device__ __forceinline__ u32x4 as_u32x4(bf16x8 v) { union { u32x4 u; bf16x8 b; } x; x.b = v; return x.u; }
__device__ __forceinline__ bf16x8 ldk(const LAS unsigned char* p) { return *(const LAS bf16x8*)p; }
__device__ __forceinline__ bf16x8 ldt(const LAS unsigned char* base, int pitch, int fr, int fq) {
    const LAS unsigned char* p = base + (fq * 8 + (fr >> 2)) * pitch + (fr & 3) * 8;
    s16x4 a = __builtin_amdgcn_ds_read_tr16_b64_v4i16((LAS s16x4*)p);
    s16x4 b = __builtin_amdgcn_ds_read_tr16_b64_v4i16((LAS s16x4*)(p + 4 * pitch));
    bf16x8 r = {a[0], a[1], a[2], a[3], b[0], b[1], b[2], b[3]};
    return r;
}
__device__ __forceinline__ int opaque_tid() { int t = threadIdx.x; asm volatile("" : "+v"(t)); return t; }
#define MFMA16(a, b, c) __builtin_amdgcn_mfma_f32_16x16x32_bf16((a), (b), (c), 0, 0, 0)


#define XB_TMO      128
#define XB_XCNT(j)  (256  + 64 * (j))
#define XB_XSUB(j)  (1280 + 64 * (j))
#define XB_XGEN(j)  (2304 + 64 * (j))
#define XB_TOP      3328
#define XB_TOPGEN   3392
#define XCD_BAR_WORDS 3456
#define XB_SPIN_CAP (1u << 20)
__device__ __forceinline__ unsigned xb_ld(unsigned* p)              { return __hip_atomic_load(p, __ATOMIC_RELAXED, __HIP_MEMORY_SCOPE_AGENT); }
__device__ __forceinline__ unsigned xb_add(unsigned* p, unsigned v) { return __hip_atomic_fetch_add(p, v, __ATOMIC_RELAXED, __HIP_MEMORY_SCOPE_AGENT); }
__device__ __forceinline__ unsigned xb_xcc_id() { return (unsigned)__builtin_amdgcn_s_getreg((3 << 11) | 20) & 0xFu; }
#define XB_SPIN(cond, bar) do { unsigned _sp = 0; while (cond) { __builtin_amdgcn_s_sleep(1); \
    if ((++_sp & 255u) == 0u) { if (xb_ld(&(bar)[XB_TMO])) break; if (_sp > XB_SPIN_CAP) { atomicAdd(&(bar)[XB_TMO], 1u); break; } } } } while (0)
struct XcdBarrier { unsigned* bar; unsigned x; volatile LAS unsigned* st; };
__device__ __forceinline__ XcdBarrier xcd_barrier_post(unsigned* bar, volatile LAS unsigned* st) {
    XcdBarrier b; b.bar = bar; b.x = xb_xcc_id(); b.st = st;
    if (threadIdx.x == 0) (void)xb_add(&bar[XB_XCNT(b.x)], 1u);
    return b;
}
__device__ __forceinline__ void xcd_barrier_complete(unsigned* bar, unsigned x, unsigned& nloc, unsigned& nx) {
    const unsigned G = gridDim.x * gridDim.y * gridDim.z;
    unsigned sum, cnt, mine, sp = 0u;
    for (;;) {
        sum = 0u; cnt = 0u; mine = 0u;
#pragma unroll
        for (unsigned j = 0; j < 16; ++j) { const unsigned c = xb_ld(&bar[XB_XCNT(j)]); sum += c; cnt += (c > 0u) ? 1u : 0u; mine = (j == x) ? c : mine; }
        if (sum == G) break;
        __builtin_amdgcn_s_sleep(1);
        if ((++sp & 255u) == 0u) { if (xb_ld(&bar[XB_TMO])) break; if (sp > XB_SPIN_CAP) { atomicAdd(&bar[XB_TMO], 1u); break; } }
    }
    nloc = mine > 0u ? mine : 1u; nx = cnt > 0u ? cnt : 1u;
}
__device__ __forceinline__ void xcd_barrier(const XcdBarrier& b) {
    asm volatile("s_waitcnt vmcnt(0)" ::: "memory");
    __syncthreads();
    if (threadIdx.x == 0) {
        unsigned* bar = b.bar;
        __builtin_amdgcn_s_waitcnt(0);
        unsigned nloc = b.st[0], nx = b.st[1];
        if (nloc == 0u) { xcd_barrier_complete(bar, b.x, nloc, nx); b.st[0] = nloc; b.st[1] = nx; }
        const unsigned old = xb_add(&bar[XB_XSUB(b.x)], 1u);
        const unsigned gen = old / nloc;
        if (old + 1u == (gen + 1u) * nloc) {
            __builtin_amdgcn_fence(__ATOMIC_RELEASE, "agent");
            asm volatile("s_waitcnt vmcnt(0)" ::: "memory");
            const unsigned og = xb_add(&bar[XB_TOP], 1u);
            const unsigned tg = og / nx;
            if (og + 1u == (tg + 1u) * nx) xb_add(&bar[XB_TOPGEN], 1u);
            else XB_SPIN(xb_ld(&bar[XB_TOPGEN]) == tg, bar);
            __builtin_amdgcn_fence(__ATOMIC_ACQUIRE, "agent");
            xb_add(&bar[XB_XGEN(b.x)], 1u);
            asm volatile("s_waitcnt vmcnt(0)" ::: "memory");
        } else {
            XB_SPIN(xb_ld(&bar[XB_XGEN(b.x)]) == gen, bar);
            __builtin_amdgcn_fence(__ATOMIC_ACQUIRE, "agent");
            asm volatile("s_waitcnt vmcnt(0)" ::: "memory");
        }
    }
    __syncthreads();
}

namespace pg8 {
constexpr int BM = 256, BK = 64, HALF = 128, HTB = HALF * BK * 2, STAGE_BYTES = 8 * HTB, NXCD = 8, WGM = 8;
__device__ __forceinline__ int lds_byte(int r, int c) { const int st = (r >> 4) * 2 + (c >> 5), rr = r & 15, cc = c & 31, ob = rr * 64 + cc * 2; return st * 1024 + (ob ^ (((ob >> 9) & 1) << 5)); }
__device__ __forceinline__ void stage_rc(int b, int& R, int& C) { const int st = b / 1024, sb = b % 1024, swz = sb ^ (((sb >> 9) & 1) << 5); R = (st >> 1) * 16 + swz / 64; C = (st & 1) * 32 + (swz % 64) / 2; }
__device__ __forceinline__ int perm32(int rho) { const int n = rho >> 4, i = rho & 15; return 8 * (i >> 2) + 4 * n + (i & 3); }
struct Unit { int pm, pn; };
struct Gemm { const bf16_t* A; const bf16_t* Bt; int M, N, K, lda, ldb; };
struct StaticOrder {
    int nM, nN, nwg, G, c;
    __device__ void init(int M, int N, int G_, int c_) { nM = M / BM; nN = N / BM; nwg = nM * nN; G = G_; c = c_; }
    __device__ bool next(int i, Unit& u) const {
        const long L = (long)i * G + c; if (L >= nwg) return false;
        int wgid = (int)L; { const int q = nwg / NXCD, r = nwg % NXCD, xcd = wgid % NXCD, off = wgid / NXCD; wgid = (xcd < r ? xcd * (q + 1) : r * (q + 1) + (xcd - r) * q) + off; }
        const int nig = WGM * nN, gid = wgid / nig, fm = gid * WGM, gsz = (nM - fm) < WGM ? (nM - fm) : WGM;
        u.pm = fm + ((wgid % nig) % gsz); u.pn = (wgid % nig) / gsz; return true;
    }
};
template <class Epi>
__device__ __forceinline__ void gemm_phase(LAS unsigned char* lds, const Gemm g, const StaticOrder& S, const Epi& E) {
    const int tid = opaque_tid(), wid = __builtin_amdgcn_readfirstlane(tid >> 6), lane = tid & 63, wr = wid >> 2, wc = wid & 3, fr = lane & 15, fq = lane >> 4;
    const int K = g.K, nt = K / BK;
    unsigned voffA[2], voffB[2];
#pragma unroll
    for (int i = 0; i < 2; ++i) { int R, C; stage_rc(tid * 16 + i * 8192, R, C); const int Rb = (R & ~31) + perm32(R & 31);
        voffA[i] = (unsigned)(R * g.lda + C) * 2u; voffB[i] = (unsigned)(Rb * g.ldb + C) * 2u; }
    const size_t kstep = (size_t)(BK * 2);
    const size_t hstepA = (size_t)HALF * g.lda * 2, hstepB = (size_t)HALF * g.ldb * 2;
    const size_t tstepA = 2 * hstepA, tstepB = 2 * hstepB;
    const unsigned ldsw = (unsigned)wid * 1024u;
    const int aoff = lds_byte(wr * 64 + fr, fq * 8), boff = lds_byte(wc * 32 + fr, fq * 8);
#define PG8_SA(b, h) (((b) * 2 + (h)) * HTB)
#define PG8_SB(b, h) ((4 + (b) * 2 + (h)) * HTB)
#define PG8_STAGE(bufoff, gbase, voff) do { _Pragma("unroll") for (int _i = 0; _i < 2; ++_i) \
        __builtin_amdgcn_global_load_lds((const unsigned*)((const char*)(gbase) + (voff)[_i]), (LAS unsigned*)(lds + (bufoff) + ldsw + _i * 8192), 16, 0, 0); } while (0)
#define PG8_LDA(dst, b, h) do { _Pragma("unroll") for (int m = 0; m < 4; ++m) _Pragma("unroll") for (int k = 0; k < 2; ++k) dst[m][k] = *(const LAS bf16x8*)(lds + PG8_SA(b, h) + aoff + m * 2048 + k * 1024); } while (0)
#define PG8_LDB(dst, b, h) do { _Pragma("unroll") for (int n = 0; n < 2; ++n) _Pragma("unroll") for (int k = 0; k < 2; ++k) dst[n][k] = *(const LAS bf16x8*)(lds + PG8_SB(b, h) + boff + n * 2048 + k * 1024); } while (0)
#define PG8_MMA(ai, bj, At, Bt) do { __builtin_amdgcn_s_setprio(1); _Pragma("unroll") for (int m = 0; m < 4; ++m) _Pragma("unroll") for (int n = 0; n < 2; ++n) _Pragma("unroll") for (int k = 0; k < 2; ++k) \
        acc[ai][bj][m][n] = __builtin_amdgcn_mfma_f32_16x16x32_bf16(Bt[n][k], At[m][k], acc[ai][bj][m][n], 0, 0, 0); __builtin_amdgcn_s_setprio(0); } while (0)
#define PG8_WAIT_V(n) asm volatile("s_waitcnt vmcnt(" #n ")" ::: "memory")
#define PG8_WAIT_L(n) asm volatile("s_waitcnt lgkmcnt(" #n ")" ::: "memory")
#define PG8_BAR __builtin_amdgcn_s_barrier()
#define PG8_SCHED __builtin_amdgcn_sched_barrier(0)
    Unit cur, nxt; int ui = 0;
    if (!S.next(0, cur)) return;
    f32x4 acc[2][2][4][2];
#pragma unroll
    for (int a = 0; a < 2; ++a)
#pragma unroll
        for (int b = 0; b < 2; ++b)
#pragma unroll
            for (int m = 0; m < 4; ++m)
#pragma unroll
                for (int n = 0; n < 2; ++n) acc[a][b][m][n] = (f32x4){0.f, 0.f, 0.f, 0.f};
    bf16x8 At[4][2], B0[2][2], B1[2][2];
    const char* cA = (const char*)g.A + (size_t)cur.pm * tstepA; const char* cB = (const char*)g.Bt + (size_t)cur.pn * tstepB;
    PG8_STAGE(PG8_SB(0, 0), cB, voffB); PG8_STAGE(PG8_SA(0, 0), cA, voffA); PG8_STAGE(PG8_SB(0, 1), cB + hstepB, voffB); PG8_STAGE(PG8_SA(0, 1), cA + hstepA, voffA);
    if (wr == 1) PG8_BAR;
    PG8_WAIT_V(4); PG8_BAR;
    PG8_STAGE(PG8_SB(1, 0), cB + kstep, voffB); PG8_STAGE(PG8_SA(1, 0), cA + kstep, voffA); PG8_STAGE(PG8_SB(1, 1), cB + hstepB + kstep, voffB);
    PG8_WAIT_V(6); PG8_BAR;
    for (;;) {
        const bool has_next = S.next(ui + 1, nxt);
        const char* nA = has_next ? (const char*)g.A + (size_t)nxt.pm * tstepA : cA; const char* nB = has_next ? (const char*)g.Bt + (size_t)nxt.pn * tstepB : cB;
        for (int t = 0; t < nt; t += 2) {
            const bool last = (t == nt - 2);
            const char* a1 = cA + (size_t)(t + 1) * kstep;
            const char* a2 = last ? nA : cA + (size_t)(t + 2) * kstep; const char* b2 = last ? nB : cB + (size_t)(t + 2) * kstep;
            const char* a3 = a2 + kstep; const char* b3 = b2 + kstep;
            PG8_LDB(B0, 0, 0); PG8_SCHED; PG8_LDA(At, 0, 0); PG8_STAGE(PG8_SA(1, 1), a1 + hstepA, voffA);
            PG8_WAIT_L(8); PG8_BAR; PG8_WAIT_L(0); PG8_MMA(0, 0, At, B0); PG8_BAR; PG8_SCHED;
            PG8_LDB(B1, 0, 1); PG8_STAGE(PG8_SB(0, 0), b2, voffB);
            PG8_BAR; PG8_WAIT_L(0); PG8_MMA(0, 1, At, B1); PG8_BAR;
            PG8_LDA(At, 0, 1); PG8_STAGE(PG8_SA(0, 0), a2, voffA);
            PG8_BAR; PG8_WAIT_L(0); PG8_MMA(1, 0, At, B0); PG8_BAR; PG8_SCHED;
            PG8_STAGE(PG8_SB(0, 1), b2 + hstepB, voffB);
            PG8_WAIT_V(6); PG8_BAR; PG8_MMA(1, 1, At, B1); PG8_BAR;
            PG8_LDB(B0, 1, 0); PG8_SCHED; PG8_LDA(At, 1, 0); PG8_STAGE(PG8_SA(0, 1), a2 + hstepA, voffA);
            PG8_WAIT_L(8); PG8_BAR; PG8_WAIT_L(0); PG8_MMA(0, 0, At, B0); PG8_BAR; PG8_SCHED;
            PG8_LDB(B1, 1, 1); PG8_STAGE(PG8_SB(1, 0), b3, voffB);
            PG8_BAR; PG8_WAIT_L(0); PG8_MMA(0, 1, At, B1); PG8_BAR;
            PG8_LDA(At, 1, 1); PG8_STAGE(PG8_SA(1, 0), a3, voffA);
            PG8_BAR; PG8_WAIT_L(0); PG8_MMA(1, 0, At, B0); PG8_BAR; PG8_SCHED;
            PG8_STAGE(PG8_SB(1, 1), b3 + hstepB, voffB);
            PG8_WAIT_V(6); PG8_BAR; PG8_MMA(1, 1, At, B1); PG8_BAR;
        }
        E(acc, cur, wr, wc, fr, fq);
        if (!has_next) break;
#pragma unroll
        for (int a = 0; a < 2; ++a)
#pragma unroll
            for (int b = 0; b < 2; ++b)
#pragma unroll
                for (int m = 0; m < 4; ++m)
#pragma unroll
                    for (int n = 0; n < 2; ++n) acc[a][b][m][n] = (f32x4){0.f, 0.f, 0.f, 0.f};
        cur = nxt; cA = nA; cB = nB; ++ui;
    }
    PG8_WAIT_V(0);
    if (wr == 0) PG8_BAR;
    PG8_BAR;
#undef PG8_SA
#undef PG8_SB
#undef PG8_STAGE
#undef PG8_LDA
#undef PG8_LDB
#undef PG8_MMA
#undef PG8_WAIT_V
#undef PG8_WAIT_L
#undef PG8_BAR
#undef PG8_SCHED
}
}

struct EpiGen {
    bf16_t* O; int ldc; int act;
    float* gate; int gate_pn;
    __device__ __forceinline__ void operator()(const f32x4 (&acc)[2][2][4][2], const pg8::Unit& u, int wr, int wc, int fr, int fq) const {
        const int row0 = u.pm * 256 + wr * 64 + fr;
        if (u.pn == gate_pn) {
            if (wc == 0 && fq < 2) {
#pragma unroll
                for (int ai = 0; ai < 2; ++ai)
#pragma unroll
                    for (int m = 0; m < 4; ++m) { float* gp = gate + (size_t)(row0 + ai * 128 + m * 16) * 16 + 8 * fq;
                        *(f32x4*)gp = acc[ai][0][m][0]; *(f32x4*)(gp + 4) = acc[ai][0][m][1]; }
            }
            return;
        }
        const int col0 = u.pn * 256 + wc * 32 + 8 * fq;
#pragma unroll
        for (int ai = 0; ai < 2; ++ai)
#pragma unroll
            for (int m = 0; m < 4; ++m) { bf16_t* rowp = O + (size_t)(row0 + ai * 128 + m * 16) * ldc + col0;
#pragma unroll
                for (int bj = 0; bj < 2; ++bj) { f32x4 v0 = acc[ai][bj][m][0], v1 = acc[ai][bj][m][1];
                    if (act == 1) {
#pragma unroll
                        for (int j = 0; j < 4; ++j) { v0[j] = gelu_tanh(v0[j]); v1[j] = gelu_tanh(v1[j]); }
                    } else if (act == 2) {
#pragma unroll
                        for (int j = 0; j < 4; ++j) { const float a = fmaxf(v0[j], 0.f), b = fmaxf(v1[j], 0.f); v0[j] = a * a; v1[j] = b * b; }
                    } else if (act == 3) {
                        const u32x4 pu = *(const u32x4*)(rowp + bj * 128);
                        v0[0] = sigmoidf_(v0[0]) * bflo(pu.x); v0[1] = sigmoidf_(v0[1]) * bfhi(pu.x); v0[2] = sigmoidf_(v0[2]) * bflo(pu.y); v0[3] = sigmoidf_(v0[3]) * bfhi(pu.y);
                        v1[0] = sigmoidf_(v1[0]) * bflo(pu.z); v1[1] = sigmoidf_(v1[1]) * bfhi(pu.z); v1[2] = sigmoidf_(v1[2]) * bflo(pu.w); v1[3] = sigmoidf_(v1[3]) * bfhi(pu.w);
                    }
                    u32x4 w; w.x = pk2(v0[0], v0[1]); w.y = pk2(v0[2], v0[3]); w.z = pk2(v1[0], v1[1]); w.w = pk2(v1[2], v1[3]);
                    *(u32x4*)(rowp + bj * 128) = w; }
                asm volatile("" ::: "memory"); }
    }
};
struct EpiRg {
    const bf16_t* xc; bf16_t* loga; bf16_t* beta; const float* b_a; const float* b_x; const float* spt; int blk;
    __device__ __forceinline__ void operator()(const f32x4 (&acc)[2][2][4][2], const pg8::Unit& u, int wr, int wc, int fr, int fq) const {
        const int row0 = u.pm * 256 + wr * 64 + fr;
        const int ch0 = blk * 256 + u.pn * 128 + wc * 32 + 8 * fq;
#pragma unroll
        for (int ai = 0; ai < 2; ++ai)
#pragma unroll
            for (int m = 0; m < 4; ++m) { const size_t off = (size_t)(row0 + ai * 128 + m * 16) * 1024 + ch0;
                const u32x4 xv = *(const u32x4*)(xc + off);
                u32x4 wl, wb;
#pragma unroll
                for (int hh = 0; hh < 2; ++hh) {
                    const f32x4 ba = *(const f32x4*)(b_a + ch0 + hh * 4), bx = *(const f32x4*)(b_x + ch0 + hh * 4), sp = *(const f32x4*)(spt + ch0 + hh * 4);
                    const unsigned x01 = hh ? xv.z : xv.x, x23 = hh ? xv.w : xv.y;
                    const float x[4] = {bflo(x01), bfhi(x01), bflo(x23), bfhi(x23)};
                    float la[4], be[4];
#pragma unroll
                    for (int e = 0; e < 4; ++e) { const float rp = acc[ai][0][m][hh][e] + ba[e], ip = acc[ai][1][m][hh][e] + bx[e];
                        const float r = sigmoidf_(rp), ig = sigmoidf_(ip); const float l = sp[e] * r; la[e] = l;
                        be[e] = __builtin_amdgcn_sqrtf(fmaxf(1.0f - __expf(2.0f * l), 0.f)) * ig * x[e]; }
                    if (hh == 0) { wl.x = pk2(la[0], la[1]); wl.y = pk2(la[2], la[3]); wb.x = pk2(be[0], be[1]); wb.y = pk2(be[2], be[3]); }
                    else { wl.z = pk2(la[0], la[1]); wl.w = pk2(la[2], la[3]); wb.z = pk2(be[0], be[1]); wb.w = pk2(be[2], be[3]); }
                }
                *(u32x4*)(loga + off) = wl; *(u32x4*)(beta + off) = wb;
                asm volatile("" ::: "memory"); }
    }
};

__device__ __forceinline__ void rowpass(const float* hin, const bf16_t* hinb, const bf16_t* y, const float* gadd, float* hout, bf16_t* houtb, const float* gnext, bf16_t* hn, int normnext,
                                        const float* psrc, bf16_t* pdst) {
    const int tid_ = opaque_tid(); const int lane = tid_ & 63, wave = tid_ >> 6;
    const int gw = blockIdx.x * 8 + wave, nw = gridDim.x * 8;
    f32x4 ga[4], gn[4];
#pragma unroll
    for (int q = 0; q < 4; ++q) { ga[q] = y ? *(const f32x4*)(gadd + q * 256 + lane * 4) : (f32x4){0.f, 0.f, 0.f, 0.f}; gn[q] = (hn && normnext) ? *(const f32x4*)(gnext + q * 256 + lane * 4) : (f32x4){1.f, 1.f, 1.f, 1.f}; }
    for (int row0_ = gw; row0_ < MTOK; row0_ += 4 * nw) {
        f32x4 h[4][4]; u32x2 yv[4][4]; f32x4 pv[4];
#pragma unroll
        for (int u = 0; u < 4; ++u) { const int row = row0_ + u * nw; if (row < MTOK) { const size_t base = (size_t)row * DM + lane * 4;
            if (hin) {
#pragma unroll
                for (int q = 0; q < 4; ++q) h[u][q] = *(const f32x4*)(hin + base + q * 256);
            } else {
#pragma unroll
                for (int q = 0; q < 4; ++q) { const u32x2 hv = *(const u32x2*)(hinb + base + q * 256); h[u][q] = (f32x4){bflo(hv.x), bfhi(hv.x), bflo(hv.y), bfhi(hv.y)}; }
            }
            if (y) {
#pragma unroll
                for (int q = 0; q < 4; ++q) yv[u][q] = *(const u32x2*)(y + base + q * 256);
            }
            if (psrc) pv[u] = *(const f32x4*)(psrc + (size_t)row * 256 + lane * 4); } }
#pragma unroll
        for (int u = 0; u < 4; ++u) { const int row = row0_ + u * nw; if (row < MTOK) { const size_t base = (size_t)row * DM + lane * 4;
            if (y) {
                f32x4 yf[4]; float ss = 0.f;
#pragma unroll
                for (int q = 0; q < 4; ++q) { yf[q] = (f32x4){bflo(yv[u][q].x), bfhi(yv[u][q].x), bflo(yv[u][q].y), bfhi(yv[u][q].y)}; ss += yf[q][0] * yf[q][0] + yf[q][1] * yf[q][1] + yf[q][2] * yf[q][2] + yf[q][3] * yf[q][3]; }
                ss = wave_sum(ss);
                const float rs = __builtin_amdgcn_rsqf(ss * (1.0f / DM) + EPS);
#pragma unroll
                for (int q = 0; q < 4; ++q) h[u][q] = h[u][q] + yf[q] * rs * ga[q];
            }
            if (hout) {
#pragma unroll
                for (int q = 0; q < 4; ++q) *(f32x4*)(hout + base + q * 256) = h[u][q];
            }
            if (houtb) {
#pragma unroll
                for (int q = 0; q < 4; ++q) { u32x2 w; w.x = pk2(h[u][q][0], h[u][q][1]); w.y = pk2(h[u][q][2], h[u][q][3]); *(u32x2*)(houtb + base + q * 256) = w; }
            }
            if (hn) {
                float rs2 = 1.0f;
                if (normnext) { float ss = 0.f;
#pragma unroll
                    for (int q = 0; q < 4; ++q) ss += h[u][q][0] * h[u][q][0] + h[u][q][1] * h[u][q][1] + h[u][q][2] * h[u][q][2] + h[u][q][3] * h[u][q][3];
                    ss = wave_sum(ss); rs2 = __builtin_amdgcn_rsqf(ss * (1.0f / DM) + EPS); }
#pragma unroll
                for (int q = 0; q < 4; ++q) { const f32x4 o = h[u][q] * rs2 * gn[q]; u32x2 w; w.x = pk2(o[0], o[1]); w.y = pk2(o[2], o[3]); *(u32x2*)(hn + base + q * 256) = w; }
            }
            if (psrc) { u32x2 w; w.x = pk2(pv[u][0], pv[u][1]); w.y = pk2(pv[u][2], pv[u][3]); *(u32x2*)(pdst + (size_t)row * 256 + lane * 4) = w; } } }
    }
}

struct TJob { const float* src; bf16_t* dst; int lds, ldd, K, nvalid, ntn, t0; };
__device__ __forceinline__ TJob make_tjob(KP P, int j) {
    TJob t; bf16_t* W = (bf16_t*)(P->ws + WS_W); int npad;
    if (j < 16) { const int i = j >> 2, k = j & 3; bf16_t* L = W + (size_t)i * LW;
        if (k == 0) { t.src = P->in[I_WUP] + (size_t)i * 1024 * 4096; t.lds = 4096; t.K = 1024; t.nvalid = 4096; t.dst = L; }
        else if (k == 1) { t.src = P->in[I_WDN] + (size_t)i * 4096 * 1024; t.lds = 1024; t.K = 4096; t.nvalid = 1024; t.dst = L + W_UP; }
        else if (k == 2) { t.src = P->in[I_PG] + (size_t)i * 1024 * 1024; t.lds = 1024; t.K = 1024; t.nvalid = 1024; t.dst = L + W_UP + W_DN; }
        else { t.src = P->in[I_PUP] + (size_t)i * 256 * 1024; t.lds = 1024; t.K = 256; t.nvalid = 1024; t.dst = L + W_UP + W_DN + W_G; }
        npad = t.nvalid; }
    else if (j == 16) { t.src = P->in[I_AIN]; t.lds = 3088; t.K = 1024; t.nvalid = 3088; npad = 3328; t.dst = W + OFF_A_IN; }
    else if (j == 17) { t.src = P->in[I_AOUT]; t.lds = 1024; t.K = 1024; t.nvalid = 1024; npad = 1024; t.dst = W + OFF_A_OUT; }
    else if (j == 18) { t.src = P->in[I_BIN]; t.lds = 4096; t.K = 1024; t.nvalid = 4096; npad = 4096; t.dst = W + OFF_B_IN; }
    else if (j == 19) { t.src = P->in[I_BOUT]; t.lds = 1024; t.K = 1024; t.nvalid = 1024; npad = 1024; t.dst = W + OFF_B_OUT; }
    else if (j == 20) { t.src = P->in[I_CIN]; t.lds = 4096; t.K = 1024; t.nvalid = 4096; npad = 4096; t.dst = W + OFF_C_IN; }
    else if (j == 21) { t.src = P->in[I_COUT]; t.lds = 1024; t.K = 2048; t.nvalid = 1024; npad = 1024; t.dst = W + OFF_C_OUT; }
    else if (j == 22) { t.src = P->in[I_DIN]; t.lds = 2048; t.K = 1024; t.nvalid = 2048; npad = 2048; t.dst = W + OFF_D_IN; }
    else if (j == 23) { t.src = P->in[I_DOUT]; t.lds = 1024; t.K = 1024; t.nvalid = 1024; npad = 1024; t.dst = W + OFF_D_OUT; }
    else { const int q = j - 24, blk = q >> 2, pn = (q >> 1) & 1, which = q & 1;
        t.src = (which ? P->in[I_DWX] : P->in[I_DWA]) + (size_t)blk * 65536 + pn * 128; t.lds = 256; t.K = 256; t.nvalid = 128; npad = 128;
        t.dst = W + OFF_D_G + (size_t)blk * 512 * 256 + (size_t)(pn * 256 + which * 128) * 256; }
    t.ldd = t.K; t.ntn = npad / 64; t.t0 = (t.K / 64) * t.ntn;
    return t;
}
constexpr int NTJOBS = 40;
__device__ __forceinline__ void prep_phase(KP P, LAS unsigned char* lds) {
    const int tid = opaque_tid();
    LAS int* tstart = (LAS int*)(lds + 32768);
    LAS float* tile = (LAS float*)lds;
    if (tid == 0) { int s = 0; for (int j = 0; j < NTJOBS; ++j) { tstart[j] = s; s += make_tjob(P, j).t0; } tstart[NTJOBS] = s; }
    __syncthreads();
    const int total = tstart[NTJOBS];
    for (int gt = blockIdx.x; gt < total; gt += gridDim.x) {
        int j = 0; while (tstart[j + 1] <= gt) ++j;
        const TJob t = make_tjob(P, j);
        const int lt = gt - tstart[j]; const int kt = lt / t.ntn, ntile = lt - kt * t.ntn; const int k0 = kt * 64, n0 = ntile * 64;
        { const int kk = tid >> 4, nn = (tid & 15) * 4;
#pragma unroll
            for (int i = 0; i < 2; ++i) { const int k = kk + 32 * i; f32x4 v = (f32x4){0.f, 0.f, 0.f, 0.f};
                if (n0 + nn < t.nvalid) v = *(const f32x4*)(t.src + (size_t)(k0 + k) * t.lds + n0 + nn);
                tile[k * 65 + nn] = v[0]; tile[k * 65 + nn + 1] = v[1]; tile[k * 65 + nn + 2] = v[2]; tile[k * 65 + nn + 3] = v[3]; } }
        __syncthreads();
        { const int n = tid >> 3, k8 = (tid & 7) * 8; float v[8];
#pragma unroll
            for (int e = 0; e < 8; ++e) v[e] = tile[(k8 + e) * 65 + n];
            u32x4 w; w.x = pk2(v[0], v[1]); w.y = pk2(v[2], v[3]); w.z = pk2(v[4], v[5]); w.w = pk2(v[6], v[7]);
            *(u32x4*)(t.dst + (size_t)(n0 + n) * t.ldd + k0 + k8) = w; }
        __syncthreads();
    }
    { bf16_t* Wsb = (bf16_t*)(P->ws + WS_W) + OFF_C_WS; const float* sw = P->in[I_CSW];
        for (int i = blockIdx.x * NTHREADS + tid; i < 8 * 128 * 128; i += gridDim.x * NTHREADS) { const int s = i & 127, t = (i >> 7) & 127; Wsb[i] = f2bf(s <= t ? sw[i] : 0.f); } }
    if (blockIdx.x == 0) { float* lb = (float*)(P->ws + WS_LB); const float* s = P->in[I_BLB];
        for (int c = tid; c < 1024; c += NTHREADS) { const float a0 = s[c], a1 = s[1024 + c], a2 = s[2048 + c], a3 = s[3072 + c]; const float mx = fmaxf(fmaxf(a0, a1), fmaxf(a2, a3));
            const float e0 = __expf(a0 - mx), e1 = __expf(a1 - mx), e2 = __expf(a2 - mx), e3 = __expf(a3 - mx); lb[c] = e1 * fast_rcp(e0 + e1 + e2 + e3);
            lb[1024 + c] = -8.0f * __logf(1.0f + __expf(-P->in[I_DLAM][c])); } }
    rowpass(P->in[I_X], nullptr, nullptr, nullptr, nullptr, nullptr, P->in[I_NG], (bf16_t*)(P->ws + WS_HN), 1, nullptr, nullptr);
}

__device__ __forceinline__ float incl_scan_sum(float v, int lane) {
#pragma unroll
    for (int d = 1; d < 64; d <<= 1) { const float t = __shfl_up(v, d); if (lane >= d) v += t; }
    return v;
}
__device__ __forceinline__ float incl_scan_max(float v, int lane) {
#pragma unroll
    for (int d = 1; d < 64; d <<= 1) { const float t = __shfl_up(v, d); if (lane >= d) v = fmaxf(v, t); }
    return v;
}
#define LDS_BARRIER() do { asm volatile("s_waitcnt lgkmcnt(0)" ::: "memory"); __builtin_amdgcn_s_barrier(); asm volatile("" ::: "memory"); } while (0)
__device__ __forceinline__ void mlstm_core(KP P, LAS unsigned char* lds) {
    const int tid = opaque_tid(), w = __builtin_amdgcn_readfirstlane(tid >> 6), lane = tid & 63, fr = lane & 15, fq = lane >> 4;
    const bf16_t* z = (const bf16_t*)(P->ws + WS_Z); const float* gate = (const float*)(P->ws + WS_GATE); bf16_t* yout = (bf16_t*)(P->ws + WS_YP);
    constexpr int PQ = 160, PV = 320, PP = 288, PC = 160;
    LAS unsigned char* Qs = lds; LAS unsigned char* Ks = lds + 20480; LAS unsigned char* Vs = lds + 40960; LAS unsigned char* Ps = lds + 81920; LAS unsigned char* Cb = lds + 118784;
    LAS float* fa = (LAS float*)(lds + 141824); LAS float* fM = fa + 128; LAS float* fb = fa + 256; LAS float* fwk = fa + 384;
    for (int unit = blockIdx.x; unit < 256; unit += gridDim.x) {
        const int b = unit >> 3, h = unit & 7;
        const float ib = P->in[I_AIB][h], fbias = P->in[I_AFB][h];
        __syncthreads();
        for (int i = tid; i < 144 * 80 / 2; i += NTHREADS) ((LAS unsigned*)Cb)[i] = 0u;
        if (tid < 128) { LAS unsigned* vp = (LAS unsigned*)(Vs + tid * PV + 256); unsigned zz, one; asm volatile("v_mov_b32 %0, 0" : "=v"(zz)); asm volatile("v_mov_b32 %0, 0x3f80" : "=v"(one)); vp[0] = one;
#pragma unroll
            for (int i = 1; i < 16; ++i) vp[i] = zz; }
        f32x4 st[5];
#pragma unroll
        for (int i = 0; i < 5; ++i) st[i] = (f32x4){0.f, 0.f, 0.f, 0.f};
        float m_state = 0.f;
        u32x4 nq[2], nk[2], nv[4]; float nig = 0.f, nfg = 0.f;
        { const size_t r0 = (size_t)b * SEQL;
#pragma unroll
            for (int i = 0; i < 2; ++i) { const int idx = tid + i * 512, row = idx >> 3, pc = idx & 7;
                nq[i] = *(const u32x4*)(z + (r0 + row) * 3072 + h * 64 + pc * 8); nk[i] = *(const u32x4*)(z + (r0 + row) * 3072 + 512 + h * 64 + pc * 8); }
#pragma unroll
            for (int i = 0; i < 4; ++i) { const int idx = tid + i * 512, row = idx >> 4, pc = idx & 15; nv[i] = *(const u32x4*)(z + (r0 + row) * 3072 + 1024 + h * 128 + pc * 8); }
            if (tid < 128) { nig = gate[(r0 + tid) * 16 + h]; nfg = gate[(r0 + tid) * 16 + 8 + h]; } }
        for (int chunk = 0; chunk < 16; ++chunk) {
            const size_t r0 = (size_t)b * SEQL + chunk * 128;
#pragma unroll
            for (int i = 0; i < 2; ++i) { const int idx = tid + i * 512, row = idx >> 3, pc = idx & 7;
                u32x4 q = nq[i];
                q.x = pk2(bflo(q.x) * 0.125f, bfhi(q.x) * 0.125f); q.y = pk2(bflo(q.y) * 0.125f, bfhi(q.y) * 0.125f); q.z = pk2(bflo(q.z) * 0.125f, bfhi(q.z) * 0.125f); q.w = pk2(bflo(q.w) * 0.125f, bfhi(q.w) * 0.125f);
                *(LAS u32x4*)(Qs + row * PQ + pc * 16) = q;
                *(LAS u32x4*)(Ks + row * PQ + pc * 16) = nk[i]; }
#pragma unroll
            for (int i = 0; i < 4; ++i) { const int idx = tid + i * 512, row = idx >> 4, pc = idx & 15;
                *(LAS u32x4*)(Vs + row * PV + pc * 16) = nv[i]; }
            if (tid < 128) { const float ig = nig, fg = nfg;
                const float xf = fg + fbias; const float lf = fminf(xf, 0.f) - __logf(1.0f + __expf(-fabsf(xf)));
                fa[tid] = ig + ib; fb[tid] = lf; }
            if (chunk + 1 < 16) { const size_t r1 = r0 + 128;
#pragma unroll
                for (int i = 0; i < 2; ++i) { const int idx = tid + i * 512, row = idx >> 3, pc = idx & 7;
                    nq[i] = *(const u32x4*)(z + (r1 + row) * 3072 + h * 64 + pc * 8); nk[i] = *(const u32x4*)(z + (r1 + row) * 3072 + 512 + h * 64 + pc * 8); }
#pragma unroll
                for (int i = 0; i < 4; ++i) { const int idx = tid + i * 512, row = idx >> 4, pc = idx & 15; nv[i] = *(const u32x4*)(z + (r1 + row) * 3072 + 1024 + h * 128 + pc * 8); }
                if (tid < 128) { nig = gate[(r1 + tid) * 16 + h]; nfg = gate[(r1 + tid) * 16 + 8 + h]; } }
            LDS_BARRIER();
            if (w == 0) {
                const float lf0 = fb[lane], lf1 = fb[64 + lane], li0 = fa[lane], li1 = fa[64 + lane];
                const float c0 = incl_scan_sum(lf0, lane); const float tot0 = __shfl(c0, 63); const float c1 = incl_scan_sum(lf1, lane) + tot0;
                const float a0 = li0 - c0, a1 = li1 - c1;
                const float p0 = incl_scan_max(a0, lane); const float pt = __shfl(p0, 63); const float p1 = fmaxf(incl_scan_max(a1, lane), pt);
                const float M0 = fmaxf(m_state, p0), M1 = fmaxf(m_state, p1);
                const float Ml = __shfl(M1, 63);
                fa[lane] = a0; fa[64 + lane] = a1; fM[lane] = M0; fM[64 + lane] = M1; fb[lane] = c0; fb[64 + lane] = c1;
                fwk[lane] = __expf(a0 - Ml); fwk[64 + lane] = __expf(a1 - Ml);
            }
            LDS_BARRIER();
            const float Mlast = fM[127], blast = fb[127];
            const int t = 16 * w + fr;
            const float Mt = fM[t], bt = fb[t];
            const float winter = __expf(m_state - Mt);
            bf16x8 qf[2];
            qf[0] = ldk(Qs + t * PQ + fq * 16); qf[1] = ldk(Qs + t * PQ + 64 + fq * 16);
            for (int n = 0; n <= (w | 1); ++n) {
                f32x4 a = (f32x4){0.f, 0.f, 0.f, 0.f};
                if (n <= w) {
                    const bf16x8 k0 = ldk(Ks + (16 * n + fr) * PQ + fq * 16), k1 = ldk(Ks + (16 * n + fr) * PQ + 64 + fq * 16);
                    a = MFMA16(k0, qf[0], a); a = MFMA16(k1, qf[1], a);
                    const f32x4 as4 = *(const LAS f32x4*)(fa + 16 * n + fq * 4);
#pragma unroll
                    for (int j = 0; j < 4; ++j) { const int s = 16 * n + fq * 4 + j; a[j] = (s <= t) ? a[j] * __expf(as4[j] - Mt) : 0.f; }
                }
                u32x2 pw; pw.x = pk2(a[0], a[1]); pw.y = pk2(a[2], a[3]);
                *(LAS u32x2*)(Ps + t * PP + (16 * n + fq * 4) * 2) = pw;
            }
            asm volatile("s_waitcnt lgkmcnt(0)" ::: "memory");
            f32x4 o[9];
#pragma unroll
            for (int n = 0; n < 9; ++n) { f32x4 c = (f32x4){0.f, 0.f, 0.f, 0.f};
                c = MFMA16(ldk(Cb + (16 * n + fr) * PC + fq * 16), qf[0], c); c = MFMA16(ldk(Cb + (16 * n + fr) * PC + 64 + fq * 16), qf[1], c);
                o[n] = c * winter; }
            for (int ks = 0; ks <= (w >> 1); ++ks) {
                const bf16x8 pf = ldk(Ps + t * PP + ks * 64 + fq * 16);
#pragma unroll
                for (int n = 0; n < 9; ++n) o[n] = MFMA16(ldt(Vs + (ks * 32) * PV + (16 * n) * 2, PV, fr, fq), pf, o[n]);
            }
            {
                float den = __shfl(o[8][0], fr);
                const float dn = fast_rcp(fmaxf(fabsf(den), __expf(-(bt + Mt))));
                float ss = 0.f;
#pragma unroll
                for (int n = 0; n < 8; ++n) { o[n] = o[n] * dn; ss += o[n][0] * o[n][0] + o[n][1] * o[n][1] + o[n][2] * o[n][2] + o[n][3] * o[n][3]; }
                ss += __shfl_xor(ss, 16); ss += __shfl_xor(ss, 32);
                const float rs = __builtin_amdgcn_rsqf(ss * (1.0f / 128.0f) + EPS);
                const float* hg = P->in[I_AHG] + h * 128;
#pragma unroll
                for (int n = 0; n < 8; ++n) { const int v0 = 16 * n + fq * 4;
                    const u32x2 og = *(const u32x2*)(z + (r0 + t) * 3072 + 2048 + h * 128 + v0);
                    const f32x4 g4 = *(const f32x4*)(hg + v0);
                    const float y0 = o[n][0] * rs * g4[0] * sigmoidf_(bflo(og.x)), y1 = o[n][1] * rs * g4[1] * sigmoidf_(bfhi(og.x));
                    const float y2 = o[n][2] * rs * g4[2] * sigmoidf_(bflo(og.y)), y3 = o[n][3] * rs * g4[3] * sigmoidf_(bfhi(og.y));
                    u32x2 yw; yw.x = pk2(y0, y1); yw.y = pk2(y2, y3);
                    *(u32x2*)(yout + (r0 + t) * 1024 + h * 128 + v0) = yw; }
            }
            {
                const float decay = __expf(m_state - Mlast);
#pragma unroll
                for (int i = 0; i < 5; ++i) st[i] = st[i] * decay;
                for (int ks = 0; ks < 4; ++ks) {
                    const f32x4 wa = *(const LAS f32x4*)(fwk + ks * 32 + fq * 8), wb = *(const LAS f32x4*)(fwk + ks * 32 + fq * 8 + 4);
                    const bf16x8 vf = ldt(Vs + (ks * 32) * PV + (16 * w) * 2, PV, fr, fq);
                    bf16x8 kf[4];
#pragma unroll
                    for (int dt = 0; dt < 4; ++dt) { const u32x4 kr = as_u32x4(ldt(Ks + (ks * 32) * PQ + (16 * dt) * 2, PQ, fr, fq)); u32x4 ksc;
                        ksc.x = pk2(bflo(kr.x) * wa[0], bfhi(kr.x) * wa[1]); ksc.y = pk2(bflo(kr.y) * wa[2], bfhi(kr.y) * wa[3]);
                        ksc.z = pk2(bflo(kr.z) * wb[0], bfhi(kr.z) * wb[1]); ksc.w = pk2(bflo(kr.w) * wb[2], bfhi(kr.w) * wb[3]);
                        kf[dt] = as_bf16x8(ksc); st[dt] = MFMA16(kf[dt], vf, st[dt]); }
                    if (w < 4) { const bf16x8 v8 = ldt(Vs + (ks * 32) * PV + 128 * 2, PV, fr, fq);
                        const bf16x8 kw = (w == 0) ? kf[0] : (w == 1) ? kf[1] : (w == 2) ? kf[2] : kf[3];
                        st[4] = MFMA16(kw, v8, st[4]); }
                }
            }
            m_state = blast + Mlast;
            LDS_BARRIER();
#pragma unroll
            for (int dt = 0; dt < 4; ++dt) { u32x2 cw; cw.x = pk2(st[dt][0], st[dt][1]); cw.y = pk2(st[dt][2], st[dt][3]);
                *(LAS u32x2*)(Cb + (16 * w + fr) * PC + (16 * dt + fq * 4) * 2) = cw; }
            if (w < 4) { u32x2 cw; cw.x = pk2(st[4][0], st[4][1]); cw.y = pk2(st[4][2], st[4][3]);
                *(LAS u32x2*)(Cb + (128 + fr) * PC + (16 * w + fq * 4) * 2) = cw; }
        }
    }
    __syncthreads();
}

__device__ __forceinline__ void hgrn_core(KP P, LAS unsigned char* lds) {
    const int tid = opaque_tid(), w = __builtin_amdgcn_readfirstlane(tid >> 6), lane = tid & 63, fr = lane & 15, fq = lane >> 4;
    const bf16_t* z = (const bf16_t*)(P->ws + WS_Z); const float* lbv = (const float*)(P->ws + WS_LB); bf16_t* yout = (bf16_t*)(P->ws + WS_YP);
    constexpr int PT = 288, PA = 96;
    LAS unsigned char* Qt = lds; LAS unsigned char* Qh = lds + 9216; LAS unsigned char* Kh = lds + 18432; LAS unsigned char* Vs = lds + 27648; LAS unsigned char* At = lds + 36864;
    LAS unsigned char* Sb = lds + 40960;
    LAS float* gl = (LAS float*)(lds + 77824);
    LAS float* seg = (LAS float*)(lds + 78336);
    LAS float* ssp = (LAS float*)(lds + 80384);
    const int c = tid & 127, tq = tid >> 7;
    for (int unit = blockIdx.x; unit < 256; unit += gridDim.x) {
        const int b = unit >> 3, h = unit & 7;
        const float lb = lbv[h * 128 + c];
        __syncthreads();
        for (int i = tid; i < 128 * 144 / 2; i += NTHREADS) ((LAS unsigned*)Sb)[i] = 0u;
        f32x4 S[8];
#pragma unroll
        for (int i = 0; i < 8; ++i) S[i] = (f32x4){0.f, 0.f, 0.f, 0.f};
        bf16_t nq[8], nf[8]; u32x4 nv; u32x2 ng2[2];
        { const size_t r0 = (size_t)b * SEQL;
#pragma unroll
            for (int i = 0; i < 8; ++i) { const size_t ro = (r0 + tq * 8 + i) * 4096 + h * 128 + c; nq[i] = z[ro]; nf[i] = z[ro + 1024]; }
            nv = *(const u32x4*)(z + (r0 + (tid >> 4)) * 4096 + 2048 + h * 128 + (tid & 15) * 8);
#pragma unroll
            for (int tt = 0; tt < 2; ++tt) ng2[tt] = *(const u32x2*)(z + (r0 + 16 * tt + fr) * 4096 + 3072 + h * 128 + 16 * w + fq * 4); }
        for (int chunk = 0; chunk < 64; ++chunk) {
            const size_t r0 = (size_t)b * SEQL + chunk * 32;
            float qv[8], kv[8], cs[8];
            const u32x2 cg0 = ng2[0], cg1 = ng2[1];
            { float run = 0.f;
#pragma unroll
                for (int i = 0; i < 8; ++i) {
                    qv[i] = bf2f(nq[i]); const float fz = bf2f(nf[i]);
                    const float f = lb + (1.0f - lb) * sigmoidf_(fz); kv[i] = 1.0f - f; run += __logf(f); cs[i] = run; }
                seg[tq * 128 + c] = run; }
            { const int row = tid >> 4, pc = tid & 15;
                *(LAS u32x4*)(Vs + row * PT + pc * 16) = nv; }
            if (chunk + 1 < 64) { const size_t r1 = r0 + 32;
#pragma unroll
                for (int i = 0; i < 8; ++i) { const size_t ro = (r1 + tq * 8 + i) * 4096 + h * 128 + c; nq[i] = z[ro]; nf[i] = z[ro + 1024]; }
                nv = *(const u32x4*)(z + (r1 + (tid >> 4)) * 4096 + 2048 + h * 128 + (tid & 15) * 8);
#pragma unroll
                for (int tt = 0; tt < 2; ++tt) ng2[tt] = *(const u32x2*)(z + (r1 + 16 * tt + fr) * 4096 + 3072 + h * 128 + 16 * w + fq * 4); }
            LDS_BARRIER();
            { const float s0 = seg[c], s1 = seg[128 + c], s2 = seg[256 + c], s3 = seg[384 + c];
                const float pre = (tq > 0 ? s0 : 0.f) + (tq > 1 ? s1 : 0.f) + (tq > 2 ? s2 : 0.f); const float glast = (s0 + s1) + (s2 + s3);
#pragma unroll
                for (int i = 0; i < 8; ++i) { const float g = pre + cs[i]; const int t = tq * 8 + i;
                    const float eg = __expf(g), er = __expf(g - glast);
                    *(LAS bf16_t*)(Qh + t * PT + c * 2) = f2bf(qv[i] * eg);
                    *(LAS bf16_t*)(Qt + t * PT + c * 2) = f2bf(qv[i] * er);
                    *(LAS bf16_t*)(Kh + t * PT + c * 2) = f2bf(kv[i] * fast_rcp(er)); }
                if (tq == 0) gl[c] = __expf(glast); }
            LDS_BARRIER();
            f32x4 o[2];
#pragma unroll
            for (int tt = 0; tt < 2; ++tt) { f32x4 a = (f32x4){0.f, 0.f, 0.f, 0.f};
#pragma unroll
                for (int ks = 0; ks < 4; ++ks) a = MFMA16(ldk(Sb + (16 * w + fr) * PT + ks * 64 + fq * 16), ldk(Qh + (16 * tt + fr) * PT + ks * 64 + fq * 16), a);
                o[tt] = a; }
            if (w < 4) { const int tt = w >> 1, stl = w & 1; f32x4 a = (f32x4){0.f, 0.f, 0.f, 0.f};
                if (!(tt == 0 && stl == 1)) {
#pragma unroll
                    for (int ks = 0; ks < 4; ++ks) a = MFMA16(ldk(Kh + (16 * stl + fr) * PT + ks * 64 + fq * 16), ldk(Qt + (16 * tt + fr) * PT + ks * 64 + fq * 16), a);
                    const int t = 16 * tt + fr;
#pragma unroll
                    for (int j = 0; j < 4; ++j) { const int s = 16 * stl + fq * 4 + j; if (s > t) a[j] = 0.f; }
                }
                u32x2 aw; aw.x = pk2(a[0], a[1]); aw.y = pk2(a[2], a[3]);
                *(LAS u32x2*)(At + (16 * tt + fr) * PA + (16 * stl + fq * 4) * 2) = aw; }
            LDS_BARRIER();
            { const bf16x8 vf = ldt(Vs + (16 * w) * 2, PT, fr, fq);
#pragma unroll
                for (int tt = 0; tt < 2; ++tt) { o[tt] = MFMA16(vf, ldk(At + (16 * tt + fr) * PA + fq * 16), o[tt]);
                    float ss = o[tt][0] * o[tt][0] + o[tt][1] * o[tt][1] + o[tt][2] * o[tt][2] + o[tt][3] * o[tt][3];
                    ss += __shfl_xor(ss, 16); ss += __shfl_xor(ss, 32);
                    if (fq == 0) ssp[(16 * tt + fr) * 8 + w] = ss; }
                const bf16x8 kf = ldt(Kh + (16 * w) * 2, PT, fr, fq);
                const f32x4 dc = *(const LAS f32x4*)(gl + 16 * w + fq * 4);
#pragma unroll
                for (int vt = 0; vt < 8; ++vt) { S[vt] = S[vt] * dc; S[vt] = MFMA16(kf, ldt(Vs + (16 * vt) * 2, PT, fr, fq), S[vt]); } }
            LDS_BARRIER();
#pragma unroll
            for (int vt = 0; vt < 8; ++vt) { u32x2 sw; sw.x = pk2(S[vt][0], S[vt][1]); sw.y = pk2(S[vt][2], S[vt][3]);
                *(LAS u32x2*)(Sb + (16 * vt + fr) * PT + (16 * w + fq * 4) * 2) = sw; }
            { const float* hg = P->in[I_BHG] + h * 128; const int v0 = 16 * w + fq * 4; const f32x4 g4 = *(const f32x4*)(hg + v0);
#pragma unroll
                for (int tt = 0; tt < 2; ++tt) { const int t = 16 * tt + fr;
                    const f32x4 sa = *(const LAS f32x4*)(ssp + t * 8), sb = *(const LAS f32x4*)(ssp + t * 8 + 4);
                    const float tot = ((sa[0] + sa[1]) + (sa[2] + sa[3])) + ((sb[0] + sb[1]) + (sb[2] + sb[3]));
                    const float rs = __builtin_amdgcn_rsqf(tot * (1.0f / 128.0f) + EPS);
                    const u32x2 gg = tt ? cg1 : cg0;
                    const float g0 = bflo(gg.x), g1 = bfhi(gg.x), g2 = bflo(gg.y), g3 = bfhi(gg.y);
                    const float y0 = o[tt][0] * rs * g4[0] * g0 * sigmoidf_(g0), y1 = o[tt][1] * rs * g4[1] * g1 * sigmoidf_(g1);
                    const float y2 = o[tt][2] * rs * g4[2] * g2 * sigmoidf_(g2), y3 = o[tt][3] * rs * g4[3] * g3 * sigmoidf_(g3);
                    u32x2 yw; yw.x = pk2(y0, y1); yw.y = pk2(y2, y3);
                    *(u32x2*)(yout + (r0 + t) * 1024 + h * 128 + v0) = yw; } }
        }
    }
    __syncthreads();
}

__device__ __forceinline__ void spatial_core(KP P, LAS unsigned char* lds) {
    const int tid = opaque_tid(), w = __builtin_amdgcn_readfirstlane(tid >> 6), lane = tid & 63, fr = lane & 15, fq = lane >> 4;
    bf16_t* z = (bf16_t*)(P->ws + WS_Z); const bf16_t* Wsb = (const bf16_t*)(P->ws + WS_W) + OFF_C_WS;
    constexpr int PVh = 544, PW = 288;
    LAS unsigned char* Vh = lds; LAS unsigned char* Wg = lds + 69632; LAS float* mu = (LAS float*)(lds + 106496); LAS float* rsd = mu + 128;
    for (int unit = blockIdx.x; unit < 512; unit += gridDim.x) {
        const size_t r0 = (size_t)unit * 128;
        __syncthreads();
        for (int rr = 0; rr < 16; ++rr) { const int row = 16 * w + rr; const bf16_t* vp = z + (r0 + row) * 4096 + 2048;
            float x[32]; float s = 0.f;
#pragma unroll
            for (int q = 0; q < 4; ++q) { const u32x4 v = *(const u32x4*)(vp + (q * 64 + lane) * 8);
                x[q * 8 + 0] = bflo(v.x); x[q * 8 + 1] = bfhi(v.x); x[q * 8 + 2] = bflo(v.y); x[q * 8 + 3] = bfhi(v.y); x[q * 8 + 4] = bflo(v.z); x[q * 8 + 5] = bfhi(v.z); x[q * 8 + 6] = bflo(v.w); x[q * 8 + 7] = bfhi(v.w); }
#pragma unroll
            for (int e = 0; e < 32; ++e) s += x[e];
            s = wave_sum(s); const float mean = s * (1.0f / 2048.0f); float qd = 0.f;
#pragma unroll
            for (int e = 0; e < 32; ++e) { const float d = x[e] - mean; qd += d * d; }
            qd = wave_sum(qd);
            if (lane == 0) { mu[row] = mean; rsd[row] = __builtin_amdgcn_rsqf(qd * (1.0f / 2048.0f) + EPS); } }
        __syncthreads();
        for (int g = 0; g < 8; ++g) {
            { const int pc = tid & 31; float gn[8], bi[8];
#pragma unroll
                for (int e = 0; e < 8; ++e) { gn[e] = P->in[I_CLG][g * 256 + pc * 8 + e]; bi[e] = P->in[I_CLB][g * 256 + pc * 8 + e]; }
#pragma unroll
                for (int i = 0; i < 8; ++i) { const int row = (tid >> 5) + i * 16;
                    const u32x4 v = *(const u32x4*)(z + (r0 + row) * 4096 + 2048 + g * 256 + pc * 8); const float m = mu[row], r = rsd[row];
                    u32x4 o; o.x = pk2((bflo(v.x) - m) * r * gn[0] + bi[0], (bfhi(v.x) - m) * r * gn[1] + bi[1]); o.y = pk2((bflo(v.y) - m) * r * gn[2] + bi[2], (bfhi(v.y) - m) * r * gn[3] + bi[3]);
                    o.z = pk2((bflo(v.z) - m) * r * gn[4] + bi[4], (bfhi(v.z) - m) * r * gn[5] + bi[5]); o.w = pk2((bflo(v.w) - m) * r * gn[6] + bi[6], (bfhi(v.w) - m) * r * gn[7] + bi[7]);
                    *(LAS u32x4*)(Vh + row * PVh + pc * 16) = o; }
#pragma unroll
                for (int i = 0; i < 4; ++i) { const int idx = tid + i * 512, row = idx >> 4, p2 = idx & 15;
                    *(LAS u32x4*)(Wg + row * PW + p2 * 16) = *(const u32x4*)(Wsb + (size_t)g * 16384 + row * 128 + p2 * 8); } }
            __syncthreads();
            bf16x8 bf[2][4];
#pragma unroll
            for (int ci = 0; ci < 2; ++ci)
#pragma unroll
                for (int ks = 0; ks < 4; ++ks) bf[ci][ks] = ldt(Vh + (ks * 32) * PVh + (16 * (2 * w + ci)) * 2, PVh, fr, fq);
#pragma unroll
            for (int tt = 0; tt < 8; ++tt) { f32x4 a0 = (f32x4){0.f, 0.f, 0.f, 0.f}, a1 = a0;
#pragma unroll
                for (int ks = 0; ks < 4; ++ks) if (ks <= (tt >> 1)) { const bf16x8 af = ldk(Wg + (16 * tt + fr) * PW + ks * 64 + fq * 16); a0 = MFMA16(bf[0][ks], af, a0); a1 = MFMA16(bf[1][ks], af, a1); }
                const int t = 16 * tt + fr; const float bs = P->in[I_CSB][g * 128 + t];
                bf16_t* up = z + (r0 + t) * 4096 + g * 256 + 32 * w + fq * 4;
                { const u32x2 uu = *(const u32x2*)up; u32x2 yw; yw.x = pk2(bflo(uu.x) * (a0[0] + bs), bfhi(uu.x) * (a0[1] + bs)); yw.y = pk2(bflo(uu.y) * (a0[2] + bs), bfhi(uu.y) * (a0[3] + bs)); *(u32x2*)up = yw; }
                { const u32x2 uu = *(const u32x2*)(up + 16); u32x2 yw; yw.x = pk2(bflo(uu.x) * (a1[0] + bs), bfhi(uu.x) * (a1[1] + bs)); yw.y = pk2(bflo(uu.y) * (a1[2] + bs), bfhi(uu.y) * (a1[3] + bs)); *(u32x2*)(up + 16) = yw; } }
            __syncthreads();
        }
    }
    __syncthreads();
}

__device__ __forceinline__ void conv_pass(KP P) {
    const bf16_t* z = (const bf16_t*)(P->ws + WS_Z); bf16_t* xc = (bf16_t*)(P->ws + WS_YP);
    const int gtid = blockIdx.x * NTHREADS + opaque_tid(), nth = gridDim.x * NTHREADS;
    const int oct = gtid & 127;
    float cw[4][8], cb[8];
#pragma unroll
    for (int e = 0; e < 8; ++e) { cb[e] = P->in[I_DCB][oct * 8 + e];
#pragma unroll
        for (int j = 0; j < 4; ++j) cw[j][e] = P->in[I_DCW][j * 1024 + oct * 8 + e]; }
    for (int idx = gtid; idx < (MTOK / 8) * 128; idx += nth) {
        const int r0 = (idx >> 7) * 8; const bool first = (r0 & (SEQL - 1)) == 0;
        u32x4 xr[11];
#pragma unroll
        for (int i = 0; i < 11; ++i) { xr[i] = (u32x4){0u, 0u, 0u, 0u}; if (i >= 3 || !first) xr[i] = *(const u32x4*)(z + (size_t)(r0 - 3 + i) * 2048 + 1024 + oct * 8); }
#pragma unroll
        for (int o = 0; o < 8; ++o) { float a[8];
#pragma unroll
            for (int e = 0; e < 8; ++e) a[e] = cb[e];
#pragma unroll
            for (int j = 0; j < 4; ++j) { const u32x4 v = xr[o + j];
                a[0] += cw[j][0] * bflo(v.x); a[1] += cw[j][1] * bfhi(v.x); a[2] += cw[j][2] * bflo(v.y); a[3] += cw[j][3] * bfhi(v.y);
                a[4] += cw[j][4] * bflo(v.z); a[5] += cw[j][5] * bfhi(v.z); a[6] += cw[j][6] * bflo(v.w); a[7] += cw[j][7] * bfhi(v.w); }
            u32x4 ow; ow.x = pk2(a[0], a[1]); ow.y = pk2(a[2], a[3]); ow.z = pk2(a[4], a[5]); ow.w = pk2(a[6], a[7]);
            *(u32x4*)(xc + (size_t)(r0 + o) * 1024 + oct * 8) = ow; }
    }
}
__device__ __forceinline__ void scan_pass(KP P, LAS unsigned char* lds) {
    const bf16_t* z = (const bf16_t*)(P->ws + WS_Z); const bf16_t* loga = z + (size_t)MTOK * 2048; const bf16_t* beta = loga + (size_t)MTOK * 1024; bf16_t* y = (bf16_t*)(P->ws + WS_YP);
    LAS float* sA = (LAS float*)lds; LAS float* sB = sA + 512 * 8;
    const int tid = opaque_tid(), seg = tid >> 4, o = tid & 15;
    for (int unit = blockIdx.x; unit < 256; unit += gridDim.x) {
        const int b = unit >> 3; const int ch0 = ((unit & 7) * 16 + o) * 8; const size_t row0 = (size_t)b * SEQL + seg * 64;
        float SL[8], B[8];
#pragma unroll
        for (int e = 0; e < 8; ++e) { SL[e] = 0.f; B[e] = 0.f; }
#pragma unroll 4
        for (int t = 0; t < 64; ++t) { const u32x4 lv = *(const u32x4*)(loga + (row0 + t) * 1024 + ch0), bv = *(const u32x4*)(beta + (row0 + t) * 1024 + ch0);
            const float l[8] = {bflo(lv.x), bfhi(lv.x), bflo(lv.y), bfhi(lv.y), bflo(lv.z), bfhi(lv.z), bflo(lv.w), bfhi(lv.w)};
            const float be[8] = {bflo(bv.x), bfhi(bv.x), bflo(bv.y), bfhi(bv.y), bflo(bv.z), bfhi(bv.z), bflo(bv.w), bfhi(bv.w)};
#pragma unroll
            for (int e = 0; e < 8; ++e) { B[e] = __expf(l[e]) * B[e] + be[e]; SL[e] += l[e]; } }
        __syncthreads();
#pragma unroll
        for (int e = 0; e < 8; ++e) { sA[tid * 8 + e] = __expf(SL[e]); sB[tid * 8 + e] = B[e]; }
        __syncthreads();
        float H[8];
#pragma unroll
        for (int e = 0; e < 8; ++e) H[e] = 0.f;
        for (int s = 0; s < seg; ++s) {
#pragma unroll
            for (int e = 0; e < 8; ++e) H[e] = sA[(s * 16 + o) * 8 + e] * H[e] + sB[(s * 16 + o) * 8 + e]; }
#pragma unroll 4
        for (int t = 0; t < 64; ++t) { const u32x4 lv = *(const u32x4*)(loga + (row0 + t) * 1024 + ch0), bv = *(const u32x4*)(beta + (row0 + t) * 1024 + ch0);
            const u32x4 gv = *(const u32x4*)(z + (row0 + t) * 2048 + ch0);
            const float l[8] = {bflo(lv.x), bfhi(lv.x), bflo(lv.y), bfhi(lv.y), bflo(lv.z), bfhi(lv.z), bflo(lv.w), bfhi(lv.w)};
            const float be[8] = {bflo(bv.x), bfhi(bv.x), bflo(bv.y), bfhi(bv.y), bflo(bv.z), bfhi(bv.z), bflo(bv.w), bfhi(bv.w)};
            const float gg[8] = {bflo(gv.x), bfhi(gv.x), bflo(gv.y), bfhi(gv.y), bflo(gv.z), bfhi(gv.z), bflo(gv.w), bfhi(gv.w)};
            float yv[8];
#pragma unroll
            for (int e = 0; e < 8; ++e) { H[e] = __expf(l[e]) * H[e] + be[e]; yv[e] = H[e] * gelu_tanh(gg[e]); }
            u32x4 ow; ow.x = pk2(yv[0], yv[1]); ow.y = pk2(yv[2], yv[3]); ow.z = pk2(yv[4], yv[5]); ow.w = pk2(yv[6], yv[7]);
            *(u32x4*)(y + (row0 + t) * 1024 + ch0) = ow; }
    }
    __syncthreads();
}

constexpr int NPHASES = 39;
enum { T_PREP, T_GEMM, T_GEMMRG, T_ROW, T_MLSTM, T_HGRN, T_SPATIAL, T_CONV, T_SCAN };
__device__ __forceinline__ void decode(int ph, int& type, int& layer, int& sub) {
    if (ph == 0) { type = T_PREP; layer = 0; sub = 0; return; }
    int base, cbase;
    if (ph < 10) { layer = 0; base = 1; cbase = 4; } else if (ph < 19) { layer = 1; base = 10; cbase = 13; } else if (ph < 28) { layer = 2; base = 19; cbase = 22; } else { layer = 3; base = 28; cbase = 33; }
    if (ph >= cbase) { const int k = ph - cbase;
        if (k == 0) { type = T_ROW; sub = 1; } else if (k == 1) { type = T_GEMM; sub = 2; } else if (k == 2) { type = T_GEMM; sub = 3; } else if (k == 3) { type = T_ROW; sub = 2; } else if (k == 4) { type = T_GEMM; sub = 4; } else { type = T_ROW; sub = 3; }
        return; }
    const int k = ph - base;
    if (layer < 3) { if (k == 0) { type = T_GEMM; sub = 0; } else if (k == 1) { type = layer == 0 ? T_MLSTM : layer == 1 ? T_HGRN : T_SPATIAL; sub = 0; } else { type = T_GEMM; sub = 1; } }
    else { if (k == 0) { type = T_GEMM; sub = 0; } else if (k == 1) { type = T_CONV; sub = 0; } else if (k == 2) { type = T_GEMMRG; sub = 0; } else if (k == 3) { type = T_SCAN; sub = 0; } else { type = T_GEMM; sub = 1; } }
}

__global__ void __launch_bounds__(NTHREADS, 2) fwd_kernel(Params Pk) {
    extern __shared__ __attribute__((aligned(16))) unsigned char smem[];
    LAS unsigned char* lds = (LAS unsigned char*)smem;
    const int ph_lo = Pk.ph_lo, ph_hi = Pk.ph_hi;
    if (ph_lo < 0) cg::this_grid().sync();
    volatile LAS unsigned* bst = (volatile LAS unsigned*)(lds + (LDS_BYTES - 16));
    if (threadIdx.x == 0) { bst[0] = 0u; bst[1] = 0u; }
    __syncthreads();
    const XcdBarrier gbar = xcd_barrier_post((unsigned*)(Pk.ws + WS_BAR), bst);
    for (int ph = ph_lo; ph < ph_hi; ++ph) {
        KP P = (KP)__builtin_amdgcn_kernarg_segment_ptr();
        asm volatile("" : "+s"(P));
        unsigned char* ws = P->ws;
        bf16_t* W = (bf16_t*)(ws + WS_W); bf16_t* HN = (bf16_t*)(ws + WS_HN); bf16_t* Z = (bf16_t*)(ws + WS_Z); bf16_t* YP = (bf16_t*)(ws + WS_YP); bf16_t* PB = (bf16_t*)(ws + WS_PB);
        int type, layer, sub; decode(ph, type, layer, sub);
        if (type == T_PREP) prep_phase(P, lds);
        else if (type == T_GEMM) {
            const int njobs = (sub == 2) ? 2 : 1;
            for (int j = 0; j < njobs; ++j) {
                pg8::Gemm g; EpiGen e; e.gate = nullptr; e.gate_pn = -1; e.act = 0; g.M = MTOK;
                bf16_t* L = W + (size_t)layer * LW;
                if (sub == 0) { g.A = HN; g.lda = 1024; g.K = 1024; g.ldb = 1024; e.O = Z;
                    if (layer == 0) { g.Bt = W + OFF_A_IN; g.N = 3328; e.ldc = 3072; e.gate = (float*)(ws + WS_GATE); e.gate_pn = 12; }
                    else if (layer == 1) { g.Bt = W + OFF_B_IN; g.N = 4096; e.ldc = 4096; }
                    else if (layer == 2) { g.Bt = W + OFF_C_IN; g.N = 4096; e.ldc = 4096; e.act = 1; }
                    else { g.Bt = W + OFF_D_IN; g.N = 2048; e.ldc = 2048; } }
                else if (sub == 1) { g.N = 1024; e.O = HN; e.ldc = 1024;
                    if (layer == 2) { g.A = Z; g.lda = 4096; g.K = 2048; g.ldb = 2048; g.Bt = W + OFF_C_OUT; }
                    else { g.A = YP; g.lda = 1024; g.K = 1024; g.ldb = 1024; g.Bt = W + (layer == 0 ? OFF_A_OUT : layer == 1 ? OFF_B_OUT : OFF_D_OUT); } }
                else if (sub == 2) {
                    if (j == 0) { g.A = HN; g.lda = 1024; g.K = 1024; g.ldb = 1024; g.Bt = L; g.N = 4096; e.O = Z; e.ldc = 4096; e.act = 2; }
                    else { g.A = PB; g.lda = 256; g.K = 256; g.ldb = 256; g.Bt = L + W_UP + W_DN + W_G; g.N = 1024; e.O = YP; e.ldc = 1024; } }
                else if (sub == 3) { g.A = Z; g.lda = 4096; g.K = 4096; g.ldb = 4096; g.Bt = L + W_UP; g.N = 1024; e.O = HN; e.ldc = 1024; }
                else { g.A = HN; g.lda = 1024; g.K = 1024; g.ldb = 1024; g.Bt = L + W_UP + W_DN; g.N = 1024; e.O = YP; e.ldc = 1024; e.act = 3; }
                pg8::StaticOrder S; S.init(g.M, g.N, (int)gridDim.x, (int)blockIdx.x);
                pg8::gemm_phase<EpiGen>(lds, g, S, e);
            }
        }
        else if (type == T_GEMMRG) {
            for (int blk = 0; blk < 4; ++blk) {
                pg8::Gemm g; g.M = MTOK; g.N = 512; g.K = 256; g.A = YP + blk * 256; g.lda = 1024; g.Bt = W + OFF_D_G + (size_t)blk * 512 * 256; g.ldb = 256;
                EpiRg e; e.xc = YP; e.loga = Z + (size_t)MTOK * 2048; e.beta = e.loga + (size_t)MTOK * 1024; e.b_a = P->in[I_DBA]; e.b_x = P->in[I_DBX]; e.spt = (const float*)(ws + WS_LB) + 1024; e.blk = blk;
                pg8::StaticOrder S; S.init(g.M, g.N, (int)gridDim.x, (int)blockIdx.x);
                pg8::gemm_phase<EpiRg>(lds, g, S, e);
            }
        }
        else if (type == T_ROW) {
            const float* ng = P->in[I_NG] + (size_t)layer * 5 * 1024;
            bf16_t* HBuf = (bf16_t*)P->out;
            if (sub == 1) rowpass(layer == 0 ? P->in[I_X] : nullptr, HBuf, HN, ng + 1024, nullptr, HBuf, ng + 2048, HN, 1, P->in[I_P] + (size_t)layer * MTOK * 256, PB);
            else if (sub == 2) rowpass(nullptr, HBuf, HN, ng + 3072, nullptr, nullptr, nullptr, HN, 0, nullptr, nullptr);
            else if (layer < 3) rowpass(nullptr, HN, YP, ng + 4096, nullptr, HBuf, ng + 5120, HN, 1, nullptr, nullptr);
            else rowpass(nullptr, HN, YP, ng + 4096, P->out, nullptr, nullptr, nullptr, 0, nullptr, nullptr);
        }
        else if (type == T_MLSTM) mlstm_core(P, lds);
        else if (type == T_HGRN) hgrn_core(P, lds);
        else if (type == T_SPATIAL) spatial_core(P, lds);
        else if (type == T_CONV) conv_pass(P);
        else if (type == T_SCAN) scan_pass(P, lds);
        if (ph + 1 < ph_hi) xcd_barrier(gbar);
    }
}

extern "C" void kernel_launch(void* const* d_in, const int* in_sizes, int n_in, void* d_out, int out_size, void* d_ws, size_t ws_size, hipStream_t stream) {
    static int grid = 0;
    if (grid == 0) {
        if (n_in != 31 || in_sizes[0] != MTOK * DM || out_size != MTOK * DM || ws_size < WS_END) { fprintf(stderr, "kernel_launch: unexpected shapes (n_in %d, ws %zu)\n", n_in, ws_size); grid = -1; return; }
        int dev = 0, cus = 0, per_cu = 0;
        hipGetDevice(&dev); hipDeviceGetAttribute(&cus, hipDeviceAttributeMultiprocessorCount, dev);
        hipFuncSetAttribute((const void*)fwd_kernel, hipFuncAttributeMaxDynamicSharedMemorySize, LDS_BYTES);
        hipOccupancyMaxActiveBlocksPerMultiprocessor(&per_cu, (const void*)fwd_kernel, NTHREADS, LDS_BYTES);
        if (per_cu < 1) per_cu = 1;
        grid = cus * per_cu;
        (void)hipGetLastError();
    }
    if (grid < 0) return;
    Params p{};
    for (int i = 0; i < 31; ++i) p.in[i] = (const float*)d_in[i];
    p.out = (float*)d_out; p.ws = (unsigned char*)d_ws;
    (void)hipMemsetAsync((unsigned char*)d_ws + WS_BAR, 0, XCD_BAR_WORDS * sizeof(unsigned), stream);
#if ONE_LAUNCH
    p.ph_lo = 0; p.ph_hi = NPHASES;
    void* args[] = {&p};
    hipError_t e = hipLaunchCooperativeKernel((const void*)fwd_kernel, dim3(grid), dim3(NTHREADS), args, LDS_BYTES, stream);
    if (e != hipSuccess) fprintf(stderr, "cooperative launch failed: %s (grid %d)\n", hipGetErrorString(e), grid);
#else
    for (int ph = 0; ph < NPHASES; ++ph) { p.ph_lo = ph; p.ph_hi = ph + 1; hipLaunchKernelGGL(fwd_kernel, dim3(grid), dim3(NTHREADS), LDS_BYTES, stream, p); }
#endif
}
```

```cpp
#include <hip/hip_runtime.h>
#include <hip/hip_cooperative_groups.h>
#include <cstdio>
namespace cg = cooperative_groups;

#ifndef ONE_LAUNCH
#define ONE_LAUNCH 1
#endif

#define LAS __attribute__((address_space(3)))
typedef unsigned short bf16_t;
typedef short bf16x8 __attribute__((ext_vector_type(8)));
typedef short s16x4 __attribute__((ext_vector_type(4)));
typedef float f32x4 __attribute__((ext_vector_type(4)));
typedef float f32x2 __attribute__((ext_vector_type(2)));
typedef unsigned u32x4 __attribute__((ext_vector_type(4)));
typedef unsigned u32x2 __attribute__((ext_vector_type(2)));

constexpr int MTOK = 65536, DM = 1024, SEQL = 2048;
constexpr float EPS = 1e-6f;
constexpr int NTHREADS = 512;
constexpr int LDS_BYTES = 147456;

constexpr size_t W_UP = 4096ull * 1024, W_DN = 1024ull * 4096, W_G = 1024ull * 1024, W_PU = 1024ull * 256;
constexpr size_t LW = W_UP + W_DN + W_G + W_PU;
constexpr size_t OFF_A_IN = 4 * LW;
constexpr size_t OFF_A_OUT = OFF_A_IN + 3328ull * 1024;
constexpr size_t OFF_B_IN = OFF_A_OUT + 1024ull * 1024;
constexpr size_t OFF_B_OUT = OFF_B_IN + 4096ull * 1024;
constexpr size_t OFF_C_IN = OFF_B_OUT + 1024ull * 1024;
constexpr size_t OFF_C_OUT = OFF_C_IN + 4096ull * 1024;
constexpr size_t OFF_C_WS = OFF_C_OUT + 1024ull * 2048;
constexpr size_t OFF_D_IN = OFF_C_WS + 8ull * 128 * 128;
constexpr size_t OFF_D_G = OFF_D_IN + 2048ull * 1024;
constexpr size_t OFF_D_OUT = OFF_D_G + 4ull * 512 * 256;
constexpr size_t W_TOTAL = OFF_D_OUT + 1024ull * 1024;
constexpr size_t MiB = 1024ull * 1024;
static_assert(W_TOTAL * 2 <= 112 * MiB, "weights region");
constexpr size_t WS_W = 0, WS_HN = 112 * MiB, WS_Z = 240 * MiB, WS_YP = 752 * MiB, WS_PB = 880 * MiB, WS_GATE = 912 * MiB, WS_LB = 916 * MiB, WS_BAR = 917 * MiB, WS_END = 918 * MiB;

struct Params {
    const float* in[31];
    float* out;
    unsigned char* ws;
    int ph_lo, ph_hi;
};
typedef const __attribute__((address_space(4))) Params* KP;
enum { I_X = 0, I_P, I_NG, I_WUP, I_WDN, I_PUP, I_PG, I_AIN, I_AIB, I_AFB, I_AHG, I_AOUT, I_BIN, I_BLB, I_BHG, I_BOUT, I_CIN, I_CLG, I_CLB, I_CSW, I_CSB, I_COUT,
       I_DIN, I_DCW, I_DCB, I_DWA, I_DBA, I_DWX, I_DBX, I_DLAM, I_DOUT };

__device__ __forceinline__ float bf2f(bf16_t b) { return __uint_as_float(((unsigned)b) << 16); }
__device__ __forceinline__ float bflo(unsigned u) { return __uint_as_float(u << 16); }
__device__ __forceinline__ float bfhi(unsigned u) { return __uint_as_float(u & 0xffff0000u); }
__device__ __forceinline__ unsigned pk2(float lo, float hi) { unsigned r; asm("v_cvt_pk_bf16_f32 %0, %1, %2" : "=v"(r) : "v"(lo), "v"(hi)); return r; }
__device__ __forceinline__ bf16_t f2bf(float f) { return (bf16_t)(pk2(f, 0.f) & 0xffffu); }
__device__ __forceinline__ float fast_rcp(float x) { return __builtin_amdgcn_rcpf(x); }
__device__ __forceinline__ float sigmoidf_(float x) { return fast_rcp(1.0f + __expf(-x)); }
__device__ __forceinline__ float gelu_tanh(float x) { const float t = 1.5957691216057308f * (x + 0.044715f * x * x * x); return x * fast_rcp(1.0f + __expf(-t)); }
__device__ __forceinline__ float wave_sum(float v) {
#pragma unroll
    for (int o = 32; o >= 1; o >>= 1) v += __shfl_xor(v, o);
    return v;
}
__device__ __forceinline__ bf16x8 as_bf16x8(u32x4 v) { union { u32x4 u; bf16x8 b; } x; x.u = v; return x.b; }
__device__ __forceinline__ u32x4 as_u32x4(bf16x8 v) { union { u32x4 u; bf16x8 b; } x; x.b = v; return x.u; }
__device__ __forceinline__ bf16x8 ldk(const LAS unsigned char* p) { return *(const LAS bf16x8*)p; }
__device__ __forceinline__ bf16x8 ldt(const LAS unsigned char* base, int pitch, int fr, int fq) {
    const LAS unsigned char* p = base + (fq * 8 + (fr >> 2)) * pitch + (fr & 3) * 8;
    s16x4 a = __builtin_amdgcn_ds_read_tr16_b64_v4i16((LAS s16x4*)p);
    s16x4 b = __builtin_amdgcn_ds_read_tr16_b64_v4i16((LAS s16x4*)(p + 4 * pitch));
    bf16x8 r = {a[0], a[1], a[2], a[3], b[0], b[1], b[2], b[3]};
    return r;
}
__device__ __forceinline__ int opaque_tid() { int t = threadIdx.x; asm volatile("" : "+v"(t)); return t; }
#define MFMA16(a, b, c) __builtin_amdgcn_mfma_f32_16x16x32_bf16((a), (b), (c), 0, 0, 0)


#define XB_TMO      128
#define XB_XCNT(j)  (256  + 64 * (j))
#define XB_XSUB(j)  (1280 + 64 * (j))
#define XB_XGEN(j)  (2304 + 64 * (j))
#define XB_TOP      3328
#define XB_TOPGEN   3392
#define XCD_BAR_WORDS 3456
#define XB_SPIN_CAP (1u << 20)
__device__ __forceinline__ unsigned xb_ld(unsigned* p)              { return __hip_atomic_load(p, __ATOMIC_RELAXED, __HIP_MEMORY_SCOPE_AGENT); }
__device__ __forceinline__ unsigned xb_add(unsigned* p, unsigned v) { return __hip_atomic_fetch_add(p, v, __ATOMIC_RELAXED, __HIP_MEMORY_SCOPE_AGENT); }
__device__ __forceinline__ unsigned xb_xcc_id() { return (unsigned)__builtin_amdgcn_s_getreg((3 << 11) | 20) & 0xFu; }
#define XB_SPIN(cond, bar) do { unsigned _sp = 0; while (cond) { __builtin_amdgcn_s_sleep(1); \
    if ((++_sp & 255u) == 0u) { if (xb_ld(&(bar)[XB_TMO])) break; if (_sp > XB_SPIN_CAP) { atomicAdd(&(bar)[XB_TMO], 1u); break; } } } } while (0)
struct XcdBarrier { unsigned* bar; unsigned x; volatile LAS unsigned* st; };
__device__ __forceinline__ XcdBarrier xcd_barrier_post(unsigned* bar, volatile LAS unsigned* st) {
    XcdBarrier b; b.bar = bar; b.x = xb_xcc_id(); b.st = st;
    if (threadIdx.x == 0) (void)xb_add(&bar[XB_XCNT(b.x)], 1u);
    return b;
}
__device__ __forceinline__ void xcd_barrier_complete(unsigned* bar, unsigned x, unsigned& nloc, unsigned& nx) {
    const unsigned G = gridDim.x * gridDim.y * gridDim.z;
    unsigned sum, cnt, mine, sp = 0u;
    for (;;) {
        sum = 0u; cnt = 0u; mine = 0u;
#pragma unroll
        for (unsigned j = 0; j < 16; ++j) { const unsigned c = xb_ld(&bar[XB_XCNT(j)]); sum += c; cnt += (c > 0u) ? 1u : 0u; mine = (j == x) ? c : mine; }
        if (sum == G) break;
        __builtin_amdgcn_s_sleep(1);
        if ((++sp & 255u) == 0u) { if (xb_ld(&bar[XB_TMO])) break; if (sp > XB_SPIN_CAP) { atomicAdd(&bar[XB_TMO], 1u); break; } }
    }
    nloc = mine > 0u ? mine : 1u; nx = cnt > 0u ? cnt : 1u;
}
__device__ __forceinline__ void xcd_barrier(const XcdBarrier& b) {
    asm volatile("s_waitcnt vmcnt(0)" ::: "memory");
    __syncthreads();
    if (threadIdx.x == 0) {
        unsigned* bar = b.bar;
        __builtin_amdgcn_s_waitcnt(0);
        unsigned nloc = b.st[0], nx = b.st[1];
        if (nloc == 0u) { xcd_barrier_complete(bar, b.x, nloc, nx); b.st[0] = nloc; b.st[1] = nx; }
        const unsigned old = xb_add(&bar[XB_XSUB(b.x)], 1u);
        const unsigned gen = old / nloc;
        if (old + 1u == (gen + 1u) * nloc) {
            __builtin_amdgcn_fence(__ATOMIC_RELEASE, "agent");
            asm volatile("s_waitcnt vmcnt(0)" ::: "memory");
            const unsigned og = xb_add(&bar[XB_TOP], 1u);
            const unsigned tg = og / nx;
            if (og + 1u == (tg + 1u) * nx) xb_add(&bar[XB_TOPGEN], 1u);
            else XB_SPIN(xb_ld(&bar[XB_TOPGEN]) == tg, bar);
            __builtin_amdgcn_fence(__ATOMIC_ACQUIRE, "agent");
            xb_add(&bar[XB_XGEN(b.x)], 1u);
            asm volatile("s_waitcnt vmcnt(0)" ::: "memory");
        } else {
            XB_SPIN(xb_ld(&bar[XB_XGEN(b.x)]) == gen, bar);
            __builtin_amdgcn_fence(__ATOMIC_ACQUIRE, "agent");
            asm volatile("s_waitcnt vmcnt(0)" ::: "memory");
        }
    }
    __syncthreads();
}

namespace pg8 {
constexpr int BM = 256, BK = 64, HALF = 128, HTB = HALF * BK * 2, STAGE_BYTES = 8 * HTB, NXCD = 8, WGM = 8;
__device__ __forceinline__ int lds_byte(int r, int c) { const int st = (r >> 4) * 2 + (c >> 5), rr = r & 15, cc = c & 31, ob = rr * 64 + cc * 2; return st * 1024 + (ob ^ (((ob >> 9) & 1) << 5)); }
__device__ __forceinline__ void stage_rc(int b, int& R, int& C) { const int st = b / 1024, sb = b % 1024, swz = sb ^ (((sb >> 9) & 1) << 5); R = (st >> 1) * 16 + swz / 64; C = (st & 1) * 32 + (swz % 64) / 2; }
__device__ __forceinline__ int perm32(int rho) { const int n = rho >> 4, i = rho & 15; return 8 * (i >> 2) + 4 * n + (i & 3); }
struct Unit { int pm, pn; };
struct Gemm { const bf16_t* A; const bf16_t* Bt; int M, N, K, lda, ldb; };
struct StaticOrder {
    int nM, nN, nwg, G, c;
    __device__ void init(int M, int N, int G_, int c_) { nM = M / BM; nN = N / BM; nwg = nM * nN; G = G_; c = c_; }
    __device__ bool next(int i, Unit& u) const {
        const long L = (long)i * G + c; if (L >= nwg) return false;
        int wgid = (int)L; { const int q = nwg / NXCD, r = nwg % NXCD, xcd = wgid % NXCD, off = wgid / NXCD; wgid = (xcd < r ? xcd * (q + 1) : r * (q + 1) + (xcd - r) * q) + off; }
        const int nig = WGM * nN, gid = wgid / nig, fm = gid * WGM, gsz = (nM - fm) < WGM ? (nM - fm) : WGM;
        u.pm = fm + ((wgid % nig) % gsz); u.pn = (wgid % nig) / gsz; return true;
    }
};
template <class Epi>
__device__ __forceinline__ void gemm_phase(LAS unsigned char* lds, const Gemm g, const StaticOrder& S, const Epi& E) {
    const int tid = opaque_tid(), wid = __builtin_amdgcn_readfirstlane(tid >> 6), lane = tid & 63, wr = wid >> 2, wc = wid & 3, fr = lane & 15, fq = lane >> 4;
    const int K = g.K, nt = K / BK;
    unsigned voffA[2], voffB[2];
#pragma unroll
    for (int i = 0; i < 2; ++i) { int R, C; stage_rc(tid * 16 + i * 8192, R, C); const int Rb = (R & ~31) + perm32(R & 31);
        voffA[i] = (unsigned)(R * g.lda + C) * 2u; voffB[i] = (unsigned)(Rb * g.ldb + C) * 2u; }
    const size_t kstep = (size_t)(BK * 2);
    const size_t hstepA = (size_t)HALF * g.lda * 2, hstepB = (size_t)HALF * g.ldb * 2;
    const size_t tstepA = 2 * hstepA, tstepB = 2 * hstepB;
    const unsigned ldsw = (unsigned)wid * 1024u;
    const int aoff = lds_byte(wr * 64 + fr, fq * 8), boff = lds_byte(wc * 32 + fr, fq * 8);
#define PG8_SA(b, h) (((b) * 2 + (h)) * HTB)
#define PG8_SB(b, h) ((4 + (b) * 2 + (h)) * HTB)
#define PG8_STAGE(bufoff, gbase, voff) do { _Pragma("unroll") for (int _i = 0; _i < 2; ++_i) \
        __builtin_amdgcn_global_load_lds((const unsigned*)((const char*)(gbase) + (voff)[_i]), (LAS unsigned*)(lds + (bufoff) + ldsw + _i * 8192), 16, 0, 0); } while (0)
#define PG8_LDA(dst, b, h) do { _Pragma("unroll") for (int m = 0; m < 4; ++m) _Pragma("unroll") for (int k = 0; k < 2; ++k) dst[m][k] = *(const LAS bf16x8*)(lds + PG8_SA(b, h) + aoff + m * 2048 + k * 1024); } while (0)
#define PG8_LDB(dst, b, h) do { _Pragma("unroll") for (int n = 0; n < 2; ++n) _Pragma("unroll") for (int k = 0; k < 2; ++k) dst[n][k] = *(const LAS bf16x8*)(lds + PG8_SB(b, h) + boff + n * 2048 + k * 1024); } while (0)
#define PG8_MMA(ai, bj, At, Bt) do { __builtin_amdgcn_s_setprio(1); _Pragma("unroll") for (int m = 0; m < 4; ++m) _Pragma("unroll") for (int n = 0; n < 2; ++n) _Pragma("unroll") for (int k = 0; k < 2; ++k) \
        acc[ai][bj][m][n] = __builtin_amdgcn_mfma_f32_16x16x32_bf16(Bt[n][k], At[m][k], acc[ai][bj][m][n], 0, 0, 0); __builtin_amdgcn_s_setprio(0); } while (0)
#define PG8_WAIT_V(n) asm volatile("s_waitcnt vmcnt(" #n ")" ::: "memory")
#define PG8_WAIT_L(n) asm volatile("s_waitcnt lgkmcnt(" #n ")" ::: "memory")
#define PG8_BAR __builtin_amdgcn_s_barrier()
#define PG8_SCHED __builtin_amdgcn_sched_barrier(0)
    Unit cur, nxt; int ui = 0;
    if (!S.next(0, cur)) return;
    f32x4 acc[2][2][4][2];
#pragma unroll
    for (int a = 0; a < 2; ++a)
#pragma unroll
        for (int b = 0; b < 2; ++b)
#pragma unroll
            for (int m = 0; m < 4; ++m)
#pragma unroll
                for (int n = 0; n < 2; ++n) acc[a][b][m][n] = (f32x4){0.f, 0.f, 0.f, 0.f};
    bf16x8 At[4][2], B0[2][2], B1[2][2];
    const char* cA = (const char*)g.A + (size_t)cur.pm * tstepA; const char* cB = (const char*)g.Bt + (size_t)cur.pn * tstepB;
    PG8_STAGE(PG8_SB(0, 0), cB, voffB); PG8_STAGE(PG8_SA(0, 0), cA, voffA); PG8_STAGE(PG8_SB(0, 1), cB + hstepB, voffB); PG8_STAGE(PG8_SA(0, 1), cA + hstepA, voffA);
    if (wr == 1) PG8_BAR;
    PG8_WAIT_V(4); PG8_BAR;
    PG8_STAGE(PG8_SB(1, 0), cB + kstep, voffB); PG8_STAGE(PG8_SA(1, 0), cA + kstep, voffA); PG8_STAGE(PG8_SB(1, 1), cB + hstepB + kstep, voffB);
    PG8_WAIT_V(6); PG8_BAR;
    for (;;) {
        const bool has_next = S.next(ui + 1, nxt);
        const char* nA = has_next ? (const char*)g.A + (size_t)nxt.pm * tstepA : cA; const char* nB = has_next ? (const char*)g.Bt + (size_t)nxt.pn * tstepB : cB;
        for (int t = 0; t < nt; t += 2) {
            const bool last = (t == nt - 2);
            const char* a1 = cA + (size_t)(t + 1) * kstep;
            const char* a2 = last ? nA : cA + (size_t)(t + 2) * kstep; const char* b2 = last ? nB : cB + (size_t)(t + 2) * kstep;
            const char* a3 = a2 + kstep; const char* b3 = b2 + kstep;
            PG8_LDB(B0, 0, 0); PG8_SCHED; PG8_LDA(At, 0, 0); PG8_STAGE(PG8_SA(1, 1), a1 + hstepA, voffA);
            PG8_WAIT_L(8); PG8_BAR; PG8_WAIT_L(0); PG8_MMA(0, 0, At, B0); PG8_BAR; PG8_SCHED;
            PG8_LDB(B1, 0, 1); PG8_STAGE(PG8_SB(0, 0), b2, voffB);
            PG8_BAR; PG8_WAIT_L(0); PG8_MMA(0, 1, At, B1); PG8_BAR;
            PG8_LDA(At, 0, 1); PG8_STAGE(PG8_SA(0, 0), a2, voffA);
            PG8_BAR; PG8_WAIT_L(0); PG8_MMA(1, 0, At, B0); PG8_BAR; PG8_SCHED;
            PG8_STAGE(PG8_SB(0, 1), b2 + hstepB, voffB);
            PG8_WAIT_V(6); PG8_BAR; PG8_MMA(1, 1, At, B1); PG8_BAR;
            PG8_LDB(B0, 1, 0); PG8_SCHED; PG8_LDA(At, 1, 0); PG8_STAGE(PG8_SA(0, 1), a2 + hstepA, voffA);
            PG8_WAIT_L(8); PG8_BAR; PG8_WAIT_L(0); PG8_MMA(0, 0, At, B0); PG8_BAR; PG8_SCHED;
            PG8_LDB(B1, 1, 1); PG8_STAGE(PG8_SB(1, 0), b3, voffB);
            PG8_BAR; PG8_WAIT_L(0); PG8_MMA(0, 1, At, B1); PG8_BAR;
            PG8_LDA(At, 1, 1); PG8_STAGE(PG8_SA(1, 0), a3, voffA);
            PG8_BAR; PG8_WAIT_L(0); PG8_MMA(1, 0, At, B0); PG8_BAR; PG8_SCHED;
            PG8_STAGE(PG8_SB(1, 1), b3 + hstepB, voffB);
            PG8_WAIT_V(6); PG8_BAR; PG8_MMA(1, 1, At, B1); PG8_BAR;
        }
        E(acc, cur, wr, wc, fr, fq);
        if (!has_next) break;
#pragma unroll
        for (int a = 0; a < 2; ++a)
#pragma unroll
            for (int b = 0; b < 2; ++b)
#pragma unroll
                for (int m = 0; m < 4; ++m)
#pragma unroll
                    for (int n = 0; n < 2; ++n) acc[a][b][m][n] = (f32x4){0.f, 0.f, 0.f, 0.f};
        cur = nxt; cA = nA; cB = nB; ++ui;
    }
    PG8_WAIT_V(0);
    if (wr == 0) PG8_BAR;
    PG8_BAR;
#undef PG8_SA
#undef PG8_SB
#undef PG8_STAGE
#undef PG8_LDA
#undef PG8_LDB
#undef PG8_MMA
#undef PG8_WAIT_V
#undef PG8_WAIT_L
#undef PG8_BAR
#undef PG8_SCHED
}
}

struct EpiGen {
    bf16_t* O; int ldc; int act;
    float* gate; int gate_pn;
    __device__ __forceinline__ void operator()(const f32x4 (&acc)[2][2][4][2], const pg8::Unit& u, int wr, int wc, int fr_, int fq_) const {
        int fr = fr_, fq = fq_; asm volatile("" : "+v"(fr), "+v"(fq));
        const int row0 = u.pm * 256 + wr * 64 + fr;
        if (act == 3) {
            const int col0 = u.pn * 256 + wc * 32 + 8 * fq;
#pragma unroll
            for (int q = 0; q < 4; ++q) { const int ai = q >> 1; u32x4 pv[2][2];
#pragma unroll
                for (int mm = 0; mm < 2; ++mm)
#pragma unroll
                    for (int bj = 0; bj < 2; ++bj) pv[mm][bj] = *(const u32x4*)(O + (size_t)(row0 + ai * 128 + ((q & 1) * 2 + mm) * 16) * ldc + col0 + bj * 128);
#pragma unroll
                for (int mm = 0; mm < 2; ++mm)
#pragma unroll
                    for (int bj = 0; bj < 2; ++bj) { const int m = (q & 1) * 2 + mm; const f32x4 v0 = acc[ai][bj][m][0], v1 = acc[ai][bj][m][1]; const u32x4 pu = pv[mm][bj]; u32x4 w;
                        w.x = pk2(sigmoidf_(v0[0]) * bflo(pu.x), sigmoidf_(v0[1]) * bfhi(pu.x)); w.y = pk2(sigmoidf_(v0[2]) * bflo(pu.y), sigmoidf_(v0[3]) * bfhi(pu.y));
                        w.z = pk2(sigmoidf_(v1[0]) * bflo(pu.z), sigmoidf_(v1[1]) * bfhi(pu.z)); w.w = pk2(sigmoidf_(v1[2]) * bflo(pu.w), sigmoidf_(v1[3]) * bfhi(pu.w));
                        *(u32x4*)(O + (size_t)(row0 + ai * 128 + m * 16) * ldc + col0 + bj * 128) = w; }
                asm volatile("" ::: "memory"); }
            return;
        }
        if (u.pn == gate_pn) {
            if (wc == 0 && fq < 2) {
#pragma unroll
                for (int ai = 0; ai < 2; ++ai)
#pragma unroll
                    for (int m = 0; m < 4; ++m) { float* gp = gate + (size_t)(row0 + ai * 128 + m * 16) * 16 + 8 * fq;
                        *(f32x4*)gp = acc[ai][0][m][0]; *(f32x4*)(gp + 4) = acc[ai][0][m][1]; }
            }
            return;
        }
        const int col0 = u.pn * 256 + wc * 32 + 8 * fq;
#pragma unroll
        for (int ai = 0; ai < 2; ++ai)
#pragma unroll
            for (int m = 0; m < 4; ++m) { bf16_t* rowp = O + (size_t)(row0 + ai * 128 + m * 16) * ldc + col0;
#pragma unroll
                for (int bj = 0; bj < 2; ++bj) { f32x4 v0 = acc[ai][bj][m][0], v1 = acc[ai][bj][m][1];
                    if (act == 1) {
#pragma unroll
                        for (int j = 0; j < 4; ++j) { v0[j] = gelu_tanh(v0[j]); v1[j] = gelu_tanh(v1[j]); }
                    } else if (act == 2) {
#pragma unroll
                        for (int j = 0; j < 4; ++j) { const float a = fmaxf(v0[j], 0.f), b = fmaxf(v1[j], 0.f); v0[j] = a * a; v1[j] = b * b; }
                    } else if (act == 3) {
                        const u32x4 pu = *(const u32x4*)(rowp + bj * 128);
                        v0[0] = sigmoidf_(v0[0]) * bflo(pu.x); v0[1] = sigmoidf_(v0[1]) * bfhi(pu.x); v0[2] = sigmoidf_(v0[2]) * bflo(pu.y); v0[3] = sigmoidf_(v0[3]) * bfhi(pu.y);
                        v1[0] = sigmoidf_(v1[0]) * bflo(pu.z); v1[1] = sigmoidf_(v1[1]) * bfhi(pu.z); v1[2] = sigmoidf_(v1[2]) * bflo(pu.w); v1[3] = sigmoidf_(v1[3]) * bfhi(pu.w);
                    }
                    u32x4 w; w.x = pk2(v0[0], v0[1]); w.y = pk2(v0[2], v0[3]); w.z = pk2(v1[0], v1[1]); w.w = pk2(v1[2], v1[3]);
                    *(u32x4*)(rowp + bj * 128) = w; }
                asm volatile("" ::: "memory"); }
    }
};
struct EpiRg {
    const bf16_t* xc; bf16_t* loga; bf16_t* beta; const float* b_a; const float* b_x; const float* spt; int blk;
    __device__ __forceinline__ void operator()(const f32x4 (&acc)[2][2][4][2], const pg8::Unit& u, int wr, int wc, int fr_, int fq_) const {
        int fr = fr_, fq = fq_; asm volatile("" : "+v"(fr), "+v"(fq));
        const int row0 = u.pm * 256 + wr * 64 + fr;
        const int ch0 = blk * 256 + u.pn * 128 + wc * 32 + 8 * fq;
#pragma unroll
        for (int q = 0; q < 4; ++q) { const int ai = q >> 1; u32x4 xq[2];
#pragma unroll
            for (int mm = 0; mm < 2; ++mm) xq[mm] = *(const u32x4*)(xc + (size_t)(row0 + ai * 128 + ((q & 1) * 2 + mm) * 16) * 1024 + ch0);
            f32x4 ba[2], bx[2], sp[2];
#pragma unroll
            for (int hh = 0; hh < 2; ++hh) { ba[hh] = *(const f32x4*)(b_a + ch0 + hh * 4); bx[hh] = *(const f32x4*)(b_x + ch0 + hh * 4); sp[hh] = *(const f32x4*)(spt + ch0 + hh * 4); }
#pragma unroll
            for (int mm = 0; mm < 2; ++mm) { const int m = (q & 1) * 2 + mm; const size_t off = (size_t)(row0 + ai * 128 + m * 16) * 1024 + ch0; const u32x4 xv = xq[mm];
                u32x4 wl, wb;
#pragma unroll
                for (int hh = 0; hh < 2; ++hh) {
                    const unsigned x01 = hh ? xv.z : xv.x, x23 = hh ? xv.w : xv.y;
                    const float x[4] = {bflo(x01), bfhi(x01), bflo(x23), bfhi(x23)};
                    float la[4], be[4];
#pragma unroll
                    for (int e = 0; e < 4; ++e) { const float rp = acc[ai][0][m][hh][e] + ba[hh][e], ip = acc[ai][1][m][hh][e] + bx[hh][e];
                        const float r = sigmoidf_(rp), ig = sigmoidf_(ip); const float l = sp[hh][e] * r; la[e] = l;
                        be[e] = __builtin_amdgcn_sqrtf(fmaxf(1.0f - __expf(2.0f * l), 0.f)) * ig * x[e]; }
                    if (hh == 0) { wl.x = pk2(la[0], la[1]); wl.y = pk2(la[2], la[3]); wb.x = pk2(be[0], be[1]); wb.y = pk2(be[2], be[3]); }
                    else { wl.z = pk2(la[0], la[1]); wl.w = pk2(la[2], la[3]); wb.z = pk2(be[0], be[1]); wb.w = pk2(be[2], be[3]); }
                }
                *(u32x4*)(loga + off) = wl; *(u32x4*)(beta + off) = wb; }
            asm volatile("" ::: "memory"); }
    }
};

__device__ __forceinline__ void rowpass(const float* hin, const bf16_t* hinb, const bf16_t* y, const float* gadd, float* hout, bf16_t* houtb, const float* gnext, bf16_t* hn, int normnext,
                                        const float* psrc, bf16_t* pdst) {
    const int tid_ = opaque_tid(); const int lane = tid_ & 63, wave = tid_ >> 6;
    const int gw = blockIdx.x * 8 + wave, nw = gridDim.x * 8;
    f32x4 ga[4], gn[4];
#pragma unroll
    for (int q = 0; q < 4; ++q) { ga[q] = y ? *(const f32x4*)(gadd + q * 256 + lane * 4) : (f32x4){0.f, 0.f, 0.f, 0.f}; gn[q] = (hn && normnext) ? *(const f32x4*)(gnext + q * 256 + lane * 4) : (f32x4){1.f, 1.f, 1.f, 1.f}; }
    for (int row0_ = gw; row0_ < MTOK; row0_ += 4 * nw) {
        f32x4 h[4][4]; u32x2 yv[4][4]; f32x4 pv[4];
#pragma unroll
        for (int u = 0; u < 4; ++u) { const int row = row0_ + u * nw; if (row < MTOK) { const size_t base = (size_t)row * DM + lane * 4;
            if (hin) {
#pragma unroll
                for (int q = 0; q < 4; ++q) h[u][q] = *(const f32x4*)(hin + base + q * 256);
            } else {
#pragma unroll
                for (int q = 0; q < 4; ++q) { const u32x2 hv = *(const u32x2*)(hinb + base + q * 256); h[u][q] = (f32x4){bflo(hv.x), bfhi(hv.x), bflo(hv.y), bfhi(hv.y)}; }
            }
            if (y) {
#pragma unroll
                for (int q = 0; q < 4; ++q) yv[u][q] = *(const u32x2*)(y + base + q * 256);
            }
            if (psrc) pv[u] = *(const f32x4*)(psrc + (size_t)row * 256 + lane * 4); } }
#pragma unroll
        for (int u = 0; u < 4; ++u) { const int row = row0_ + u * nw; if (row < MTOK) { const size_t base = (size_t)row * DM + lane * 4;
            if (y) {
                f32x4 yf[4]; float ss = 0.f;
#pragma unroll
                for (int q = 0; q < 4; ++q) { yf[q] = (f32x4){bflo(yv[u][q].x), bfhi(yv[u][q].x), bflo(yv[u][q].y), bfhi(yv[u][q].y)}; ss += yf[q][0] * yf[q][0] + yf[q][1] * yf[q][1] + yf[q][2] * yf[q][2] + yf[q][3] * yf[q][3]; }
                ss = wave_sum(ss);
                const float rs = __builtin_amdgcn_rsqf(ss * (1.0f / DM) + EPS);
#pragma unroll
                for (int q = 0; q < 4; ++q) h[u][q] = h[u][q] + yf[q] * rs * ga[q];
            }
            if (hout) {
#pragma unroll
                for (int q = 0; q < 4; ++q) *(f32x4*)(hout + base + q * 256) = h[u][q];
            }
            if (houtb) {
#pragma unroll
                for (int q = 0; q < 4; ++q) { u32x2 w; w.x = pk2(h[u][q][0], h[u][q][1]); w.y = pk2(h[u][q][2], h[u][q][3]); *(u32x2*)(houtb + base + q * 256) = w; }
            }
            if (hn) {
                float rs2 = 1.0f;
                if (normnext) { float ss = 0.f;
#pragma unroll
                    for (int q = 0; q < 4; ++q) ss += h[u][q][0] * h[u][q][0] + h[u][q][1] * h[u][q][1] + h[u][q][2] * h[u][q][2] + h[u][q][3] * h[u][q][3];
                    ss = wave_sum(ss); rs2 = __builtin_amdgcn_rsqf(ss * (1.0f / DM) + EPS); }
#pragma unroll
                for (int q = 0; q < 4; ++q) { const f32x4 o = h[u][q] * rs2 * gn[q]; u32x2 w; w.x = pk2(o[0], o[1]); w.y = pk2(o[2], o[3]); *(u32x2*)(hn + base + q * 256) = w; }
            }
            if (psrc) { u32x2 w; w.x = pk2(pv[u][0], pv[u][1]); w.y = pk2(pv[u][2], pv[u][3]); *(u32x2*)(pdst + (size_t)row * 256 + lane * 4) = w; } } }
    }
}

struct TJob { const float* src; bf16_t* dst; int lds, ldd, K, nvalid, ntn, t0; };
__device__ __forceinline__ TJob make_tjob(KP P, int j) {
    TJob t; bf16_t* W = (bf16_t*)(P->ws + WS_W); int npad;
    if (j < 16) { const int i = j >> 2, k = j & 3; bf16_t* L = W + (size_t)i * LW;
        if (k == 0) { t.src = P->in[I_WUP] + (size_t)i * 1024 * 4096; t.lds = 4096; t.K = 1024; t.nvalid = 4096; t.dst = L; }
        else if (k == 1) { t.src = P->in[I_WDN] + (size_t)i * 4096 * 1024; t.lds = 1024; t.K = 4096; t.nvalid = 1024; t.dst = L + W_UP; }
        else if (k == 2) { t.src = P->in[I_PG] + (size_t)i * 1024 * 1024; t.lds = 1024; t.K = 1024; t.nvalid = 1024; t.dst = L + W_UP + W_DN; }
        else { t.src = P->in[I_PUP] + (size_t)i * 256 * 1024; t.lds = 1024; t.K = 256; t.nvalid = 1024; t.dst = L + W_UP + W_DN + W_G; }
        npad = t.nvalid; }
    else if (j == 16) { t.src = P->in[I_AIN]; t.lds = 3088; t.K = 1024; t.nvalid = 3088; npad = 3328; t.dst = W + OFF_A_IN; }
    else if (j == 17) { t.src = P->in[I_AOUT]; t.lds = 1024; t.K = 1024; t.nvalid = 1024; npad = 1024; t.dst = W + OFF_A_OUT; }
    else if (j == 18) { t.src = P->in[I_BIN]; t.lds = 4096; t.K = 1024; t.nvalid = 4096; npad = 4096; t.dst = W + OFF_B_IN; }
    else if (j == 19) { t.src = P->in[I_BOUT]; t.lds = 1024; t.K = 1024; t.nvalid = 1024; npad = 1024; t.dst = W + OFF_B_OUT; }
    else if (j == 20) { t.src = P->in[I_CIN]; t.lds = 4096; t.K = 1024; t.nvalid = 4096; npad = 4096; t.dst = W + OFF_C_IN; }
    else if (j == 21) { t.src = P->in[I_COUT]; t.lds = 1024; t.K = 2048; t.nvalid = 1024; npad = 1024; t.dst = W + OFF_C_OUT; }
    else if (j == 22) { t.src = P->in[I_DIN]; t.lds = 2048; t.K = 1024; t.nvalid = 2048; npad = 2048; t.dst = W + OFF_D_IN; }
    else if (j == 23) { t.src = P->in[I_DOUT]; t.lds = 1024; t.K = 1024; t.nvalid = 1024; npad = 1024; t.dst = W + OFF_D_OUT; }
    else { const int q = j - 24, blk = q >> 2, pn = (q >> 1) & 1, which = q & 1;
        t.src = (which ? P->in[I_DWX] : P->in[I_DWA]) + (size_t)blk * 65536 + pn * 128; t.lds = 256; t.K = 256; t.nvalid = 128; npad = 128;
        t.dst = W + OFF_D_G + (size_t)blk * 512 * 256 + (size_t)(pn * 256 + which * 128) * 256; }
    t.ldd = t.K; t.ntn = npad / 64; t.t0 = (t.K / 64) * t.ntn;
    return t;
}
constexpr int NTJOBS = 40;
__device__ __forceinline__ void prep_phase(KP P, LAS unsigned char* lds) {
    const int tid = opaque_tid();
    LAS int* tstart = (LAS int*)(lds + 32768);
    LAS float* tile = (LAS float*)lds;
    if (tid == 0) { int s = 0; for (int j = 0; j < NTJOBS; ++j) { tstart[j] = s; s += make_tjob(P, j).t0; } tstart[NTJOBS] = s; }
    __syncthreads();
    const int total = tstart[NTJOBS];
    for (int gt = blockIdx.x; gt < total; gt += gridDim.x) {
        int j = 0; while (tstart[j + 1] <= gt) ++j;
        const TJob t = make_tjob(P, j);
        const int lt = gt - tstart[j]; const int kt = lt / t.ntn, ntile = lt - kt * t.ntn; const int k0 = kt * 64, n0 = ntile * 64;
        { const int kk = tid >> 4, nn = (tid & 15) * 4;
#pragma unroll
            for (int i = 0; i < 2; ++i) { const int k = kk + 32 * i; f32x4 v = (f32x4){0.f, 0.f, 0.f, 0.f};
                if (n0 + nn < t.nvalid) v = *(const f32x4*)(t.src + (size_t)(k0 + k) * t.lds + n0 + nn);
                tile[k * 65 + nn] = v[0]; tile[k * 65 + nn + 1] = v[1]; tile[k * 65 + nn + 2] = v[2]; tile[k * 65 + nn + 3] = v[3]; } }
        __syncthreads();
        { const int n = tid >> 3, k8 = (tid & 7) * 8; float v[8];
#pragma unroll
            for (int e = 0; e < 8; ++e) v[e] = tile[(k8 + e) * 65 + n];
            u32x4 w; w.x = pk2(v[0], v[1]); w.y = pk2(v[2], v[3]); w.z = pk2(v[4], v[5]); w.w = pk2(v[6], v[7]);
            *(u32x4*)(t.dst + (size_t)(n0 + n) * t.ldd + k0 + k8) = w; }
        __syncthreads();
    }
    { bf16_t* Wsb = (bf16_t*)(P->ws + WS_W) + OFF_C_WS; const float* sw = P->in[I_CSW];
        for (int i = blockIdx.x * NTHREADS + tid; i < 8 * 128 * 128; i += gridDim.x * NTHREADS) { const int s = i & 127, t = (i >> 7) & 127; Wsb[i] = f2bf(s <= t ? sw[i] : 0.f); } }
    if (blockIdx.x == 0) { float* lb = (float*)(P->ws + WS_LB); const float* s = P->in[I_BLB];
        for (int c = tid; c < 1024; c += NTHREADS) { const float a0 = s[c], a1 = s[1024 + c], a2 = s[2048 + c], a3 = s[3072 + c]; const float mx = fmaxf(fmaxf(a0, a1), fmaxf(a2, a3));
            const float e0 = __expf(a0 - mx), e1 = __expf(a1 - mx), e2 = __expf(a2 - mx), e3 = __expf(a3 - mx); lb[c] = e1 * fast_rcp(e0 + e1 + e2 + e3);
            lb[1024 + c] = -8.0f * __logf(1.0f + __expf(-P->in[I_DLAM][c])); } }
    rowpass(P->in[I_X], nullptr, nullptr, nullptr, nullptr, nullptr, P->in[I_NG], (bf16_t*)(P->ws + WS_HN), 1, nullptr, nullptr);
}

__device__ __forceinline__ float incl_scan_sum(float v, int lane) {
#pragma unroll
    for (int d = 1; d < 64; d <<= 1) { const float t = __shfl_up(v, d); if (lane >= d) v += t; }
    return v;
}
__device__ __forceinline__ float incl_scan_max(float v, int lane) {
#pragma unroll
    for (int d = 1; d < 64; d <<= 1) { const float t = __shfl_up(v, d); if (lane >= d) v = fmaxf(v, t); }
    return v;
}
#define LDS_BARRIER() do { asm volatile("s_waitcnt lgkmcnt(0)" ::: "memory"); __builtin_amdgcn_s_barrier(); asm volatile("" ::: "memory"); } while (0)
__device__ __forceinline__ void mlstm_core(KP P, LAS unsigned char* lds) {
    const int tid = opaque_tid(), w = __builtin_amdgcn_readfirstlane(tid >> 6), lane = tid & 63, fr = lane & 15, fq = lane >> 4;
    const bf16_t* z = (const bf16_t*)(P->ws + WS_Z); const float* gate = (const float*)(P->ws + WS_GATE); bf16_t* yout = (bf16_t*)(P->ws + WS_YP);
    constexpr int PQ = 160, PV = 320, PP = 288, PC = 160;
    LAS unsigned char* Qs = lds; LAS unsigned char* Ks = lds + 20480; LAS unsigned char* Vs = lds + 40960; LAS unsigned char* Ps = lds + 81920; LAS unsigned char* Cb = lds + 118784;
    LAS float* fa = (LAS float*)(lds + 141824); LAS float* fM = fa + 128; LAS float* fb = fa + 256; LAS float* fwk = fa + 384;
    for (int unit = blockIdx.x; unit < 256; unit += gridDim.x) {
        const int b = unit >> 3, h = unit & 7;
        const float ib = P->in[I_AIB][h], fbias = P->in[I_AFB][h];
        __syncthreads();
        for (int i = tid; i < 144 * 80 / 2; i += NTHREADS) ((LAS unsigned*)Cb)[i] = 0u;
        if (tid < 128) { LAS unsigned* vp = (LAS unsigned*)(Vs + tid * PV + 256); unsigned zz, one; asm volatile("v_mov_b32 %0, 0" : "=v"(zz)); asm volatile("v_mov_b32 %0, 0x3f80" : "=v"(one)); vp[0] = one;
#pragma unroll
            for (int i = 1; i < 16; ++i) vp[i] = zz; }
        f32x4 st[5];
#pragma unroll
        for (int i = 0; i < 5; ++i) st[i] = (f32x4){0.f, 0.f, 0.f, 0.f};
        float m_state = 0.f;
        u32x4 nq[2], nk[2], nv[4]; float nig = 0.f, nfg = 0.f;
        { const size_t r0 = (size_t)b * SEQL;
#pragma unroll
            for (int i = 0; i < 2; ++i) { const int idx = tid + i * 512, row = idx >> 3, pc = idx & 7;
                nq[i] = *(const u32x4*)(z + (r0 + row) * 3072 + h * 64 + pc * 8); nk[i] = *(const u32x4*)(z + (r0 + row) * 3072 + 512 + h * 64 + pc * 8); }
#pragma unroll
            for (int i = 0; i < 4; ++i) { const int idx = tid + i * 512, row = idx >> 4, pc = idx & 15; nv[i] = *(const u32x4*)(z + (r0 + row) * 3072 + 1024 + h * 128 + pc * 8); }
            if (tid < 128) { nig = gate[(r0 + tid) * 16 + h]; nfg = gate[(r0 + tid) * 16 + 8 + h]; } }
        for (int chunk = 0; chunk < 16; ++chunk) {
            const size_t r0 = (size_t)b * SEQL + chunk * 128;
#pragma unroll
            for (int i = 0; i < 2; ++i) { const int idx = tid + i * 512, row = idx >> 3, pc = idx & 7;
                u32x4 q = nq[i];
                q.x = pk2(bflo(q.x) * 0.125f, bfhi(q.x) * 0.125f); q.y = pk2(bflo(q.y) * 0.125f, bfhi(q.y) * 0.125f); q.z = pk2(bflo(q.z) * 0.125f, bfhi(q.z) * 0.125f); q.w = pk2(bflo(q.w) * 0.125f, bfhi(q.w) * 0.125f);
                *(LAS u32x4*)(Qs + row * PQ + pc * 16) = q;
                *(LAS u32x4*)(Ks + row * PQ + pc * 16) = nk[i]; }
#pragma unroll
            for (int i = 0; i < 4; ++i) { const int idx = tid + i * 512, row = idx >> 4, pc = idx & 15;
                *(LAS u32x4*)(Vs + row * PV + pc * 16) = nv[i]; }
            if (tid < 128) { const float ig = nig, fg = nfg;
                const float xf = fg + fbias; const float lf = fminf(xf, 0.f) - __logf(1.0f + __expf(-fabsf(xf)));
                fa[tid] = ig + ib; fb[tid] = lf; }
            if (chunk + 1 < 16) { const size_t r1 = r0 + 128;
#pragma unroll
                for (int i = 0; i < 2; ++i) { const int idx = tid + i * 512, row = idx >> 3, pc = idx & 7;
                    nq[i] = *(const u32x4*)(z + (r1 + row) * 3072 + h * 64 + pc * 8); nk[i] = *(const u32x4*)(z + (r1 + row) * 3072 + 512 + h * 64 + pc * 8); }
#pragma unroll
                for (int i = 0; i < 4; ++i) { const int idx = tid + i * 512, row = idx >> 4, pc = idx & 15; nv[i] = *(const u32x4*)(z + (r1 + row) * 3072 + 1024 + h * 128 + pc * 8); }
                if (tid < 128) { nig = gate[(r1 + tid) * 16 + h]; nfg = gate[(r1 + tid) * 16 + 8 + h]; } }
            LDS_BARRIER();
            if (w == 0) {
                const float lf0 = fb[lane], lf1 = fb[64 + lane], li0 = fa[lane], li1 = fa[64 + lane];
                const float c0 = incl_scan_sum(lf0, lane); const float tot0 = __shfl(c0, 63); const float c1 = incl_scan_sum(lf1, lane) + tot0;
                const float a0 = li0 - c0, a1 = li1 - c1;
                const float p0 = incl_scan_max(a0, lane); const float pt = __shfl(p0, 63); const float p1 = fmaxf(incl_scan_max(a1, lane), pt);
                const float M0 = fmaxf(m_state, p0), M1 = fmaxf(m_state, p1);
                const float Ml = __shfl(M1, 63);
                fa[lane] = a0; fa[64 + lane] = a1; fM[lane] = M0; fM[64 + lane] = M1; fb[lane] = c0; fb[64 + lane] = c1;
                fwk[lane] = __expf(a0 - Ml); fwk[64 + lane] = __expf(a1 - Ml);
            }
            LDS_BARRIER();
            const float Mlast = fM[127], blast = fb[127];
            const int t = 16 * w + fr;
            const float Mt = fM[t], bt = fb[t];
            const float winter = __expf(m_state - Mt);
            bf16x8 qf[2];
            qf[0] = ldk(Qs + t * PQ + fq * 16); qf[1] = ldk(Qs + t * PQ + 64 + fq * 16);
            for (int n = 0; n <= (w | 1); ++n) {
                f32x4 a = (f32x4){0.f, 0.f, 0.f, 0.f};
                if (n <= w) {
                    const bf16x8 k0 = ldk(Ks + (16 * n + fr) * PQ + fq * 16), k1 = ldk(Ks + (16 * n + fr) * PQ + 64 + fq * 16);
                    a = MFMA16(k0, qf[0], a); a = MFMA16(k1, qf[1], a);
                    const f32x4 as4 = *(const LAS f32x4*)(fa + 16 * n + fq * 4);
#pragma unroll
                    for (int j = 0; j < 4; ++j) { const int s = 16 * n + fq * 4 + j; a[j] = (s <= t) ? a[j] * __expf(as4[j] - Mt) : 0.f; }
                }
                u32x2 pw; pw.x = pk2(a[0], a[1]); pw.y = pk2(a[2], a[3]);
                *(LAS u32x2*)(Ps + t * PP + (16 * n + fq * 4) * 2) = pw;
            }
            asm volatile("s_waitcnt lgkmcnt(0)" ::: "memory");
            f32x4 o[9];
#pragma unroll
            for (int n = 0; n < 9; ++n) { f32x4 c = (f32x4){0.f, 0.f, 0.f, 0.f};
                c = MFMA16(ldk(Cb + (16 * n + fr) * PC + fq * 16), qf[0], c); c = MFMA16(ldk(Cb + (16 * n + fr) * PC + 64 + fq * 16), qf[1], c);
                o[n] = c * winter; }
            for (int ks = 0; ks <= (w >> 1); ++ks) {
                const bf16x8 pf = ldk(Ps + t * PP + ks * 64 + fq * 16);
#pragma unroll
                for (int n = 0; n < 9; ++n) o[n] = MFMA16(ldt(Vs + (ks * 32) * PV + (16 * n) * 2, PV, fr, fq), pf, o[n]);
            }
            {
                float den = __shfl(o[8][0], fr);
                const float dn = fast_rcp(fmaxf(fabsf(den), __expf(-(bt + Mt))));
                float ss = 0.f;
#pragma unroll
                for (int n = 0; n < 8; ++n) { o[n] = o[n] * dn; ss += o[n][0] * o[n][0] + o[n][1] * o[n][1] + o[n][2] * o[n][2] + o[n][3] * o[n][3]; }
                ss += __shfl_xor(ss, 16); ss += __shfl_xor(ss, 32);
                const float rs = __builtin_amdgcn_rsqf(ss * (1.0f / 128.0f) + EPS);
                const float* hg = P->in[I_AHG] + h * 128;
#pragma unroll
                for (int n = 0; n < 8; ++n) { const int v0 = 16 * n + fq * 4;
                    const u32x2 og = *(const u32x2*)(z + (r0 + t) * 3072 + 2048 + h * 128 + v0);
                    const f32x4 g4 = *(const f32x4*)(hg + v0);
                    const float y0 = o[n][0] * rs * g4[0] * sigmoidf_(bflo(og.x)), y1 = o[n][1] * rs * g4[1] * sigmoidf_(bfhi(og.x));
                    const float y2 = o[n][2] * rs * g4[2] * sigmoidf_(bflo(og.y)), y3 = o[n][3] * rs * g4[3] * sigmoidf_(bfhi(og.y));
                    u32x2 yw; yw.x = pk2(y0, y1); yw.y = pk2(y2, y3);
                    *(u32x2*)(yout + (r0 + t) * 1024 + h * 128 + v0) = yw; }
            }
            {
                const float decay = __expf(m_state - Mlast);
#pragma unroll
                for (int i = 0; i < 5; ++i) st[i] = st[i] * decay;
                for (int ks = 0; ks < 4; ++ks) {
                    const f32x4 wa = *(const LAS f32x4*)(fwk + ks * 32 + fq * 8), wb = *(const LAS f32x4*)(fwk + ks * 32 + fq * 8 + 4);
                    const bf16x8 vf = ldt(Vs + (ks * 32) * PV + (16 * w) * 2, PV, fr, fq);
                    bf16x8 kf[4];
#pragma unroll
                    for (int dt = 0; dt < 4; ++dt) { const u32x4 kr = as_u32x4(ldt(Ks + (ks * 32) * PQ + (16 * dt) * 2, PQ, fr, fq)); u32x4 ksc;
                        ksc.x = pk2(bflo(kr.x) * wa[0], bfhi(kr.x) * wa[1]); ksc.y = pk2(bflo(kr.y) * wa[2], bfhi(kr.y) * wa[3]);
                        ksc.z = pk2(bflo(kr.z) * wb[0], bfhi(kr.z) * wb[1]); ksc.w = pk2(bflo(kr.w) * wb[2], bfhi(kr.w) * wb[3]);
                        kf[dt] = as_bf16x8(ksc); st[dt] = MFMA16(kf[dt], vf, st[dt]); }
                    if (w < 4) { const bf16x8 v8 = ldt(Vs + (ks * 32) * PV + 128 * 2, PV, fr, fq);
                        const bf16x8 kw = (w == 0) ? kf[0] : (w == 1) ? kf[1] : (w == 2) ? kf[2] : kf[3];
                        st[4] = MFMA16(kw, v8, st[4]); }
                }
            }
            m_state = blast + Mlast;
            LDS_BARRIER();
#pragma unroll
            for (int dt = 0; dt < 4; ++dt) { u32x2 cw; cw.x = pk2(st[dt][0], st[dt][1]); cw.y = pk2(st[dt][2], st[dt][3]);
                *(LAS u32x2*)(Cb + (16 * w + fr) * PC + (16 * dt + fq * 4) * 2) = cw; }
            if (w < 4) { u32x2 cw; cw.x = pk2(st[4][0], st[4][1]); cw.y = pk2(st[4][2], st[4][3]);
                *(LAS u32x2*)(Cb + (128 + fr) * PC + (16 * w + fq * 4) * 2) = cw; }
        }
    }
    __syncthreads();
}

__device__ __forceinline__ void hgrn_core(KP P, LAS unsigned char* lds) {
    const int tid = opaque_tid(), w = __builtin_amdgcn_readfirstlane(tid >> 6), lane = tid & 63, fr = lane & 15, fq = lane >> 4;
    const bf16_t* z = (const bf16_t*)(P->ws + WS_Z); const float* lbv = (const float*)(P->ws + WS_LB); bf16_t* yout = (bf16_t*)(P->ws + WS_YP);
    constexpr int PT = 288, PA = 96;
    LAS unsigned char* Qt = lds; LAS unsigned char* Qh = lds + 9216; LAS unsigned char* Kh = lds + 18432; LAS unsigned char* Vs = lds + 27648; LAS unsigned char* At = lds + 36864;
    LAS unsigned char* Sb = lds + 40960;
    LAS float* gl = (LAS float*)(lds + 77824);
    LAS float* seg = (LAS float*)(lds + 78336);
    LAS float* ssp = (LAS float*)(lds + 80384);
    const int c = tid & 127, tq = tid >> 7;
    for (int unit = blockIdx.x; unit < 256; unit += gridDim.x) {
        const int b = unit >> 3, h = unit & 7;
        const float lb = lbv[h * 128 + c];
        __syncthreads();
        for (int i = tid; i < 128 * 144 / 2; i += NTHREADS) ((LAS unsigned*)Sb)[i] = 0u;
        f32x4 S[8];
#pragma unroll
        for (int i = 0; i < 8; ++i) S[i] = (f32x4){0.f, 0.f, 0.f, 0.f};
        bf16_t nq[8], nf[8]; u32x4 nv; u32x2 ng2[2];
        { const size_t r0 = (size_t)b * SEQL;
#pragma unroll
            for (int i = 0; i < 8; ++i) { const size_t ro = (r0 + tq * 8 + i) * 4096 + h * 128 + c; nq[i] = z[ro]; nf[i] = z[ro + 1024]; }
            nv = *(const u32x4*)(z + (r0 + (tid >> 4)) * 4096 + 2048 + h * 128 + (tid & 15) * 8);
#pragma unroll
            for (int tt = 0; tt < 2; ++tt) ng2[tt] = *(const u32x2*)(z + (r0 + 16 * tt + fr) * 4096 + 3072 + h * 128 + 16 * w + fq * 4); }
        for (int chunk = 0; chunk < 64; ++chunk) {
            const size_t r0 = (size_t)b * SEQL + chunk * 32;
            float qv[8], kv[8], cs[8];
            const u32x2 cg0 = ng2[0], cg1 = ng2[1];
            { float run = 0.f;
#pragma unroll
                for (int i = 0; i < 8; ++i) {
                    qv[i] = bf2f(nq[i]); const float fz = bf2f(nf[i]);
                    const float f = lb + (1.0f - lb) * sigmoidf_(fz); kv[i] = 1.0f - f; run += __logf(f); cs[i] = run; }
                seg[tq * 128 + c] = run; }
            { const int row = tid >> 4, pc = tid & 15;
                *(LAS u32x4*)(Vs + row * PT + pc * 16) = nv; }
            if (chunk + 1 < 64) { const size_t r1 = r0 + 32;
#pragma unroll
                for (int i = 0; i < 8; ++i) { const size_t ro = (r1 + tq * 8 + i) * 4096 + h * 128 + c; nq[i] = z[ro]; nf[i] = z[ro + 1024]; }
                nv = *(const u32x4*)(z + (r1 + (tid >> 4)) * 4096 + 2048 + h * 128 + (tid & 15) * 8);
#pragma unroll
                for (int tt = 0; tt < 2; ++tt) ng2[tt] = *(const u32x2*)(z + (r1 + 16 * tt + fr) * 4096 + 3072 + h * 128 + 16 * w + fq * 4); }
            LDS_BARRIER();
            { const float s0 = seg[c], s1 = seg[128 + c], s2 = seg[256 + c], s3 = seg[384 + c];
                const float pre = (tq > 0 ? s0 : 0.f) + (tq > 1 ? s1 : 0.f) + (tq > 2 ? s2 : 0.f); const float glast = (s0 + s1) + (s2 + s3);
#pragma unroll
                for (int i = 0; i < 8; ++i) { const float g = pre + cs[i]; const int t = tq * 8 + i;
                    const float eg = __expf(g), er = __expf(g - glast);
                    *(LAS bf16_t*)(Qh + t * PT + c * 2) = f2bf(qv[i] * eg);
                    *(LAS bf16_t*)(Qt + t * PT + c * 2) = f2bf(qv[i] * er);
                    *(LAS bf16_t*)(Kh + t * PT + c * 2) = f2bf(kv[i] * fast_rcp(er)); }
                if (tq == 0) gl[c] = __expf(glast); }
            LDS_BARRIER();
            f32x4 o[2];
#pragma unroll
            for (int tt = 0; tt < 2; ++tt) { f32x4 a = (f32x4){0.f, 0.f, 0.f, 0.f};
#pragma unroll
                for (int ks = 0; ks < 4; ++ks) a = MFMA16(ldk(Sb + (16 * w + fr) * PT + ks * 64 + fq * 16), ldk(Qh + (16 * tt + fr) * PT + ks * 64 + fq * 16), a);
                o[tt] = a; }
            if (w < 4) { const int tt = w >> 1, stl = w & 1; f32x4 a = (f32x4){0.f, 0.f, 0.f, 0.f};
                if (!(tt == 0 && stl == 1)) {
#pragma unroll
                    for (int ks = 0; ks < 4; ++ks) a = MFMA16(ldk(Kh + (16 * stl + fr) * PT + ks * 64 + fq * 16), ldk(Qt + (16 * tt + fr) * PT + ks * 64 + fq * 16), a);
                    const int t = 16 * tt + fr;
#pragma unroll
                    for (int j = 0; j < 4; ++j) { const int s = 16 * stl + fq * 4 + j; if (s > t) a[j] = 0.f; }
                }
                u32x2 aw; aw.x = pk2(a[0], a[1]); aw.y = pk2(a[2], a[3]);
                *(LAS u32x2*)(At + (16 * tt + fr) * PA + (16 * stl + fq * 4) * 2) = aw; }
            LDS_BARRIER();
            { const bf16x8 vf = ldt(Vs + (16 * w) * 2, PT, fr, fq);
#pragma unroll
                for (int tt = 0; tt < 2; ++tt) { o[tt] = MFMA16(vf, ldk(At + (16 * tt + fr) * PA + fq * 16), o[tt]);
                    float ss = o[tt][0] * o[tt][0] + o[tt][1] * o[tt][1] + o[tt][2] * o[tt][2] + o[tt][3] * o[tt][3];
                    ss += __shfl_xor(ss, 16); ss += __shfl_xor(ss, 32);
                    if (fq == 0) ssp[(16 * tt + fr) * 8 + w] = ss; }
                const bf16x8 kf = ldt(Kh + (16 * w) * 2, PT, fr, fq);
                const f32x4 dc = *(const LAS f32x4*)(gl + 16 * w + fq * 4);
#pragma unroll
                for (int vt = 0; vt < 8; ++vt) { S[vt] = S[vt] * dc; S[vt] = MFMA16(kf, ldt(Vs + (16 * vt) * 2, PT, fr, fq), S[vt]); } }
            LDS_BARRIER();
#pragma unroll
            for (int vt = 0; vt < 8; ++vt) { u32x2 sw; sw.x = pk2(S[vt][0], S[vt][1]); sw.y = pk2(S[vt][2], S[vt][3]);
                *(LAS u32x2*)(Sb + (16 * vt + fr) * PT + (16 * w + fq * 4) * 2) = sw; }
            { const float* hg = P->in[I_BHG] + h * 128; const int v0 = 16 * w + fq * 4; const f32x4 g4 = *(const f32x4*)(hg + v0);
#pragma unroll
                for (int tt = 0; tt < 2; ++tt) { const int t = 16 * tt + fr;
                    const f32x4 sa = *(const LAS f32x4*)(ssp + t * 8), sb = *(const LAS f32x4*)(ssp + t * 8 + 4);
                    const float tot = ((sa[0] + sa[1]) + (sa[2] + sa[3])) + ((sb[0] + sb[1]) + (sb[2] + sb[3]));
                    const float rs = __builtin_amdgcn_rsqf(tot * (1.0f / 128.0f) + EPS);
                    const u32x2 gg = tt ? cg1 : cg0;
                    const float g0 = bflo(gg.x), g1 = bfhi(gg.x), g2 = bflo(gg.y), g3 = bfhi(gg.y);
                    const float y0 = o[tt][0] * rs * g4[0] * g0 * sigmoidf_(g0), y1 = o[tt][1] * rs * g4[1] * g1 * sigmoidf_(g1);
                    const float y2 = o[tt][2] * rs * g4[2] * g2 * sigmoidf_(g2), y3 = o[tt][3] * rs * g4[3] * g3 * sigmoidf_(g3);
                    u32x2 yw; yw.x = pk2(y0, y1); yw.y = pk2(y2, y3);
                    *(u32x2*)(yout + (r0 + t) * 1024 + h * 128 + v0) = yw; } }
        }
    }
    __syncthreads();
}

__device__ __forceinline__ void spatial_core(KP P, LAS unsigned char* lds) {
    const int tid = opaque_tid(), w = __builtin_amdgcn_readfirstlane(tid >> 6), lane = tid & 63, fr = lane & 15, fq = lane >> 4;
    bf16_t* z = (bf16_t*)(P->ws + WS_Z); const bf16_t* Wsb = (const bf16_t*)(P->ws + WS_W) + OFF_C_WS;
    constexpr int PVh = 544, PW = 288;
    LAS unsigned char* Vh = lds; LAS unsigned char* Wg = lds + 69632; LAS float* mu = (LAS float*)(lds + 106496); LAS float* rsd = mu + 128;
    for (int unit = blockIdx.x; unit < 512; unit += gridDim.x) {
        const size_t r0 = (size_t)unit * 128;
        __syncthreads();
        for (int rr = 0; rr < 16; ++rr) { const int row = 16 * w + rr; const bf16_t* vp = z + (r0 + row) * 4096 + 2048;
            float x[32]; float s = 0.f;
#pragma unroll
            for (int q = 0; q < 4; ++q) { const u32x4 v = *(const u32x4*)(vp + (q * 64 + lane) * 8);
                x[q * 8 + 0] = bflo(v.x); x[q * 8 + 1] = bfhi(v.x); x[q * 8 + 2] = bflo(v.y); x[q * 8 + 3] = bfhi(v.y); x[q * 8 + 4] = bflo(v.z); x[q * 8 + 5] = bfhi(v.z); x[q * 8 + 6] = bflo(v.w); x[q * 8 + 7] = bfhi(v.w); }
#pragma unroll
            for (int e = 0; e < 32; ++e) s += x[e];
            s = wave_sum(s); const float mean = s * (1.0f / 2048.0f); float qd = 0.f;
#pragma unroll
            for (int e = 0; e < 32; ++e) { const float d = x[e] - mean; qd += d * d; }
            qd = wave_sum(qd);
            if (lane == 0) { mu[row] = mean; rsd[row] = __builtin_amdgcn_rsqf(qd * (1.0f / 2048.0f) + EPS); } }
        __syncthreads();
        for (int g = 0; g < 8; ++g) {
            { const int pc = tid & 31; float gn[8], bi[8];
#pragma unroll
                for (int e = 0; e < 8; ++e) { gn[e] = P->in[I_CLG][g * 256 + pc * 8 + e]; bi[e] = P->in[I_CLB][g * 256 + pc * 8 + e]; }
#pragma unroll
                for (int i = 0; i < 8; ++i) { const int row = (tid >> 5) + i * 16;
                    const u32x4 v = *(const u32x4*)(z + (r0 + row) * 4096 + 2048 + g * 256 + pc * 8); const float m = mu[row], r = rsd[row];
                    u32x4 o; o.x = pk2((bflo(v.x) - m) * r * gn[0] + bi[0], (bfhi(v.x) - m) * r * gn[1] + bi[1]); o.y = pk2((bflo(v.y) - m) * r * gn[2] + bi[2], (bfhi(v.y) - m) * r * gn[3] + bi[3]);
                    o.z = pk2((bflo(v.z) - m) * r * gn[4] + bi[4], (bfhi(v.z) - m) * r * gn[5] + bi[5]); o.w = pk2((bflo(v.w) - m) * r * gn[6] + bi[6], (bfhi(v.w) - m) * r * gn[7] + bi[7]);
                    *(LAS u32x4*)(Vh + row * PVh + pc * 16) = o; }
#pragma unroll
                for (int i = 0; i < 4; ++i) { const int idx = tid + i * 512, row = idx >> 4, p2 = idx & 15;
                    *(LAS u32x4*)(Wg + row * PW + p2 * 16) = *(const u32x4*)(Wsb + (size_t)g * 16384 + row * 128 + p2 * 8); } }
            __syncthreads();
            bf16x8 bf[2][4];
#pragma unroll
            for (int ci = 0; ci < 2; ++ci)
#pragma unroll
                for (int ks = 0; ks < 4; ++ks) bf[ci][ks] = ldt(Vh + (ks * 32) * PVh + (16 * (2 * w + ci)) * 2, PVh, fr, fq);
#pragma unroll
            for (int tt = 0; tt < 8; ++tt) { f32x4 a0 = (f32x4){0.f, 0.f, 0.f, 0.f}, a1 = a0;
#pragma unroll
                for (int ks = 0; ks < 4; ++ks) if (ks <= (tt >> 1)) { const bf16x8 af = ldk(Wg + (16 * tt + fr) * PW + ks * 64 + fq * 16); a0 = MFMA16(bf[0][ks], af, a0); a1 = MFMA16(bf[1][ks], af, a1); }
                const int t = 16 * tt + fr; const float bs = P->in[I_CSB][g * 128 + t];
                bf16_t* up = z + (r0 + t) * 4096 + g * 256 + 32 * w + fq * 4;
                { const u32x2 uu = *(const u32x2*)up; u32x2 yw; yw.x = pk2(bflo(uu.x) * (a0[0] + bs), bfhi(uu.x) * (a0[1] + bs)); yw.y = pk2(bflo(uu.y) * (a0[2] + bs), bfhi(uu.y) * (a0[3] + bs)); *(u32x2*)up = yw; }
                { const u32x2 uu = *(const u32x2*)(up + 16); u32x2 yw; yw.x = pk2(bflo(uu.x) * (a1[0] + bs), bfhi(uu.x) * (a1[1] + bs)); yw.y = pk2(bflo(uu.y) * (a1[2] + bs), bfhi(uu.y) * (a1[3] + bs)); *(u32x2*)(up + 16) = yw; } }
            __syncthreads();
        }
    }
    __syncthreads();
}

__device__ __forceinline__ void conv_pass(KP P) {
    const bf16_t* z = (const bf16_t*)(P->ws + WS_Z); bf16_t* xc = (bf16_t*)(P->ws + WS_YP);
    const int gtid = blockIdx.x * NTHREADS + opaque_tid(), nth = gridDim.x * NTHREADS;
    const int oct = gtid & 127;
    float cw[4][8], cb[8];
#pragma unroll
    for (int e = 0; e < 8; ++e) { cb[e] = P->in[I_DCB][oct * 8 + e];
#pragma unroll
        for (int j = 0; j < 4; ++j) cw[j][e] = P->in[I_DCW][j * 1024 + oct * 8 + e]; }
    for (int idx = gtid; idx < (MTOK / 8) * 128; idx += nth) {
        const int r0 = (idx >> 7) * 8; const bool first = (r0 & (SEQL - 1)) == 0;
        u32x4 xr[11];
#pragma unroll
        for (int i = 0; i < 11; ++i) { xr[i] = (u32x4){0u, 0u, 0u, 0u}; if (i >= 3 || !first) xr[i] = *(const u32x4*)(z + (size_t)(r0 - 3 + i) * 2048 + 1024 + oct * 8); }
#pragma unroll
        for (int o = 0; o < 8; ++o) { float a[8];
#pragma unroll
            for (int e = 0; e < 8; ++e) a[e] = cb[e];
#pragma unroll
            for (int j = 0; j < 4; ++j) { const u32x4 v = xr[o + j];
                a[0] += cw[j][0] * bflo(v.x); a[1] += cw[j][1] * bfhi(v.x); a[2] += cw[j][2] * bflo(v.y); a[3] += cw[j][3] * bfhi(v.y);
                a[4] += cw[j][4] * bflo(v.z); a[5] += cw[j][5] * bfhi(v.z); a[6] += cw[j][6] * bflo(v.w); a[7] += cw[j][7] * bfhi(v.w); }
            u32x4 ow; ow.x = pk2(a[0], a[1]); ow.y = pk2(a[2], a[3]); ow.z = pk2(a[4], a[5]); ow.w = pk2(a[6], a[7]);
            *(u32x4*)(xc + (size_t)(r0 + o) * 1024 + oct * 8) = ow; }
    }
}
__device__ __forceinline__ void scan_pass(KP P, LAS unsigned char* lds) {
    const bf16_t* z = (const bf16_t*)(P->ws + WS_Z); const bf16_t* loga = z + (size_t)MTOK * 2048; const bf16_t* beta = loga + (size_t)MTOK * 1024; bf16_t* y = (bf16_t*)(P->ws + WS_YP);
    LAS float* sA = (LAS float*)lds; LAS float* sB = sA + 512 * 8;
    const int tid = opaque_tid(), seg = tid >> 4, o = tid & 15;
    for (int unit = blockIdx.x; unit < 256; unit += gridDim.x) {
        const int b = unit >> 3; const int ch0 = ((unit & 7) * 16 + o) * 8; const size_t row0 = (size_t)b * SEQL + seg * 64;
        float SL[8], B[8];
#pragma unroll
        for (int e = 0; e < 8; ++e) { SL[e] = 0.f; B[e] = 0.f; }
#pragma unroll 4
        for (int t = 0; t < 64; ++t) { const u32x4 lv = *(const u32x4*)(loga + (row0 + t) * 1024 + ch0), bv = *(const u32x4*)(beta + (row0 + t) * 1024 + ch0);
            const float l[8] = {bflo(lv.x), bfhi(lv.x), bflo(lv.y), bfhi(lv.y), bflo(lv.z), bfhi(lv.z), bflo(lv.w), bfhi(lv.w)};
            const float be[8] = {bflo(bv.x), bfhi(bv.x), bflo(bv.y), bfhi(bv.y), bflo(bv.z), bfhi(bv.z), bflo(bv.w), bfhi(bv.w)};
#pragma unroll
            for (int e = 0; e < 8; ++e) { B[e] = __expf(l[e]) * B[e] + be[e]; SL[e] += l[e]; } }
        __syncthreads();
#pragma unroll
        for (int e = 0; e < 8; ++e) { sA[tid * 8 + e] = __expf(SL[e]); sB[tid * 8 + e] = B[e]; }
        __syncthreads();
        float H[8];
#pragma unroll
        for (int e = 0; e < 8; ++e) H[e] = 0.f;
        for (int s = 0; s < seg; ++s) {
#pragma unroll
            for (int e = 0; e < 8; ++e) H[e] = sA[(s * 16 + o) * 8 + e] * H[e] + sB[(s * 16 + o) * 8 + e]; }
#pragma unroll 4
        for (int t = 0; t < 64; ++t) { const u32x4 lv = *(const u32x4*)(loga + (row0 + t) * 1024 + ch0), bv = *(const u32x4*)(beta + (row0 + t) * 1024 + ch0);
            const u32x4 gv = *(const u32x4*)(z + (row0 + t) * 2048 + ch0);
            const float l[8] = {bflo(lv.x), bfhi(lv.x), bflo(lv.y), bfhi(lv.y), bflo(lv.z), bfhi(lv.z), bflo(lv.w), bfhi(lv.w)};
            const float be[8] = {bflo(bv.x), bfhi(bv.x), bflo(bv.y), bfhi(bv.y), bflo(bv.z), bfhi(bv.z), bflo(bv.w), bfhi(bv.w)};
            const float gg[8] = {bflo(gv.x), bfhi(gv.x), bflo(gv.y), bfhi(gv.y), bflo(gv.z), bfhi(gv.z), bflo(gv.w), bfhi(gv.w)};
            float yv[8];
#pragma unroll
            for (int e = 0; e < 8; ++e) { H[e] = __expf(l[e]) * H[e] + be[e]; yv[e] = H[e] * gelu_tanh(gg[e]); }
            u32x4 ow; ow.x = pk2(yv[0], yv[1]); ow.y = pk2(yv[2], yv[3]); ow.z = pk2(yv[4], yv[5]); ow.w = pk2(yv[6], yv[7]);
            *(u32x4*)(y + (row0 + t) * 1024 + ch0) = ow; }
    }
    __syncthreads();
}

constexpr int NPHASES = 39;
enum { T_PREP, T_GEMM, T_GEMMRG, T_ROW, T_MLSTM, T_HGRN, T_SPATIAL, T_CONV, T_SCAN };
__device__ __forceinline__ void decode(int ph, int& type, int& layer, int& sub) {
    if (ph == 0) { type = T_PREP; layer = 0; sub = 0; return; }
    int base, cbase;
    if (ph < 10) { layer = 0; base = 1; cbase = 4; } else if (ph < 19) { layer = 1; base = 10; cbase = 13; } else if (ph < 28) { layer = 2; base = 19; cbase = 22; } else { layer = 3; base = 28; cbase = 33; }
    if (ph >= cbase) { const int k = ph - cbase;
        if (k == 0) { type = T_ROW; sub = 1; } else if (k == 1) { type = T_GEMM; sub = 2; } else if (k == 2) { type = T_GEMM; sub = 3; } else if (k == 3) { type = T_ROW; sub = 2; } else if (k == 4) { type = T_GEMM; sub = 4; } else { type = T_ROW; sub = 3; }
        return; }
    const int k = ph - base;
    if (layer < 3) { if (k == 0) { type = T_GEMM; sub = 0; } else if (k == 1) { type = layer == 0 ? T_MLSTM : layer == 1 ? T_HGRN : T_SPATIAL; sub = 0; } else { type = T_GEMM; sub = 1; } }
    else { if (k == 0) { type = T_GEMM; sub = 0; } else if (k == 1) { type = T_CONV; sub = 0; } else if (k == 2) { type = T_GEMMRG; sub = 0; } else if (k == 3) { type = T_SCAN; sub = 0; } else { type = T_GEMM; sub = 1; } }
}

__global__ void __launch_bounds__(NTHREADS, 2) fwd_kernel(Params Pk) {
    extern __shared__ __attribute__((aligned(16))) unsigned char smem[];
    LAS unsigned char* lds = (LAS unsigned char*)smem;
    const int ph_lo = Pk.ph_lo, ph_hi = Pk.ph_hi;
    if (ph_lo < 0) cg::this_grid().sync();
    volatile LAS unsigned* bst = (volatile LAS unsigned*)(lds + (LDS_BYTES - 16));
    if (threadIdx.x == 0) { bst[0] = 0u; bst[1] = 0u; }
    __syncthreads();
    const XcdBarrier gbar = xcd_barrier_post((unsigned*)(Pk.ws + WS_BAR), bst);
    for (int ph = ph_lo; ph < ph_hi; ++ph) {
        KP P = (KP)__builtin_amdgcn_kernarg_segment_ptr();
        asm volatile("" : "+s"(P));
        unsigned char* ws = P->ws;
        bf16_t* W = (bf16_t*)(ws + WS_W); bf16_t* HN = (bf16_t*)(ws + WS_HN); bf16_t* Z = (bf16_t*)(ws + WS_Z); bf16_t* YP = (bf16_t*)(ws + WS_YP); bf16_t* PB = (bf16_t*)(ws + WS_PB);
        int type, layer, sub; decode(ph, type, layer, sub);
        if (type == T_PREP) prep_phase(P, lds);
        else if (type == T_GEMM) {
            const int njobs = (sub == 2) ? 2 : 1;
            for (int j = 0; j < njobs; ++j) {
                pg8::Gemm g; EpiGen e; e.gate = nullptr; e.gate_pn = -1; e.act = 0; g.M = MTOK;
                bf16_t* L = W + (size_t)layer * LW;
                if (sub == 0) { g.A = HN; g.lda = 1024; g.K = 1024; g.ldb = 1024; e.O = Z;
                    if (layer == 0) { g.Bt = W + OFF_A_IN; g.N = 3328; e.ldc = 3072; e.gate = (float*)(ws + WS_GATE); e.gate_pn = 12; }
                    else if (layer == 1) { g.Bt = W + OFF_B_IN; g.N = 4096; e.ldc = 4096; }
                    else if (layer == 2) { g.Bt = W + OFF_C_IN; g.N = 4096; e.ldc = 4096; e.act = 1; }
                    else { g.Bt = W + OFF_D_IN; g.N = 2048; e.ldc = 2048; } }
                else if (sub == 1) { g.N = 1024; e.O = HN; e.ldc = 1024;
                    if (layer == 2) { g.A = Z; g.lda = 4096; g.K = 2048; g.ldb = 2048; g.Bt = W + OFF_C_OUT; }
                    else { g.A = YP; g.lda = 1024; g.K = 1024; g.ldb = 1024; g.Bt = W + (layer == 0 ? OFF_A_OUT : layer == 1 ? OFF_B_OUT : OFF_D_OUT); } }
                else if (sub == 2) {
                    if (j == 0) { g.A = HN; g.lda = 1024; g.K = 1024; g.ldb = 1024; g.Bt = L; g.N = 4096; e.O = Z; e.ldc = 4096; e.act = 2; }
                    else { g.A = PB; g.lda = 256; g.K = 256; g.ldb = 256; g.Bt = L + W_UP + W_DN + W_G; g.N = 1024; e.O = YP; e.ldc = 1024; } }
                else if (sub == 3) { g.A = Z; g.lda = 4096; g.K = 4096; g.ldb = 4096; g.Bt = L + W_UP; g.N = 1024; e.O = HN; e.ldc = 1024; }
                else { g.A = HN; g.lda = 1024; g.K = 1024; g.ldb = 1024; g.Bt = L + W_UP + W_DN; g.N = 1024; e.O = YP; e.ldc = 1024; e.act = 3; }
                pg8::StaticOrder S; S.init(g.M, g.N, (int)gridDim.x, (int)blockIdx.x);
                pg8::gemm_phase<EpiGen>(lds, g, S, e);
            }
        }
        else if (type == T_GEMMRG) {
            for (int blk = 0; blk < 4; ++blk) {
                pg8::Gemm g; g.M = MTOK; g.N = 512; g.K = 256; g.A = YP + blk * 256; g.lda = 1024; g.Bt = W + OFF_D_G + (size_t)blk * 512 * 256; g.ldb = 256;
                EpiRg e; e.xc = YP; e.loga = Z + (size_t)MTOK * 2048; e.beta = e.loga + (size_t)MTOK * 1024; e.b_a = P->in[I_DBA]; e.b_x = P->in[I_DBX]; e.spt = (const float*)(ws + WS_LB) + 1024; e.blk = blk;
                pg8::StaticOrder S; S.init(g.M, g.N, (int)gridDim.x, (int)blockIdx.x);
                pg8::gemm_phase<EpiRg>(lds, g, S, e);
            }
        }
        else if (type == T_ROW) {
            const float* ng = P->in[I_NG] + (size_t)layer * 5 * 1024;
            bf16_t* HBuf = (bf16_t*)P->out;
            if (sub == 1) rowpass(layer == 0 ? P->in[I_X] : nullptr, HBuf, HN, ng + 1024, nullptr, HBuf, ng + 2048, HN, 1, P->in[I_P] + (size_t)layer * MTOK * 256, PB);
            else if (sub == 2) rowpass(nullptr, HBuf, HN, ng + 3072, nullptr, nullptr, nullptr, HN, 0, nullptr, nullptr);
            else if (layer < 3) rowpass(nullptr, HN, YP, ng + 4096, nullptr, HBuf, ng + 5120, HN, 1, nullptr, nullptr);
            else rowpass(nullptr, HN, YP, ng + 4096, P->out, nullptr, nullptr, nullptr, 0, nullptr, nullptr);
        }
        else if (type == T_MLSTM) mlstm_core(P, lds);
        else if (type == T_HGRN) hgrn_core(P, lds);
        else if (type == T_SPATIAL) spatial_core(P, lds);
        else if (type == T_CONV) conv_pass(P);
        else if (type == T_SCAN) scan_pass(P, lds);
        if (ph + 1 < ph_hi) xcd_barrier(gbar);
    }
}

extern "C" void kernel_launch(void* const* d_in, const int* in_sizes, int n_in, void* d_out, int out_size, void* d_ws, size_t ws_size, hipStream_t stream) {
    static int grid = 0;
    if (grid == 0) {
        if (n_in != 31 || in_sizes[0] != MTOK * DM || out_size != MTOK * DM || ws_size < WS_END) { fprintf(stderr, "kernel_launch: unexpected shapes (n_in %d, ws %zu)\n", n_in, ws_size); grid = -1; return; }
        int dev = 0, cus = 0, per_cu = 0;
        hipGetDevice(&dev); hipDeviceGetAttribute(&cus, hipDeviceAttributeMultiprocessorCount, dev);
        hipFuncSetAttribute((const void*)fwd_kernel, hipFuncAttributeMaxDynamicSharedMemorySize, LDS_BYTES);
        hipOccupancyMaxActiveBlocksPerMultiprocessor(&per_cu, (const void*)fwd_kernel, NTHREADS, LDS_BYTES);
        if (per_cu < 1) per_cu = 1;
        grid = cus * per_cu;
        (void)hipGetLastError();
    }
    if (grid < 0) return;
    Params p{};
    for (int i = 0; i < 31; ++i) p.in[i] = (const float*)d_in[i];
    p.out = (float*)d_out; p.ws = (unsigned char*)d_ws;
    (void)hipMemsetAsync((unsigned char*)d_ws + WS_BAR, 0, XCD_BAR_WORDS * sizeof(unsigned), stream);
#if ONE_LAUNCH
    p.ph_lo = 0; p.ph_hi = NPHASES;
    void* args[] = {&p};
    hipError_t e = hipLaunchCooperativeKernel((const void*)fwd_kernel, dim3(grid), dim3(NTHREADS), args, LDS_BYTES, stream);
    if (e != hipSuccess) fprintf(stderr, "cooperative launch failed: %s (grid %d)\n", hipGetErrorString(e), grid);
#else
    for (int ph = 0; ph < NPHASES; ++ph) { p.ph_lo = ph; p.ph_hi = ph + 1; hipLaunchKernelGGL(fwd_kernel, dim3(grid), dim3(NTHREADS), LDS_BYTES, stream, p); }
#endif
}
```

```cpp
#include <hip/hip_runtime.h>
#include <hip/hip_cooperative_groups.h>
#include <cstdio>
namespace cg = cooperative_groups;

#ifndef ONE_LAUNCH
#define ONE_LAUNCH 1
#endif

#define LAS __attribute__((address_space(3)))
typedef unsigned short bf16_t;
typedef short bf16x8 __attribute__((ext_vector_type(8)));
typedef short s16x4 __attribute__((ext_vector_type(4)));
typedef float f32x4 __attribute__((ext_vector_type(4)));
typedef float f32x2 __attribute__((ext_vector_type(2)));
typedef unsigned u32x4 __attribute__((ext_vector_type(4)));
typedef unsigned u32x2 __attribute__((ext_vector_type(2)));

constexpr int MTOK = 65536, DM = 1024, SEQL = 2048;
constexpr float EPS = 1e-6f;
constexpr int NTHREADS = 512;
constexpr int LDS_BYTES = 147456;

constexpr size_t W_UP = 4096ull * 1024, W_DN = 1024ull * 4096, W_G = 1024ull * 1024, W_PU = 1024ull * 256;
constexpr size_t LW = W_UP + W_DN + W_G + W_PU;
constexpr size_t OFF_A_IN = 4 * LW;
constexpr size_t OFF_A_OUT = OFF_A_IN + 3328ull * 1024;
constexpr size_t OFF_B_IN = OFF_A_OUT + 1024ull * 1024;
constexpr size_t OFF_B_OUT = OFF_B_IN + 4096ull * 1024;
constexpr size_t OFF_C_IN = OFF_B_OUT + 1024ull * 1024;
constexpr size_t OFF_C_OUT = OFF_C_IN + 4096ull * 1024;
constexpr size_t OFF_C_WS = OFF_C_OUT + 1024ull * 2048;
constexpr size_t OFF_D_IN = OFF_C_WS + 8ull * 128 * 128;
constexpr size_t OFF_D_G = OFF_D_IN + 2048ull * 1024;
constexpr size_t OFF_D_OUT = OFF_D_G + 4ull * 512 * 256;
constexpr size_t W_TOTAL = OFF_D_OUT + 1024ull * 1024;
constexpr size_t MiB = 1024ull * 1024;
static_assert(W_TOTAL * 2 <= 112 * MiB, "weights region");
constexpr size_t WS_W = 0, WS_HN = 112 * MiB, WS_Z = 240 * MiB, WS_YP = 752 * MiB, WS_PB = 880 * MiB, WS_GATE = 912 * MiB, WS_LB = 916 * MiB, WS_BAR = 917 * MiB, WS_END = 918 * MiB;

struct Params {
    const float* in[31];
    float* out;
    unsigned char* ws;
    int ph_lo, ph_hi;
};
typedef const __attribute__((address_space(4))) Params* KP;
enum { I_X = 0, I_P, I_NG, I_WUP, I_WDN, I_PUP, I_PG, I_AIN, I_AIB, I_AFB, I_AHG, I_AOUT, I_BIN, I_BLB, I_BHG, I_BOUT, I_CIN, I_CLG, I_CLB, I_CSW, I_CSB, I_COUT,
       I_DIN, I_DCW, I_DCB, I_DWA, I_DBA, I_DWX, I_DBX, I_DLAM, I_DOUT };

__device__ __forceinline__ float bf2f(bf16_t b) { return __uint_as_float(((unsigned)b) << 16); }
__device__ __forceinline__ float bflo(unsigned u) { return __uint_as_float(u << 16); }
__device__ __forceinline__ float bfhi(unsigned u) { return __uint_as_float(u & 0xffff0000u); }
__device__ __forceinline__ unsigned pk2(float lo, float hi) { unsigned r; asm("v_cvt_pk_bf16_f32 %0, %1, %2" : "=v"(r) : "v"(lo), "v"(hi)); return r; }
__device__ __forceinline__ bf16_t f2bf(float f) { return (bf16_t)(pk2(f, 0.f) & 0xffffu); }
__device__ __forceinline__ float fast_rcp(float x) { return __builtin_amdgcn_rcpf(x); }
__device__ __forceinline__ float sigmoidf_(float x) { return fast_rcp(1.0f + __expf(-x)); }
__device__ __forceinline__ float gelu_tanh(float x) { const float t = 1.5957691216057308f * (x + 0.044715f * x * x * x); return x * fast_rcp(1.0f + __expf(-t)); }
__device__ __forceinline__ float wave_sum(float v) {
#pragma unroll
    for (int o = 32; o >= 1; o >>= 1) v += __shfl_xor(v, o);
    return v;
}
__device__ __forceinline__ bf16x8 as_bf16x8(u32x4 v) { union { u32x4 u; bf16x8 b; } x; x.u = v; return x.b; }
__device__ __forceinline__ u32x4 as_u32x4(bf16x8 v) { union { u32x4 u; bf16x8 b; } x; x.b = v; return x.u; }
__device__ __forceinline__ bf16x8 ldk(const LAS unsigned char* p) { return *(const LAS bf16x8*)p; }
__device__ __forceinline__ bf16x8 ldt(const LAS unsigned char* base, int pitch, int fr, int fq) {
    const LAS unsigned char* p = base + (fq * 8 + (fr >> 2)) * pitch + (fr & 3) * 8;
    s16x4 a = __builtin_amdgcn_ds_read_tr16_b64_v4i16((LAS s16x4*)p);
    s16x4 b = __builtin_amdgcn_ds_read_tr16_b64_v4i16((LAS s16x4*)(p + 4 * pitch));
    bf16x8 r = {a[0], a[1], a[2], a[3], b[0], b[1], b[2], b[3]};
    return r;
}
__device__ __forceinline__ int opaque_tid() { int t = threadIdx.x; asm volatile("" : "+v"(t)); return t; }
#define MFMA16(a, b, c) __builtin_amdgcn_mfma_f32_16x16x32_bf16((a), (b), (c), 0, 0, 0)


#define XB_TMO      128
#define XB_XCNT(j)  (256  + 64 * (j))
#define XB_XSUB(j)  (1280 + 64 * (j))
#define XB_XGEN(j)  (2304 + 64 * (j))
#define XB_TOP      3328
#define XB_TOPGEN   3392
#define XCD_BAR_WORDS 3456
#define XB_SPIN_CAP (1u << 20)
__device__ __forceinline__ unsigned xb_ld(unsigned* p)              { return __hip_atomic_load(p, __ATOMIC_RELAXED, __HIP_MEMORY_SCOPE_AGENT); }
__device__ __forceinline__ unsigned xb_add(unsigned* p, unsigned v) { return __hip_atomic_fetch_add(p, v, __ATOMIC_RELAXED, __HIP_MEMORY_SCOPE_AGENT); }
__device__ __forceinline__ unsigned xb_xcc_id() { return (unsigned)__builtin_amdgcn_s_getreg((3 << 11) | 20) & 0xFu; }
#define XB_SPIN(cond, bar) do { unsigned _sp = 0; while (cond) { __builtin_amdgcn_s_sleep(1); \
    if ((++_sp & 255u) == 0u) { if (xb_ld(&(bar)[XB_TMO])) break; if (_sp > XB_SPIN_CAP) { atomicAdd(&(bar)[XB_TMO], 1u); break; } } } } while (0)
struct XcdBarrier { unsigned* bar; unsigned x; volatile LAS unsigned* st; };
__device__ __forceinline__ XcdBarrier xcd_barrier_post(unsigned* bar, volatile LAS unsigned* st) {
    XcdBarrier b; b.bar = bar; b.x = xb_xcc_id(); b.st = st;
    if (threadIdx.x == 0) (void)xb_add(&bar[XB_XCNT(b.x)], 1u);
    return b;
}
__device__ __forceinline__ void xcd_barrier_complete(unsigned* bar, unsigned x, unsigned& nloc, unsigned& nx) {
    const unsigned G = gridDim.x * gridDim.y * gridDim.z;
    unsigned sum, cnt, mine, sp = 0u;
    for (;;) {
        sum = 0u; cnt = 0u; mine = 0u;
#pragma unroll
        for (unsigned j = 0; j < 16; ++j) { const unsigned c = xb_ld(&bar[XB_XCNT(j)]); sum += c; cnt += (c > 0u) ? 1u : 0u; mine = (j == x) ? c : mine; }
        if (sum == G) break;
        __builtin_amdgcn_s_sleep(1);
        if ((++sp & 255u) == 0u) { if (xb_ld(&bar[XB_TMO])) break; if (sp > XB_SPIN_CAP) { atomicAdd(&bar[XB_TMO], 1u); break; } }
    }
    nloc = mine > 0u ? mine : 1u; nx = cnt > 0u ? cnt : 1u;
}
__device__ __forceinline__ void xcd_barrier(const XcdBarrier& b) {
    asm volatile("s_waitcnt vmcnt(0)" ::: "memory");
    __syncthreads();
    if (threadIdx.x == 0) {
        unsigned* bar = b.bar;
        __builtin_amdgcn_s_waitcnt(0);
        unsigned nloc = b.st[0], nx = b.st[1];
        if (nloc == 0u) { xcd_barrier_complete(bar, b.x, nloc, nx); b.st[0] = nloc; b.st[1] = nx; }
        const unsigned old = xb_add(&bar[XB_XSUB(b.x)], 1u);
        const unsigned gen = old / nloc;
        if (old + 1u == (gen + 1u) * nloc) {
            __builtin_amdgcn_fence(__ATOMIC_RELEASE, "agent");
            asm volatile("s_waitcnt vmcnt(0)" ::: "memory");
            const unsigned og = xb_add(&bar[XB_TOP], 1u);
            const unsigned tg = og / nx;
            if (og + 1u == (tg + 1u) * nx) xb_add(&bar[XB_TOPGEN], 1u);
            else XB_SPIN(xb_ld(&bar[XB_TOPGEN]) == tg, bar);
            __builtin_amdgcn_fence(__ATOMIC_ACQUIRE, "agent");
            xb_add(&bar[XB_XGEN(b.x)], 1u);
            asm volatile("s_waitcnt vmcnt(0)" ::: "memory");
        } else {
            XB_SPIN(xb_ld(&bar[XB_XGEN(b.x)]) == gen, bar);
            __builtin_amdgcn_fence(__ATOMIC_ACQUIRE, "agent");
            asm volatile("s_waitcnt vmcnt(0)" ::: "memory");
        }
    }
    __syncthreads();
}

namespace pg8 {
constexpr int BM = 256, BK = 64, HALF = 128, HTB = HALF * BK * 2, STAGE_BYTES = 8 * HTB, NXCD = 8, WGM = 8;
__device__ __forceinline__ int lds_byte(int r, int c) { const int st = (r >> 4) * 2 + (c >> 5), rr = r & 15, cc = c & 31, ob = rr * 64 + cc * 2; return st * 1024 + (ob ^ (((ob >> 9) & 1) << 5)); }
__device__ __forceinline__ void stage_rc(int b, int& R, int& C) { const int st = b / 1024, sb = b % 1024, swz = sb ^ (((sb >> 9) & 1) << 5); R = (st >> 1) * 16 + swz / 64; C = (st & 1) * 32 + (swz % 64) / 2; }
__device__ __forceinline__ int perm32(int rho) { const int n = rho >> 4, i = rho & 15; return 8 * (i >> 2) + 4 * n + (i & 3); }
struct Unit { int pm, pn; };
struct Gemm { const bf16_t* A; const bf16_t* Bt; int M, N, K, lda, ldb; };
struct StaticOrder {
    int nM, nN, nwg, G, c;
    __device__ void init(int M, int N, int G_, int c_) { nM = M / BM; nN = N / BM; nwg = nM * nN; G = G_; c = c_; }
    __device__ bool next(int i, Unit& u) const {
        const long L = (long)i * G + c; if (L >= nwg) return false;
        int wgid = (int)L; { const int q = nwg / NXCD, r = nwg % NXCD, xcd = wgid % NXCD, off = wgid / NXCD; wgid = (xcd < r ? xcd * (q + 1) : r * (q + 1) + (xcd - r) * q) + off; }
        const int nig = WGM * nN, gid = wgid / nig, fm = gid * WGM, gsz = (nM - fm) < WGM ? (nM - fm) : WGM;
        u.pm = fm + ((wgid % nig) % gsz); u.pn = (wgid % nig) / gsz; return true;
    }
};
template <class Epi>
__device__ __forceinline__ void gemm_phase(LAS unsigned char* lds, const Gemm g, const StaticOrder& S, const Epi& E) {
    const int tid = opaque_tid(), wid = __builtin_amdgcn_readfirstlane(tid >> 6), lane = tid & 63, wr = wid >> 2, wc = wid & 3, fr = lane & 15, fq = lane >> 4;
    const int K = g.K, nt = K / BK;
    unsigned voffA[2], voffB[2];
#pragma unroll
    for (int i = 0; i < 2; ++i) { int R, C; stage_rc(tid * 16 + i * 8192, R, C); const int Rb = (R & ~31) + perm32(R & 31);
        voffA[i] = (unsigned)(R * g.lda + C) * 2u; voffB[i] = (unsigned)(Rb * g.ldb + C) * 2u; }
    const size_t kstep = (size_t)(BK * 2);
    const size_t hstepA = (size_t)HALF * g.lda * 2, hstepB = (size_t)HALF * g.ldb * 2;
    const size_t tstepA = 2 * hstepA, tstepB = 2 * hstepB;
    const unsigned ldsw = (unsigned)wid * 1024u;
    const int aoff = lds_byte(wr * 64 + fr, fq * 8), boff = lds_byte(wc * 32 + fr, fq * 8);
#define PG8_SA(b, h) (((b) * 2 + (h)) * HTB)
#define PG8_SB(b, h) ((4 + (b) * 2 + (h)) * HTB)
#define PG8_STAGE(bufoff, gbase, voff) do { _Pragma("unroll") for (int _i = 0; _i < 2; ++_i) \
        __builtin_amdgcn_global_load_lds((const unsigned*)((const char*)(gbase) + (voff)[_i]), (LAS unsigned*)(lds + (bufoff) + ldsw + _i * 8192), 16, 0, 0); } while (0)
#define PG8_LDA(dst, b, h) do { _Pragma("unroll") for (int m = 0; m < 4; ++m) _Pragma("unroll") for (int k = 0; k < 2; ++k) dst[m][k] = *(const LAS bf16x8*)(lds + PG8_SA(b, h) + aoff + m * 2048 + k * 1024); } while (0)
#define PG8_LDB(dst, b, h) do { _Pragma("unroll") for (int n = 0; n < 2; ++n) _Pragma("unroll") for (int k = 0; k < 2; ++k) dst[n][k] = *(const LAS bf16x8*)(lds + PG8_SB(b, h) + boff + n * 2048 + k * 1024); } while (0)
#define PG8_MMA(ai, bj, At, Bt) do { __builtin_amdgcn_s_setprio(1); _Pragma("unroll") for (int m = 0; m < 4; ++m) _Pragma("unroll") for (int n = 0; n < 2; ++n) _Pragma("unroll") for (int k = 0; k < 2; ++k) \
        acc[ai][bj][m][n] = __builtin_amdgcn_mfma_f32_16x16x32_bf16(Bt[n][k], At[m][k], acc[ai][bj][m][n], 0, 0, 0); __builtin_amdgcn_s_setprio(0); } while (0)
#define PG8_WAIT_V(n) asm volatile("s_waitcnt vmcnt(" #n ")" ::: "memory")
#define PG8_WAIT_L(n) asm volatile("s_waitcnt lgkmcnt(" #n ")" ::: "memory")
#define PG8_BAR __builtin_amdgcn_s_barrier()
#define PG8_SCHED __builtin_amdgcn_sched_barrier(0)
    Unit cur, nxt; int ui = 0;
    if (!S.next(0, cur)) return;
    f32x4 acc[2][2][4][2];
#pragma unroll
    for (int a = 0; a < 2; ++a)
#pragma unroll
        for (int b = 0; b < 2; ++b)
#pragma unroll
            for (int m = 0; m < 4; ++m)
#pragma unroll
                for (int n = 0; n < 2; ++n) acc[a][b][m][n] = (f32x4){0.f, 0.f, 0.f, 0.f};
    bf16x8 At[4][2], B0[2][2], B1[2][2];
    const char* cA = (const char*)g.A + (size_t)cur.pm * tstepA; const char* cB = (const char*)g.Bt + (size_t)cur.pn * tstepB;
    PG8_STAGE(PG8_SB(0, 0), cB, voffB); PG8_STAGE(PG8_SA(0, 0), cA, voffA); PG8_STAGE(PG8_SB(0, 1), cB + hstepB, voffB); PG8_STAGE(PG8_SA(0, 1), cA + hstepA, voffA);
    if (wr == 1) PG8_BAR;
    PG8_WAIT_V(4); PG8_BAR;
    PG8_STAGE(PG8_SB(1, 0), cB + kstep, voffB); PG8_STAGE(PG8_SA(1, 0), cA + kstep, voffA); PG8_STAGE(PG8_SB(1, 1), cB + hstepB + kstep, voffB);
    PG8_WAIT_V(6); PG8_BAR;
    for (;;) {
        const bool has_next = S.next(ui + 1, nxt);
        const char* nA = has_next ? (const char*)g.A + (size_t)nxt.pm * tstepA : cA; const char* nB = has_next ? (const char*)g.Bt + (size_t)nxt.pn * tstepB : cB;
        for (int t = 0; t < nt; t += 2) {
            const bool last = (t == nt - 2);
            const char* a1 = cA + (size_t)(t + 1) * kstep;
            const char* a2 = last ? nA : cA + (size_t)(t + 2) * kstep; const char* b2 = last ? nB : cB + (size_t)(t + 2) * kstep;
            const char* a3 = a2 + kstep; const char* b3 = b2 + kstep;
            PG8_LDB(B0, 0, 0); PG8_SCHED; PG8_LDA(At, 0, 0); PG8_STAGE(PG8_SA(1, 1), a1 + hstepA, voffA);
            PG8_WAIT_L(8); PG8_BAR; PG8_WAIT_L(0); PG8_MMA(0, 0, At, B0); PG8_BAR; PG8_SCHED;
            PG8_LDB(B1, 0, 1); PG8_STAGE(PG8_SB(0, 0), b2, voffB);
            PG8_BAR; PG8_WAIT_L(0); PG8_MMA(0, 1, At, B1); PG8_BAR;
            PG8_LDA(At, 0, 1); PG8_STAGE(PG8_SA(0, 0), a2, voffA);
            PG8_BAR; PG8_WAIT_L(0); PG8_MMA(1, 0, At, B0); PG8_BAR; PG8_SCHED;
            PG8_STAGE(PG8_SB(0, 1), b2 + hstepB, voffB);
            PG8_WAIT_V(6); PG8_BAR; PG8_MMA(1, 1, At, B1); PG8_BAR;
            PG8_LDB(B0, 1, 0); PG8_SCHED; PG8_LDA(At, 1, 0); PG8_STAGE(PG8_SA(0, 1), a2 + hstepA, voffA);
            PG8_WAIT_L(8); PG8_BAR; PG8_WAIT_L(0); PG8_MMA(0, 0, At, B0); PG8_BAR; PG8_SCHED;
            PG8_LDB(B1, 1, 1); PG8_STAGE(PG8_SB(1, 0), b3, voffB);
            PG8_BAR; PG8_WAIT_L(0); PG8_MMA(0, 1, At, B1); PG8_BAR;
            PG8_LDA(At, 1, 1); PG8_STAGE(PG8_SA(1, 0), a3, voffA);
            PG8_BAR; PG8_WAIT_L(0); PG8_MMA(1, 0, At, B0); PG8_BAR; PG8_SCHED;
            PG8_STAGE(PG8_SB(1, 1), b3 + hstepB, voffB);
            PG8_WAIT_V(6); PG8_BAR; PG8_MMA(1, 1, At, B1); PG8_BAR;
        }
        E(acc, cur, wr, wc, fr, fq);
        if (!has_next) break;
#pragma unroll
        for (int a = 0; a < 2; ++a)
#pragma unroll
            for (int b = 0; b < 2; ++b)
#pragma unroll
                for (int m = 0; m < 4; ++m)
#pragma unroll
                    for (int n = 0; n < 2; ++n) acc[a][b][m][n] = (f32x4){0.f, 0.f, 0.f, 0.f};
        cur = nxt; cA = nA; cB = nB; ++ui;
    }
    PG8_WAIT_V(0);
    if (wr == 0) PG8_BAR;
    PG8_BAR;
#undef PG8_SA
#undef PG8_SB
#undef PG8_STAGE
#undef PG8_LDA
#undef PG8_LDB
#undef PG8_MMA
#undef PG8_WAIT_V
#undef PG8_WAIT_L
#undef PG8_BAR
#undef PG8_SCHED
}
}

struct EpiGen {
    bf16_t* O; int ldc; int act;
    float* gate; int gate_pn;
    __device__ __forceinline__ void operator()(const f32x4 (&acc)[2][2][4][2], const pg8::Unit& u, int wr, int wc, int fr_, int fq_) const {
        int fr = fr_, fq = fq_; asm volatile("" : "+v"(fr), "+v"(fq));
        const int row0 = u.pm * 256 + wr * 64 + fr;
        if (act == 3) {
            const int col0 = u.pn * 256 + wc * 32 + 8 * fq;
#pragma unroll
            for (int q = 0; q < 4; ++q) { const int ai = q >> 1; u32x4 pv[2][2];
#pragma unroll
                for (int mm = 0; mm < 2; ++mm)
#pragma unroll
                    for (int bj = 0; bj < 2; ++bj) pv[mm][bj] = *(const u32x4*)(O + (size_t)(row0 + ai * 128 + ((q & 1) * 2 + mm) * 16) * ldc + col0 + bj * 128);
#pragma unroll
                for (int mm = 0; mm < 2; ++mm)
#pragma unroll
                    for (int bj = 0; bj < 2; ++bj) { const int m = (q & 1) * 2 + mm; const f32x4 v0 = acc[ai][bj][m][0], v1 = acc[ai][bj][m][1]; const u32x4 pu = pv[mm][bj]; u32x4 w;
                        w.x = pk2(sigmoidf_(v0[0]) * bflo(pu.x), sigmoidf_(v0[1]) * bfhi(pu.x)); w.y = pk2(sigmoidf_(v0[2]) * bflo(pu.y), sigmoidf_(v0[3]) * bfhi(pu.y));
                        w.z = pk2(sigmoidf_(v1[0]) * bflo(pu.z), sigmoidf_(v1[1]) * bfhi(pu.z)); w.w = pk2(sigmoidf_(v1[2]) * bflo(pu.w), sigmoidf_(v1[3]) * bfhi(pu.w));
                        *(u32x4*)(O + (size_t)(row0 + ai * 128 + m * 16) * ldc + col0 + bj * 128) = w; }
                asm volatile("" ::: "memory"); }
            return;
        }
        if (u.pn == gate_pn) {
            if (wc == 0 && fq < 2) {
#pragma unroll
                for (int ai = 0; ai < 2; ++ai)
#pragma unroll
                    for (int m = 0; m < 4; ++m) { float* gp = gate + (size_t)(row0 + ai * 128 + m * 16) * 16 + 8 * fq;
                        *(f32x4*)gp = acc[ai][0][m][0]; *(f32x4*)(gp + 4) = acc[ai][0][m][1]; }
            }
            return;
        }
        const int col0 = u.pn * 256 + wc * 32 + 8 * fq;
#pragma unroll
        for (int ai = 0; ai < 2; ++ai)
#pragma unroll
            for (int m = 0; m < 4; ++m) { bf16_t* rowp = O + (size_t)(row0 + ai * 128 + m * 16) * ldc + col0;
#pragma unroll
                for (int bj = 0; bj < 2; ++bj) { f32x4 v0 = acc[ai][bj][m][0], v1 = acc[ai][bj][m][1];
                    if (act == 1) {
#pragma unroll
                        for (int j = 0; j < 4; ++j) { v0[j] = gelu_tanh(v0[j]); v1[j] = gelu_tanh(v1[j]); }
                    } else if (act == 2) {
#pragma unroll
                        for (int j = 0; j < 4; ++j) { const float a = fmaxf(v0[j], 0.f), b = fmaxf(v1[j], 0.f); v0[j] = a * a; v1[j] = b * b; }
                    } else if (act == 3) {
                        const u32x4 pu = *(const u32x4*)(rowp + bj * 128);
                        v0[0] = sigmoidf_(v0[0]) * bflo(pu.x); v0[1] = sigmoidf_(v0[1]) * bfhi(pu.x); v0[2] = sigmoidf_(v0[2]) * bflo(pu.y); v0[3] = sigmoidf_(v0[3]) * bfhi(pu.y);
                        v1[0] = sigmoidf_(v1[0]) * bflo(pu.z); v1[1] = sigmoidf_(v1[1]) * bfhi(pu.z); v1[2] = sigmoidf_(v1[2]) * bflo(pu.w); v1[3] = sigmoidf_(v1[3]) * bfhi(pu.w);
                    }
                    u32x4 w; w.x = pk2(v0[0], v0[1]); w.y = pk2(v0[2], v0[3]); w.z = pk2(v1[0], v1[1]); w.w = pk2(v1[2], v1[3]);
                    *(u32x4*)(rowp + bj * 128) = w; }
                asm volatile("" ::: "memory"); }
    }
};
struct EpiRg {
    const bf16_t* xc; bf16_t* loga; bf16_t* beta; const float* b_a; const float* b_x; const float* spt; int blk;
    __device__ __forceinline__ void operator()(const f32x4 (&acc)[2][2][4][2], const pg8::Unit& u, int wr, int wc, int fr_, int fq_) const {
        int fr = fr_, fq = fq_; asm volatile("" : "+v"(fr), "+v"(fq));
        const int row0 = u.pm * 256 + wr * 64 + fr;
        const int ch0 = blk * 256 + u.pn * 128 + wc * 32 + 8 * fq;
#pragma unroll
        for (int q = 0; q < 4; ++q) { const int ai = q >> 1; u32x4 xq[2];
#pragma unroll
            for (int mm = 0; mm < 2; ++mm) xq[mm] = *(const u32x4*)(xc + (size_t)(row0 + ai * 128 + ((q & 1) * 2 + mm) * 16) * 1024 + ch0);
            f32x4 ba[2], bx[2], sp[2];
#pragma unroll
            for (int hh = 0; hh < 2; ++hh) { ba[hh] = *(const f32x4*)(b_a + ch0 + hh * 4); bx[hh] = *(const f32x4*)(b_x + ch0 + hh * 4); sp[hh] = *(const f32x4*)(spt + ch0 + hh * 4); }
#pragma unroll
            for (int mm = 0; mm < 2; ++mm) { const int m = (q & 1) * 2 + mm; const size_t off = (size_t)(row0 + ai * 128 + m * 16) * 1024 + ch0; const u32x4 xv = xq[mm];
                u32x4 wl, wb;
#pragma unroll
                for (int hh = 0; hh < 2; ++hh) {
                    const unsigned x01 = hh ? xv.z : xv.x, x23 = hh ? xv.w : xv.y;
                    const float x[4] = {bflo(x01), bfhi(x01), bflo(x23), bfhi(x23)};
                    float la[4], be[4];
#pragma unroll
                    for (int e = 0; e < 4; ++e) { const float rp = acc[ai][0][m][hh][e] + ba[hh][e], ip = acc[ai][1][m][hh][e] + bx[hh][e];
                        const float r = sigmoidf_(rp), ig = sigmoidf_(ip); const float l = sp[hh][e] * r; la[e] = l;
                        be[e] = __builtin_amdgcn_sqrtf(fmaxf(1.0f - __expf(2.0f * l), 0.f)) * ig * x[e]; }
                    if (hh == 0) { wl.x = pk2(la[0], la[1]); wl.y = pk2(la[2], la[3]); wb.x = pk2(be[0], be[1]); wb.y = pk2(be[2], be[3]); }
                    else { wl.z = pk2(la[0], la[1]); wl.w = pk2(la[2], la[3]); wb.z = pk2(be[0], be[1]); wb.w = pk2(be[2], be[3]); }
                }
                *(u32x4*)(loga + off) = wl; *(u32x4*)(beta + off) = wb; }
            asm volatile("" ::: "memory"); }
    }
};

__device__ __forceinline__ void rowpass(const float* hin, const bf16_t* hinb, const bf16_t* y, const float* gadd, float* hout, bf16_t* houtb, const float* gnext, bf16_t* hn, int normnext,
                                        const float* psrc, bf16_t* pdst) {
    const int tid_ = opaque_tid(); const int lane = tid_ & 63, wave = tid_ >> 6;
    const int gw = blockIdx.x * 8 + wave, nw = gridDim.x * 8;
    f32x4 ga[4], gn[4];
#pragma unroll
    for (int q = 0; q < 4; ++q) { ga[q] = y ? *(const f32x4*)(gadd + q * 256 + lane * 4) : (f32x4){0.f, 0.f, 0.f, 0.f}; gn[q] = (hn && normnext) ? *(const f32x4*)(gnext + q * 256 + lane * 4) : (f32x4){1.f, 1.f, 1.f, 1.f}; }
    for (int row0_ = gw; row0_ < MTOK; row0_ += 4 * nw) {
        f32x4 h[4][4]; u32x2 yv[4][4]; f32x4 pv[4];
#pragma unroll
        for (int u = 0; u < 4; ++u) { const int row = row0_ + u * nw; if (row < MTOK) { const size_t base = (size_t)row * DM + lane * 4;
            if (hin) {
#pragma unroll
                for (int q = 0; q < 4; ++q) h[u][q] = *(const f32x4*)(hin + base + q * 256);
            } else {
#pragma unroll
                for (int q = 0; q < 4; ++q) { const u32x2 hv = *(const u32x2*)(hinb + base + q * 256); h[u][q] = (f32x4){bflo(hv.x), bfhi(hv.x), bflo(hv.y), bfhi(hv.y)}; }
            }
            if (y) {
#pragma unroll
                for (int q = 0; q < 4; ++q) yv[u][q] = *(const u32x2*)(y + base + q * 256);
            }
            if (psrc) pv[u] = *(const f32x4*)(psrc + (size_t)row * 256 + lane * 4); } }
#pragma unroll
        for (int u = 0; u < 4; ++u) { const int row = row0_ + u * nw; if (row < MTOK) { const size_t base = (size_t)row * DM + lane * 4;
            if (y) {
                f32x4 yf[4]; float ss = 0.f;
#pragma unroll
                for (int q = 0; q < 4; ++q) { yf[q] = (f32x4){bflo(yv[u][q].x), bfhi(yv[u][q].x), bflo(yv[u][q].y), bfhi(yv[u][q].y)}; ss += yf[q][0] * yf[q][0] + yf[q][1] * yf[q][1] + yf[q][2] * yf[q][2] + yf[q][3] * yf[q][3]; }
                ss = wave_sum(ss);
                const float rs = __builtin_amdgcn_rsqf(ss * (1.0f / DM) + EPS);
#pragma unroll
                for (int q = 0; q < 4; ++q) h[u][q] = h[u][q] + yf[q] * rs * ga[q];
            }
            if (hout) {
#pragma unroll
                for (int q = 0; q < 4; ++q) *(f32x4*)(hout + base + q * 256) = h[u][q];
            }
            if (houtb) {
#pragma unroll
                for (int q = 0; q < 4; ++q) { u32x2 w; w.x = pk2(h[u][q][0], h[u][q][1]); w.y = pk2(h[u][q][2], h[u][q][3]); *(u32x2*)(houtb + base + q * 256) = w; }
            }
            if (hn) {
                float rs2 = 1.0f;
                if (normnext) { float ss = 0.f;
#pragma unroll
                    for (int q = 0; q < 4; ++q) ss += h[u][q][0] * h[u][q][0] + h[u][q][1] * h[u][q][1] + h[u][q][2] * h[u][q][2] + h[u][q][3] * h[u][q][3];
                    ss = wave_sum(ss); rs2 = __builtin_amdgcn_rsqf(ss * (1.0f / DM) + EPS); }
#pragma unroll
                for (int q = 0; q < 4; ++q) { const f32x4 o = h[u][q] * rs2 * gn[q]; u32x2 w; w.x = pk2(o[0], o[1]); w.y = pk2(o[2], o[3]); *(u32x2*)(hn + base + q * 256) = w; }
            }
            if (psrc) { u32x2 w; w.x = pk2(pv[u][0], pv[u][1]); w.y = pk2(pv[u][2], pv[u][3]); *(u32x2*)(pdst + (size_t)row * 256 + lane * 4) = w; } } }
    }
}

struct TJob { const float* src; bf16_t* dst; int lds, ldd, K, nvalid, ntn, t0; };
__device__ __forceinline__ TJob make_tjob(KP P, int j) {
    TJob t; bf16_t* W = (bf16_t*)(P->ws + WS_W); int npad;
    if (j < 16) { const int i = j >> 2, k = j & 3; bf16_t* L = W + (size_t)i * LW;
        if (k == 0) { t.src = P->in[I_WUP] + (size_t)i * 1024 * 4096; t.lds = 4096; t.K = 1024; t.nvalid = 4096; t.dst = L; }
        else if (k == 1) { t.src = P->in[I_WDN] + (size_t)i * 4096 * 1024; t.lds = 1024; t.K = 4096; t.nvalid = 1024; t.dst = L + W_UP; }
        else if (k == 2) { t.src = P->in[I_PG] + (size_t)i * 1024 * 1024; t.lds = 1024; t.K = 1024; t.nvalid = 1024; t.dst = L + W_UP + W_DN; }
        else { t.src = P->in[I_PUP] + (size_t)i * 256 * 1024; t.lds = 1024; t.K = 256; t.nvalid = 1024; t.dst = L + W_UP + W_DN + W_G; }
        npad = t.nvalid; }
    else if (j == 16) { t.src = P->in[I_AIN]; t.lds = 3088; t.K = 1024; t.nvalid = 3088; npad = 3328; t.dst = W + OFF_A_IN; }
    else if (j == 17) { t.src = P->in[I_AOUT]; t.lds = 1024; t.K = 1024; t.nvalid = 1024; npad = 1024; t.dst = W + OFF_A_OUT; }
    else if (j == 18) { t.src = P->in[I_BIN]; t.lds = 4096; t.K = 1024; t.nvalid = 4096; npad = 4096; t.dst = W + OFF_B_IN; }
    else if (j == 19) { t.src = P->in[I_BOUT]; t.lds = 1024; t.K = 1024; t.nvalid = 1024; npad = 1024; t.dst = W + OFF_B_OUT; }
    else if (j == 20) { t.src = P->in[I_CIN]; t.lds = 4096; t.K = 1024; t.nvalid = 4096; npad = 4096; t.dst = W + OFF_C_IN; }
    else if (j == 21) { t.src = P->in[I_COUT]; t.lds = 1024; t.K = 2048; t.nvalid = 1024; npad = 1024; t.dst = W + OFF_C_OUT; }
    else if (j == 22) { t.src = P->in[I_DIN]; t.lds = 2048; t.K = 1024; t.nvalid = 2048; npad = 2048; t.dst = W + OFF_D_IN; }
    else if (j == 23) { t.src = P->in[I_DOUT]; t.lds = 1024; t.K = 1024; t.nvalid = 1024; npad = 1024; t.dst = W + OFF_D_OUT; }
    else { const int q = j - 24, blk = q >> 2, pn = (q >> 1) & 1, which = q & 1;
        t.src = (which ? P->in[I_DWX] : P->in[I_DWA]) + (size_t)blk * 65536 + pn * 128; t.lds = 256; t.K = 256; t.nvalid = 128; npad = 128;
        t.dst = W + OFF_D_G + (size_t)blk * 512 * 256 + (size_t)(pn * 256 + which * 128) * 256; }
    t.ldd = t.K; t.ntn = npad / 64; t.t0 = (t.K / 64) * t.ntn;
    return t;
}
constexpr int NTJOBS = 40;
__device__ __forceinline__ void prep_phase(KP P, LAS unsigned char* lds) {
    const int tid = opaque_tid();
    LAS int* tstart = (LAS int*)(lds + 32768);
    LAS float* tile = (LAS float*)lds;
    if (tid == 0) { int s = 0; for (int j = 0; j < NTJOBS; ++j) { tstart[j] = s; s += make_tjob(P, j).t0; } tstart[NTJOBS] = s; }
    __syncthreads();
    const int total = tstart[NTJOBS];
    for (int gt = blockIdx.x; gt < total; gt += gridDim.x) {
        int j = 0; while (tstart[j + 1] <= gt) ++j;
        const TJob t = make_tjob(P, j);
        const int lt = gt - tstart[j]; const int kt = lt / t.ntn, ntile = lt - kt * t.ntn; const int k0 = kt * 64, n0 = ntile * 64;
        { const int kk = tid >> 4, nn = (tid & 15) * 4;
#pragma unroll
            for (int i = 0; i < 2; ++i) { const int k = kk + 32 * i; f32x4 v = (f32x4){0.f, 0.f, 0.f, 0.f};
                if (n0 + nn < t.nvalid) v = *(const f32x4*)(t.src + (size_t)(k0 + k) * t.lds + n0 + nn);
                tile[k * 65 + nn] = v[0]; tile[k * 65 + nn + 1] = v[1]; tile[k * 65 + nn + 2] = v[2]; tile[k * 65 + nn + 3] = v[3]; } }
        __syncthreads();
        { const int n = tid >> 3, k8 = (tid & 7) * 8; float v[8];
#pragma unroll
            for (int e = 0; e < 8; ++e) v[e] = tile[(k8 + e) * 65 + n];
            u32x4 w; w.x = pk2(v[0], v[1]); w.y = pk2(v[2], v[3]); w.z = pk2(v[4], v[5]); w.w = pk2(v[6], v[7]);
            *(u32x4*)(t.dst + (size_t)(n0 + n) * t.ldd + k0 + k8) = w; }
        __syncthreads();
    }
    { bf16_t* Wsb = (bf16_t*)(P->ws + WS_W) + OFF_C_WS; const float* sw = P->in[I_CSW];
        for (int i = blockIdx.x * NTHREADS + tid; i < 8 * 128 * 128; i += gridDim.x * NTHREADS) { const int s = i & 127, t = (i >> 7) & 127; Wsb[i] = f2bf(s <= t ? sw[i] : 0.f); } }
    if (blockIdx.x == 0) { float* lb = (float*)(P->ws + WS_LB); const float* s = P->in[I_BLB];
        for (int c = tid; c < 1024; c += NTHREADS) { const float a0 = s[c], a1 = s[1024 + c], a2 = s[2048 + c], a3 = s[3072 + c]; const float mx = fmaxf(fmaxf(a0, a1), fmaxf(a2, a3));
            const float e0 = __expf(a0 - mx), e1 = __expf(a1 - mx), e2 = __expf(a2 - mx), e3 = __expf(a3 - mx); lb[c] = e1 * fast_rcp(e0 + e1 + e2 + e3);
            lb[1024 + c] = -8.0f * __logf(1.0f + __expf(-P->in[I_DLAM][c])); } }
    rowpass(P->in[I_X], nullptr, nullptr, nullptr, nullptr, nullptr, P->in[I_NG], (bf16_t*)(P->ws + WS_HN), 1, nullptr, nullptr);
}

__device__ __forceinline__ float incl_scan_sum(float v, int lane) {
#pragma unroll
    for (int d = 1; d < 64; d <<= 1) { const float t = __shfl_up(v, d); if (lane >= d) v += t; }
    return v;
}
__device__ __forceinline__ float incl_scan_max(float v, int lane) {
#pragma unroll
    for (int d = 1; d < 64; d <<= 1) { const float t = __shfl_up(v, d); if (lane >= d) v = fmaxf(v, t); }
    return v;
}
#define LDS_BARRIER() do { asm volatile("s_waitcnt lgkmcnt(0)" ::: "memory"); __builtin_amdgcn_s_barrier(); asm volatile("" ::: "memory"); } while (0)
__device__ __forceinline__ void mlstm_core(KP P, LAS unsigned char* lds) {
    const int tid = opaque_tid(), w = __builtin_amdgcn_readfirstlane(tid >> 6), lane = tid & 63, fr = lane & 15, fq = lane >> 4;
    const bf16_t* z = (const bf16_t*)(P->ws + WS_Z); const float* gate = (const float*)(P->ws + WS_GATE); bf16_t* yout = (bf16_t*)(P->ws + WS_YP);
    constexpr int PQ = 160, PV = 320, PP = 288, PC = 160;
    LAS unsigned char* Qs = lds; LAS unsigned char* Ks = lds + 20480; LAS unsigned char* Vs = lds + 40960; LAS unsigned char* Ps = lds + 81920; LAS unsigned char* Cb = lds + 118784;
    LAS float* fa = (LAS float*)(lds + 141824); LAS float* fM = fa + 128; LAS float* fb = fa + 256; LAS float* fwk = fa + 384;
    for (int unit = blockIdx.x; unit < 256; unit += gridDim.x) {
        const int b = unit >> 3, h = unit & 7;
        const float ib = P->in[I_AIB][h], fbias = P->in[I_AFB][h];
        __syncthreads();
        for (int i = tid; i < 144 * 80 / 2; i += NTHREADS) ((LAS unsigned*)Cb)[i] = 0u;
        if (tid < 128) { LAS unsigned* vp = (LAS unsigned*)(Vs + tid * PV + 256); unsigned zz, one; asm volatile("v_mov_b32 %0, 0" : "=v"(zz)); asm volatile("v_mov_b32 %0, 0x3f80" : "=v"(one)); vp[0] = one;
#pragma unroll
            for (int i = 1; i < 16; ++i) vp[i] = zz; }
        f32x4 st[5];
#pragma unroll
        for (int i = 0; i < 5; ++i) st[i] = (f32x4){0.f, 0.f, 0.f, 0.f};
        float m_state = 0.f;
        u32x4 nq[2], nk[2], nv[4]; float nig = 0.f, nfg = 0.f;
        { const size_t r0 = (size_t)b * SEQL;
#pragma unroll
            for (int i = 0; i < 2; ++i) { const int idx = tid + i * 512, row = idx >> 3, pc = idx & 7;
                nq[i] = *(const u32x4*)(z + (r0 + row) * 3072 + h * 64 + pc * 8); nk[i] = *(const u32x4*)(z + (r0 + row) * 3072 + 512 + h * 64 + pc * 8); }
#pragma unroll
            for (int i = 0; i < 4; ++i) { const int idx = tid + i * 512, row = idx >> 4, pc = idx & 15; nv[i] = *(const u32x4*)(z + (r0 + row) * 3072 + 1024 + h * 128 + pc * 8); }
            if (tid < 128) { nig = gate[(r0 + tid) * 16 + h]; nfg = gate[(r0 + tid) * 16 + 8 + h]; } }
        for (int chunk = 0; chunk < 16; ++chunk) {
            const size_t r0 = (size_t)b * SEQL + chunk * 128;
#pragma unroll
            for (int i = 0; i < 2; ++i) { const int idx = tid + i * 512, row = idx >> 3, pc = idx & 7;
                u32x4 q = nq[i];
                q.x = pk2(bflo(q.x) * 0.125f, bfhi(q.x) * 0.125f); q.y = pk2(bflo(q.y) * 0.125f, bfhi(q.y) * 0.125f); q.z = pk2(bflo(q.z) * 0.125f, bfhi(q.z) * 0.125f); q.w = pk2(bflo(q.w) * 0.125f, bfhi(q.w) * 0.125f);
                *(LAS u32x4*)(Qs + row * PQ + pc * 16) = q;
                *(LAS u32x4*)(Ks + row * PQ + pc * 16) = nk[i]; }
#pragma unroll
            for (int i = 0; i < 4; ++i) { const int idx = tid + i * 512, row = idx >> 4, pc = idx & 15;
                *(LAS u32x4*)(Vs + row * PV + pc * 16) = nv[i]; }
            if (tid < 128) { const float ig = nig, fg = nfg;
                const float xf = fg + fbias; const float lf = fminf(xf, 0.f) - __logf(1.0f + __expf(-fabsf(xf)));
                fa[tid] = ig + ib; fb[tid] = lf; }
            if (chunk + 1 < 16) { const size_t r1 = r0 + 128;
#pragma unroll
                for (int i = 0; i < 2; ++i) { const int idx = tid + i * 512, row = idx >> 3, pc = idx & 7;
                    nq[i] = *(const u32x4*)(z + (r1 + row) * 3072 + h * 64 + pc * 8); nk[i] = *(const u32x4*)(z + (r1 + row) * 3072 + 512 + h * 64 + pc * 8); }
#pragma unroll
                for (int i = 0; i < 4; ++i) { const int idx = tid + i * 512, row = idx >> 4, pc = idx & 15; nv[i] = *(const u32x4*)(z + (r1 + row) * 3072 + 1024 + h * 128 + pc * 8); }
                if (tid < 128) { nig = gate[(r1 + tid) * 16 + h]; nfg = gate[(r1 + tid) * 16 + 8 + h]; } }
            LDS_BARRIER();
            if (w == 0) {
                const float lf0 = fb[lane], lf1 = fb[64 + lane], li0 = fa[lane], li1 = fa[64 + lane];
                const float c0 = incl_scan_sum(lf0, lane); const float tot0 = __shfl(c0, 63); const float c1 = incl_scan_sum(lf1, lane) + tot0;
                const float a0 = li0 - c0, a1 = li1 - c1;
                const float p0 = incl_scan_max(a0, lane); const float pt = __shfl(p0, 63); const float p1 = fmaxf(incl_scan_max(a1, lane), pt);
                const float M0 = fmaxf(m_state, p0), M1 = fmaxf(m_state, p1);
                const float Ml = __shfl(M1, 63);
                fa[lane] = a0; fa[64 + lane] = a1; fM[lane] = M0; fM[64 + lane] = M1; fb[lane] = c0; fb[64 + lane] = c1;
                fwk[lane] = __expf(a0 - Ml); fwk[64 + lane] = __expf(a1 - Ml);
            }
            LDS_BARRIER();
            const float Mlast = fM[127], blast = fb[127];
            const int t = 16 * w + fr;
            const float Mt = fM[t], bt = fb[t];
            const float winter = __expf(m_state - Mt);
            u32x2 ogv[8];
#pragma unroll
            for (int n = 0; n < 8; ++n) ogv[n] = *(const u32x2*)(z + (r0 + t) * 3072 + 2048 + h * 128 + 16 * n + fq * 4);
            bf16x8 qf[2];
            qf[0] = ldk(Qs + t * PQ + fq * 16); qf[1] = ldk(Qs + t * PQ + 64 + fq * 16);
            for (int n = 0; n <= (w | 1); ++n) {
                f32x4 a = (f32x4){0.f, 0.f, 0.f, 0.f};
                if (n <= w) {
                    const bf16x8 k0 = ldk(Ks + (16 * n + fr) * PQ + fq * 16), k1 = ldk(Ks + (16 * n + fr) * PQ + 64 + fq * 16);
                    a = MFMA16(k0, qf[0], a); a = MFMA16(k1, qf[1], a);
                    const f32x4 as4 = *(const LAS f32x4*)(fa + 16 * n + fq * 4);
#pragma unroll
                    for (int j = 0; j < 4; ++j) { const int s = 16 * n + fq * 4 + j; a[j] = (s <= t) ? a[j] * __expf(as4[j] - Mt) : 0.f; }
                }
                u32x2 pw; pw.x = pk2(a[0], a[1]); pw.y = pk2(a[2], a[3]);
                *(LAS u32x2*)(Ps + t * PP + (16 * n + fq * 4) * 2) = pw;
            }
            asm volatile("s_waitcnt lgkmcnt(0)" ::: "memory");
            f32x4 o[9];
#pragma unroll
            for (int n = 0; n < 9; ++n) { f32x4 c = (f32x4){0.f, 0.f, 0.f, 0.f};
                c = MFMA16(ldk(Cb + (16 * n + fr) * PC + fq * 16), qf[0], c); c = MFMA16(ldk(Cb + (16 * n + fr) * PC + 64 + fq * 16), qf[1], c);
                o[n] = c * winter; }
            for (int ks = 0; ks <= (w >> 1); ++ks) {
                const bf16x8 pf = ldk(Ps + t * PP + ks * 64 + fq * 16);
#pragma unroll
                for (int n = 0; n < 9; ++n) o[n] = MFMA16(ldt(Vs + (ks * 32) * PV + (16 * n) * 2, PV, fr, fq), pf, o[n]);
            }
            {
                float den = __shfl(o[8][0], fr);
                const float dn = fast_rcp(fmaxf(fabsf(den), __expf(-(bt + Mt))));
                float ss = 0.f;
#pragma unroll
                for (int n = 0; n < 8; ++n) { o[n] = o[n] * dn; ss += o[n][0] * o[n][0] + o[n][1] * o[n][1] + o[n][2] * o[n][2] + o[n][3] * o[n][3]; }
                ss += __shfl_xor(ss, 16); ss += __shfl_xor(ss, 32);
                const float rs = __builtin_amdgcn_rsqf(ss * (1.0f / 128.0f) + EPS);
                const float* hg = P->in[I_AHG] + h * 128;
#pragma unroll
                for (int n = 0; n < 8; ++n) { const int v0 = 16 * n + fq * 4;
                    const u32x2 og = ogv[n];
                    const f32x4 g4 = *(const f32x4*)(hg + v0);
                    const float y0 = o[n][0] * rs * g4[0] * sigmoidf_(bflo(og.x)), y1 = o[n][1] * rs * g4[1] * sigmoidf_(bfhi(og.x));
                    const float y2 = o[n][2] * rs * g4[2] * sigmoidf_(bflo(og.y)), y3 = o[n][3] * rs * g4[3] * sigmoidf_(bfhi(og.y));
                    u32x2 yw; yw.x = pk2(y0, y1); yw.y = pk2(y2, y3);
                    *(u32x2*)(yout + (r0 + t) * 1024 + h * 128 + v0) = yw; }
            }
            {
                const float decay = __expf(m_state - Mlast);
#pragma unroll
                for (int i = 0; i < 5; ++i) st[i] = st[i] * decay;
                for (int ks = 0; ks < 4; ++ks) {
                    const f32x4 wa = *(const LAS f32x4*)(fwk + ks * 32 + fq * 8), wb = *(const LAS f32x4*)(fwk + ks * 32 + fq * 8 + 4);
                    const bf16x8 vf = ldt(Vs + (ks * 32) * PV + (16 * w) * 2, PV, fr, fq);
                    bf16x8 kf[4];
#pragma unroll
                    for (int dt = 0; dt < 4; ++dt) { const u32x4 kr = as_u32x4(ldt(Ks + (ks * 32) * PQ + (16 * dt) * 2, PQ, fr, fq)); u32x4 ksc;
                        ksc.x = pk2(bflo(kr.x) * wa[0], bfhi(kr.x) * wa[1]); ksc.y = pk2(bflo(kr.y) * wa[2], bfhi(kr.y) * wa[3]);
                        ksc.z = pk2(bflo(kr.z) * wb[0], bfhi(kr.z) * wb[1]); ksc.w = pk2(bflo(kr.w) * wb[2], bfhi(kr.w) * wb[3]);
                        kf[dt] = as_bf16x8(ksc); st[dt] = MFMA16(kf[dt], vf, st[dt]); }
                    if (w < 4) { const bf16x8 v8 = ldt(Vs + (ks * 32) * PV + 128 * 2, PV, fr, fq);
                        const bf16x8 kw = (w == 0) ? kf[0] : (w == 1) ? kf[1] : (w == 2) ? kf[2] : kf[3];
                        st[4] = MFMA16(kw, v8, st[4]); }
                }
            }
            m_state = blast + Mlast;
            LDS_BARRIER();
#pragma unroll
            for (int dt = 0; dt < 4; ++dt) { u32x2 cw; cw.x = pk2(st[dt][0], st[dt][1]); cw.y = pk2(st[dt][2], st[dt][3]);
                *(LAS u32x2*)(Cb + (16 * w + fr) * PC + (16 * dt + fq * 4) * 2) = cw; }
            if (w < 4) { u32x2 cw; cw.x = pk2(st[4][0], st[4][1]); cw.y = pk2(st[4][2], st[4][3]);
                *(LAS u32x2*)(Cb + (128 + fr) * PC + (16 * w + fq * 4) * 2) = cw; }
        }
    }
    __syncthreads();
}

__device__ __forceinline__ void hgrn_core(KP P, LAS unsigned char* lds) {
    const int tid = opaque_tid(), w = __builtin_amdgcn_readfirstlane(tid >> 6), lane = tid & 63, fr = lane & 15, fq = lane >> 4;
    const bf16_t* z = (const bf16_t*)(P->ws + WS_Z); const float* lbv = (const float*)(P->ws + WS_LB); bf16_t* yout = (bf16_t*)(P->ws + WS_YP);
    constexpr int PT = 288, PA = 96;
    LAS unsigned char* Qt = lds; LAS unsigned char* Qh = lds + 9216; LAS unsigned char* Kh = lds + 18432; LAS unsigned char* Vs = lds + 27648; LAS unsigned char* At = lds + 36864;
    LAS unsigned char* Sb = lds + 40960;
    LAS float* gl = (LAS float*)(lds + 77824);
    LAS float* seg = (LAS float*)(lds + 78336);
    LAS float* ssp = (LAS float*)(lds + 80384);
    const int c = tid & 127, tq = tid >> 7;
    for (int unit = blockIdx.x; unit < 256; unit += gridDim.x) {
        const int b = unit >> 3, h = unit & 7;
        const float lb = lbv[h * 128 + c];
        __syncthreads();
        for (int i = tid; i < 128 * 144 / 2; i += NTHREADS) ((LAS unsigned*)Sb)[i] = 0u;
        f32x4 S[8];
#pragma unroll
        for (int i = 0; i < 8; ++i) S[i] = (f32x4){0.f, 0.f, 0.f, 0.f};
        bf16_t nq[8], nf[8]; u32x4 nv; u32x2 ng2[2];
        { const size_t r0 = (size_t)b * SEQL;
#pragma unroll
            for (int i = 0; i < 8; ++i) { const size_t ro = (r0 + tq * 8 + i) * 4096 + h * 128 + c; nq[i] = z[ro]; nf[i] = z[ro + 1024]; }
            nv = *(const u32x4*)(z + (r0 + (tid >> 4)) * 4096 + 2048 + h * 128 + (tid & 15) * 8);
#pragma unroll
            for (int tt = 0; tt < 2; ++tt) ng2[tt] = *(const u32x2*)(z + (r0 + 16 * tt + fr) * 4096 + 3072 + h * 128 + 16 * w + fq * 4); }
        for (int chunk = 0; chunk < 64; ++chunk) {
            const size_t r0 = (size_t)b * SEQL + chunk * 32;
            float qv[8], kv[8], cs[8];
            const u32x2 cg0 = ng2[0], cg1 = ng2[1];
            { float run = 0.f;
#pragma unroll
                for (int i = 0; i < 8; ++i) {
                    qv[i] = bf2f(nq[i]); const float fz = bf2f(nf[i]);
                    const float f = lb + (1.0f - lb) * sigmoidf_(fz); kv[i] = 1.0f - f; run += __logf(f); cs[i] = run; }
                seg[tq * 128 + c] = run; }
            { const int row = tid >> 4, pc = tid & 15;
                *(LAS u32x4*)(Vs + row * PT + pc * 16) = nv; }
            if (chunk + 1 < 64) { const size_t r1 = r0 + 32;
#pragma unroll
                for (int i = 0; i < 8; ++i) { const size_t ro = (r1 + tq * 8 + i) * 4096 + h * 128 + c; nq[i] = z[ro]; nf[i] = z[ro + 1024]; }
                nv = *(const u32x4*)(z + (r1 + (tid >> 4)) * 4096 + 2048 + h * 128 + (tid & 15) * 8);
#pragma unroll
                for (int tt = 0; tt < 2; ++tt) ng2[tt] = *(const u32x2*)(z + (r1 + 16 * tt + fr) * 4096 + 3072 + h * 128 + 16 * w + fq * 4); }
            LDS_BARRIER();
            { const float s0 = seg[c], s1 = seg[128 + c], s2 = seg[256 + c], s3 = seg[384 + c];
                const float pre = (tq > 0 ? s0 : 0.f) + (tq > 1 ? s1 : 0.f) + (tq > 2 ? s2 : 0.f); const float glast = (s0 + s1) + (s2 + s3);
#pragma unroll
                for (int i = 0; i < 8; ++i) { const float g = pre + cs[i]; const int t = tq * 8 + i;
                    const float eg = __expf(g), er = __expf(g - glast);
                    *(LAS bf16_t*)(Qh + t * PT + c * 2) = f2bf(qv[i] * eg);
                    *(LAS bf16_t*)(Qt + t * PT + c * 2) = f2bf(qv[i] * er);
                    *(LAS bf16_t*)(Kh + t * PT + c * 2) = f2bf(kv[i] * fast_rcp(er)); }
                if (tq == 0) gl[c] = __expf(glast); }
            LDS_BARRIER();
            f32x4 o[2];
#pragma unroll
            for (int tt = 0; tt < 2; ++tt) { f32x4 a = (f32x4){0.f, 0.f, 0.f, 0.f};
#pragma unroll
                for (int ks = 0; ks < 4; ++ks) a = MFMA16(ldk(Sb + (16 * w + fr) * PT + ks * 64 + fq * 16), ldk(Qh + (16 * tt + fr) * PT + ks * 64 + fq * 16), a);
                o[tt] = a; }
            if (w < 4) { const int tt = w >> 1, stl = w & 1; f32x4 a = (f32x4){0.f, 0.f, 0.f, 0.f};
                if (!(tt == 0 && stl == 1)) {
#pragma unroll
                    for (int ks = 0; ks < 4; ++ks) a = MFMA16(ldk(Kh + (16 * stl + fr) * PT + ks * 64 + fq * 16), ldk(Qt + (16 * tt + fr) * PT + ks * 64 + fq * 16), a);
                    const int t = 16 * tt + fr;
#pragma unroll
                    for (int j = 0; j < 4; ++j) { const int s = 16 * stl + fq * 4 + j; if (s > t) a[j] = 0.f; }
                }
                u32x2 aw; aw.x = pk2(a[0], a[1]); aw.y = pk2(a[2], a[3]);
                *(LAS u32x2*)(At + (16 * tt + fr) * PA + (16 * stl + fq * 4) * 2) = aw; }
            LDS_BARRIER();
            { const bf16x8 vf = ldt(Vs + (16 * w) * 2, PT, fr, fq);
#pragma unroll
                for (int tt = 0; tt < 2; ++tt) { o[tt] = MFMA16(vf, ldk(At + (16 * tt + fr) * PA + fq * 16), o[tt]);
                    float ss = o[tt][0] * o[tt][0] + o[tt][1] * o[tt][1] + o[tt][2] * o[tt][2] + o[tt][3] * o[tt][3];
                    ss += __shfl_xor(ss, 16); ss += __shfl_xor(ss, 32);
                    if (fq == 0) ssp[(16 * tt + fr) * 8 + w] = ss; }
                const bf16x8 kf = ldt(Kh + (16 * w) * 2, PT, fr, fq);
                const f32x4 dc = *(const LAS f32x4*)(gl + 16 * w + fq * 4);
#pragma unroll
                for (int vt = 0; vt < 8; ++vt) { S[vt] = S[vt] * dc; S[vt] = MFMA16(kf, ldt(Vs + (16 * vt) * 2, PT, fr, fq), S[vt]); } }
            LDS_BARRIER();
#pragma unroll
            for (int vt = 0; vt < 8; ++vt) { u32x2 sw; sw.x = pk2(S[vt][0], S[vt][1]); sw.y = pk2(S[vt][2], S[vt][3]);
                *(LAS u32x2*)(Sb + (16 * vt + fr) * PT + (16 * w + fq * 4) * 2) = sw; }
            { const float* hg = P->in[I_BHG] + h * 128; const int v0 = 16 * w + fq * 4; const f32x4 g4 = *(const f32x4*)(hg + v0);
#pragma unroll
                for (int tt = 0; tt < 2; ++tt) { const int t = 16 * tt + fr;
                    const f32x4 sa = *(const LAS f32x4*)(ssp + t * 8), sb = *(const LAS f32x4*)(ssp + t * 8 + 4);
                    const float tot = ((sa[0] + sa[1]) + (sa[2] + sa[3])) + ((sb[0] + sb[1]) + (sb[2] + sb[3]));
                    const float rs = __builtin_amdgcn_rsqf(tot * (1.0f / 128.0f) + EPS);
                    const u32x2 gg = tt ? cg1 : cg0;
                    const float g0 = bflo(gg.x), g1 = bfhi(gg.x), g2 = bflo(gg.y), g3 = bfhi(gg.y);
                    const float y0 = o[tt][0] * rs * g4[0] * g0 * sigmoidf_(g0), y1 = o[tt][1] * rs * g4[1] * g1 * sigmoidf_(g1);
                    const float y2 = o[tt][2] * rs * g4[2] * g2 * sigmoidf_(g2), y3 = o[tt][3] * rs * g4[3] * g3 * sigmoidf_(g3);
                    u32x2 yw; yw.x = pk2(y0, y1); yw.y = pk2(y2, y3);
                    *(u32x2*)(yout + (r0 + t) * 1024 + h * 128 + v0) = yw; } }
        }
    }
    __syncthreads();
}

__device__ __forceinline__ void spatial_core(KP P, LAS unsigned char* lds) {
    const int tid = opaque_tid(), w = __builtin_amdgcn_readfirstlane(tid >> 6), lane = tid & 63, fr = lane & 15, fq = lane >> 4;
    bf16_t* z = (bf16_t*)(P->ws + WS_Z); const bf16_t* Wsb = (const bf16_t*)(P->ws + WS_W) + OFF_C_WS;
    constexpr int PVh = 544, PW = 288;
    LAS unsigned char* Vh = lds; LAS unsigned char* Wg = lds + 69632; LAS float* mu = (LAS float*)(lds + 106496); LAS float* rsd = mu + 128;
    for (int unit = blockIdx.x; unit < 512; unit += gridDim.x) {
        const size_t r0 = (size_t)unit * 128;
        __syncthreads();
        for (int rr = 0; rr < 16; ++rr) { const int row = 16 * w + rr; const bf16_t* vp = z + (r0 + row) * 4096 + 2048;
            float x[32]; float s = 0.f;
#pragma unroll
            for (int q = 0; q < 4; ++q) { const u32x4 v = *(const u32x4*)(vp + (q * 64 + lane) * 8);
                x[q * 8 + 0] = bflo(v.x); x[q * 8 + 1] = bfhi(v.x); x[q * 8 + 2] = bflo(v.y); x[q * 8 + 3] = bfhi(v.y); x[q * 8 + 4] = bflo(v.z); x[q * 8 + 5] = bfhi(v.z); x[q * 8 + 6] = bflo(v.w); x[q * 8 + 7] = bfhi(v.w); }
#pragma unroll
            for (int e = 0; e < 32; ++e) s += x[e];
            s = wave_sum(s); const float mean = s * (1.0f / 2048.0f); float qd = 0.f;
#pragma unroll
            for (int e = 0; e < 32; ++e) { const float d = x[e] - mean; qd += d * d; }
            qd = wave_sum(qd);
            if (lane == 0) { mu[row] = mean; rsd[row] = __builtin_amdgcn_rsqf(qd * (1.0f / 2048.0f) + EPS); } }
        __syncthreads();
        for (int g = 0; g < 8; ++g) {
            { const int pc = tid & 31; float gn[8], bi[8];
#pragma unroll
                for (int e = 0; e < 8; ++e) { gn[e] = P->in[I_CLG][g * 256 + pc * 8 + e]; bi[e] = P->in[I_CLB][g * 256 + pc * 8 + e]; }
#pragma unroll
                for (int i = 0; i < 8; ++i) { const int row = (tid >> 5) + i * 16;
                    const u32x4 v = *(const u32x4*)(z + (r0 + row) * 4096 + 2048 + g * 256 + pc * 8); const float m = mu[row], r = rsd[row];
                    u32x4 o; o.x = pk2((bflo(v.x) - m) * r * gn[0] + bi[0], (bfhi(v.x) - m) * r * gn[1] + bi[1]); o.y = pk2((bflo(v.y) - m) * r * gn[2] + bi[2], (bfhi(v.y) - m) * r * gn[3] + bi[3]);
                    o.z = pk2((bflo(v.z) - m) * r * gn[4] + bi[4], (bfhi(v.z) - m) * r * gn[5] + bi[5]); o.w = pk2((bflo(v.w) - m) * r * gn[6] + bi[6], (bfhi(v.w) - m) * r * gn[7] + bi[7]);
                    *(LAS u32x4*)(Vh + row * PVh + pc * 16) = o; }
#pragma unroll
                for (int i = 0; i < 4; ++i) { const int idx = tid + i * 512, row = idx >> 4, p2 = idx & 15;
                    *(LAS u32x4*)(Wg + row * PW + p2 * 16) = *(const u32x4*)(Wsb + (size_t)g * 16384 + row * 128 + p2 * 8); } }
            __syncthreads();
            bf16x8 bf[2][4];
#pragma unroll
            for (int ci = 0; ci < 2; ++ci)
#pragma unroll
                for (int ks = 0; ks < 4; ++ks) bf[ci][ks] = ldt(Vh + (ks * 32) * PVh + (16 * (2 * w + ci)) * 2, PVh, fr, fq);
#pragma unroll
            for (int tt = 0; tt < 8; ++tt) { f32x4 a0 = (f32x4){0.f, 0.f, 0.f, 0.f}, a1 = a0;
#pragma unroll
                for (int ks = 0; ks < 4; ++ks) if (ks <= (tt >> 1)) { const bf16x8 af = ldk(Wg + (16 * tt + fr) * PW + ks * 64 + fq * 16); a0 = MFMA16(bf[0][ks], af, a0); a1 = MFMA16(bf[1][ks], af, a1); }
                const int t = 16 * tt + fr; const float bs = P->in[I_CSB][g * 128 + t];
                bf16_t* up = z + (r0 + t) * 4096 + g * 256 + 32 * w + fq * 4;
                { const u32x2 uu = *(const u32x2*)up; u32x2 yw; yw.x = pk2(bflo(uu.x) * (a0[0] + bs), bfhi(uu.x) * (a0[1] + bs)); yw.y = pk2(bflo(uu.y) * (a0[2] + bs), bfhi(uu.y) * (a0[3] + bs)); *(u32x2*)up = yw; }
                { const u32x2 uu = *(const u32x2*)(up + 16); u32x2 yw; yw.x = pk2(bflo(uu.x) * (a1[0] + bs), bfhi(uu.x) * (a1[1] + bs)); yw.y = pk2(bflo(uu.y) * (a1[2] + bs), bfhi(uu.y) * (a1[3] + bs)); *(u32x2*)(up + 16) = yw; } }
            __syncthreads();
        }
    }
    __syncthreads();
}

__device__ __forceinline__ void conv_pass(KP P) {
    const bf16_t* z = (const bf16_t*)(P->ws + WS_Z); bf16_t* xc = (bf16_t*)(P->ws + WS_YP);
    const int gtid = blockIdx.x * NTHREADS + opaque_tid(), nth = gridDim.x * NTHREADS;
    const int oct = gtid & 127;
    float cw[4][8], cb[8];
#pragma unroll
    for (int e = 0; e < 8; ++e) { cb[e] = P->in[I_DCB][oct * 8 + e];
#pragma unroll
        for (int j = 0; j < 4; ++j) cw[j][e] = P->in[I_DCW][j * 1024 + oct * 8 + e]; }
    for (int idx = gtid; idx < (MTOK / 8) * 128; idx += nth) {
        const int r0 = (idx >> 7) * 8; const bool first = (r0 & (SEQL - 1)) == 0;
        u32x4 xr[11];
#pragma unroll
        for (int i = 0; i < 11; ++i) { xr[i] = (u32x4){0u, 0u, 0u, 0u}; if (i >= 3 || !first) xr[i] = *(const u32x4*)(z + (size_t)(r0 - 3 + i) * 2048 + 1024 + oct * 8); }
#pragma unroll
        for (int o = 0; o < 8; ++o) { float a[8];
#pragma unroll
            for (int e = 0; e < 8; ++e) a[e] = cb[e];
#pragma unroll
            for (int j = 0; j < 4; ++j) { const u32x4 v = xr[o + j];
                a[0] += cw[j][0] * bflo(v.x); a[1] += cw[j][1] * bfhi(v.x); a[2] += cw[j][2] * bflo(v.y); a[3] += cw[j][3] * bfhi(v.y);
                a[4] += cw[j][4] * bflo(v.z); a[5] += cw[j][5] * bfhi(v.z); a[6] += cw[j][6] * bflo(v.w); a[7] += cw[j][7] * bfhi(v.w); }
            u32x4 ow; ow.x = pk2(a[0], a[1]); ow.y = pk2(a[2], a[3]); ow.z = pk2(a[4], a[5]); ow.w = pk2(a[6], a[7]);
            *(u32x4*)(xc + (size_t)(r0 + o) * 1024 + oct * 8) = ow; }
    }
}
__device__ __forceinline__ void scan_pass(KP P, LAS unsigned char* lds) {
    const bf16_t* z = (const bf16_t*)(P->ws + WS_Z); const bf16_t* loga = z + (size_t)MTOK * 2048; const bf16_t* beta = loga + (size_t)MTOK * 1024; bf16_t* y = (bf16_t*)(P->ws + WS_YP);
    LAS float* sA = (LAS float*)lds; LAS float* sB = sA + 512 * 8;
    const int tid = opaque_tid(), seg = tid >> 4, o = tid & 15;
    for (int unit = blockIdx.x; unit < 256; unit += gridDim.x) {
        const int b = unit >> 3; const int ch0 = ((unit & 7) * 16 + o) * 8; const size_t row0 = (size_t)b * SEQL + seg * 64;
        float SL[8], B[8];
#pragma unroll
        for (int e = 0; e < 8; ++e) { SL[e] = 0.f; B[e] = 0.f; }
#pragma unroll 4
        for (int t = 0; t < 64; ++t) { const u32x4 lv = *(const u32x4*)(loga + (row0 + t) * 1024 + ch0), bv = *(const u32x4*)(beta + (row0 + t) * 1024 + ch0);
            const float l[8] = {bflo(lv.x), bfhi(lv.x), bflo(lv.y), bfhi(lv.y), bflo(lv.z), bfhi(lv.z), bflo(lv.w), bfhi(lv.w)};
            const float be[8] = {bflo(bv.x), bfhi(bv.x), bflo(bv.y), bfhi(bv.y), bflo(bv.z), bfhi(bv.z), bflo(bv.w), bfhi(bv.w)};
#pragma unroll
            for (int e = 0; e < 8; ++e) { B[e] = __expf(l[e]) * B[e] + be[e]; SL[e] += l[e]; } }
        __syncthreads();
#pragma unroll
        for (int e = 0; e < 8; ++e) { sA[tid * 8 + e] = __expf(SL[e]); sB[tid * 8 + e] = B[e]; }
        __syncthreads();
        float H[8];
#pragma unroll
        for (int e = 0; e < 8; ++e) H[e] = 0.f;
        for (int s = 0; s < seg; ++s) {
#pragma unroll
            for (int e = 0; e < 8; ++e) H[e] = sA[(s * 16 + o) * 8 + e] * H[e] + sB[(s * 16 + o) * 8 + e]; }
        for (int t0 = 0; t0 < 64; t0 += 4) { u32x4 lvv[4], bvv[4], gvv[4];
#pragma unroll
            for (int i = 0; i < 4; ++i) { lvv[i] = *(const u32x4*)(loga + (row0 + t0 + i) * 1024 + ch0); bvv[i] = *(const u32x4*)(beta + (row0 + t0 + i) * 1024 + ch0); gvv[i] = *(const u32x4*)(z + (row0 + t0 + i) * 2048 + ch0); }
#pragma unroll
            for (int i = 0; i < 4; ++i) { const u32x4 lv = lvv[i], bv = bvv[i], gv = gvv[i];
                const float l[8] = {bflo(lv.x), bfhi(lv.x), bflo(lv.y), bfhi(lv.y), bflo(lv.z), bfhi(lv.z), bflo(lv.w), bfhi(lv.w)};
                const float be[8] = {bflo(bv.x), bfhi(bv.x), bflo(bv.y), bfhi(bv.y), bflo(bv.z), bfhi(bv.z), bflo(bv.w), bfhi(bv.w)};
                const float gg[8] = {bflo(gv.x), bfhi(gv.x), bflo(gv.y), bfhi(gv.y), bflo(gv.z), bfhi(gv.z), bflo(gv.w), bfhi(gv.w)};
                float yv[8];
#pragma unroll
                for (int e = 0; e < 8; ++e) { H[e] = __expf(l[e]) * H[e] + be[e]; yv[e] = H[e] * gelu_tanh(gg[e]); }
                u32x4 ow; ow.x = pk2(yv[0], yv[1]); ow.y = pk2(yv[2], yv[3]); ow.z = pk2(yv[4], yv[5]); ow.w = pk2(yv[6], yv[7]);
                *(u32x4*)(y + (row0 + t0 + i) * 1024 + ch0) = ow; } }
    }
    __syncthreads();
}

constexpr int NPHASES = 39;
enum { T_PREP, T_GEMM, T_GEMMRG, T_ROW, T_MLSTM, T_HGRN, T_SPATIAL, T_CONV, T_SCAN };
__device__ __forceinline__ void decode(int ph, int& type, int& layer, int& sub) {
    if (ph == 0) { type = T_PREP; layer = 0; sub = 0; return; }
    int base, cbase;
    if (ph < 10) { layer = 0; base = 1; cbase = 4; } else if (ph < 19) { layer = 1; base = 10; cbase = 13; } else if (ph < 28) { layer = 2; base = 19; cbase = 22; } else { layer = 3; base = 28; cbase = 33; }
    if (ph >= cbase) { const int k = ph - cbase;
        if (k == 0) { type = T_ROW; sub = 1; } else if (k == 1) { type = T_GEMM; sub = 2; } else if (k == 2) { type = T_GEMM; sub = 3; } else if (k == 3) { type = T_ROW; sub = 2; } else if (k == 4) { type = T_GEMM; sub = 4; } else { type = T_ROW; sub = 3; }
        return; }
    const int k = ph - base;
    if (layer < 3) { if (k == 0) { type = T_GEMM; sub = 0; } else if (k == 1) { type = layer == 0 ? T_MLSTM : layer == 1 ? T_HGRN : T_SPATIAL; sub = 0; } else { type = T_GEMM; sub = 1; } }
    else { if (k == 0) { type = T_GEMM; sub = 0; } else if (k == 1) { type = T_CONV; sub = 0; } else if (k == 2) { type = T_GEMMRG; sub = 0; } else if (k == 3) { type = T_SCAN; sub = 0; } else { type = T_GEMM; sub = 1; } }
}

__global__ void __launch_bounds__(NTHREADS, 2) fwd_kernel(Params Pk) {
    extern __shared__ __attribute__((aligned(16))) unsigned char smem[];
    LAS unsigned char* lds = (LAS unsigned char*)smem;
    const int ph_lo = Pk.ph_lo, ph_hi = Pk.ph_hi;
    if (ph_lo < 0) cg::this_grid().sync();
    volatile LAS unsigned* bst = (volatile LAS unsigned*)(lds + (LDS_BYTES - 16));
    if (threadIdx.x == 0) { bst[0] = 0u; bst[1] = 0u; }
    __syncthreads();
    const XcdBarrier gbar = xcd_barrier_post((unsigned*)(Pk.ws + WS_BAR), bst);
    for (int ph = ph_lo; ph < ph_hi; ++ph) {
        KP P = (KP)__builtin_amdgcn_kernarg_segment_ptr();
        asm volatile("" : "+s"(P));
        unsigned char* ws = P->ws;
        bf16_t* W = (bf16_t*)(ws + WS_W); bf16_t* HN = (bf16_t*)(ws + WS_HN); bf16_t* Z = (bf16_t*)(ws + WS_Z); bf16_t* YP = (bf16_t*)(ws + WS_YP); bf16_t* PB = (bf16_t*)(ws + WS_PB);
        int type, layer, sub; decode(ph, type, layer, sub);
        if (type == T_PREP) prep_phase(P, lds);
        else if (type == T_GEMM) {
            const int njobs = (sub == 2) ? 2 : 1;
            for (int j = 0; j < njobs; ++j) {
                pg8::Gemm g; EpiGen e; e.gate = nullptr; e.gate_pn = -1; e.act = 0; g.M = MTOK;
                bf16_t* L = W + (size_t)layer * LW;
                if (sub == 0) { g.A = HN; g.lda = 1024; g.K = 1024; g.ldb = 1024; e.O = Z;
                    if (layer == 0) { g.Bt = W + OFF_A_IN; g.N = 3328; e.ldc = 3072; e.gate = (float*)(ws + WS_GATE); e.gate_pn = 12; }
                    else if (layer == 1) { g.Bt = W + OFF_B_IN; g.N = 4096; e.ldc = 4096; }
                    else if (layer == 2) { g.Bt = W + OFF_C_IN; g.N = 4096; e.ldc = 4096; e.act = 1; }
                    else { g.Bt = W + OFF_D_IN; g.N = 2048; e.ldc = 2048; } }
                else if (sub == 1) { g.N = 1024; e.O = HN; e.ldc = 1024;
                    if (layer == 2) { g.A = Z; g.lda = 4096; g.K = 2048; g.ldb = 2048; g.Bt = W + OFF_C_OUT; }
                    else { g.A = YP; g.lda = 1024; g.K = 1024; g.ldb = 1024; g.Bt = W + (layer == 0 ? OFF_A_OUT : layer == 1 ? OFF_B_OUT : OFF_D_OUT); } }
                else if (sub == 2) {
                    if (j == 0) { g.A = HN; g.lda = 1024; g.K = 1024; g.ldb = 1024; g.Bt = L; g.N = 4096; e.O = Z; e.ldc = 4096; e.act = 2; }
                    else { g.A = PB; g.lda = 256; g.K = 256; g.ldb = 256; g.Bt = L + W_UP + W_DN + W_G; g.N = 1024; e.O = YP; e.ldc = 1024; } }
                else if (sub == 3) { g.A = Z; g.lda = 4096; g.K = 4096; g.ldb = 4096; g.Bt = L + W_UP; g.N = 1024; e.O = HN; e.ldc = 1024; }
                else { g.A = HN; g.lda = 1024; g.K = 1024; g.ldb = 1024; g.Bt = L + W_UP + W_DN; g.N = 1024; e.O = YP; e.ldc = 1024; e.act = 3; }
                pg8::StaticOrder S; S.init(g.M, g.N, (int)gridDim.x, (int)blockIdx.x);
                pg8::gemm_phase<EpiGen>(lds, g, S, e);
            }
        }
        else if (type == T_GEMMRG) {
            for (int blk = 0; blk < 4; ++blk) {
                pg8::Gemm g; g.M = MTOK; g.N = 512; g.K = 256; g.A = YP + blk * 256; g.lda = 1024; g.Bt = W + OFF_D_G + (size_t)blk * 512 * 256; g.ldb = 256;
                EpiRg e; e.xc = YP; e.loga = Z + (size_t)MTOK * 2048; e.beta = e.loga + (size_t)MTOK * 1024; e.b_a = P->in[I_DBA]; e.b_x = P->in[I_DBX]; e.spt = (const float*)(ws + WS_LB) + 1024; e.blk = blk;
                pg8::StaticOrder S; S.init(g.M, g.N, (int)gridDim.x, (int)blockIdx.x);
                pg8::gemm_phase<EpiRg>(lds, g, S, e);
            }
        }
        else if (type == T_ROW) {
            const float* ng = P->in[I_NG] + (size_t)layer * 5 * 1024;
            bf16_t* HBuf = (bf16_t*)P->out;
            if (sub == 1) rowpass(layer == 0 ? P->in[I_X] : nullptr, HBuf, HN, ng + 1024, nullptr, HBuf, ng + 2048, HN, 1, P->in[I_P] + (size_t)layer * MTOK * 256, PB);
            else if (sub == 2) rowpass(nullptr, HBuf, HN, ng + 3072, nullptr, nullptr, nullptr, HN, 0, nullptr, nullptr);
            else if (layer < 3) rowpass(nullptr, HN, YP, ng + 4096, nullptr, HBuf, ng + 5120, HN, 1, nullptr, nullptr);
            else rowpass(nullptr, HN, YP, ng + 4096, P->out, nullptr, nullptr, nullptr, 0, nullptr, nullptr);
        }
        else if (type == T_MLSTM) mlstm_core(P, lds);
        else if (type == T_HGRN) hgrn_core(P, lds);
        else if (type == T_SPATIAL) spatial_core(P, lds);
        else if (type == T_CONV) conv_pass(P);
        else if (type == T_SCAN) scan_pass(P, lds);
        if (ph + 1 < ph_hi) xcd_barrier(gbar);
    }
}

extern "C" void kernel_launch(void* const* d_in, const int* in_sizes, int n_in, void* d_out, int out_size, void* d_ws, size_t ws_size, hipStream_t stream) {
    static int grid = 0;
    if (grid == 0) {
        if (n_in != 31 || in_sizes[0] != MTOK * DM || out_size != MTOK * DM || ws_size < WS_END) { fprintf(stderr, "kernel_launch: unexpected shapes (n_in %d, ws %zu)\n", n_in, ws_size); grid = -1; return; }
        int dev = 0, cus = 0, per_cu = 0;
        hipGetDevice(&dev); hipDeviceGetAttribute(&cus, hipDeviceAttributeMultiprocessorCount, dev);
        hipFuncSetAttribute((const void*)fwd_kernel, hipFuncAttributeMaxDynamicSharedMemorySize, LDS_BYTES);
        hipOccupancyMaxActiveBlocksPerMultiprocessor(&per_cu, (const void*)fwd_kernel, NTHREADS, LDS_BYTES);
        if (per_cu < 1) per_cu = 1;
        grid = cus * per_cu;
        (void)hipGetLastError();
    }
    if (grid < 0) return;
    Params p{};
    for (int i = 0; i < 31; ++i) p.in[i] = (const float*)d_in[i];
    p.out = (float*)d_out; p.ws = (unsigned char*)d_ws;
    (void)hipMemsetAsync((unsigned char*)d_ws + WS_BAR, 0, XCD_BAR_WORDS * sizeof(unsigned), stream);
#if ONE_LAUNCH
    p.ph_lo = 0; p.ph_hi = NPHASES;
    void* args[] = {&p};
    hipError_t e = hipLaunchCooperativeKernel((const void*)fwd_kernel, dim3(grid), dim3(NTHREADS), args, LDS_BYTES, stream);
    if (e != hipSuccess) fprintf(stderr, "cooperative launch failed: %s (grid %d)\n", hipGetErrorString(e), grid);
#else
    for (int ph = 0; ph < NPHASES; ++ph) { p.ph_lo = ph; p.ph_hi = ph + 1; hipLaunchKernelGGL(fwd_kernel, dim3(grid), dim3(NTHREADS), LDS_BYTES, stream, p); }
#endif
}
```

```cpp
#include <hip/hip_runtime.h>
#include <hip/hip_cooperative_groups.h>
#include <cstdio>
namespace cg = cooperative_groups;

#ifndef ONE_LAUNCH
#define ONE_LAUNCH 1
#endif

#define LAS __attribute__((address_space(3)))
typedef unsigned short bf16_t;
typedef short bf16x8 __attribute__((ext_vector_type(8)));
typedef short s16x4 __attribute__((ext_vector_type(4)));
typedef float f32x4 __attribute__((ext_vector_type(4)));
typedef float f32x2 __attribute__((ext_vector_type(2)));
typedef unsigned u32x4 __attribute__((ext_vector_type(4)));
typedef unsigned u32x2 __attribute__((ext_vector_type(2)));

constexpr int MTOK = 65536, DM = 1024, SEQL = 2048;
constexpr float EPS = 1e-6f;
constexpr int NTHREADS = 512;
constexpr int LDS_BYTES = 147456;

constexpr size_t W_UP = 4096ull * 1024, W_DN = 1024ull * 4096, W_G = 1024ull * 1024, W_PU = 1024ull * 256;
constexpr size_t LW = W_UP + W_DN + W_G + W_PU;
constexpr size_t OFF_A_IN = 4 * LW;
constexpr size_t OFF_A_OUT = OFF_A_IN + 3328ull * 1024;
constexpr size_t OFF_B_IN = OFF_A_OUT + 1024ull * 1024;
constexpr size_t OFF_B_OUT = OFF_B_IN + 4096ull * 1024;
constexpr size_t OFF_C_IN = OFF_B_OUT + 1024ull * 1024;
constexpr size_t OFF_C_OUT = OFF_C_IN + 4096ull * 1024;
constexpr size_t OFF_C_WS = OFF_C_OUT + 1024ull * 2048;
constexpr size_t OFF_D_IN = OFF_C_WS + 8ull * 128 * 128;
constexpr size_t OFF_D_G = OFF_D_IN + 2048ull * 1024;
constexpr size_t OFF_D_OUT = OFF_D_G + 4ull * 512 * 256;
constexpr size_t W_TOTAL = OFF_D_OUT + 1024ull * 1024;
constexpr size_t MiB = 1024ull * 1024;
static_assert(W_TOTAL * 2 <= 112 * MiB, "weights region");
constexpr size_t WS_W = 0, WS_HN = 112 * MiB, WS_Z = 240 * MiB, WS_YP = 752 * MiB, WS_PB = 880 * MiB, WS_GATE = 912 * MiB, WS_LB = 916 * MiB, WS_BAR = 917 * MiB, WS_END = 918 * MiB;

struct Params {
    const float* in[31];
    float* out;
    unsigned char* ws;
    int ph_lo, ph_hi;
};
typedef const __attribute__((address_space(4))) Params* KP;
enum { I_X = 0, I_P, I_NG, I_WUP, I_WDN, I_PUP, I_PG, I_AIN, I_AIB, I_AFB, I_AHG, I_AOUT, I_BIN, I_BLB, I_BHG, I_BOUT, I_CIN, I_CLG, I_CLB, I_CSW, I_CSB, I_COUT,
       I_DIN, I_DCW, I_DCB, I_DWA, I_DBA, I_DWX, I_DBX, I_DLAM, I_DOUT };

__device__ __forceinline__ float bf2f(bf16_t b) { return __uint_as_float(((unsigned)b) << 16); }
__device__ __forceinline__ float bflo(unsigned u) { return __uint_as_float(u << 16); }
__device__ __forceinline__ float bfhi(unsigned u) { return __uint_as_float(u & 0xffff0000u); }
__device__ __forceinline__ unsigned pk2(float lo, float hi) { unsigned r; asm("v_cvt_pk_bf16_f32 %0, %1, %2" : "=v"(r) : "v"(lo), "v"(hi)); return r; }
__device__ __forceinline__ bf16_t f2bf(float f) { return (bf16_t)(pk2(f, 0.f) & 0xffffu); }
__device__ __forceinline__ float fast_rcp(float x) { return __builtin_amdgcn_rcpf(x); }
__device__ __forceinline__ float sigmoidf_(float x) { return fast_rcp(1.0f + __expf(-x)); }
__device__ __forceinline__ float gelu_tanh(float x) { const float t = 1.5957691216057308f * (x + 0.044715f * x * x * x); return x * fast_rcp(1.0f + __expf(-t)); }
__device__ __forceinline__ float wave_sum(float v) {
#pragma unroll
    for (int o = 32; o >= 1; o >>= 1) v += __shfl_xor(v, o);
    return v;
}
__device__ __forceinline__ bf16x8 as_bf16x8(u32x4 v) { union { u32x4 u; bf16x8 b; } x; x.u = v; return x.b; }
__device__ __forceinline__ u32x4 as_u32x4(bf16x8 v) { union { u32x4 u; bf16x8 b; } x; x.b = v; return x.u; }
__device__ __forceinline__ bf16x8 ldk(const LAS unsigned char* p) { return *(const LAS bf16x8*)p; }
__device__ __forceinline__ bf16x8 ldt(const LAS unsigned char* base, int pitch, int fr, int fq) {
    const LAS unsigned char* p = base + (fq * 8 + (fr >> 2)) * pitch + (fr & 3) * 8;
    s16x4 a = __builtin_amdgcn_ds_read_tr16_b64_v4i16((LAS s16x4*)p);
    s16x4 b = __builtin_amdgcn_ds_read_tr16_b64_v4i16((LAS s16x4*)(p + 4 * pitch));
    bf16x8 r = {a[0], a[1], a[2], a[3], b[0], b[1], b[2], b[3]};
    return r;
}
__device__ __forceinline__ int opaque_tid() { int t = threadIdx.x; asm volatile("" : "+v"(t)); return t; }
#define MFMA16(a, b, c) __builtin_amdgcn_mfma_f32_16x16x32_bf16((a), (b), (c), 0, 0, 0)


#define XB_TMO      128
#define XB_XCNT(j)  (256  + 64 * (j))
#define XB_XSUB(j)  (1280 + 64 * (j))
#define XB_XGEN(j)  (2304 + 64 * (j))
#define XB_TOP      3328
#define XB_TOPGEN   3392
#define XCD_BAR_WORDS 3456
#define XB_SPIN_CAP (1u << 20)
__device__ __forceinline__ unsigned xb_ld(unsigned* p)              { return __hip_atomic_load(p, __ATOMIC_RELAXED, __HIP_MEMORY_SCOPE_AGENT); }
__device__ __forceinline__ unsigned xb_add(unsigned* p, unsigned v) { return __hip_atomic_fetch_add(p, v, __ATOMIC_RELAXED, __HIP_MEMORY_SCOPE_AGENT); }
__device__ __forceinline__ unsigned xb_xcc_id() { return (unsigned)__builtin_amdgcn_s_getreg((3 << 11) | 20) & 0xFu; }
#define XB_SPIN(cond, bar) do { unsigned _sp = 0; while (cond) { __builtin_amdgcn_s_sleep(1); \
    if ((++_sp & 255u) == 0u) { if (xb_ld(&(bar)[XB_TMO])) break; if (_sp > XB_SPIN_CAP) { atomicAdd(&(bar)[XB_TMO], 1u); break; } } } } while (0)
struct XcdBarrier { unsigned* bar; unsigned x; volatile LAS unsigned* st; };
__device__ __forceinline__ XcdBarrier xcd_barrier_post(unsigned* bar, volatile LAS unsigned* st) {
    XcdBarrier b; b.bar = bar; b.x = xb_xcc_id(); b.st = st;
    if (threadIdx.x == 0) (void)xb_add(&bar[XB_XCNT(b.x)], 1u);
    return b;
}
__device__ __forceinline__ void xcd_barrier_complete(unsigned* bar, unsigned x, unsigned& nloc, unsigned& nx) {
    const unsigned G = gridDim.x * gridDim.y * gridDim.z;
    unsigned sum, cnt, mine, sp = 0u;
    for (;;) {
        sum = 0u; cnt = 0u; mine = 0u;
#pragma unroll
        for (unsigned j = 0; j < 16; ++j) { const unsigned c = xb_ld(&bar[XB_XCNT(j)]); sum += c; cnt += (c > 0u) ? 1u : 0u; mine = (j == x) ? c : mine; }
        if (sum == G) break;
        __builtin_amdgcn_s_sleep(1);
        if ((++sp & 255u) == 0u) { if (xb_ld(&bar[XB_TMO])) break; if (sp > XB_SPIN_CAP) { atomicAdd(&bar[XB_TMO], 1u); break; } }
    }
    nloc = mine > 0u ? mine : 1u; nx = cnt > 0u ? cnt : 1u;
}
__device__ __forceinline__ void xcd_barrier(const XcdBarrier& b) {
    asm volatile("s_waitcnt vmcnt(0)" ::: "memory");
    __syncthreads();
    if (threadIdx.x == 0) {
        unsigned* bar = b.bar;
        __builtin_amdgcn_s_waitcnt(0);
        unsigned nloc = b.st[0], nx = b.st[1];
        if (nloc == 0u) { xcd_barrier_complete(bar, b.x, nloc, nx); b.st[0] = nloc; b.st[1] = nx; }
        const unsigned old = xb_add(&bar[XB_XSUB(b.x)], 1u);
        const unsigned gen = old / nloc;
        if (old + 1u == (gen + 1u) * nloc) {
            __builtin_amdgcn_fence(__ATOMIC_RELEASE, "agent");
            asm volatile("s_waitcnt vmcnt(0)" ::: "memory");
            const unsigned og = xb_add(&bar[XB_TOP], 1u);
            const unsigned tg = og / nx;
            if (og + 1u == (tg + 1u) * nx) xb_add(&bar[XB_TOPGEN], 1u);
            else XB_SPIN(xb_ld(&bar[XB_TOPGEN]) == tg, bar);
            __builtin_amdgcn_fence(__ATOMIC_ACQUIRE, "agent");
            xb_add(&bar[XB_XGEN(b.x)], 1u);
            asm volatile("s_waitcnt vmcnt(0)" ::: "memory");
        } else {
            XB_SPIN(xb_ld(&bar[XB_XGEN(b.x)]) == gen, bar);
            __builtin_amdgcn_fence(__ATOMIC_ACQUIRE, "agent");
            asm volatile("s_waitcnt vmcnt(0)" ::: "memory");
        }
    }
    __syncthreads();
}

namespace pg8 {
constexpr int BM = 256, BK = 64, HALF = 128, HTB = HALF * BK * 2, STAGE_BYTES = 8 * HTB, NXCD = 8, WGM = 8;
__device__ __forceinline__ int lds_byte(int r, int c) { const int st = (r >> 4) * 2 + (c >> 5), rr = r & 15, cc = c & 31, ob = rr * 64 + cc * 2; return st * 1024 + (ob ^ (((ob >> 9) & 1) << 5)); }
__device__ __forceinline__ void stage_rc(int b, int& R, int& C) { const int st = b / 1024, sb = b % 1024, swz = sb ^ (((sb >> 9) & 1) << 5); R = (st >> 1) * 16 + swz / 64; C = (st & 1) * 32 + (swz % 64) / 2; }
__device__ __forceinline__ int perm32(int rho) { const int n = rho >> 4, i = rho & 15; return 8 * (i >> 2) + 4 * n + (i & 3); }
struct Unit { int pm, pn; };
struct Gemm { const bf16_t* A; const bf16_t* Bt; int M, N, K, lda, ldb; };
struct StaticOrder {
    int nM, nN, nwg, G, c;
    __device__ void init(int M, int N, int G_, int c_) { nM = M / BM; nN = N / BM; nwg = nM * nN; G = G_; c = c_; }
    __device__ bool next(int i, Unit& u) const {
        const long L = (long)i * G + c; if (L >= nwg) return false;
        int wgid = (int)L; { const int q = nwg / NXCD, r = nwg % NXCD, xcd = wgid % NXCD, off = wgid / NXCD; wgid = (xcd < r ? xcd * (q + 1) : r * (q + 1) + (xcd - r) * q) + off; }
        const int nig = WGM * nN, gid = wgid / nig, fm = gid * WGM, gsz = (nM - fm) < WGM ? (nM - fm) : WGM;
        u.pm = fm + ((wgid % nig) % gsz); u.pn = (wgid % nig) / gsz; return true;
    }
};
template <class Epi>
__device__ __forceinline__ void gemm_phase(LAS unsigned char* lds, const Gemm g, const StaticOrder& S, const Epi& E) {
    const int tid = opaque_tid(), wid = __builtin_amdgcn_readfirstlane(tid >> 6), lane = tid & 63, wr = wid >> 2, wc = wid & 3, fr = lane & 15, fq = lane >> 4;
    const int K = g.K, nt = K / BK;
    unsigned voffA[2], voffB[2];
#pragma unroll
    for (int i = 0; i < 2; ++i) { int R, C; stage_rc(tid * 16 + i * 8192, R, C); const int Rb = (R & ~31) + perm32(R & 31);
        voffA[i] = (unsigned)(R * g.lda + C) * 2u; voffB[i] = (unsigned)(Rb * g.ldb + C) * 2u; }
    const size_t kstep = (size_t)(BK * 2);
    const size_t hstepA = (size_t)HALF * g.lda * 2, hstepB = (size_t)HALF * g.ldb * 2;
    const size_t tstepA = 2 * hstepA, tstepB = 2 * hstepB;
    const unsigned ldsw = (unsigned)wid * 1024u;
    const int aoff = lds_byte(wr * 64 + fr, fq * 8), boff = lds_byte(wc * 32 + fr, fq * 8);
#define PG8_SA(b, h) (((b) * 2 + (h)) * HTB)
#define PG8_SB(b, h) ((4 + (b) * 2 + (h)) * HTB)
#define PG8_STAGE(bufoff, gbase, voff) do { _Pragma("unroll") for (int _i = 0; _i < 2; ++_i) \
        __builtin_amdgcn_global_load_lds((const unsigned*)((const char*)(gbase) + (voff)[_i]), (LAS unsigned*)(lds + (bufoff) + ldsw + _i * 8192), 16, 0, 0); } while (0)
#define PG8_LDA(dst, b, h) do { _Pragma("unroll") for (int m = 0; m < 4; ++m) _Pragma("unroll") for (int k = 0; k < 2; ++k) dst[m][k] = *(const LAS bf16x8*)(lds + PG8_SA(b, h) + aoff + m * 2048 + k * 1024); } while (0)
#define PG8_LDB(dst, b, h) do { _Pragma("unroll") for (int n = 0; n < 2; ++n) _Pragma("unroll") for (int k = 0; k < 2; ++k) dst[n][k] = *(const LAS bf16x8*)(lds + PG8_SB(b, h) + boff + n * 2048 + k * 1024); } while (0)
#define PG8_MMA(ai, bj, At, Bt) do { __builtin_amdgcn_s_setprio(1); _Pragma("unroll") for (int m = 0; m < 4; ++m) _Pragma("unroll") for (int n = 0; n < 2; ++n) _Pragma("unroll") for (int k = 0; k < 2; ++k) \
        acc[ai][bj][m][n] = __builtin_amdgcn_mfma_f32_16x16x32_bf16(Bt[n][k], At[m][k], acc[ai][bj][m][n], 0, 0, 0); __builtin_amdgcn_s_setprio(0); } while (0)
#define PG8_WAIT_V(n) asm volatile("s_waitcnt vmcnt(" #n ")" ::: "memory")
#define PG8_WAIT_L(n) asm volatile("s_waitcnt lgkmcnt(" #n ")" ::: "memory")
#define PG8_BAR __builtin_amdgcn_s_barrier()
#define PG8_SCHED __builtin_amdgcn_sched_barrier(0)
    Unit cur, nxt; int ui = 0;
    if (!S.next(0, cur)) return;
    f32x4 acc[2][2][4][2];
#pragma unroll
    for (int a = 0; a < 2; ++a)
#pragma unroll
        for (int b = 0; b < 2; ++b)
#pragma unroll
            for (int m = 0; m < 4; ++m)
#pragma unroll
                for (int n = 0; n < 2; ++n) acc[a][b][m][n] = (f32x4){0.f, 0.f, 0.f, 0.f};
    bf16x8 At[4][2], B0[2][2], B1[2][2];
    const char* cA = (const char*)g.A + (size_t)cur.pm * tstepA; const char* cB = (const char*)g.Bt + (size_t)cur.pn * tstepB;
    PG8_STAGE(PG8_SB(0, 0), cB, voffB); PG8_STAGE(PG8_SA(0, 0), cA, voffA); PG8_STAGE(PG8_SB(0, 1), cB + hstepB, voffB); PG8_STAGE(PG8_SA(0, 1), cA + hstepA, voffA);
    if (wr == 1) PG8_BAR;
    PG8_WAIT_V(4); PG8_BAR;
    PG8_STAGE(PG8_SB(1, 0), cB + kstep, voffB); PG8_STAGE(PG8_SA(1, 0), cA + kstep, voffA); PG8_STAGE(PG8_SB(1, 1), cB + hstepB + kstep, voffB);
    PG8_WAIT_V(6); PG8_BAR;
    for (;;) {
        const bool has_next = S.next(ui + 1, nxt);
        const char* nA = has_next ? (const char*)g.A + (size_t)nxt.pm * tstepA : cA; const char* nB = has_next ? (const char*)g.Bt + (size_t)nxt.pn * tstepB : cB;
        for (int t = 0; t < nt; t += 2) {
            const bool last = (t == nt - 2);
            const char* a1 = cA + (size_t)(t + 1) * kstep;
            const char* a2 = last ? nA : cA + (size_t)(t + 2) * kstep; const char* b2 = last ? nB : cB + (size_t)(t + 2) * kstep;
            const char* a3 = a2 + kstep; const char* b3 = b2 + kstep;
            PG8_LDB(B0, 0, 0); PG8_SCHED; PG8_LDA(At, 0, 0); PG8_STAGE(PG8_SA(1, 1), a1 + hstepA, voffA);
            PG8_WAIT_L(8); PG8_BAR; PG8_WAIT_L(0); PG8_MMA(0, 0, At, B0); PG8_BAR; PG8_SCHED;
            PG8_LDB(B1, 0, 1); PG8_STAGE(PG8_SB(0, 0), b2, voffB);
            PG8_BAR; PG8_WAIT_L(0); PG8_MMA(0, 1, At, B1); PG8_BAR;
            PG8_LDA(At, 0, 1); PG8_STAGE(PG8_SA(0, 0), a2, voffA);
            PG8_BAR; PG8_WAIT_L(0); PG8_MMA(1, 0, At, B0); PG8_BAR; PG8_SCHED;
            PG8_STAGE(PG8_SB(0, 1), b2 + hstepB, voffB);
            PG8_WAIT_V(6); PG8_BAR; PG8_MMA(1, 1, At, B1); PG8_BAR;
            PG8_LDB(B0, 1, 0); PG8_SCHED; PG8_LDA(At, 1, 0); PG8_STAGE(PG8_SA(0, 1), a2 + hstepA, voffA);
            PG8_WAIT_L(8); PG8_BAR; PG8_WAIT_L(0); PG8_MMA(0, 0, At, B0); PG8_BAR; PG8_SCHED;
            PG8_LDB(B1, 1, 1); PG8_STAGE(PG8_SB(1, 0), b3, voffB);
            PG8_BAR; PG8_WAIT_L(0); PG8_MMA(0, 1, At, B1); PG8_BAR;
            PG8_LDA(At, 1, 1); PG8_STAGE(PG8_SA(1, 0), a3, voffA);
            PG8_BAR; PG8_WAIT_L(0); PG8_MMA(1, 0, At, B0); PG8_BAR; PG8_SCHED;
            PG8_STAGE(PG8_SB(1, 1), b3 + hstepB, voffB);
            PG8_WAIT_V(6); PG8_BAR; PG8_MMA(1, 1, At, B1); PG8_BAR;
        }
        E(acc, cur, wr, wc, fr, fq);
        if (!has_next) break;
#pragma unroll
        for (int a = 0; a < 2; ++a)
#pragma unroll
            for (int b = 0; b < 2; ++b)
#pragma unroll
                for (int m = 0; m < 4; ++m)
#pragma unroll
                    for (int n = 0; n < 2; ++n) acc[a][b][m][n] = (f32x4){0.f, 0.f, 0.f, 0.f};
        cur = nxt; cA = nA; cB = nB; ++ui;
    }
    PG8_WAIT_V(0);
    if (wr == 0) PG8_BAR;
    PG8_BAR;
#undef PG8_SA
#undef PG8_SB
#undef PG8_STAGE
#undef PG8_LDA
#undef PG8_LDB
#undef PG8_MMA
#undef PG8_WAIT_V
#undef PG8_WAIT_L
#undef PG8_BAR
#undef PG8_SCHED
}
}

struct EpiGen {
    bf16_t* O; int ldc; int act;
    float* gate; int gate_pn;
    __device__ __forceinline__ void operator()(const f32x4 (&acc)[2][2][4][2], const pg8::Unit& u, int wr, int wc, int fr_, int fq_) const {
        int fr = fr_, fq = fq_; asm volatile("" : "+v"(fr), "+v"(fq));
        const int row0 = u.pm * 256 + wr * 64 + fr;
        if (act == 3) {
            const int col0 = u.pn * 256 + wc * 32 + 8 * fq;
#pragma unroll
            for (int q = 0; q < 4; ++q) { const int ai = q >> 1; u32x4 pv[2][2];
#pragma unroll
                for (int mm = 0; mm < 2; ++mm)
#pragma unroll
                    for (int bj = 0; bj < 2; ++bj) pv[mm][bj] = *(const u32x4*)(O + (size_t)(row0 + ai * 128 + ((q & 1) * 2 + mm) * 16) * ldc + col0 + bj * 128);
#pragma unroll
                for (int mm = 0; mm < 2; ++mm)
#pragma unroll
                    for (int bj = 0; bj < 2; ++bj) { const int m = (q & 1) * 2 + mm; const f32x4 v0 = acc[ai][bj][m][0], v1 = acc[ai][bj][m][1]; const u32x4 pu = pv[mm][bj]; u32x4 w;
                        w.x = pk2(sigmoidf_(v0[0]) * bflo(pu.x), sigmoidf_(v0[1]) * bfhi(pu.x)); w.y = pk2(sigmoidf_(v0[2]) * bflo(pu.y), sigmoidf_(v0[3]) * bfhi(pu.y));
                        w.z = pk2(sigmoidf_(v1[0]) * bflo(pu.z), sigmoidf_(v1[1]) * bfhi(pu.z)); w.w = pk2(sigmoidf_(v1[2]) * bflo(pu.w), sigmoidf_(v1[3]) * bfhi(pu.w));
                        *(u32x4*)(O + (size_t)(row0 + ai * 128 + m * 16) * ldc + col0 + bj * 128) = w; }
                asm volatile("" ::: "memory"); }
            return;
        }
        if (u.pn == gate_pn) {
            if (wc == 0 && fq < 2) {
#pragma unroll
                for (int ai = 0; ai < 2; ++ai)
#pragma unroll
                    for (int m = 0; m < 4; ++m) { float* gp = gate + (size_t)(row0 + ai * 128 + m * 16) * 16 + 8 * fq;
                        *(f32x4*)gp = acc[ai][0][m][0]; *(f32x4*)(gp + 4) = acc[ai][0][m][1]; }
            }
            return;
        }
        const int col0 = u.pn * 256 + wc * 32 + 8 * fq;
#pragma unroll
        for (int ai = 0; ai < 2; ++ai)
#pragma unroll
            for (int m = 0; m < 4; ++m) { bf16_t* rowp = O + (size_t)(row0 + ai * 128 + m * 16) * ldc + col0;
#pragma unroll
                for (int bj = 0; bj < 2; ++bj) { f32x4 v0 = acc[ai][bj][m][0], v1 = acc[ai][bj][m][1];
                    if (act == 1) {
#pragma unroll
                        for (int j = 0; j < 4; ++j) { v0[j] = gelu_tanh(v0[j]); v1[j] = gelu_tanh(v1[j]); }
                    } else if (act == 2) {
#pragma unroll
                        for (int j = 0; j < 4; ++j) { const float a = fmaxf(v0[j], 0.f), b = fmaxf(v1[j], 0.f); v0[j] = a * a; v1[j] = b * b; }
                    } else if (act == 3) {
                        const u32x4 pu = *(const u32x4*)(rowp + bj * 128);
                        v0[0] = sigmoidf_(v0[0]) * bflo(pu.x); v0[1] = sigmoidf_(v0[1]) * bfhi(pu.x); v0[2] = sigmoidf_(v0[2]) * bflo(pu.y); v0[3] = sigmoidf_(v0[3]) * bfhi(pu.y);
                        v1[0] = sigmoidf_(v1[0]) * bflo(pu.z); v1[1] = sigmoidf_(v1[1]) * bfhi(pu.z); v1[2] = sigmoidf_(v1[2]) * bflo(pu.w); v1[3] = sigmoidf_(v1[3]) * bfhi(pu.w);
                    }
                    u32x4 w; w.x = pk2(v0[0], v0[1]); w.y = pk2(v0[2], v0[3]); w.z = pk2(v1[0], v1[1]); w.w = pk2(v1[2], v1[3]);
                    *(u32x4*)(rowp + bj * 128) = w; }
                asm volatile("" ::: "memory"); }
    }
};
struct EpiRg {
    const bf16_t* xc; bf16_t* loga; bf16_t* beta; const float* b_a; const float* b_x; const float* spt; int blk;
    __device__ __forceinline__ void operator()(const f32x4 (&acc)[2][2][4][2], const pg8::Unit& u, int wr, int wc, int fr_, int fq_) const {
        int fr = fr_, fq = fq_; asm volatile("" : "+v"(fr), "+v"(fq));
        const int row0 = u.pm * 256 + wr * 64 + fr;
        const int ch0 = blk * 256 + u.pn * 128 + wc * 32 + 8 * fq;
#pragma unroll
        for (int q = 0; q < 4; ++q) { const int ai = q >> 1; u32x4 xq[2];
#pragma unroll
            for (int mm = 0; mm < 2; ++mm) xq[mm] = *(const u32x4*)(xc + (size_t)(row0 + ai * 128 + ((q & 1) * 2 + mm) * 16) * 1024 + ch0);
            f32x4 ba[2], bx[2], sp[2];
#pragma unroll
            for (int hh = 0; hh < 2; ++hh) { ba[hh] = *(const f32x4*)(b_a + ch0 + hh * 4); bx[hh] = *(const f32x4*)(b_x + ch0 + hh * 4); sp[hh] = *(const f32x4*)(spt + ch0 + hh * 4); }
#pragma unroll
            for (int mm = 0; mm < 2; ++mm) { const int m = (q & 1) * 2 + mm; const size_t off = (size_t)(row0 + ai * 128 + m * 16) * 1024 + ch0; const u32x4 xv = xq[mm];
                u32x4 wl, wb;
#pragma unroll
                for (int hh = 0; hh < 2; ++hh) {
                    const unsigned x01 = hh ? xv.z : xv.x, x23 = hh ? xv.w : xv.y;
                    const float x[4] = {bflo(x01), bfhi(x01), bflo(x23), bfhi(x23)};
                    float la[4], be[4];
#pragma unroll
                    for (int e = 0; e < 4; ++e) { const float rp = acc[ai][0][m][hh][e] + ba[hh][e], ip = acc[ai][1][m][hh][e] + bx[hh][e];
                        const float r = sigmoidf_(rp), ig = sigmoidf_(ip); const float l = sp[hh][e] * r; la[e] = l;
                        be[e] = __builtin_amdgcn_sqrtf(fmaxf(1.0f - __expf(2.0f * l), 0.f)) * ig * x[e]; }
                    if (hh == 0) { wl.x = pk2(la[0], la[1]); wl.y = pk2(la[2], la[3]); wb.x = pk2(be[0], be[1]); wb.y = pk2(be[2], be[3]); }
                    else { wl.z = pk2(la[0], la[1]); wl.w = pk2(la[2], la[3]); wb.z = pk2(be[0], be[1]); wb.w = pk2(be[2], be[3]); }
                }
                *(u32x4*)(loga + off) = wl; *(u32x4*)(beta + off) = wb; }
            asm volatile("" ::: "memory"); }
    }
};

__device__ __forceinline__ void rowpass(const float* hin, const bf16_t* hinb, const bf16_t* y, const float* gadd, float* hout, bf16_t* houtb, const float* gnext, bf16_t* hn, int normnext,
                                        const float* psrc, bf16_t* pdst, const float* rs_in = nullptr, const float* g_in = nullptr, float* rs_out = nullptr) {
    const int tid_ = opaque_tid(); const int lane = tid_ & 63, wave = tid_ >> 6;
    const int gw = blockIdx.x * 8 + wave, nw = gridDim.x * 8;
    f32x4 ga[4], gn[4], gi[4];
#pragma unroll
    for (int q = 0; q < 4; ++q) { gi[q] = (f32x4){1.f, 1.f, 1.f, 1.f}; if (rs_in) { const f32x4 t = *(const f32x4*)(g_in + q * 256 + lane * 4); gi[q] = (f32x4){fast_rcp(t[0]), fast_rcp(t[1]), fast_rcp(t[2]), fast_rcp(t[3])}; } }
#pragma unroll
    for (int q = 0; q < 4; ++q) { ga[q] = y ? *(const f32x4*)(gadd + q * 256 + lane * 4) : (f32x4){0.f, 0.f, 0.f, 0.f}; gn[q] = (hn && normnext) ? *(const f32x4*)(gnext + q * 256 + lane * 4) : (f32x4){1.f, 1.f, 1.f, 1.f}; }
    for (int row0_ = gw; row0_ < MTOK; row0_ += 4 * nw) {
        f32x4 h[4][4]; u32x2 yv[4][4]; f32x4 pv[4]; float rsi[4];
#pragma unroll
        for (int u = 0; u < 4; ++u) { const int row = row0_ + u * nw; rsi[u] = 1.0f; if (row < MTOK) { const size_t base = (size_t)row * DM + lane * 4;
            if (rs_in) rsi[u] = rs_in[row];
            if (hin) {
#pragma unroll
                for (int q = 0; q < 4; ++q) h[u][q] = *(const f32x4*)(hin + base + q * 256);
            } else {
#pragma unroll
                for (int q = 0; q < 4; ++q) { const u32x2 hv = *(const u32x2*)(hinb + base + q * 256); h[u][q] = (f32x4){bflo(hv.x), bfhi(hv.x), bflo(hv.y), bfhi(hv.y)}; }
            }
            if (y) {
#pragma unroll
                for (int q = 0; q < 4; ++q) yv[u][q] = *(const u32x2*)(y + base + q * 256);
            }
            if (psrc) pv[u] = *(const f32x4*)(psrc + (size_t)row * 256 + lane * 4); } }
#pragma unroll
        for (int u = 0; u < 4; ++u) { const int row = row0_ + u * nw; if (row < MTOK) { const size_t base = (size_t)row * DM + lane * 4;
            if (rs_in) { const float ir = fast_rcp(rsi[u]);
#pragma unroll
                for (int q = 0; q < 4; ++q) h[u][q] = h[u][q] * ir * gi[q]; }
            if (y) {
                f32x4 yf[4]; float ss = 0.f;
#pragma unroll
                for (int q = 0; q < 4; ++q) { yf[q] = (f32x4){bflo(yv[u][q].x), bfhi(yv[u][q].x), bflo(yv[u][q].y), bfhi(yv[u][q].y)}; ss += yf[q][0] * yf[q][0] + yf[q][1] * yf[q][1] + yf[q][2] * yf[q][2] + yf[q][3] * yf[q][3]; }
                ss = wave_sum(ss);
                const float rs = __builtin_amdgcn_rsqf(ss * (1.0f / DM) + EPS);
#pragma unroll
                for (int q = 0; q < 4; ++q) h[u][q] = h[u][q] + yf[q] * rs * ga[q];
            }
            if (hout) {
#pragma unroll
                for (int q = 0; q < 4; ++q) *(f32x4*)(hout + base + q * 256) = h[u][q];
            }
            if (houtb) {
#pragma unroll
                for (int q = 0; q < 4; ++q) { u32x2 w; w.x = pk2(h[u][q][0], h[u][q][1]); w.y = pk2(h[u][q][2], h[u][q][3]); *(u32x2*)(houtb + base + q * 256) = w; }
            }
            if (hn) {
                float rs2 = 1.0f;
                if (normnext) { float ss = 0.f;
#pragma unroll
                    for (int q = 0; q < 4; ++q) ss += h[u][q][0] * h[u][q][0] + h[u][q][1] * h[u][q][1] + h[u][q][2] * h[u][q][2] + h[u][q][3] * h[u][q][3];
                    ss = wave_sum(ss); rs2 = __builtin_amdgcn_rsqf(ss * (1.0f / DM) + EPS); if (rs_out && lane == 0) rs_out[row] = rs2; }
#pragma unroll
                for (int q = 0; q < 4; ++q) { const f32x4 o = h[u][q] * rs2 * gn[q]; u32x2 w; w.x = pk2(o[0], o[1]); w.y = pk2(o[2], o[3]); *(u32x2*)(hn + base + q * 256) = w; }
            }
            if (psrc) { u32x2 w; w.x = pk2(pv[u][0], pv[u][1]); w.y = pk2(pv[u][2], pv[u][3]); *(u32x2*)(pdst + (size_t)row * 256 + lane * 4) = w; } } }
    }
}

struct TJob { const float* src; bf16_t* dst; int lds, ldd, K, nvalid, ntn, t0; };
__device__ __forceinline__ TJob make_tjob(KP P, int j) {
    TJob t; bf16_t* W = (bf16_t*)(P->ws + WS_W); int npad;
    if (j < 16) { const int i = j >> 2, k = j & 3; bf16_t* L = W + (size_t)i * LW;
        if (k == 0) { t.src = P->in[I_WUP] + (size_t)i * 1024 * 4096; t.lds = 4096; t.K = 1024; t.nvalid = 4096; t.dst = L; }
        else if (k == 1) { t.src = P->in[I_WDN] + (size_t)i * 4096 * 1024; t.lds = 1024; t.K = 4096; t.nvalid = 1024; t.dst = L + W_UP; }
        else if (k == 2) { t.src = P->in[I_PG] + (size_t)i * 1024 * 1024; t.lds = 1024; t.K = 1024; t.nvalid = 1024; t.dst = L + W_UP + W_DN; }
        else { t.src = P->in[I_PUP] + (size_t)i * 256 * 1024; t.lds = 1024; t.K = 256; t.nvalid = 1024; t.dst = L + W_UP + W_DN + W_G; }
        npad = t.nvalid; }
    else if (j == 16) { t.src = P->in[I_AIN]; t.lds = 3088; t.K = 1024; t.nvalid = 3088; npad = 3328; t.dst = W + OFF_A_IN; }
    else if (j == 17) { t.src = P->in[I_AOUT]; t.lds = 1024; t.K = 1024; t.nvalid = 1024; npad = 1024; t.dst = W + OFF_A_OUT; }
    else if (j == 18) { t.src = P->in[I_BIN]; t.lds = 4096; t.K = 1024; t.nvalid = 4096; npad = 4096; t.dst = W + OFF_B_IN; }
    else if (j == 19) { t.src = P->in[I_BOUT]; t.lds = 1024; t.K = 1024; t.nvalid = 1024; npad = 1024; t.dst = W + OFF_B_OUT; }
    else if (j == 20) { t.src = P->in[I_CIN]; t.lds = 4096; t.K = 1024; t.nvalid = 4096; npad = 4096; t.dst = W + OFF_C_IN; }
    else if (j == 21) { t.src = P->in[I_COUT]; t.lds = 1024; t.K = 2048; t.nvalid = 1024; npad = 1024; t.dst = W + OFF_C_OUT; }
    else if (j == 22) { t.src = P->in[I_DIN]; t.lds = 2048; t.K = 1024; t.nvalid = 2048; npad = 2048; t.dst = W + OFF_D_IN; }
    else if (j == 23) { t.src = P->in[I_DOUT]; t.lds = 1024; t.K = 1024; t.nvalid = 1024; npad = 1024; t.dst = W + OFF_D_OUT; }
    else { const int q = j - 24, blk = q >> 2, pn = (q >> 1) & 1, which = q & 1;
        t.src = (which ? P->in[I_DWX] : P->in[I_DWA]) + (size_t)blk * 65536 + pn * 128; t.lds = 256; t.K = 256; t.nvalid = 128; npad = 128;
        t.dst = W + OFF_D_G + (size_t)blk * 512 * 256 + (size_t)(pn * 256 + which * 128) * 256; }
    t.ldd = t.K; t.ntn = npad / 64; t.t0 = (t.K / 64) * t.ntn;
    return t;
}
constexpr int NTJOBS = 40;
__device__ __forceinline__ void prep_phase(KP P, LAS unsigned char* lds) {
    const int tid = opaque_tid();
    LAS int* tstart = (LAS int*)(lds + 32768);
    LAS float* tile = (LAS float*)lds;
    if (tid == 0) { int s = 0; for (int j = 0; j < NTJOBS; ++j) { tstart[j] = s; s += make_tjob(P, j).t0; } tstart[NTJOBS] = s; }
    __syncthreads();
    const int total = tstart[NTJOBS];
    for (int gt = blockIdx.x; gt < total; gt += gridDim.x) {
        int j = 0; while (tstart[j + 1] <= gt) ++j;
        const TJob t = make_tjob(P, j);
        const int lt = gt - tstart[j]; const int kt = lt / t.ntn, ntile = lt - kt * t.ntn; const int k0 = kt * 64, n0 = ntile * 64;
        { const int kk = tid >> 4, nn = (tid & 15) * 4;
#pragma unroll
            for (int i = 0; i < 2; ++i) { const int k = kk + 32 * i; f32x4 v = (f32x4){0.f, 0.f, 0.f, 0.f};
                if (n0 + nn < t.nvalid) v = *(const f32x4*)(t.src + (size_t)(k0 + k) * t.lds + n0 + nn);
                tile[k * 65 + nn] = v[0]; tile[k * 65 + nn + 1] = v[1]; tile[k * 65 + nn + 2] = v[2]; tile[k * 65 + nn + 3] = v[3]; } }
        __syncthreads();
        { const int n = tid >> 3, k8 = (tid & 7) * 8; float v[8];
#pragma unroll
            for (int e = 0; e < 8; ++e) v[e] = tile[(k8 + e) * 65 + n];
            u32x4 w; w.x = pk2(v[0], v[1]); w.y = pk2(v[2], v[3]); w.z = pk2(v[4], v[5]); w.w = pk2(v[6], v[7]);
            *(u32x4*)(t.dst + (size_t)(n0 + n) * t.ldd + k0 + k8) = w; }
        __syncthreads();
    }
    { bf16_t* Wsb = (bf16_t*)(P->ws + WS_W) + OFF_C_WS; const float* sw = P->in[I_CSW];
        for (int i = blockIdx.x * NTHREADS + tid; i < 8 * 128 * 128; i += gridDim.x * NTHREADS) { const int s = i & 127, t = (i >> 7) & 127; Wsb[i] = f2bf(s <= t ? sw[i] : 0.f); } }
    if (blockIdx.x == 0) { float* lb = (float*)(P->ws + WS_LB); const float* s = P->in[I_BLB];
        for (int c = tid; c < 1024; c += NTHREADS) { const float a0 = s[c], a1 = s[1024 + c], a2 = s[2048 + c], a3 = s[3072 + c]; const float mx = fmaxf(fmaxf(a0, a1), fmaxf(a2, a3));
            const float e0 = __expf(a0 - mx), e1 = __expf(a1 - mx), e2 = __expf(a2 - mx), e3 = __expf(a3 - mx); lb[c] = e1 * fast_rcp(e0 + e1 + e2 + e3);
            lb[1024 + c] = -8.0f * __logf(1.0f + __expf(-P->in[I_DLAM][c])); } }
    rowpass(P->in[I_X], nullptr, nullptr, nullptr, nullptr, nullptr, P->in[I_NG], (bf16_t*)(P->ws + WS_HN), 1, nullptr, nullptr, nullptr, nullptr, (float*)(P->ws + WS_LB + 512 * 1024));
}

__device__ __forceinline__ float incl_scan_sum(float v, int lane) {
#pragma unroll
    for (int d = 1; d < 64; d <<= 1) { const float t = __shfl_up(v, d); if (lane >= d) v += t; }
    return v;
}
__device__ __forceinline__ float incl_scan_max(float v, int lane) {
#pragma unroll
    for (int d = 1; d < 64; d <<= 1) { const float t = __shfl_up(v, d); if (lane >= d) v = fmaxf(v, t); }
    return v;
}
#define LDS_BARRIER() do { asm volatile("s_waitcnt lgkmcnt(0)" ::: "memory"); __builtin_amdgcn_s_barrier(); asm volatile("" ::: "memory"); } while (0)
__device__ __forceinline__ void mlstm_core(KP P, LAS unsigned char* lds) {
    const int tid = opaque_tid(), w = __builtin_amdgcn_readfirstlane(tid >> 6), lane = tid & 63, fr = lane & 15, fq = lane >> 4;
    const bf16_t* z = (const bf16_t*)(P->ws + WS_Z); const float* gate = (const float*)(P->ws + WS_GATE); bf16_t* yout = (bf16_t*)(P->ws + WS_YP);
    constexpr int PQ = 160, PV = 320, PP = 288, PC = 160;
    LAS unsigned char* Qs = lds; LAS unsigned char* Ks = lds + 20480; LAS unsigned char* Vs = lds + 40960; LAS unsigned char* Ps = lds + 81920; LAS unsigned char* Cb = lds + 118784;
    LAS float* fa = (LAS float*)(lds + 141824); LAS float* fM = fa + 128; LAS float* fb = fa + 256; LAS float* fwk = fa + 384;
    for (int unit = blockIdx.x; unit < 256; unit += gridDim.x) {
        const int b = unit >> 3, h = unit & 7;
        const float ib = P->in[I_AIB][h], fbias = P->in[I_AFB][h];
        __syncthreads();
        for (int i = tid; i < 144 * 80 / 2; i += NTHREADS) ((LAS unsigned*)Cb)[i] = 0u;
        if (tid < 128) { LAS unsigned* vp = (LAS unsigned*)(Vs + tid * PV + 256); unsigned zz, one; asm volatile("v_mov_b32 %0, 0" : "=v"(zz)); asm volatile("v_mov_b32 %0, 0x3f80" : "=v"(one)); vp[0] = one;
#pragma unroll
            for (int i = 1; i < 16; ++i) vp[i] = zz; }
        f32x4 st[5];
#pragma unroll
        for (int i = 0; i < 5; ++i) st[i] = (f32x4){0.f, 0.f, 0.f, 0.f};
        float m_state = 0.f;
        u32x4 nq[2], nk[2], nv[4]; float nig = 0.f, nfg = 0.f;
        { const size_t r0 = (size_t)b * SEQL;
#pragma unroll
            for (int i = 0; i < 2; ++i) { const int idx = tid + i * 512, row = idx >> 3, pc = idx & 7;
                nq[i] = *(const u32x4*)(z + (r0 + row) * 3072 + h * 64 + pc * 8); nk[i] = *(const u32x4*)(z + (r0 + row) * 3072 + 512 + h * 64 + pc * 8); }
#pragma unroll
            for (int i = 0; i < 4; ++i) { const int idx = tid + i * 512, row = idx >> 4, pc = idx & 15; nv[i] = *(const u32x4*)(z + (r0 + row) * 3072 + 1024 + h * 128 + pc * 8); }
            if (tid < 128) { nig = gate[(r0 + tid) * 16 + h]; nfg = gate[(r0 + tid) * 16 + 8 + h]; } }
        for (int chunk = 0; chunk < 16; ++chunk) {
            const size_t r0 = (size_t)b * SEQL + chunk * 128;
#pragma unroll
            for (int i = 0; i < 2; ++i) { const int idx = tid + i * 512, row = idx >> 3, pc = idx & 7;
                u32x4 q = nq[i];
                q.x = pk2(bflo(q.x) * 0.125f, bfhi(q.x) * 0.125f); q.y = pk2(bflo(q.y) * 0.125f, bfhi(q.y) * 0.125f); q.z = pk2(bflo(q.z) * 0.125f, bfhi(q.z) * 0.125f); q.w = pk2(bflo(q.w) * 0.125f, bfhi(q.w) * 0.125f);
                *(LAS u32x4*)(Qs + row * PQ + pc * 16) = q;
                *(LAS u32x4*)(Ks + row * PQ + pc * 16) = nk[i]; }
#pragma unroll
            for (int i = 0; i < 4; ++i) { const int idx = tid + i * 512, row = idx >> 4, pc = idx & 15;
                *(LAS u32x4*)(Vs + row * PV + pc * 16) = nv[i]; }
            if (tid < 128) { const float ig = nig, fg = nfg;
                const float xf = fg + fbias; const float lf = fminf(xf, 0.f) - __logf(1.0f + __expf(-fabsf(xf)));
                fa[tid] = ig + ib; fb[tid] = lf; }
            if (chunk + 1 < 16) { const size_t r1 = r0 + 128;
#pragma unroll
                for (int i = 0; i < 2; ++i) { const int idx = tid + i * 512, row = idx >> 3, pc = idx & 7;
                    nq[i] = *(const u32x4*)(z + (r1 + row) * 3072 + h * 64 + pc * 8); nk[i] = *(const u32x4*)(z + (r1 + row) * 3072 + 512 + h * 64 + pc * 8); }
#pragma unroll
                for (int i = 0; i < 4; ++i) { const int idx = tid + i * 512, row = idx >> 4, pc = idx & 15; nv[i] = *(const u32x4*)(z + (r1 + row) * 3072 + 1024 + h * 128 + pc * 8); }
                if (tid < 128) { nig = gate[(r1 + tid) * 16 + h]; nfg = gate[(r1 + tid) * 16 + 8 + h]; } }
            LDS_BARRIER();
            if (w == 0) {
                const float lf0 = fb[lane], lf1 = fb[64 + lane], li0 = fa[lane], li1 = fa[64 + lane];
                const float c0 = incl_scan_sum(lf0, lane); const float tot0 = __shfl(c0, 63); const float c1 = incl_scan_sum(lf1, lane) + tot0;
                const float a0 = li0 - c0, a1 = li1 - c1;
                const float p0 = incl_scan_max(a0, lane); const float pt = __shfl(p0, 63); const float p1 = fmaxf(incl_scan_max(a1, lane), pt);
                const float M0 = fmaxf(m_state, p0), M1 = fmaxf(m_state, p1);
                const float Ml = __shfl(M1, 63);
                fa[lane] = a0; fa[64 + lane] = a1; fM[lane] = M0; fM[64 + lane] = M1; fb[lane] = c0; fb[64 + lane] = c1;
                fwk[lane] = __expf(a0 - Ml); fwk[64 + lane] = __expf(a1 - Ml);
            }
            LDS_BARRIER();
            const float Mlast = fM[127], blast = fb[127];
            const int t = 16 * w + fr;
            const float Mt = fM[t], bt = fb[t];
            const float winter = __expf(m_state - Mt);
            u32x2 ogv[8];
#pragma unroll
            for (int n = 0; n < 8; ++n) ogv[n] = *(const u32x2*)(z + (r0 + t) * 3072 + 2048 + h * 128 + 16 * n + fq * 4);
            bf16x8 qf[2];
            qf[0] = ldk(Qs + t * PQ + fq * 16); qf[1] = ldk(Qs + t * PQ + 64 + fq * 16);
            for (int n = 0; n <= (w | 1); ++n) {
                f32x4 a = (f32x4){0.f, 0.f, 0.f, 0.f};
                if (n <= w) {
                    const bf16x8 k0 = ldk(Ks + (16 * n + fr) * PQ + fq * 16), k1 = ldk(Ks + (16 * n + fr) * PQ + 64 + fq * 16);
                    a = MFMA16(k0, qf[0], a); a = MFMA16(k1, qf[1], a);
                    const f32x4 as4 = *(const LAS f32x4*)(fa + 16 * n + fq * 4);
#pragma unroll
                    for (int j = 0; j < 4; ++j) { const int s = 16 * n + fq * 4 + j; a[j] = (s <= t) ? a[j] * __expf(as4[j] - Mt) : 0.f; }
                }
                u32x2 pw; pw.x = pk2(a[0], a[1]); pw.y = pk2(a[2], a[3]);
                *(LAS u32x2*)(Ps + t * PP + (16 * n + fq * 4) * 2) = pw;
            }
            asm volatile("s_waitcnt lgkmcnt(0)" ::: "memory");
            f32x4 o[9];
#pragma unroll
            for (int n = 0; n < 9; ++n) { f32x4 c = (f32x4){0.f, 0.f, 0.f, 0.f};
                c = MFMA16(ldk(Cb + (16 * n + fr) * PC + fq * 16), qf[0], c); c = MFMA16(ldk(Cb + (16 * n + fr) * PC + 64 + fq * 16), qf[1], c);
                o[n] = c * winter; }
            for (int ks = 0; ks <= (w >> 1); ++ks) {
                const bf16x8 pf = ldk(Ps + t * PP + ks * 64 + fq * 16);
#pragma unroll
                for (int n = 0; n < 9; ++n) o[n] = MFMA16(ldt(Vs + (ks * 32) * PV + (16 * n) * 2, PV, fr, fq), pf, o[n]);
            }
            {
                float den = __shfl(o[8][0], fr);
                const float dn = fast_rcp(fmaxf(fabsf(den), __expf(-(bt + Mt))));
                float ss = 0.f;
#pragma unroll
                for (int n = 0; n < 8; ++n) { o[n] = o[n] * dn; ss += o[n][0] * o[n][0] + o[n][1] * o[n][1] + o[n][2] * o[n][2] + o[n][3] * o[n][3]; }
                ss += __shfl_xor(ss, 16); ss += __shfl_xor(ss, 32);
                const float rs = __builtin_amdgcn_rsqf(ss * (1.0f / 128.0f) + EPS);
                const float* hg = P->in[I_AHG] + h * 128;
#pragma unroll
                for (int n = 0; n < 8; ++n) { const int v0 = 16 * n + fq * 4;
                    const u32x2 og = ogv[n];
                    const f32x4 g4 = *(const f32x4*)(hg + v0);
                    const float y0 = o[n][0] * rs * g4[0] * sigmoidf_(bflo(og.x)), y1 = o[n][1] * rs * g4[1] * sigmoidf_(bfhi(og.x));
                    const float y2 = o[n][2] * rs * g4[2] * sigmoidf_(bflo(og.y)), y3 = o[n][3] * rs * g4[3] * sigmoidf_(bfhi(og.y));
                    u32x2 yw; yw.x = pk2(y0, y1); yw.y = pk2(y2, y3);
                    *(u32x2*)(yout + (r0 + t) * 1024 + h * 128 + v0) = yw; }
            }
            {
                const float decay = __expf(m_state - Mlast);
#pragma unroll
                for (int i = 0; i < 5; ++i) st[i] = st[i] * decay;
                for (int ks = 0; ks < 4; ++ks) {
                    const f32x4 wa = *(const LAS f32x4*)(fwk + ks * 32 + fq * 8), wb = *(const LAS f32x4*)(fwk + ks * 32 + fq * 8 + 4);
                    const bf16x8 vf = ldt(Vs + (ks * 32) * PV + (16 * w) * 2, PV, fr, fq);
                    bf16x8 kf[4];
#pragma unroll
                    for (int dt = 0; dt < 4; ++dt) { const u32x4 kr = as_u32x4(ldt(Ks + (ks * 32) * PQ + (16 * dt) * 2, PQ, fr, fq)); u32x4 ksc;
                        ksc.x = pk2(bflo(kr.x) * wa[0], bfhi(kr.x) * wa[1]); ksc.y = pk2(bflo(kr.y) * wa[2], bfhi(kr.y) * wa[3]);
                        ksc.z = pk2(bflo(kr.z) * wb[0], bfhi(kr.z) * wb[1]); ksc.w = pk2(bflo(kr.w) * wb[2], bfhi(kr.w) * wb[3]);
                        kf[dt] = as_bf16x8(ksc); st[dt] = MFMA16(kf[dt], vf, st[dt]); }
                    if (w < 4) { const bf16x8 v8 = ldt(Vs + (ks * 32) * PV + 128 * 2, PV, fr, fq);
                        const bf16x8 kw = (w == 0) ? kf[0] : (w == 1) ? kf[1] : (w == 2) ? kf[2] : kf[3];
                        st[4] = MFMA16(kw, v8, st[4]); }
                }
            }
            m_state = blast + Mlast;
            LDS_BARRIER();
#pragma unroll
            for (int dt = 0; dt < 4; ++dt) { u32x2 cw; cw.x = pk2(st[dt][0], st[dt][1]); cw.y = pk2(st[dt][2], st[dt][3]);
                *(LAS u32x2*)(Cb + (16 * w + fr) * PC + (16 * dt + fq * 4) * 2) = cw; }
            if (w < 4) { u32x2 cw; cw.x = pk2(st[4][0], st[4][1]); cw.y = pk2(st[4][2], st[4][3]);
                *(LAS u32x2*)(Cb + (128 + fr) * PC + (16 * w + fq * 4) * 2) = cw; }
        }
    }
    __syncthreads();
}

__device__ __forceinline__ void hgrn_core(KP P, LAS unsigned char* lds) {
    const int tid = opaque_tid(), w = __builtin_amdgcn_readfirstlane(tid >> 6), lane = tid & 63, fr = lane & 15, fq = lane >> 4;
    const bf16_t* z = (const bf16_t*)(P->ws + WS_Z); const float* lbv = (const float*)(P->ws + WS_LB); bf16_t* yout = (bf16_t*)(P->ws + WS_YP);
    constexpr int PT = 288, PA = 96;
    LAS unsigned char* Qt = lds; LAS unsigned char* Qh = lds + 9216; LAS unsigned char* Kh = lds + 18432; LAS unsigned char* Vs = lds + 27648; LAS unsigned char* At = lds + 36864;
    LAS unsigned char* Sb = lds + 40960;
    LAS float* gl = (LAS float*)(lds + 77824);
    LAS float* seg = (LAS float*)(lds + 78336);
    LAS float* ssp = (LAS float*)(lds + 80384);
    const int c = tid & 127, tq = tid >> 7;
    for (int unit = blockIdx.x; unit < 256; unit += gridDim.x) {
        const int b = unit >> 3, h = unit & 7;
        const float lb = lbv[h * 128 + c];
        __syncthreads();
        for (int i = tid; i < 128 * 144 / 2; i += NTHREADS) ((LAS unsigned*)Sb)[i] = 0u;
        f32x4 S[8];
#pragma unroll
        for (int i = 0; i < 8; ++i) S[i] = (f32x4){0.f, 0.f, 0.f, 0.f};
        bf16_t nq[8], nf[8]; u32x4 nv; u32x2 ng2[2];
        { const size_t r0 = (size_t)b * SEQL;
#pragma unroll
            for (int i = 0; i < 8; ++i) { const size_t ro = (r0 + tq * 8 + i) * 4096 + h * 128 + c; nq[i] = z[ro]; nf[i] = z[ro + 1024]; }
            nv = *(const u32x4*)(z + (r0 + (tid >> 4)) * 4096 + 2048 + h * 128 + (tid & 15) * 8);
#pragma unroll
            for (int tt = 0; tt < 2; ++tt) ng2[tt] = *(const u32x2*)(z + (r0 + 16 * tt + fr) * 4096 + 3072 + h * 128 + 16 * w + fq * 4); }
        for (int chunk = 0; chunk < 64; ++chunk) {
            const size_t r0 = (size_t)b * SEQL + chunk * 32;
            float qv[8], kv[8], cs[8];
            const u32x2 cg0 = ng2[0], cg1 = ng2[1];
            { float run = 0.f;
#pragma unroll
                for (int i = 0; i < 8; ++i) {
                    qv[i] = bf2f(nq[i]); const float fz = bf2f(nf[i]);
                    const float f = lb + (1.0f - lb) * sigmoidf_(fz); kv[i] = 1.0f - f; run += __logf(f); cs[i] = run; }
                seg[tq * 128 + c] = run; }
            { const int row = tid >> 4, pc = tid & 15;
                *(LAS u32x4*)(Vs + row * PT + pc * 16) = nv; }
            if (chunk + 1 < 64) { const size_t r1 = r0 + 32;
#pragma unroll
                for (int i = 0; i < 8; ++i) { const size_t ro = (r1 + tq * 8 + i) * 4096 + h * 128 + c; nq[i] = z[ro]; nf[i] = z[ro + 1024]; }
                nv = *(const u32x4*)(z + (r1 + (tid >> 4)) * 4096 + 2048 + h * 128 + (tid & 15) * 8);
#pragma unroll
                for (int tt = 0; tt < 2; ++tt) ng2[tt] = *(const u32x2*)(z + (r1 + 16 * tt + fr) * 4096 + 3072 + h * 128 + 16 * w + fq * 4); }
            LDS_BARRIER();
            { const float s0 = seg[c], s1 = seg[128 + c], s2 = seg[256 + c], s3 = seg[384 + c];
                const float pre = (tq > 0 ? s0 : 0.f) + (tq > 1 ? s1 : 0.f) + (tq > 2 ? s2 : 0.f); const float glast = (s0 + s1) + (s2 + s3);
#pragma unroll
                for (int i = 0; i < 8; ++i) { const float g = pre + cs[i]; const int t = tq * 8 + i;
                    const float eg = __expf(g), er = __expf(g - glast);
                    *(LAS bf16_t*)(Qh + t * PT + c * 2) = f2bf(qv[i] * eg);
                    *(LAS bf16_t*)(Qt + t * PT + c * 2) = f2bf(qv[i] * er);
                    *(LAS bf16_t*)(Kh + t * PT + c * 2) = f2bf(kv[i] * fast_rcp(er)); }
                if (tq == 0) gl[c] = __expf(glast); }
            LDS_BARRIER();
            f32x4 o[2];
#pragma unroll
            for (int tt = 0; tt < 2; ++tt) { f32x4 a = (f32x4){0.f, 0.f, 0.f, 0.f};
#pragma unroll
                for (int ks = 0; ks < 4; ++ks) a = MFMA16(ldk(Sb + (16 * w + fr) * PT + ks * 64 + fq * 16), ldk(Qh + (16 * tt + fr) * PT + ks * 64 + fq * 16), a);
                o[tt] = a; }
            if (w < 4) { const int tt = w >> 1, stl = w & 1; f32x4 a = (f32x4){0.f, 0.f, 0.f, 0.f};
                if (!(tt == 0 && stl == 1)) {
#pragma unroll
                    for (int ks = 0; ks < 4; ++ks) a = MFMA16(ldk(Kh + (16 * stl + fr) * PT + ks * 64 + fq * 16), ldk(Qt + (16 * tt + fr) * PT + ks * 64 + fq * 16), a);
                    const int t = 16 * tt + fr;
#pragma unroll
                    for (int j = 0; j < 4; ++j) { const int s = 16 * stl + fq * 4 + j; if (s > t) a[j] = 0.f; }
                }
                u32x2 aw; aw.x = pk2(a[0], a[1]); aw.y = pk2(a[2], a[3]);
                *(LAS u32x2*)(At + (16 * tt + fr) * PA + (16 * stl + fq * 4) * 2) = aw; }
            LDS_BARRIER();
            { const bf16x8 vf = ldt(Vs + (16 * w) * 2, PT, fr, fq);
#pragma unroll
                for (int tt = 0; tt < 2; ++tt) { o[tt] = MFMA16(vf, ldk(At + (16 * tt + fr) * PA + fq * 16), o[tt]);
                    float ss = o[tt][0] * o[tt][0] + o[tt][1] * o[tt][1] + o[tt][2] * o[tt][2] + o[tt][3] * o[tt][3];
                    ss += __shfl_xor(ss, 16); ss += __shfl_xor(ss, 32);
                    if (fq == 0) ssp[(16 * tt + fr) * 8 + w] = ss; }
                const bf16x8 kf = ldt(Kh + (16 * w) * 2, PT, fr, fq);
                const f32x4 dc = *(const LAS f32x4*)(gl + 16 * w + fq * 4);
#pragma unroll
                for (int vt = 0; vt < 8; ++vt) { S[vt] = S[vt] * dc; S[vt] = MFMA16(kf, ldt(Vs + (16 * vt) * 2, PT, fr, fq), S[vt]); } }
            LDS_BARRIER();
#pragma unroll
            for (int vt = 0; vt < 8; ++vt) { u32x2 sw; sw.x = pk2(S[vt][0], S[vt][1]); sw.y = pk2(S[vt][2], S[vt][3]);
                *(LAS u32x2*)(Sb + (16 * vt + fr) * PT + (16 * w + fq * 4) * 2) = sw; }
            { const float* hg = P->in[I_BHG] + h * 128; const int v0 = 16 * w + fq * 4; const f32x4 g4 = *(const f32x4*)(hg + v0);
#pragma unroll
                for (int tt = 0; tt < 2; ++tt) { const int t = 16 * tt + fr;
                    const f32x4 sa = *(const LAS f32x4*)(ssp + t * 8), sb = *(const LAS f32x4*)(ssp + t * 8 + 4);
                    const float tot = ((sa[0] + sa[1]) + (sa[2] + sa[3])) + ((sb[0] + sb[1]) + (sb[2] + sb[3]));
                    const float rs = __builtin_amdgcn_rsqf(tot * (1.0f / 128.0f) + EPS);
                    const u32x2 gg = tt ? cg1 : cg0;
                    const float g0 = bflo(gg.x), g1 = bfhi(gg.x), g2 = bflo(gg.y), g3 = bfhi(gg.y);
                    const float y0 = o[tt][0] * rs * g4[0] * g0 * sigmoidf_(g0), y1 = o[tt][1] * rs * g4[1] * g1 * sigmoidf_(g1);
                    const float y2 = o[tt][2] * rs * g4[2] * g2 * sigmoidf_(g2), y3 = o[tt][3] * rs * g4[3] * g3 * sigmoidf_(g3);
                    u32x2 yw; yw.x = pk2(y0, y1); yw.y = pk2(y2, y3);
                    *(u32x2*)(yout + (r0 + t) * 1024 + h * 128 + v0) = yw; } }
        }
    }
    __syncthreads();
}

__device__ __forceinline__ void spatial_core(KP P, LAS unsigned char* lds) {
    const int tid = opaque_tid(), w = __builtin_amdgcn_readfirstlane(tid >> 6), lane = tid & 63, fr = lane & 15, fq = lane >> 4;
    bf16_t* z = (bf16_t*)(P->ws + WS_Z); const bf16_t* Wsb = (const bf16_t*)(P->ws + WS_W) + OFF_C_WS;
    constexpr int PVh = 544, PW = 288;
    LAS unsigned char* Vh = lds; LAS unsigned char* Wg = lds + 69632; LAS float* mu = (LAS float*)(lds + 106496); LAS float* rsd = mu + 128;
    for (int unit = blockIdx.x; unit < 512; unit += gridDim.x) {
        const size_t r0 = (size_t)unit * 128;
        __syncthreads();
        for (int rr = 0; rr < 16; ++rr) { const int row = 16 * w + rr; const bf16_t* vp = z + (r0 + row) * 4096 + 2048;
            float x[32]; float s = 0.f;
#pragma unroll
            for (int q = 0; q < 4; ++q) { const u32x4 v = *(const u32x4*)(vp + (q * 64 + lane) * 8);
                x[q * 8 + 0] = bflo(v.x); x[q * 8 + 1] = bfhi(v.x); x[q * 8 + 2] = bflo(v.y); x[q * 8 + 3] = bfhi(v.y); x[q * 8 + 4] = bflo(v.z); x[q * 8 + 5] = bfhi(v.z); x[q * 8 + 6] = bflo(v.w); x[q * 8 + 7] = bfhi(v.w); }
#pragma unroll
            for (int e = 0; e < 32; ++e) s += x[e];
            s = wave_sum(s); const float mean = s * (1.0f / 2048.0f); float qd = 0.f;
#pragma unroll
            for (int e = 0; e < 32; ++e) { const float d = x[e] - mean; qd += d * d; }
            qd = wave_sum(qd);
            if (lane == 0) { mu[row] = mean; rsd[row] = __builtin_amdgcn_rsqf(qd * (1.0f / 2048.0f) + EPS); } }
        __syncthreads();
        for (int g = 0; g < 8; ++g) {
            { const int pc = tid & 31; float gn[8], bi[8];
#pragma unroll
                for (int e = 0; e < 8; ++e) { gn[e] = P->in[I_CLG][g * 256 + pc * 8 + e]; bi[e] = P->in[I_CLB][g * 256 + pc * 8 + e]; }
#pragma unroll
                for (int i = 0; i < 8; ++i) { const int row = (tid >> 5) + i * 16;
                    const u32x4 v = *(const u32x4*)(z + (r0 + row) * 4096 + 2048 + g * 256 + pc * 8); const float m = mu[row], r = rsd[row];
                    u32x4 o; o.x = pk2((bflo(v.x) - m) * r * gn[0] + bi[0], (bfhi(v.x) - m) * r * gn[1] + bi[1]); o.y = pk2((bflo(v.y) - m) * r * gn[2] + bi[2], (bfhi(v.y) - m) * r * gn[3] + bi[3]);
                    o.z = pk2((bflo(v.z) - m) * r * gn[4] + bi[4], (bfhi(v.z) - m) * r * gn[5] + bi[5]); o.w = pk2((bflo(v.w) - m) * r * gn[6] + bi[6], (bfhi(v.w) - m) * r * gn[7] + bi[7]);
                    *(LAS u32x4*)(Vh + row * PVh + pc * 16) = o; }
#pragma unroll
                for (int i = 0; i < 4; ++i) { const int idx = tid + i * 512, row = idx >> 4, p2 = idx & 15;
                    *(LAS u32x4*)(Wg + row * PW + p2 * 16) = *(const u32x4*)(Wsb + (size_t)g * 16384 + row * 128 + p2 * 8); } }
            __syncthreads();
            bf16x8 bf[2][4];
#pragma unroll
            for (int ci = 0; ci < 2; ++ci)
#pragma unroll
                for (int ks = 0; ks < 4; ++ks) bf[ci][ks] = ldt(Vh + (ks * 32) * PVh + (16 * (2 * w + ci)) * 2, PVh, fr, fq);
#pragma unroll
            for (int tt = 0; tt < 8; ++tt) { f32x4 a0 = (f32x4){0.f, 0.f, 0.f, 0.f}, a1 = a0;
#pragma unroll
                for (int ks = 0; ks < 4; ++ks) if (ks <= (tt >> 1)) { const bf16x8 af = ldk(Wg + (16 * tt + fr) * PW + ks * 64 + fq * 16); a0 = MFMA16(bf[0][ks], af, a0); a1 = MFMA16(bf[1][ks], af, a1); }
                const int t = 16 * tt + fr; const float bs = P->in[I_CSB][g * 128 + t];
                bf16_t* up = z + (r0 + t) * 4096 + g * 256 + 32 * w + fq * 4;
                { const u32x2 uu = *(const u32x2*)up; u32x2 yw; yw.x = pk2(bflo(uu.x) * (a0[0] + bs), bfhi(uu.x) * (a0[1] + bs)); yw.y = pk2(bflo(uu.y) * (a0[2] + bs), bfhi(uu.y) * (a0[3] + bs)); *(u32x2*)up = yw; }
                { const u32x2 uu = *(const u32x2*)(up + 16); u32x2 yw; yw.x = pk2(bflo(uu.x) * (a1[0] + bs), bfhi(uu.x) * (a1[1] + bs)); yw.y = pk2(bflo(uu.y) * (a1[2] + bs), bfhi(uu.y) * (a1[3] + bs)); *(u32x2*)(up + 16) = yw; } }
            __syncthreads();
        }
    }
    __syncthreads();
}

__device__ __forceinline__ void conv_pass(KP P) {
    const bf16_t* z = (const bf16_t*)(P->ws + WS_Z); bf16_t* xc = (bf16_t*)(P->ws + WS_YP);
    const int gtid = blockIdx.x * NTHREADS + opaque_tid(), nth = gridDim.x * NTHREADS;
    const int oct = gtid & 127;
    float cw[4][8], cb[8];
#pragma unroll
    for (int e = 0; e < 8; ++e) { cb[e] = P->in[I_DCB][oct * 8 + e];
#pragma unroll
        for (int j = 0; j < 4; ++j) cw[j][e] = P->in[I_DCW][j * 1024 + oct * 8 + e]; }
    for (int idx = gtid; idx < (MTOK / 8) * 128; idx += nth) {
        const int r0 = (idx >> 7) * 8; const bool first = (r0 & (SEQL - 1)) == 0;
        u32x4 xr[11];
#pragma unroll
        for (int i = 0; i < 11; ++i) { xr[i] = (u32x4){0u, 0u, 0u, 0u}; if (i >= 3 || !first) xr[i] = *(const u32x4*)(z + (size_t)(r0 - 3 + i) * 2048 + 1024 + oct * 8); }
#pragma unroll
        for (int o = 0; o < 8; ++o) { float a[8];
#pragma unroll
            for (int e = 0; e < 8; ++e) a[e] = cb[e];
#pragma unroll
            for (int j = 0; j < 4; ++j) { const u32x4 v = xr[o + j];
                a[0] += cw[j][0] * bflo(v.x); a[1] += cw[j][1] * bfhi(v.x); a[2] += cw[j][2] * bflo(v.y); a[3] += cw[j][3] * bfhi(v.y);
                a[4] += cw[j][4] * bflo(v.z); a[5] += cw[j][5] * bfhi(v.z); a[6] += cw[j][6] * bflo(v.w); a[7] += cw[j][7] * bfhi(v.w); }
            u32x4 ow; ow.x = pk2(a[0], a[1]); ow.y = pk2(a[2], a[3]); ow.z = pk2(a[4], a[5]); ow.w = pk2(a[6], a[7]);
            *(u32x4*)(xc + (size_t)(r0 + o) * 1024 + oct * 8) = ow; }
    }
}
__device__ __forceinline__ void scan_pass(KP P, LAS unsigned char* lds) {
    const bf16_t* z = (const bf16_t*)(P->ws + WS_Z); const bf16_t* loga = z + (size_t)MTOK * 2048; const bf16_t* beta = loga + (size_t)MTOK * 1024; bf16_t* y = (bf16_t*)(P->ws + WS_YP);
    LAS float* sA = (LAS float*)lds; LAS float* sB = sA + 512 * 8;
    const int tid = opaque_tid(), seg = tid >> 4, o = tid & 15;
    for (int unit = blockIdx.x; unit < 256; unit += gridDim.x) {
        const int b = unit >> 3; const int ch0 = ((unit & 7) * 16 + o) * 8; const size_t row0 = (size_t)b * SEQL + seg * 64;
        float SL[8], B[8];
#pragma unroll
        for (int e = 0; e < 8; ++e) { SL[e] = 0.f; B[e] = 0.f; }
#pragma unroll 4
        for (int t = 0; t < 64; ++t) { const u32x4 lv = *(const u32x4*)(loga + (row0 + t) * 1024 + ch0), bv = *(const u32x4*)(beta + (row0 + t) * 1024 + ch0);
            const float l[8] = {bflo(lv.x), bfhi(lv.x), bflo(lv.y), bfhi(lv.y), bflo(lv.z), bfhi(lv.z), bflo(lv.w), bfhi(lv.w)};
            const float be[8] = {bflo(bv.x), bfhi(bv.x), bflo(bv.y), bfhi(bv.y), bflo(bv.z), bfhi(bv.z), bflo(bv.w), bfhi(bv.w)};
#pragma unroll
            for (int e = 0; e < 8; ++e) { B[e] = __expf(l[e]) * B[e] + be[e]; SL[e] += l[e]; } }
        __syncthreads();
#pragma unroll
        for (int e = 0; e < 8; ++e) { sA[tid * 8 + e] = __expf(SL[e]); sB[tid * 8 + e] = B[e]; }
        __syncthreads();
        float H[8];
#pragma unroll
        for (int e = 0; e < 8; ++e) H[e] = 0.f;
        for (int s = 0; s < seg; ++s) {
#pragma unroll
            for (int e = 0; e < 8; ++e) H[e] = sA[(s * 16 + o) * 8 + e] * H[e] + sB[(s * 16 + o) * 8 + e]; }
        for (int t0 = 0; t0 < 64; t0 += 4) { u32x4 lvv[4], bvv[4], gvv[4];
#pragma unroll
            for (int i = 0; i < 4; ++i) { lvv[i] = *(const u32x4*)(loga + (row0 + t0 + i) * 1024 + ch0); bvv[i] = *(const u32x4*)(beta + (row0 + t0 + i) * 1024 + ch0); gvv[i] = *(const u32x4*)(z + (row0 + t0 + i) * 2048 + ch0); }
#pragma unroll
            for (int i = 0; i < 4; ++i) { const u32x4 lv = lvv[i], bv = bvv[i], gv = gvv[i];
                const float l[8] = {bflo(lv.x), bfhi(lv.x), bflo(lv.y), bfhi(lv.y), bflo(lv.z), bfhi(lv.z), bflo(lv.w), bfhi(lv.w)};
                const float be[8] = {bflo(bv.x), bfhi(bv.x), bflo(bv.y), bfhi(bv.y), bflo(bv.z), bfhi(bv.z), bflo(bv.w), bfhi(bv.w)};
                const float gg[8] = {bflo(gv.x), bfhi(gv.x), bflo(gv.y), bfhi(gv.y), bflo(gv.z), bfhi(gv.z), bflo(gv.w), bfhi(gv.w)};
                float yv[8];
#pragma unroll
                for (int e = 0; e < 8; ++e) { H[e] = __expf(l[e]) * H[e] + be[e]; yv[e] = H[e] * gelu_tanh(gg[e]); }
                u32x4 ow; ow.x = pk2(yv[0], yv[1]); ow.y = pk2(yv[2], yv[3]); ow.z = pk2(yv[4], yv[5]); ow.w = pk2(yv[6], yv[7]);
                *(u32x4*)(y + (row0 + t0 + i) * 1024 + ch0) = ow; } }
    }
    __syncthreads();
}

constexpr int NPHASES = 39;
enum { T_PREP, T_GEMM, T_GEMMRG, T_ROW, T_MLSTM, T_HGRN, T_SPATIAL, T_CONV, T_SCAN };
__device__ __forceinline__ void decode(int ph, int& type, int& layer, int& sub) {
    if (ph == 0) { type = T_PREP; layer = 0; sub = 0; return; }
    int base, cbase;
    if (ph < 10) { layer = 0; base = 1; cbase = 4; } else if (ph < 19) { layer = 1; base = 10; cbase = 13; } else if (ph < 28) { layer = 2; base = 19; cbase = 22; } else { layer = 3; base = 28; cbase = 33; }
    if (ph >= cbase) { const int k = ph - cbase;
        if (k == 0) { type = T_ROW; sub = 1; } else if (k == 1) { type = T_GEMM; sub = 2; } else if (k == 2) { type = T_GEMM; sub = 3; } else if (k == 3) { type = T_ROW; sub = 2; } else if (k == 4) { type = T_GEMM; sub = 4; } else { type = T_ROW; sub = 3; }
        return; }
    const int k = ph - base;
    if (layer < 3) { if (k == 0) { type = T_GEMM; sub = 0; } else if (k == 1) { type = layer == 0 ? T_MLSTM : layer == 1 ? T_HGRN : T_SPATIAL; sub = 0; } else { type = T_GEMM; sub = 1; } }
    else { if (k == 0) { type = T_GEMM; sub = 0; } else if (k == 1) { type = T_CONV; sub = 0; } else if (k == 2) { type = T_GEMMRG; sub = 0; } else if (k == 3) { type = T_SCAN; sub = 0; } else { type = T_GEMM; sub = 1; } }
}

__global__ void __launch_bounds__(NTHREADS, 2) fwd_kernel(Params Pk) {
    extern __shared__ __attribute__((aligned(16))) unsigned char smem[];
    LAS unsigned char* lds = (LAS unsigned char*)smem;
    const int ph_lo = Pk.ph_lo, ph_hi = Pk.ph_hi;
    if (ph_lo < 0) cg::this_grid().sync();
    volatile LAS unsigned* bst = (volatile LAS unsigned*)(lds + (LDS_BYTES - 16));
    if (threadIdx.x == 0) { bst[0] = 0u; bst[1] = 0u; }
    __syncthreads();
    const XcdBarrier gbar = xcd_barrier_post((unsigned*)(Pk.ws + WS_BAR), bst);
    for (int ph = ph_lo; ph < ph_hi; ++ph) {
        KP P = (KP)__builtin_amdgcn_kernarg_segment_ptr();
        asm volatile("" : "+s"(P));
        unsigned char* ws = P->ws;
        bf16_t* W = (bf16_t*)(ws + WS_W); bf16_t* HN = (bf16_t*)(ws + WS_HN); bf16_t* Z = (bf16_t*)(ws + WS_Z); bf16_t* YP = (bf16_t*)(ws + WS_YP); bf16_t* PB = (bf16_t*)(ws + WS_PB);
        int type, layer, sub; decode(ph, type, layer, sub);
        if (type == T_PREP) prep_phase(P, lds);
        else if (type == T_GEMM) {
            const int njobs = (sub == 2) ? 2 : 1;
            for (int j = 0; j < njobs; ++j) {
                pg8::Gemm g; EpiGen e; e.gate = nullptr; e.gate_pn = -1; e.act = 0; g.M = MTOK;
                bf16_t* L = W + (size_t)layer * LW;
                if (sub == 0) { g.A = HN; g.lda = 1024; g.K = 1024; g.ldb = 1024; e.O = Z;
                    if (layer == 0) { g.Bt = W + OFF_A_IN; g.N = 3328; e.ldc = 3072; e.gate = (float*)(ws + WS_GATE); e.gate_pn = 12; }
                    else if (layer == 1) { g.Bt = W + OFF_B_IN; g.N = 4096; e.ldc = 4096; }
                    else if (layer == 2) { g.Bt = W + OFF_C_IN; g.N = 4096; e.ldc = 4096; e.act = 1; }
                    else { g.Bt = W + OFF_D_IN; g.N = 2048; e.ldc = 2048; } }
                else if (sub == 1) { g.N = 1024; e.O = (bf16_t*)P->out; e.ldc = 1024;
                    if (layer == 2) { g.A = Z; g.lda = 4096; g.K = 2048; g.ldb = 2048; g.Bt = W + OFF_C_OUT; }
                    else { g.A = YP; g.lda = 1024; g.K = 1024; g.ldb = 1024; g.Bt = W + (layer == 0 ? OFF_A_OUT : layer == 1 ? OFF_B_OUT : OFF_D_OUT); } }
                else if (sub == 2) {
                    if (j == 0) { g.A = HN; g.lda = 1024; g.K = 1024; g.ldb = 1024; g.Bt = L; g.N = 4096; e.O = Z; e.ldc = 4096; e.act = 2; }
                    else { g.A = PB; g.lda = 256; g.K = 256; g.ldb = 256; g.Bt = L + W_UP + W_DN + W_G; g.N = 1024; e.O = YP; e.ldc = 1024; } }
                else if (sub == 3) { g.A = Z; g.lda = 4096; g.K = 4096; g.ldb = 4096; g.Bt = L + W_UP; g.N = 1024; e.O = (bf16_t*)P->out; e.ldc = 1024; }
                else { g.A = HN; g.lda = 1024; g.K = 1024; g.ldb = 1024; g.Bt = L + W_UP + W_DN; g.N = 1024; e.O = YP; e.ldc = 1024; e.act = 3; }
                pg8::StaticOrder S; S.init(g.M, g.N, (int)gridDim.x, (int)blockIdx.x);
                pg8::gemm_phase<EpiGen>(lds, g, S, e);
            }
        }
        else if (type == T_GEMMRG) {
            for (int blk = 0; blk < 4; ++blk) {
                pg8::Gemm g; g.M = MTOK; g.N = 512; g.K = 256; g.A = YP + blk * 256; g.lda = 1024; g.Bt = W + OFF_D_G + (size_t)blk * 512 * 256; g.ldb = 256;
                EpiRg e; e.xc = YP; e.loga = Z + (size_t)MTOK * 2048; e.beta = e.loga + (size_t)MTOK * 1024; e.b_a = P->in[I_DBA]; e.b_x = P->in[I_DBX]; e.spt = (const float*)(ws + WS_LB) + 1024; e.blk = blk;
                pg8::StaticOrder S; S.init(g.M, g.N, (int)gridDim.x, (int)blockIdx.x);
                pg8::gemm_phase<EpiRg>(lds, g, S, e);
            }
        }
        else if (type == T_ROW) {
            const float* ng = P->in[I_NG] + (size_t)layer * 5 * 1024;
            bf16_t* HBuf = (bf16_t*)P->out;
            float* RS = (float*)(ws + WS_LB + 512 * 1024);
            if (sub == 1) rowpass(layer == 0 ? P->in[I_X] : nullptr, HN, HBuf, ng + 1024, nullptr, nullptr, ng + 2048, HN, 1, P->in[I_P] + (size_t)layer * MTOK * 256, PB, layer == 0 ? nullptr : RS, ng, RS);
            else if (sub == 2) rowpass(nullptr, HN, HBuf, ng + 3072, nullptr, nullptr, nullptr, HN, 0, nullptr, nullptr, RS, ng + 2048, nullptr);
            else if (layer < 3) rowpass(nullptr, HN, YP, ng + 4096, nullptr, nullptr, ng + 5120, HN, 1, nullptr, nullptr, nullptr, nullptr, RS);
            else rowpass(nullptr, HN, YP, ng + 4096, P->out, nullptr, nullptr, nullptr, 0, nullptr, nullptr);
        }
        else if (type == T_MLSTM) mlstm_core(P, lds);
        else if (type == T_HGRN) hgrn_core(P, lds);
        else if (type == T_SPATIAL) spatial_core(P, lds);
        else if (type == T_CONV) conv_pass(P);
        else if (type == T_SCAN) scan_pass(P, lds);
        if (ph + 1 < ph_hi) xcd_barrier(gbar);
    }
}

extern "C" void kernel_launch(void* const* d_in, const int* in_sizes, int n_in, void* d_out, int out_size, void* d_ws, size_t ws_size, hipStream_t stream) {
    static int grid = 0;
    if (grid == 0) {
        if (n_in != 31 || in_sizes[0] != MTOK * DM || out_size != MTOK * DM || ws_size < WS_END) { fprintf(stderr, "kernel_launch: unexpected shapes (n_in %d, ws %zu)\n", n_in, ws_size); grid = -1; return; }
        int dev = 0, cus = 0, per_cu = 0;
        hipGetDevice(&dev); hipDeviceGetAttribute(&cus, hipDeviceAttributeMultiprocessorCount, dev);
        hipFuncSetAttribute((const void*)fwd_kernel, hipFuncAttributeMaxDynamicSharedMemorySize, LDS_BYTES);
        hipOccupancyMaxActiveBlocksPerMultiprocessor(&per_cu, (const void*)fwd_kernel, NTHREADS, LDS_BYTES);
        if (per_cu < 1) per_cu = 1;
        grid = cus * per_cu;
        (void)hipGetLastError();
    }
    if (grid < 0) return;
    Params p{};
    for (int i = 0; i < 31; ++i) p.in[i] = (const float*)d_in[i];
    p.out = (float*)d_out; p.ws = (unsigned char*)d_ws;
    (void)hipMemsetAsync((unsigned char*)d_ws + WS_BAR, 0, XCD_BAR_WORDS * sizeof(unsigned), stream);
#if ONE_LAUNCH
    p.ph_lo = 0; p.ph_hi = NPHASES;
    void* args[] = {&p};
    hipError_t e = hipLaunchCooperativeKernel((const void*)fwd_kernel, dim3(grid), dim3(NTHREADS), args, LDS_BYTES, stream);
    if (e != hipSuccess) fprintf(stderr, "cooperative launch failed: %s (grid %d)\n", hipGetErrorString(e), grid);
#else
    for (int ph = 0; ph < NPHASES; ++ph) { p.ph_lo = ph; p.ph_hi = ph + 1; hipLaunchKernelGGL(fwd_kernel, dim3(grid), dim3(NTHREADS), LDS_BYTES, stream, p); }
#endif
}
```

```cpp
#include <hip/hip_runtime.h>
#include <hip/hip_cooperative_groups.h>
#include <cstdio>
namespace cg = cooperative_groups;

#ifndef ONE_LAUNCH
#define ONE_LAUNCH 1
#endif

#define LAS __attribute__((address_space(3)))
typedef unsigned short bf16_t;
typedef short bf16x8 __attribute__((ext_vector_type(8)));
typedef short s16x4 __attribute__((ext_vector_type(4)));
typedef float f32x4 __attribute__((ext_vector_type(4)));
typedef float f32x2 __attribute__((ext_vector_type(2)));
typedef unsigned u32x4 __attribute__((ext_vector_type(4)));
typedef unsigned u32x2 __attribute__((ext_vector_type(2)));

constexpr int MTOK = 65536, DM = 1024, SEQL = 2048;
constexpr float EPS = 1e-6f;
constexpr int NTHREADS = 512;
constexpr int LDS_BYTES = 147456;

constexpr size_t W_UP = 4096ull * 1024, W_DN = 1024ull * 4096, W_G = 1024ull * 1024, W_PU = 1024ull * 256;
constexpr size_t LW = W_UP + W_DN + W_G + W_PU;
constexpr size_t OFF_A_IN = 4 * LW;
constexpr size_t OFF_A_OUT = OFF_A_IN + 3328ull * 1024;
constexpr size_t OFF_B_IN = OFF_A_OUT + 1024ull * 1024;
constexpr size_t OFF_B_OUT = OFF_B_IN + 4096ull * 1024;
constexpr size_t OFF_C_IN = OFF_B_OUT + 1024ull * 1024;
constexpr size_t OFF_C_OUT = OFF_C_IN + 4096ull * 1024;
constexpr size_t OFF_C_WS = OFF_C_OUT + 1024ull * 2048;
constexpr size_t OFF_D_IN = OFF_C_WS + 8ull * 128 * 128;
constexpr size_t OFF_D_G = OFF_D_IN + 2048ull * 1024;
constexpr size_t OFF_D_OUT = OFF_D_G + 4ull * 512 * 256;
constexpr size_t W_TOTAL = OFF_D_OUT + 1024ull * 1024;
constexpr size_t MiB = 1024ull * 1024;
static_assert(W_TOTAL * 2 <= 112 * MiB, "weights region");
constexpr size_t WS_W = 0, WS_HN = 112 * MiB, WS_Z = 240 * MiB, WS_YP = 752 * MiB, WS_PB = 880 * MiB, WS_GATE = 912 * MiB, WS_LB = 916 * MiB, WS_BAR = 917 * MiB, WS_END = 918 * MiB;

struct Params {
    const float* in[31];
    float* out;
    unsigned char* ws;
    int ph_lo, ph_hi;
};
typedef const __attribute__((address_space(4))) Params* KP;
enum { I_X = 0, I_P, I_NG, I_WUP, I_WDN, I_PUP, I_PG, I_AIN, I_AIB, I_AFB, I_AHG, I_AOUT, I_BIN, I_BLB, I_BHG, I_BOUT, I_CIN, I_CLG, I_CLB, I_CSW, I_CSB, I_COUT,
       I_DIN, I_DCW, I_DCB, I_DWA, I_DBA, I_DWX, I_DBX, I_DLAM, I_DOUT };

__device__ __forceinline__ float bf2f(bf16_t b) { return __uint_as_float(((unsigned)b) << 16); }
__device__ __forceinline__ float bflo(unsigned u) { return __uint_as_float(u << 16); }
__device__ __forceinline__ float bfhi(unsigned u) { return __uint_as_float(u & 0xffff0000u); }
__device__ __forceinline__ unsigned pk2(float lo, float hi) { unsigned r; asm("v_cvt_pk_bf16_f32 %0, %1, %2" : "=v"(r) : "v"(lo), "v"(hi)); return r; }
__device__ __forceinline__ bf16_t f2bf(float f) { return (bf16_t)(pk2(f, 0.f) & 0xffffu); }
__device__ __forceinline__ float fast_rcp(float x) { return __builtin_amdgcn_rcpf(x); }
__device__ __forceinline__ float sigmoidf_(float x) { return fast_rcp(1.0f + __expf(-x)); }
__device__ __forceinline__ float gelu_tanh(float x) { const float t = 1.5957691216057308f * (x + 0.044715f * x * x * x); return x * fast_rcp(1.0f + __expf(-t)); }
__device__ __forceinline__ float wave_sum(float v) {
#pragma unroll
    for (int o = 32; o >= 1; o >>= 1) v += __shfl_xor(v, o);
    return v;
}
__device__ __forceinline__ bf16x8 as_bf16x8(u32x4 v) { union { u32x4 u; bf16x8 b; } x; x.u = v; return x.b; }
__device__ __forceinline__ u32x4 as_u32x4(bf16x8 v) { union { u32x4 u; bf16x8 b; } x; x.b = v; return x.u; }
__device__ __forceinline__ bf16x8 ldk(const LAS unsigned char* p) { return *(const LAS bf16x8*)p; }
__device__ __forceinline__ bf16x8 ldt(const LAS unsigned char* base, int pitch, int fr, int fq) {
    const LAS unsigned char* p = base + (fq * 8 + (fr >> 2)) * pitch + (fr & 3) * 8;
    s16x4 a = __builtin_amdgcn_ds_read_tr16_b64_v4i16((LAS s16x4*)p);
    s16x4 b = __builtin_amdgcn_ds_read_tr16_b64_v4i16((LAS s16x4*)(p + 4 * pitch));
    bf16x8 r = {a[0], a[1], a[2], a[3], b[0], b[1], b[2], b[3]};
    return r;
}
__device__ __forceinline__ int opaque_tid() { int t = threadIdx.x; asm volatile("" : "+v"(t)); return t; }
#define MFMA16(a, b, c) __builtin_amdgcn_mfma_f32_16x16x32_bf16((a), (b), (c), 0, 0, 0)


#define XB_TMO      128
#define XB_XCNT(j)  (256  + 64 * (j))
#define XB_XSUB(j)  (1280 + 64 * (j))
#define XB_XGEN(j)  (2304 + 64 * (j))
#define XB_TOP      3328
#define XB_TOPGEN   3392
#define XCD_BAR_WORDS 3456
#define XB_SPIN_CAP (1u << 20)
__device__ __forceinline__ unsigned xb_ld(unsigned* p)              { return __hip_atomic_load(p, __ATOMIC_RELAXED, __HIP_MEMORY_SCOPE_AGENT); }
__device__ __forceinline__ unsigned xb_add(unsigned* p, unsigned v) { return __hip_atomic_fetch_add(p, v, __ATOMIC_RELAXED, __HIP_MEMORY_SCOPE_AGENT); }
__device__ __forceinline__ unsigned xb_xcc_id() { return (unsigned)__builtin_amdgcn_s_getreg((3 << 11) | 20) & 0xFu; }
#define XB_SPIN(cond, bar) do { unsigned _sp = 0; while (cond) { __builtin_amdgcn_s_sleep(1); \
    if ((++_sp & 255u) == 0u) { if (xb_ld(&(bar)[XB_TMO])) break; if (_sp > XB_SPIN_CAP) { atomicAdd(&(bar)[XB_TMO], 1u); break; } } } } while (0)
struct XcdBarrier { unsigned* bar; unsigned x; volatile LAS unsigned* st; };
__device__ __forceinline__ XcdBarrier xcd_barrier_post(unsigned* bar, volatile LAS unsigned* st) {
    XcdBarrier b; b.bar = bar; b.x = xb_xcc_id(); b.st = st;
    if (threadIdx.x == 0) (void)xb_add(&bar[XB_XCNT(b.x)], 1u);
    return b;
}
__device__ __forceinline__ void xcd_barrier_complete(unsigned* bar, unsigned x, unsigned& nloc, unsigned& nx) {
    const unsigned G = gridDim.x * gridDim.y * gridDim.z;
    unsigned sum, cnt, mine, sp = 0u;
    for (;;) {
        sum = 0u; cnt = 0u; mine = 0u;
#pragma unroll
        for (unsigned j = 0; j < 16; ++j) { const unsigned c = xb_ld(&bar[XB_XCNT(j)]); sum += c; cnt += (c > 0u) ? 1u : 0u; mine = (j == x) ? c : mine; }
        if (sum == G) break;
        __builtin_amdgcn_s_sleep(1);
        if ((++sp & 255u) == 0u) { if (xb_ld(&bar[XB_TMO])) break; if (sp > XB_SPIN_CAP) { atomicAdd(&bar[XB_TMO], 1u); break; } }
    }
    nloc = mine > 0u ? mine : 1u; nx = cnt > 0u ? cnt : 1u;
}
__device__ __forceinline__ void xcd_barrier(const XcdBarrier& b) {
    asm volatile("s_waitcnt vmcnt(0)" ::: "memory");
    __syncthreads();
    if (threadIdx.x == 0) {
        unsigned* bar = b.bar;
        __builtin_amdgcn_s_waitcnt(0);
        unsigned nloc = b.st[0], nx = b.st[1];
        if (nloc == 0u) { xcd_barrier_complete(bar, b.x, nloc, nx); b.st[0] = nloc; b.st[1] = nx; }
        const unsigned old = xb_add(&bar[XB_XSUB(b.x)], 1u);
        const unsigned gen = old / nloc;
        if (old + 1u == (gen + 1u) * nloc) {
            __builtin_amdgcn_fence(__ATOMIC_RELEASE, "agent");
            asm volatile("s_waitcnt vmcnt(0)" ::: "memory");
            const unsigned og = xb_add(&bar[XB_TOP], 1u);
            const unsigned tg = og / nx;
            if (og + 1u == (tg + 1u) * nx) xb_add(&bar[XB_TOPGEN], 1u);
            else XB_SPIN(xb_ld(&bar[XB_TOPGEN]) == tg, bar);
            __builtin_amdgcn_fence(__ATOMIC_ACQUIRE, "agent");
            xb_add(&bar[XB_XGEN(b.x)], 1u);
            asm volatile("s_waitcnt vmcnt(0)" ::: "memory");
        } else {
            XB_SPIN(xb_ld(&bar[XB_XGEN(b.x)]) == gen, bar);
            __builtin_amdgcn_fence(__ATOMIC_ACQUIRE, "agent");
            asm volatile("s_waitcnt vmcnt(0)" ::: "memory");
        }
    }
    __syncthreads();
}

namespace pg8 {
constexpr int BM = 256, BK = 64, HALF = 128, HTB = HALF * BK * 2, STAGE_BYTES = 8 * HTB, NXCD = 8, WGM = 8;
__device__ __forceinline__ int lds_byte(int r, int c) { const int st = (r >> 4) * 2 + (c >> 5), rr = r & 15, cc = c & 31, ob = rr * 64 + cc * 2; return st * 1024 + (ob ^ (((ob >> 9) & 1) << 5)); }
__device__ __forceinline__ void stage_rc(int b, int& R, int& C) { const int st = b / 1024, sb = b % 1024, swz = sb ^ (((sb >> 9) & 1) << 5); R = (st >> 1) * 16 + swz / 64; C = (st & 1) * 32 + (swz % 64) / 2; }
__device__ __forceinline__ int perm32(int rho) { const int n = rho >> 4, i = rho & 15; return 8 * (i >> 2) + 4 * n + (i & 3); }
struct Unit { int pm, pn; };
struct Gemm { const bf16_t* A; const bf16_t* Bt; int M, N, K, lda, ldb; };
struct StaticOrder {
    int nM, nN, nwg, G, c;
    __device__ void init(int M, int N, int G_, int c_) { nM = M / BM; nN = N / BM; nwg = nM * nN; G = G_; c = c_; }
    __device__ bool next(int i, Unit& u) const {
        const long L = (long)i * G + c; if (L >= nwg) return false;
        int wgid = (int)L; { const int q = nwg / NXCD, r = nwg % NXCD, xcd = wgid % NXCD, off = wgid / NXCD; wgid = (xcd < r ? xcd * (q + 1) : r * (q + 1) + (xcd - r) * q) + off; }
        const int nig = WGM * nN, gid = wgid / nig, fm = gid * WGM, gsz = (nM - fm) < WGM ? (nM - fm) : WGM;
        u.pm = fm + ((wgid % nig) % gsz); u.pn = (wgid % nig) / gsz; return true;
    }
};
template <class Epi>
__device__ __forceinline__ void gemm_phase(LAS unsigned char* lds, const Gemm g, const StaticOrder& S, const Epi& E) {
    const int tid = opaque_tid(), wid = __builtin_amdgcn_readfirstlane(tid >> 6), lane = tid & 63, wr = wid >> 2, wc = wid & 3, fr = lane & 15, fq = lane >> 4;
    const int K = g.K, nt = K / BK;
    unsigned voffA[2], voffB[2];
#pragma unroll
    for (int i = 0; i < 2; ++i) { int R, C; stage_rc(tid * 16 + i * 8192, R, C); const int Rb = (R & ~31) + perm32(R & 31);
        voffA[i] = (unsigned)(R * g.lda + C) * 2u; voffB[i] = (unsigned)(Rb * g.ldb + C) * 2u; }
    const size_t kstep = (size_t)(BK * 2);
    const size_t hstepA = (size_t)HALF * g.lda * 2, hstepB = (size_t)HALF * g.ldb * 2;
    const size_t tstepA = 2 * hstepA, tstepB = 2 * hstepB;
    const unsigned ldsw = (unsigned)wid * 1024u;
    const int aoff = lds_byte(wr * 64 + fr, fq * 8), boff = lds_byte(wc * 32 + fr, fq * 8);
#define PG8_SA(b, h) (((b) * 2 + (h)) * HTB)
#define PG8_SB(b, h) ((4 + (b) * 2 + (h)) * HTB)
#define PG8_STAGE(bufoff, gbase, voff) do { _Pragma("unroll") for (int _i = 0; _i < 2; ++_i) \
        __builtin_amdgcn_global_load_lds((const unsigned*)((const char*)(gbase) + (voff)[_i]), (LAS unsigned*)(lds + (bufoff) + ldsw + _i * 8192), 16, 0, 0); } while (0)
#define PG8_LDA(dst, b, h) do { _Pragma("unroll") for (int m = 0; m < 4; ++m) _Pragma("unroll") for (int k = 0; k < 2; ++k) dst[m][k] = *(const LAS bf16x8*)(lds + PG8_SA(b, h) + aoff + m * 2048 + k * 1024); } while (0)
#define PG8_LDB(dst, b, h) do { _Pragma("unroll") for (int n = 0; n < 2; ++n) _Pragma("unroll") for (int k = 0; k < 2; ++k) dst[n][k] = *(const LAS bf16x8*)(lds + PG8_SB(b, h) + boff + n * 2048 + k * 1024); } while (0)
#define PG8_MMA(ai, bj, At, Bt) do { __builtin_amdgcn_s_setprio(1); _Pragma("unroll") for (int m = 0; m < 4; ++m) _Pragma("unroll") for (int n = 0; n < 2; ++n) _Pragma("unroll") for (int k = 0; k < 2; ++k) \
        acc[ai][bj][m][n] = __builtin_amdgcn_mfma_f32_16x16x32_bf16(Bt[n][k], At[m][k], acc[ai][bj][m][n], 0, 0, 0); __builtin_amdgcn_s_setprio(0); } while (0)
#define PG8_WAIT_V(n) asm volatile("s_waitcnt vmcnt(" #n ")" ::: "memory")
#define PG8_WAIT_L(n) asm volatile("s_waitcnt lgkmcnt(" #n ")" ::: "memory")
#define PG8_BAR __builtin_amdgcn_s_barrier()
#define PG8_SCHED __builtin_amdgcn_sched_barrier(0)
    Unit cur, nxt; int ui = 0;
    if (!S.next(0, cur)) return;
    f32x4 acc[2][2][4][2];
#pragma unroll
    for (int a = 0; a < 2; ++a)
#pragma unroll
        for (int b = 0; b < 2; ++b)
#pragma unroll
            for (int m = 0; m < 4; ++m)
#pragma unroll
                for (int n = 0; n < 2; ++n) acc[a][b][m][n] = (f32x4){0.f, 0.f, 0.f, 0.f};
    bf16x8 At[4][2], B0[2][2], B1[2][2];
    const char* cA = (const char*)g.A + (size_t)cur.pm * tstepA; const char* cB = (const char*)g.Bt + (size_t)cur.pn * tstepB;
    PG8_STAGE(PG8_SB(0, 0), cB, voffB); PG8_STAGE(PG8_SA(0, 0), cA, voffA); PG8_STAGE(PG8_SB(0, 1), cB + hstepB, voffB); PG8_STAGE(PG8_SA(0, 1), cA + hstepA, voffA);
    if (wr == 1) PG8_BAR;
    PG8_WAIT_V(4); PG8_BAR;
    PG8_STAGE(PG8_SB(1, 0), cB + kstep, voffB); PG8_STAGE(PG8_SA(1, 0), cA + kstep, voffA); PG8_STAGE(PG8_SB(1, 1), cB + hstepB + kstep, voffB);
    PG8_WAIT_V(6); PG8_BAR;
    for (;;) {
        const bool has_next = S.next(ui + 1, nxt);
        const char* nA = has_next ? (const char*)g.A + (size_t)nxt.pm * tstepA : cA; const char* nB = has_next ? (const char*)g.Bt + (size_t)nxt.pn * tstepB : cB;
        for (int t = 0; t < nt; t += 2) {
            const bool last = (t == nt - 2);
            const char* a1 = cA + (size_t)(t + 1) * kstep;
            const char* a2 = last ? nA : cA + (size_t)(t + 2) * kstep; const char* b2 = last ? nB : cB + (size_t)(t + 2) * kstep;
            const char* a3 = a2 + kstep; const char* b3 = b2 + kstep;
            PG8_LDB(B0, 0, 0); PG8_SCHED; PG8_LDA(At, 0, 0); PG8_STAGE(PG8_SA(1, 1), a1 + hstepA, voffA);
            PG8_WAIT_L(8); PG8_BAR; PG8_WAIT_L(0); PG8_MMA(0, 0, At, B0); PG8_BAR; PG8_SCHED;
            PG8_LDB(B1, 0, 1); PG8_STAGE(PG8_SB(0, 0), b2, voffB);
            PG8_BAR; PG8_WAIT_L(0); PG8_MMA(0, 1, At, B1); PG8_BAR;
            PG8_LDA(At, 0, 1); PG8_STAGE(PG8_SA(0, 0), a2, voffA);
            PG8_BAR; PG8_WAIT_L(0); PG8_MMA(1, 0, At, B0); PG8_BAR; PG8_SCHED;
            PG8_STAGE(PG8_SB(0, 1), b2 + hstepB, voffB);
            PG8_WAIT_V(6); PG8_BAR; PG8_MMA(1, 1, At, B1); PG8_BAR;
            PG8_LDB(B0, 1, 0); PG8_SCHED; PG8_LDA(At, 1, 0); PG8_STAGE(PG8_SA(0, 1), a2 + hstepA, voffA);
            PG8_WAIT_L(8); PG8_BAR; PG8_WAIT_L(0); PG8_MMA(0, 0, At, B0); PG8_BAR; PG8_SCHED;
            PG8_LDB(B1, 1, 1); PG8_STAGE(PG8_SB(1, 0), b3, voffB);
            PG8_BAR; PG8_WAIT_L(0); PG8_MMA(0, 1, At, B1); PG8_BAR;
            PG8_LDA(At, 1, 1); PG8_STAGE(PG8_SA(1, 0), a3, voffA);
            PG8_BAR; PG8_WAIT_L(0); PG8_MMA(1, 0, At, B0); PG8_BAR; PG8_SCHED;
            PG8_STAGE(PG8_SB(1, 1), b3 + hstepB, voffB);
            PG8_WAIT_V(6); PG8_BAR; PG8_MMA(1, 1, At, B1); PG8_BAR;
        }
        E(acc, cur, wr, wc, fr, fq);
        if (!has_next) break;
#pragma unroll
        for (int a = 0; a < 2; ++a)
#pragma unroll
            for (int b = 0; b < 2; ++b)
#pragma unroll
                for (int m = 0; m < 4; ++m)
#pragma unroll
                    for (int n = 0; n < 2; ++n) acc[a][b][m][n] = (f32x4){0.f, 0.f, 0.f, 0.f};
        cur = nxt; cA = nA; cB = nB; ++ui;
    }
    PG8_WAIT_V(0);
    if (wr == 0) PG8_BAR;
    PG8_BAR;
#undef PG8_SA
#undef PG8_SB
#undef PG8_STAGE
#undef PG8_LDA
#undef PG8_LDB
#undef PG8_MMA
#undef PG8_WAIT_V
#undef PG8_WAIT_L
#undef PG8_BAR
#undef PG8_SCHED
}
}

struct EpiGen {
    bf16_t* O; int ldc; int act;
    float* gate; int gate_pn;
    __device__ __forceinline__ void operator()(const f32x4 (&acc)[2][2][4][2], const pg8::Unit& u, int wr, int wc, int fr_, int fq_) const {
        int fr = fr_, fq = fq_; asm volatile("" : "+v"(fr), "+v"(fq));
        const int row0 = u.pm * 256 + wr * 64 + fr;
        if (act == 3) {
            const int col0 = u.pn * 256 + wc * 32 + 8 * fq;
#pragma unroll
            for (int q = 0; q < 4; ++q) { const int ai = q >> 1; u32x4 pv[2][2];
#pragma unroll
                for (int mm = 0; mm < 2; ++mm)
#pragma unroll
                    for (int bj = 0; bj < 2; ++bj) pv[mm][bj] = *(const u32x4*)(O + (size_t)(row0 + ai * 128 + ((q & 1) * 2 + mm) * 16) * ldc + col0 + bj * 128);
#pragma unroll
                for (int mm = 0; mm < 2; ++mm)
#pragma unroll
                    for (int bj = 0; bj < 2; ++bj) { const int m = (q & 1) * 2 + mm; const f32x4 v0 = acc[ai][bj][m][0], v1 = acc[ai][bj][m][1]; const u32x4 pu = pv[mm][bj]; u32x4 w;
                        w.x = pk2(sigmoidf_(v0[0]) * bflo(pu.x), sigmoidf_(v0[1]) * bfhi(pu.x)); w.y = pk2(sigmoidf_(v0[2]) * bflo(pu.y), sigmoidf_(v0[3]) * bfhi(pu.y));
                        w.z = pk2(sigmoidf_(v1[0]) * bflo(pu.z), sigmoidf_(v1[1]) * bfhi(pu.z)); w.w = pk2(sigmoidf_(v1[2]) * bflo(pu.w), sigmoidf_(v1[3]) * bfhi(pu.w));
                        *(u32x4*)(O + (size_t)(row0 + ai * 128 + m * 16) * ldc + col0 + bj * 128) = w; }
                asm volatile("" ::: "memory"); }
            return;
        }
        if (u.pn == gate_pn) {
            if (wc == 0 && fq < 2) {
#pragma unroll
                for (int ai = 0; ai < 2; ++ai)
#pragma unroll
                    for (int m = 0; m < 4; ++m) { float* gp = gate + (size_t)(row0 + ai * 128 + m * 16) * 16 + 8 * fq;
                        *(f32x4*)gp = acc[ai][0][m][0]; *(f32x4*)(gp + 4) = acc[ai][0][m][1]; }
            }
            return;
        }
        const int col0 = u.pn * 256 + wc * 32 + 8 * fq;
#pragma unroll
        for (int ai = 0; ai < 2; ++ai)
#pragma unroll
            for (int m = 0; m < 4; ++m) { bf16_t* rowp = O + (size_t)(row0 + ai * 128 + m * 16) * ldc + col0;
#pragma unroll
                for (int bj = 0; bj < 2; ++bj) { f32x4 v0 = acc[ai][bj][m][0], v1 = acc[ai][bj][m][1];
                    if (act == 1) {
#pragma unroll
                        for (int j = 0; j < 4; ++j) { v0[j] = gelu_tanh(v0[j]); v1[j] = gelu_tanh(v1[j]); }
                    } else if (act == 2) {
#pragma unroll
                        for (int j = 0; j < 4; ++j) { const float a = fmaxf(v0[j], 0.f), b = fmaxf(v1[j], 0.f); v0[j] = a * a; v1[j] = b * b; }
                    } else if (act == 3) {
                        const u32x4 pu = *(const u32x4*)(rowp + bj * 128);
                        v0[0] = sigmoidf_(v0[0]) * bflo(pu.x); v0[1] = sigmoidf_(v0[1]) * bfhi(pu.x); v0[2] = sigmoidf_(v0[2]) * bflo(pu.y); v0[3] = sigmoidf_(v0[3]) * bfhi(pu.y);
                        v1[0] = sigmoidf_(v1[0]) * bflo(pu.z); v1[1] = sigmoidf_(v1[1]) * bfhi(pu.z); v1[2] = sigmoidf_(v1[2]) * bflo(pu.w); v1[3] = sigmoidf_(v1[3]) * bfhi(pu.w);
                    }
                    u32x4 w; w.x = pk2(v0[0], v0[1]); w.y = pk2(v0[2], v0[3]); w.z = pk2(v1[0], v1[1]); w.w = pk2(v1[2], v1[3]);
                    *(u32x4*)(rowp + bj * 128) = w; }
                asm volatile("" ::: "memory"); }
    }
};
struct EpiRg {
    const bf16_t* xc; bf16_t* loga; bf16_t* beta; const float* b_a; const float* b_x; const float* spt; int blk;
    __device__ __forceinline__ void operator()(const f32x4 (&acc)[2][2][4][2], const pg8::Unit& u, int wr, int wc, int fr_, int fq_) const {
        int fr = fr_, fq = fq_; asm volatile("" : "+v"(fr), "+v"(fq));
        const int row0 = u.pm * 256 + wr * 64 + fr;
        const int ch0 = blk * 256 + u.pn * 128 + wc * 32 + 8 * fq;
#pragma unroll
        for (int q = 0; q < 4; ++q) { const int ai = q >> 1; u32x4 xq[2];
#pragma unroll
            for (int mm = 0; mm < 2; ++mm) xq[mm] = *(const u32x4*)(xc + (size_t)(row0 + ai * 128 + ((q & 1) * 2 + mm) * 16) * 1024 + ch0);
            f32x4 ba[2], bx[2], sp[2];
#pragma unroll
            for (int hh = 0; hh < 2; ++hh) { ba[hh] = *(const f32x4*)(b_a + ch0 + hh * 4); bx[hh] = *(const f32x4*)(b_x + ch0 + hh * 4); sp[hh] = *(const f32x4*)(spt + ch0 + hh * 4); }
#pragma unroll
            for (int mm = 0; mm < 2; ++mm) { const int m = (q & 1) * 2 + mm; const size_t off = (size_t)(row0 + ai * 128 + m * 16) * 1024 + ch0; const u32x4 xv = xq[mm];
                u32x4 wl, wb;
#pragma unroll
                for (int hh = 0; hh < 2; ++hh) {
                    const unsigned x01 = hh ? xv.z : xv.x, x23 = hh ? xv.w : xv.y;
                    const float x[4] = {bflo(x01), bfhi(x01), bflo(x23), bfhi(x23)};
                    float la[4], be[4];
#pragma unroll
                    for (int e = 0; e < 4; ++e) { const float rp = acc[ai][0][m][hh][e] + ba[hh][e], ip = acc[ai][1][m][hh][e] + bx[hh][e];
                        const float r = sigmoidf_(rp), ig = sigmoidf_(ip); const float l = sp[hh][e] * r; la[e] = l;
                        be[e] = __builtin_amdgcn_sqrtf(fmaxf(1.0f - __expf(2.0f * l), 0.f)) * ig * x[e]; }
                    if (hh == 0) { wl.x = pk2(la[0], la[1]); wl.y = pk2(la[2], la[3]); wb.x = pk2(be[0], be[1]); wb.y = pk2(be[2], be[3]); }
                    else { wl.z = pk2(la[0], la[1]); wl.w = pk2(la[2], la[3]); wb.z = pk2(be[0], be[1]); wb.w = pk2(be[2], be[3]); }
                }
                *(u32x4*)(loga + off) = wl; *(u32x4*)(beta + off) = wb; }
            asm volatile("" ::: "memory"); }
    }
};

__device__ __forceinline__ void rowpass(const float* hin, const bf16_t* hinb, const bf16_t* y, const float* gadd, float* hout, bf16_t* houtb, const float* gnext, bf16_t* hn, int normnext,
                                        const float* psrc, bf16_t* pdst, const float* rs_in = nullptr, const float* g_in = nullptr, float* rs_out = nullptr) {
    const int tid_ = opaque_tid(); const int lane = tid_ & 63, wave = tid_ >> 6;
    const int gw = blockIdx.x * 8 + wave, nw = gridDim.x * 8;
    f32x4 ga[4], gn[4], gi[4];
#pragma unroll
    for (int q = 0; q < 4; ++q) { gi[q] = (f32x4){1.f, 1.f, 1.f, 1.f}; if (rs_in) { const f32x4 t = *(const f32x4*)(g_in + q * 256 + lane * 4); gi[q] = (f32x4){fast_rcp(t[0]), fast_rcp(t[1]), fast_rcp(t[2]), fast_rcp(t[3])}; } }
#pragma unroll
    for (int q = 0; q < 4; ++q) { ga[q] = y ? *(const f32x4*)(gadd + q * 256 + lane * 4) : (f32x4){0.f, 0.f, 0.f, 0.f}; gn[q] = (hn && normnext) ? *(const f32x4*)(gnext + q * 256 + lane * 4) : (f32x4){1.f, 1.f, 1.f, 1.f}; }
    for (int row0_ = gw; row0_ < MTOK; row0_ += 4 * nw) {
        f32x4 h[4][4]; u32x2 yv[4][4]; f32x4 pv[4]; float rsi[4];
#pragma unroll
        for (int u = 0; u < 4; ++u) { const int row = row0_ + u * nw; rsi[u] = 1.0f; if (row < MTOK) { const size_t base = (size_t)row * DM + lane * 4;
            if (rs_in) rsi[u] = rs_in[row];
            if (hin) {
#pragma unroll
                for (int q = 0; q < 4; ++q) h[u][q] = __builtin_nontemporal_load((const f32x4*)(hin + base + q * 256));
            } else {
#pragma unroll
                for (int q = 0; q < 4; ++q) { const u32x2 hv = __builtin_nontemporal_load((const u32x2*)(hinb + base + q * 256)); h[u][q] = (f32x4){bflo(hv.x), bfhi(hv.x), bflo(hv.y), bfhi(hv.y)}; }
            }
            if (y) {
#pragma unroll
                for (int q = 0; q < 4; ++q) yv[u][q] = __builtin_nontemporal_load((const u32x2*)(y + base + q * 256));
            }
            if (psrc) pv[u] = __builtin_nontemporal_load((const f32x4*)(psrc + (size_t)row * 256 + lane * 4)); } }
#pragma unroll
        for (int u = 0; u < 4; ++u) { const int row = row0_ + u * nw; if (row < MTOK) { const size_t base = (size_t)row * DM + lane * 4;
            if (rs_in) { const float ir = fast_rcp(rsi[u]);
#pragma unroll
                for (int q = 0; q < 4; ++q) h[u][q] = h[u][q] * ir * gi[q]; }
            if (y) {
                f32x4 yf[4]; float ss = 0.f;
#pragma unroll
                for (int q = 0; q < 4; ++q) { yf[q] = (f32x4){bflo(yv[u][q].x), bfhi(yv[u][q].x), bflo(yv[u][q].y), bfhi(yv[u][q].y)}; ss += yf[q][0] * yf[q][0] + yf[q][1] * yf[q][1] + yf[q][2] * yf[q][2] + yf[q][3] * yf[q][3]; }
                ss = wave_sum(ss);
                const float rs = __builtin_amdgcn_rsqf(ss * (1.0f / DM) + EPS);
#pragma unroll
                for (int q = 0; q < 4; ++q) h[u][q] = h[u][q] + yf[q] * rs * ga[q];
            }
            if (hout) {
#pragma unroll
                for (int q = 0; q < 4; ++q) __builtin_nontemporal_store(h[u][q], (f32x4*)(hout + base + q * 256));
            }
            if (houtb) {
#pragma unroll
                for (int q = 0; q < 4; ++q) { u32x2 w; w.x = pk2(h[u][q][0], h[u][q][1]); w.y = pk2(h[u][q][2], h[u][q][3]); __builtin_nontemporal_store(w, (u32x2*)(houtb + base + q * 256)); }
            }
            if (hn) {
                float rs2 = 1.0f;
                if (normnext) { float ss = 0.f;
#pragma unroll
                    for (int q = 0; q < 4; ++q) ss += h[u][q][0] * h[u][q][0] + h[u][q][1] * h[u][q][1] + h[u][q][2] * h[u][q][2] + h[u][q][3] * h[u][q][3];
                    ss = wave_sum(ss); rs2 = __builtin_amdgcn_rsqf(ss * (1.0f / DM) + EPS); if (rs_out && lane == 0) rs_out[row] = rs2; }
#pragma unroll
                for (int q = 0; q < 4; ++q) { const f32x4 o = h[u][q] * rs2 * gn[q]; u32x2 w; w.x = pk2(o[0], o[1]); w.y = pk2(o[2], o[3]); __builtin_nontemporal_store(w, (u32x2*)(hn + base + q * 256)); }
            }
            if (psrc) { u32x2 w; w.x = pk2(pv[u][0], pv[u][1]); w.y = pk2(pv[u][2], pv[u][3]); __builtin_nontemporal_store(w, (u32x2*)(pdst + (size_t)row * 256 + lane * 4)); } } }
    }
}

struct TJob { const float* src; bf16_t* dst; int lds, ldd, K, nvalid, ntn, t0; };
__device__ __forceinline__ TJob make_tjob(KP P, int j) {
    TJob t; bf16_t* W = (bf16_t*)(P->ws + WS_W); int npad;
    if (j < 16) { const int i = j >> 2, k = j & 3; bf16_t* L = W + (size_t)i * LW;
        if (k == 0) { t.src = P->in[I_WUP] + (size_t)i * 1024 * 4096; t.lds = 4096; t.K = 1024; t.nvalid = 4096; t.dst = L; }
        else if (k == 1) { t.src = P->in[I_WDN] + (size_t)i * 4096 * 1024; t.lds = 1024; t.K = 4096; t.nvalid = 1024; t.dst = L + W_UP; }
        else if (k == 2) { t.src = P->in[I_PG] + (size_t)i * 1024 * 1024; t.lds = 1024; t.K = 1024; t.nvalid = 1024; t.dst = L + W_UP + W_DN; }
        else { t.src = P->in[I_PUP] + (size_t)i * 256 * 1024; t.lds = 1024; t.K = 256; t.nvalid = 1024; t.dst = L + W_UP + W_DN + W_G; }
        npad = t.nvalid; }
    else if (j == 16) { t.src = P->in[I_AIN]; t.lds = 3088; t.K = 1024; t.nvalid = 3088; npad = 3328; t.dst = W + OFF_A_IN; }
    else if (j == 17) { t.src = P->in[I_AOUT]; t.lds = 1024; t.K = 1024; t.nvalid = 1024; npad = 1024; t.dst = W + OFF_A_OUT; }
    else if (j == 18) { t.src = P->in[I_BIN]; t.lds = 4096; t.K = 1024; t.nvalid = 4096; npad = 4096; t.dst = W + OFF_B_IN; }
    else if (j == 19) { t.src = P->in[I_BOUT]; t.lds = 1024; t.K = 1024; t.nvalid = 1024; npad = 1024; t.dst = W + OFF_B_OUT; }
    else if (j == 20) { t.src = P->in[I_CIN]; t.lds = 4096; t.K = 1024; t.nvalid = 4096; npad = 4096; t.dst = W + OFF_C_IN; }
    else if (j == 21) { t.src = P->in[I_COUT]; t.lds = 1024; t.K = 2048; t.nvalid = 1024; npad = 1024; t.dst = W + OFF_C_OUT; }
    else if (j == 22) { t.src = P->in[I_DIN]; t.lds = 2048; t.K = 1024; t.nvalid = 2048; npad = 2048; t.dst = W + OFF_D_IN; }
    else if (j == 23) { t.src = P->in[I_DOUT]; t.lds = 1024; t.K = 1024; t.nvalid = 1024; npad = 1024; t.dst = W + OFF_D_OUT; }
    else { const int q = j - 24, blk = q >> 2, pn = (q >> 1) & 1, which = q & 1;
        t.src = (which ? P->in[I_DWX] : P->in[I_DWA]) + (size_t)blk * 65536 + pn * 128; t.lds = 256; t.K = 256; t.nvalid = 128; npad = 128;
        t.dst = W + OFF_D_G + (size_t)blk * 512 * 256 + (size_t)(pn * 256 + which * 128) * 256; }
    t.ldd = t.K; t.ntn = npad / 64; t.t0 = (t.K / 64) * t.ntn;
    return t;
}
constexpr int NTJOBS = 40;
__device__ __forceinline__ void prep_phase(KP P, LAS unsigned char* lds) {
    const int tid = opaque_tid();
    LAS int* tstart = (LAS int*)(lds + 32768);
    LAS float* tile = (LAS float*)lds;
    if (tid == 0) { int s = 0; for (int j = 0; j < NTJOBS; ++j) { tstart[j] = s; s += make_tjob(P, j).t0; } tstart[NTJOBS] = s; }
    __syncthreads();
    const int total = tstart[NTJOBS];
    for (int gt = blockIdx.x; gt < total; gt += gridDim.x) {
        int j = 0; while (tstart[j + 1] <= gt) ++j;
        const TJob t = make_tjob(P, j);
        const int lt = gt - tstart[j]; const int kt = lt / t.ntn, ntile = lt - kt * t.ntn; const int k0 = kt * 64, n0 = ntile * 64;
        { const int kk = tid >> 4, nn = (tid & 15) * 4;
#pragma unroll
            for (int i = 0; i < 2; ++i) { const int k = kk + 32 * i; f32x4 v = (f32x4){0.f, 0.f, 0.f, 0.f};
                if (n0 + nn < t.nvalid) v = *(const f32x4*)(t.src + (size_t)(k0 + k) * t.lds + n0 + nn);
                tile[k * 65 + nn] = v[0]; tile[k * 65 + nn + 1] = v[1]; tile[k * 65 + nn + 2] = v[2]; tile[k * 65 + nn + 3] = v[3]; } }
        __syncthreads();
        { const int n = tid >> 3, k8 = (tid & 7) * 8; float v[8];
#pragma unroll
            for (int e = 0; e < 8; ++e) v[e] = tile[(k8 + e) * 65 + n];
            u32x4 w; w.x = pk2(v[0], v[1]); w.y = pk2(v[2], v[3]); w.z = pk2(v[4], v[5]); w.w = pk2(v[6], v[7]);
            *(u32x4*)(t.dst + (size_t)(n0 + n) * t.ldd + k0 + k8) = w; }
        __syncthreads();
    }
    { bf16_t* Wsb = (bf16_t*)(P->ws + WS_W) + OFF_C_WS; const float* sw = P->in[I_CSW];
        for (int i = blockIdx.x * NTHREADS + tid; i < 8 * 128 * 128; i += gridDim.x * NTHREADS) { const int s = i & 127, t = (i >> 7) & 127; Wsb[i] = f2bf(s <= t ? sw[i] : 0.f); } }
    if (blockIdx.x == 0) { float* lb = (float*)(P->ws + WS_LB); const float* s = P->in[I_BLB];
        for (int c = tid; c < 1024; c += NTHREADS) { const float a0 = s[c], a1 = s[1024 + c], a2 = s[2048 + c], a3 = s[3072 + c]; const float mx = fmaxf(fmaxf(a0, a1), fmaxf(a2, a3));
            const float e0 = __expf(a0 - mx), e1 = __expf(a1 - mx), e2 = __expf(a2 - mx), e3 = __expf(a3 - mx); lb[c] = e1 * fast_rcp(e0 + e1 + e2 + e3);
            lb[1024 + c] = -8.0f * __logf(1.0f + __expf(-P->in[I_DLAM][c])); } }
    rowpass(P->in[I_X], nullptr, nullptr, nullptr, nullptr, nullptr, P->in[I_NG], (bf16_t*)(P->ws + WS_HN), 1, nullptr, nullptr, nullptr, nullptr, (float*)(P->ws + WS_LB + 512 * 1024));
}

__device__ __forceinline__ float incl_scan_sum(float v, int lane) {
#pragma unroll
    for (int d = 1; d < 64; d <<= 1) { const float t = __shfl_up(v, d); if (lane >= d) v += t; }
    return v;
}
__device__ __forceinline__ float incl_scan_max(float v, int lane) {
#pragma unroll
    for (int d = 1; d < 64; d <<= 1) { const float t = __shfl_up(v, d); if (lane >= d) v = fmaxf(v, t); }
    return v;
}
#define LDS_BARRIER() do { asm volatile("s_waitcnt lgkmcnt(0)" ::: "memory"); __builtin_amdgcn_s_barrier(); asm volatile("" ::: "memory"); } while (0)
__device__ __forceinline__ void mlstm_core(KP P, LAS unsigned char* lds) {
    const int tid = opaque_tid(), w = __builtin_amdgcn_readfirstlane(tid >> 6), lane = tid & 63, fr = lane & 15, fq = lane >> 4;
    const bf16_t* z = (const bf16_t*)(P->ws + WS_Z); const float* gate = (const float*)(P->ws + WS_GATE); bf16_t* yout = (bf16_t*)(P->ws + WS_YP);
    constexpr int PQ = 160, PV = 320, PP = 288, PC = 160;
    LAS unsigned char* Qs = lds; LAS unsigned char* Ks = lds + 20480; LAS unsigned char* Vs = lds + 40960; LAS unsigned char* Ps = lds + 81920; LAS unsigned char* Cb = lds + 118784;
    LAS float* fa = (LAS float*)(lds + 141824); LAS float* fM = fa + 128; LAS float* fb = fa + 256; LAS float* fwk = fa + 384;
    for (int unit = blockIdx.x; unit < 256; unit += gridDim.x) {
        const int b = unit >> 3, h = unit & 7;
        const float ib = P->in[I_AIB][h], fbias = P->in[I_AFB][h];
        __syncthreads();
        for (int i = tid; i < 144 * 80 / 2; i += NTHREADS) ((LAS unsigned*)Cb)[i] = 0u;
        if (tid < 128) { LAS unsigned* vp = (LAS unsigned*)(Vs + tid * PV + 256); unsigned zz, one; asm volatile("v_mov_b32 %0, 0" : "=v"(zz)); asm volatile("v_mov_b32 %0, 0x3f80" : "=v"(one)); vp[0] = one;
#pragma unroll
            for (int i = 1; i < 16; ++i) vp[i] = zz; }
        f32x4 st[5];
#pragma unroll
        for (int i = 0; i < 5; ++i) st[i] = (f32x4){0.f, 0.f, 0.f, 0.f};
        float m_state = 0.f;
        u32x4 nq[2], nk[2], nv[4]; float nig = 0.f, nfg = 0.f;
        { const size_t r0 = (size_t)b * SEQL;
#pragma unroll
            for (int i = 0; i < 2; ++i) { const int idx = tid + i * 512, row = idx >> 3, pc = idx & 7;
                nq[i] = *(const u32x4*)(z + (r0 + row) * 3072 + h * 64 + pc * 8); nk[i] = *(const u32x4*)(z + (r0 + row) * 3072 + 512 + h * 64 + pc * 8); }
#pragma unroll
            for (int i = 0; i < 4; ++i) { const int idx = tid + i * 512, row = idx >> 4, pc = idx & 15; nv[i] = *(const u32x4*)(z + (r0 + row) * 3072 + 1024 + h * 128 + pc * 8); }
            if (tid < 128) { nig = gate[(r0 + tid) * 16 + h]; nfg = gate[(r0 + tid) * 16 + 8 + h]; } }
        for (int chunk = 0; chunk < 16; ++chunk) {
            const size_t r0 = (size_t)b * SEQL + chunk * 128;
#pragma unroll
            for (int i = 0; i < 2; ++i) { const int idx = tid + i * 512, row = idx >> 3, pc = idx & 7;
                u32x4 q = nq[i];
                q.x = pk2(bflo(q.x) * 0.125f, bfhi(q.x) * 0.125f); q.y = pk2(bflo(q.y) * 0.125f, bfhi(q.y) * 0.125f); q.z = pk2(bflo(q.z) * 0.125f, bfhi(q.z) * 0.125f); q.w = pk2(bflo(q.w) * 0.125f, bfhi(q.w) * 0.125f);
                *(LAS u32x4*)(Qs + row * PQ + pc * 16) = q;
                *(LAS u32x4*)(Ks + row * PQ + pc * 16) = nk[i]; }
#pragma unroll
            for (int i = 0; i < 4; ++i) { const int idx = tid + i * 512, row = idx >> 4, pc = idx & 15;
                *(LAS u32x4*)(Vs + row * PV + pc * 16) = nv[i]; }
            if (tid < 128) { const float ig = nig, fg = nfg;
                const float xf = fg + fbias; const float lf = fminf(xf, 0.f) - __logf(1.0f + __expf(-fabsf(xf)));
                fa[tid] = ig + ib; fb[tid] = lf; }
            if (chunk + 1 < 16) { const size_t r1 = r0 + 128;
#pragma unroll
                for (int i = 0; i < 2; ++i) { const int idx = tid + i * 512, row = idx >> 3, pc = idx & 7;
                    nq[i] = *(const u32x4*)(z + (r1 + row) * 3072 + h * 64 + pc * 8); nk[i] = *(const u32x4*)(z + (r1 + row) * 3072 + 512 + h * 64 + pc * 8); }
#pragma unroll
                for (int i = 0; i < 4; ++i) { const int idx = tid + i * 512, row = idx >> 4, pc = idx & 15; nv[i] = *(const u32x4*)(z + (r1 + row) * 3072 + 1024 + h * 128 + pc * 8); }
                if (tid < 128) { nig = gate[(r1 + tid) * 16 + h]; nfg = gate[(r1 + tid) * 16 + 8 + h]; } }
            LDS_BARRIER();
            if (w == 0) {
                const float lf0 = fb[lane], lf1 = fb[64 + lane], li0 = fa[lane], li1 = fa[64 + lane];
                const float c0 = incl_scan_sum(lf0, lane); const float tot0 = __shfl(c0, 63); const float c1 = incl_scan_sum(lf1, lane) + tot0;
                const float a0 = li0 - c0, a1 = li1 - c1;
                const float p0 = incl_scan_max(a0, lane); const float pt = __shfl(p0, 63); const float p1 = fmaxf(incl_scan_max(a1, lane), pt);
                const float M0 = fmaxf(m_state, p0), M1 = fmaxf(m_state, p1);
                const float Ml = __shfl(M1, 63);
                fa[lane] = a0; fa[64 + lane] = a1; fM[lane] = M0; fM[64 + lane] = M1; fb[lane] = c0; fb[64 + lane] = c1;
                fwk[lane] = __expf(a0 - Ml); fwk[64 + lane] = __expf(a1 - Ml);
            }
            LDS_BARRIER();
            const float Mlast = fM[127], blast = fb[127];
            const int t = 16 * w + fr;
            const float Mt = fM[t], bt = fb[t];
            const float winter = __expf(m_state - Mt);
            u32x2 ogv[8];
#pragma unroll
            for (int n = 0; n < 8; ++n) ogv[n] = *(const u32x2*)(z + (r0 + t) * 3072 + 2048 + h * 128 + 16 * n + fq * 4);
            bf16x8 qf[2];
            qf[0] = ldk(Qs + t * PQ + fq * 16); qf[1] = ldk(Qs + t * PQ + 64 + fq * 16);
            for (int n = 0; n <= (w | 1); ++n) {
                f32x4 a = (f32x4){0.f, 0.f, 0.f, 0.f};
                if (n <= w) {
                    const bf16x8 k0 = ldk(Ks + (16 * n + fr) * PQ + fq * 16), k1 = ldk(Ks + (16 * n + fr) * PQ + 64 + fq * 16);
                    a = MFMA16(k0, qf[0], a); a = MFMA16(k1, qf[1], a);
                    const f32x4 as4 = *(const LAS f32x4*)(fa + 16 * n + fq * 4);
#pragma unroll
                    for (int j = 0; j < 4; ++j) { const int s = 16 * n + fq * 4 + j; a[j] = (s <= t) ? a[j] * __expf(as4[j] - Mt) : 0.f; }
                }
                u32x2 pw; pw.x = pk2(a[0], a[1]); pw.y = pk2(a[2], a[3]);
                *(LAS u32x2*)(Ps + t * PP + (16 * n + fq * 4) * 2) = pw;
            }
            asm volatile("s_waitcnt lgkmcnt(0)" ::: "memory");
            f32x4 o[9];
#pragma unroll
            for (int n = 0; n < 9; ++n) { f32x4 c = (f32x4){0.f, 0.f, 0.f, 0.f};
                c = MFMA16(ldk(Cb + (16 * n + fr) * PC + fq * 16), qf[0], c); c = MFMA16(ldk(Cb + (16 * n + fr) * PC + 64 + fq * 16), qf[1], c);
                o[n] = c * winter; }
            for (int ks = 0; ks <= (w >> 1); ++ks) {
                const bf16x8 pf = ldk(Ps + t * PP + ks * 64 + fq * 16);
#pragma unroll
                for (int n = 0; n < 9; ++n) o[n] = MFMA16(ldt(Vs + (ks * 32) * PV + (16 * n) * 2, PV, fr, fq), pf, o[n]);
            }
            {
                float den = __shfl(o[8][0], fr);
                const float dn = fast_rcp(fmaxf(fabsf(den), __expf(-(bt + Mt))));
                float ss = 0.f;
#pragma unroll
                for (int n = 0; n < 8; ++n) { o[n] = o[n] * dn; ss += o[n][0] * o[n][0] + o[n][1] * o[n][1] + o[n][2] * o[n][2] + o[n][3] * o[n][3]; }
                ss += __shfl_xor(ss, 16); ss += __shfl_xor(ss, 32);
                const float rs = __builtin_amdgcn_rsqf(ss * (1.0f / 128.0f) + EPS);
                const float* hg = P->in[I_AHG] + h * 128;
#pragma unroll
                for (int n = 0; n < 8; ++n) { const int v0 = 16 * n + fq * 4;
                    const u32x2 og = ogv[n];
                    const f32x4 g4 = *(const f32x4*)(hg + v0);
                    const float y0 = o[n][0] * rs * g4[0] * sigmoidf_(bflo(og.x)), y1 = o[n][1] * rs * g4[1] * sigmoidf_(bfhi(og.x));
                    const float y2 = o[n][2] * rs * g4[2] * sigmoidf_(bflo(og.y)), y3 = o[n][3] * rs * g4[3] * sigmoidf_(bfhi(og.y));
                    u32x2 yw; yw.x = pk2(y0, y1); yw.y = pk2(y2, y3);
                    *(u32x2*)(yout + (r0 + t) * 1024 + h * 128 + v0) = yw; }
            }
            {
                const float decay = __expf(m_state - Mlast);
#pragma unroll
                for (int i = 0; i < 5; ++i) st[i] = st[i] * decay;
                for (int ks = 0; ks < 4; ++ks) {
                    const f32x4 wa = *(const LAS f32x4*)(fwk + ks * 32 + fq * 8), wb = *(const LAS f32x4*)(fwk + ks * 32 + fq * 8 + 4);
                    const bf16x8 vf = ldt(Vs + (ks * 32) * PV + (16 * w) * 2, PV, fr, fq);
                    bf16x8 kf[4];
#pragma unroll
                    for (int dt = 0; dt < 4; ++dt) { const u32x4 kr = as_u32x4(ldt(Ks + (ks * 32) * PQ + (16 * dt) * 2, PQ, fr, fq)); u32x4 ksc;
                        ksc.x = pk2(bflo(kr.x) * wa[0], bfhi(kr.x) * wa[1]); ksc.y = pk2(bflo(kr.y) * wa[2], bfhi(kr.y) * wa[3]);
                        ksc.z = pk2(bflo(kr.z) * wb[0], bfhi(kr.z) * wb[1]); ksc.w = pk2(bflo(kr.w) * wb[2], bfhi(kr.w) * wb[3]);
                        kf[dt] = as_bf16x8(ksc); st[dt] = MFMA16(kf[dt], vf, st[dt]); }
                    if (w < 4) { const bf16x8 v8 = ldt(Vs + (ks * 32) * PV + 128 * 2, PV, fr, fq);
                        const bf16x8 kw = (w == 0) ? kf[0] : (w == 1) ? kf[1] : (w == 2) ? kf[2] : kf[3];
                        st[4] = MFMA16(kw, v8, st[4]); }
                }
            }
            m_state = blast + Mlast;
            LDS_BARRIER();
#pragma unroll
            for (int dt = 0; dt < 4; ++dt) { u32x2 cw; cw.x = pk2(st[dt][0], st[dt][1]); cw.y = pk2(st[dt][2], st[dt][3]);
                *(LAS u32x2*)(Cb + (16 * w + fr) * PC + (16 * dt + fq * 4) * 2) = cw; }
            if (w < 4) { u32x2 cw; cw.x = pk2(st[4][0], st[4][1]); cw.y = pk2(st[4][2], st[4][3]);
                *(LAS u32x2*)(Cb + (128 + fr) * PC + (16 * w + fq * 4) * 2) = cw; }
        }
    }
    __syncthreads();
}

__device__ __forceinline__ void hgrn_core(KP P, LAS unsigned char* lds) {
    const int tid = opaque_tid(), w = __builtin_amdgcn_readfirstlane(tid >> 6), lane = tid & 63, fr = lane & 15, fq = lane >> 4;
    const bf16_t* z = (const bf16_t*)(P->ws + WS_Z); const float* lbv = (const float*)(P->ws + WS_LB); bf16_t* yout = (bf16_t*)(P->ws + WS_YP);
    constexpr int PT = 288, PA = 96;
    LAS unsigned char* Qt = lds; LAS unsigned char* Qh = lds + 9216; LAS unsigned char* Kh = lds + 18432; LAS unsigned char* Vs = lds + 27648; LAS unsigned char* At = lds + 36864;
    LAS unsigned char* Sb = lds + 40960;
    LAS float* gl = (LAS float*)(lds + 77824);
    LAS float* seg = (LAS float*)(lds + 78336);
    LAS float* ssp = (LAS float*)(lds + 80384);
    const int c = tid & 127, tq = tid >> 7;
    for (int unit = blockIdx.x; unit < 256; unit += gridDim.x) {
        const int b = unit >> 3, h = unit & 7;
        const float lb = lbv[h * 128 + c];
        __syncthreads();
        for (int i = tid; i < 128 * 144 / 2; i += NTHREADS) ((LAS unsigned*)Sb)[i] = 0u;
        f32x4 S[8];
#pragma unroll
        for (int i = 0; i < 8; ++i) S[i] = (f32x4){0.f, 0.f, 0.f, 0.f};
        bf16_t nq[8], nf[8]; u32x4 nv; u32x2 ng2[2];
        { const size_t r0 = (size_t)b * SEQL;
#pragma unroll
            for (int i = 0; i < 8; ++i) { const size_t ro = (r0 + tq * 8 + i) * 4096 + h * 128 + c; nq[i] = z[ro]; nf[i] = z[ro + 1024]; }
            nv = *(const u32x4*)(z + (r0 + (tid >> 4)) * 4096 + 2048 + h * 128 + (tid & 15) * 8);
#pragma unroll
            for (int tt = 0; tt < 2; ++tt) ng2[tt] = *(const u32x2*)(z + (r0 + 16 * tt + fr) * 4096 + 3072 + h * 128 + 16 * w + fq * 4); }
        for (int chunk = 0; chunk < 64; ++chunk) {
            const size_t r0 = (size_t)b * SEQL + chunk * 32;
            float qv[8], kv[8], cs[8];
            const u32x2 cg0 = ng2[0], cg1 = ng2[1];
            { float run = 0.f;
#pragma unroll
                for (int i = 0; i < 8; ++i) {
                    qv[i] = bf2f(nq[i]); const float fz = bf2f(nf[i]);
                    const float f = lb + (1.0f - lb) * sigmoidf_(fz); kv[i] = 1.0f - f; run += __logf(f); cs[i] = run; }
                seg[tq * 128 + c] = run; }
            { const int row = tid >> 4, pc = tid & 15;
                *(LAS u32x4*)(Vs + row * PT + pc * 16) = nv; }
            if (chunk + 1 < 64) { const size_t r1 = r0 + 32;
#pragma unroll
                for (int i = 0; i < 8; ++i) { const size_t ro = (r1 + tq * 8 + i) * 4096 + h * 128 + c; nq[i] = z[ro]; nf[i] = z[ro + 1024]; }
                nv = *(const u32x4*)(z + (r1 + (tid >> 4)) * 4096 + 2048 + h * 128 + (tid & 15) * 8);
#pragma unroll
                for (int tt = 0; tt < 2; ++tt) ng2[tt] = *(const u32x2*)(z + (r1 + 16 * tt + fr) * 4096 + 3072 + h * 128 + 16 * w + fq * 4); }
            LDS_BARRIER();
            { const float s0 = seg[c], s1 = seg[128 + c], s2 = seg[256 + c], s3 = seg[384 + c];
                const float pre = (tq > 0 ? s0 : 0.f) + (tq > 1 ? s1 : 0.f) + (tq > 2 ? s2 : 0.f); const float glast = (s0 + s1) + (s2 + s3);
#pragma unroll
                for (int i = 0; i < 8; ++i) { const float g = pre + cs[i]; const int t = tq * 8 + i;
                    const float eg = __expf(g), er = __expf(g - glast);
                    *(LAS bf16_t*)(Qh + t * PT + c * 2) = f2bf(qv[i] * eg);
                    *(LAS bf16_t*)(Qt + t * PT + c * 2) = f2bf(qv[i] * er);
                    *(LAS bf16_t*)(Kh + t * PT + c * 2) = f2bf(kv[i] * fast_rcp(er)); }
                if (tq == 0) gl[c] = __expf(glast); }
            LDS_BARRIER();
            f32x4 o[2];
#pragma unroll
            for (int tt = 0; tt < 2; ++tt) { f32x4 a = (f32x4){0.f, 0.f, 0.f, 0.f};
#pragma unroll
                for (int ks = 0; ks < 4; ++ks) a = MFMA16(ldk(Sb + (16 * w + fr) * PT + ks * 64 + fq * 16), ldk(Qh + (16 * tt + fr) * PT + ks * 64 + fq * 16), a);
                o[tt] = a; }
            if (w < 4) { const int tt = w >> 1, stl = w & 1; f32x4 a = (f32x4){0.f, 0.f, 0.f, 0.f};
                if (!(tt == 0 && stl == 1)) {
#pragma unroll
                    for (int ks = 0; ks < 4; ++ks) a = MFMA16(ldk(Kh + (16 * stl + fr) * PT + ks * 64 + fq * 16), ldk(Qt + (16 * tt + fr) * PT + ks * 64 + fq * 16), a);
                    const int t = 16 * tt + fr;
#pragma unroll
                    for (int j = 0; j < 4; ++j) { const int s = 16 * stl + fq * 4 + j; if (s > t) a[j] = 0.f; }
                }
                u32x2 aw; aw.x = pk2(a[0], a[1]); aw.y = pk2(a[2], a[3]);
                *(LAS u32x2*)(At + (16 * tt + fr) * PA + (16 * stl + fq * 4) * 2) = aw; }
            LDS_BARRIER();
            { const bf16x8 vf = ldt(Vs + (16 * w) * 2, PT, fr, fq);
#pragma unroll
                for (int tt = 0; tt < 2; ++tt) { o[tt] = MFMA16(vf, ldk(At + (16 * tt + fr) * PA + fq * 16), o[tt]);
                    float ss = o[tt][0] * o[tt][0] + o[tt][1] * o[tt][1] + o[tt][2] * o[tt][2] + o[tt][3] * o[tt][3];
                    ss += __shfl_xor(ss, 16); ss += __shfl_xor(ss, 32);
                    if (fq == 0) ssp[(16 * tt + fr) * 8 + w] = ss; }
                const bf16x8 kf = ldt(Kh + (16 * w) * 2, PT, fr, fq);
                const f32x4 dc = *(const LAS f32x4*)(gl + 16 * w + fq * 4);
#pragma unroll
                for (int vt = 0; vt < 8; ++vt) { S[vt] = S[vt] * dc; S[vt] = MFMA16(kf, ldt(Vs + (16 * vt) * 2, PT, fr, fq), S[vt]); } }
            LDS_BARRIER();
#pragma unroll
            for (int vt = 0; vt < 8; ++vt) { u32x2 sw; sw.x = pk2(S[vt][0], S[vt][1]); sw.y = pk2(S[vt][2], S[vt][3]);
                *(LAS u32x2*)(Sb + (16 * vt + fr) * PT + (16 * w + fq * 4) * 2) = sw; }
            { const float* hg = P->in[I_BHG] + h * 128; const int v0 = 16 * w + fq * 4; const f32x4 g4 = *(const f32x4*)(hg + v0);
#pragma unroll
                for (int tt = 0; tt < 2; ++tt) { const int t = 16 * tt + fr;
                    const f32x4 sa = *(const LAS f32x4*)(ssp + t * 8), sb = *(const LAS f32x4*)(ssp + t * 8 + 4);
                    const float tot = ((sa[0] + sa[1]) + (sa[2] + sa[3])) + ((sb[0] + sb[1]) + (sb[2] + sb[3]));
                    const float rs = __builtin_amdgcn_rsqf(tot * (1.0f / 128.0f) + EPS);
                    const u32x2 gg = tt ? cg1 : cg0;
                    const float g0 = bflo(gg.x), g1 = bfhi(gg.x), g2 = bflo(gg.y), g3 = bfhi(gg.y);
                    const float y0 = o[tt][0] * rs * g4[0] * g0 * sigmoidf_(g0), y1 = o[tt][1] * rs * g4[1] * g1 * sigmoidf_(g1);
                    const float y2 = o[tt][2] * rs * g4[2] * g2 * sigmoidf_(g2), y3 = o[tt][3] * rs * g4[3] * g3 * sigmoidf_(g3);
                    u32x2 yw; yw.x = pk2(y0, y1); yw.y = pk2(y2, y3);
                    *(u32x2*)(yout + (r0 + t) * 1024 + h * 128 + v0) = yw; } }
        }
    }
    __syncthreads();
}

__device__ __forceinline__ void spatial_core(KP P, LAS unsigned char* lds) {
    const int tid = opaque_tid(), w = __builtin_amdgcn_readfirstlane(tid >> 6), lane = tid & 63, fr = lane & 15, fq = lane >> 4;
    bf16_t* z = (bf16_t*)(P->ws + WS_Z); const bf16_t* Wsb = (const bf16_t*)(P->ws + WS_W) + OFF_C_WS;
    constexpr int PVh = 544, PW = 288;
    LAS unsigned char* Vh = lds; LAS unsigned char* Wg = lds + 69632; LAS float* mu = (LAS float*)(lds + 106496); LAS float* rsd = mu + 128;
    for (int unit = blockIdx.x; unit < 512; unit += gridDim.x) {
        const size_t r0 = (size_t)unit * 128;
        __syncthreads();
        for (int rr = 0; rr < 16; ++rr) { const int row = 16 * w + rr; const bf16_t* vp = z + (r0 + row) * 4096 + 2048;
            float x[32]; float s = 0.f;
#pragma unroll
            for (int q = 0; q < 4; ++q) { const u32x4 v = *(const u32x4*)(vp + (q * 64 + lane) * 8);
                x[q * 8 + 0] = bflo(v.x); x[q * 8 + 1] = bfhi(v.x); x[q * 8 + 2] = bflo(v.y); x[q * 8 + 3] = bfhi(v.y); x[q * 8 + 4] = bflo(v.z); x[q * 8 + 5] = bfhi(v.z); x[q * 8 + 6] = bflo(v.w); x[q * 8 + 7] = bfhi(v.w); }
#pragma unroll
            for (int e = 0; e < 32; ++e) s += x[e];
            s = wave_sum(s); const float mean = s * (1.0f / 2048.0f); float qd = 0.f;
#pragma unroll
            for (int e = 0; e < 32; ++e) { const float d = x[e] - mean; qd += d * d; }
            qd = wave_sum(qd);
            if (lane == 0) { mu[row] = mean; rsd[row] = __builtin_amdgcn_rsqf(qd * (1.0f / 2048.0f) + EPS); } }
        __syncthreads();
        for (int g = 0; g < 8; ++g) {
            { const int pc = tid & 31; float gn[8], bi[8];
#pragma unroll
                for (int e = 0; e < 8; ++e) { gn[e] = P->in[I_CLG][g * 256 + pc * 8 + e]; bi[e] = P->in[I_CLB][g * 256 + pc * 8 + e]; }
#pragma unroll
                for (int i = 0; i < 8; ++i) { const int row = (tid >> 5) + i * 16;
                    const u32x4 v = *(const u32x4*)(z + (r0 + row) * 4096 + 2048 + g * 256 + pc * 8); const float m = mu[row], r = rsd[row];
                    u32x4 o; o.x = pk2((bflo(v.x) - m) * r * gn[0] + bi[0], (bfhi(v.x) - m) * r * gn[1] + bi[1]); o.y = pk2((bflo(v.y) - m) * r * gn[2] + bi[2], (bfhi(v.y) - m) * r * gn[3] + bi[3]);
                    o.z = pk2((bflo(v.z) - m) * r * gn[4] + bi[4], (bfhi(v.z) - m) * r * gn[5] + bi[5]); o.w = pk2((bflo(v.w) - m) * r * gn[6] + bi[6], (bfhi(v.w) - m) * r * gn[7] + bi[7]);
                    *(LAS u32x4*)(Vh + row * PVh + pc * 16) = o; }
#pragma unroll
                for (int i = 0; i < 4; ++i) { const int idx = tid + i * 512, row = idx >> 4, p2 = idx & 15;
                    *(LAS u32x4*)(Wg + row * PW + p2 * 16) = *(const u32x4*)(Wsb + (size_t)g * 16384 + row * 128 + p2 * 8); } }
            __syncthreads();
            bf16x8 bf[2][4];
#pragma unroll
            for (int ci = 0; ci < 2; ++ci)
#pragma unroll
                for (int ks = 0; ks < 4; ++ks) bf[ci][ks] = ldt(Vh + (ks * 32) * PVh + (16 * (2 * w + ci)) * 2, PVh, fr, fq);
#pragma unroll
            for (int tt = 0; tt < 8; ++tt) { f32x4 a0 = (f32x4){0.f, 0.f, 0.f, 0.f}, a1 = a0;
#pragma unroll
                for (int ks = 0; ks < 4; ++ks) if (ks <= (tt >> 1)) { const bf16x8 af = ldk(Wg + (16 * tt + fr) * PW + ks * 64 + fq * 16); a0 = MFMA16(bf[0][ks], af, a0); a1 = MFMA16(bf[1][ks], af, a1); }
                const int t = 16 * tt + fr; const float bs = P->in[I_CSB][g * 128 + t];
                bf16_t* up = z + (r0 + t) * 4096 + g * 256 + 32 * w + fq * 4;
                { const u32x2 uu = *(const u32x2*)up; u32x2 yw; yw.x = pk2(bflo(uu.x) * (a0[0] + bs), bfhi(uu.x) * (a0[1] + bs)); yw.y = pk2(bflo(uu.y) * (a0[2] + bs), bfhi(uu.y) * (a0[3] + bs)); *(u32x2*)up = yw; }
                { const u32x2 uu = *(const u32x2*)(up + 16); u32x2 yw; yw.x = pk2(bflo(uu.x) * (a1[0] + bs), bfhi(uu.x) * (a1[1] + bs)); yw.y = pk2(bflo(uu.y) * (a1[2] + bs), bfhi(uu.y) * (a1[3] + bs)); *(u32x2*)(up + 16) = yw; } }
            __syncthreads();
        }
    }
    __syncthreads();
}

__device__ __forceinline__ void conv_pass(KP P) {
    const bf16_t* z = (const bf16_t*)(P->ws + WS_Z); bf16_t* xc = (bf16_t*)(P->ws + WS_YP);
    const int gtid = blockIdx.x * NTHREADS + opaque_tid(), nth = gridDim.x * NTHREADS;
    const int oct = gtid & 127;
    float cw[4][8], cb[8];
#pragma unroll
    for (int e = 0; e < 8; ++e) { cb[e] = P->in[I_DCB][oct * 8 + e];
#pragma unroll
        for (int j = 0; j < 4; ++j) cw[j][e] = P->in[I_DCW][j * 1024 + oct * 8 + e]; }
    for (int idx = gtid; idx < (MTOK / 8) * 128; idx += nth) {
        const int r0 = (idx >> 7) * 8; const bool first = (r0 & (SEQL - 1)) == 0;
        u32x4 xr[11];
#pragma unroll
        for (int i = 0; i < 11; ++i) { xr[i] = (u32x4){0u, 0u, 0u, 0u}; if (i >= 3 || !first) xr[i] = *(const u32x4*)(z + (size_t)(r0 - 3 + i) * 2048 + 1024 + oct * 8); }
#pragma unroll
        for (int o = 0; o < 8; ++o) { float a[8];
#pragma unroll
            for (int e = 0; e < 8; ++e) a[e] = cb[e];
#pragma unroll
            for (int j = 0; j < 4; ++j) { const u32x4 v = xr[o + j];
                a[0] += cw[j][0] * bflo(v.x); a[1] += cw[j][1] * bfhi(v.x); a[2] += cw[j][2] * bflo(v.y); a[3] += cw[j][3] * bfhi(v.y);
                a[4] += cw[j][4] * bflo(v.z); a[5] += cw[j][5] * bfhi(v.z); a[6] += cw[j][6] * bflo(v.w); a[7] += cw[j][7] * bfhi(v.w); }
            u32x4 ow; ow.x = pk2(a[0], a[1]); ow.y = pk2(a[2], a[3]); ow.z = pk2(a[4], a[5]); ow.w = pk2(a[6], a[7]);
            *(u32x4*)(xc + (size_t)(r0 + o) * 1024 + oct * 8) = ow; }
    }
}
__device__ __forceinline__ void scan_pass(KP P, LAS unsigned char* lds) {
    const bf16_t* z = (const bf16_t*)(P->ws + WS_Z); const bf16_t* loga = z + (size_t)MTOK * 2048; const bf16_t* beta = loga + (size_t)MTOK * 1024; bf16_t* y = (bf16_t*)(P->ws + WS_YP);
    LAS float* sA = (LAS float*)lds; LAS float* sB = sA + 512 * 8;
    const int tid = opaque_tid(), seg = tid >> 4, o = tid & 15;
    for (int unit = blockIdx.x; unit < 256; unit += gridDim.x) {
        const int b = unit >> 3; const int ch0 = ((unit & 7) * 16 + o) * 8; const size_t row0 = (size_t)b * SEQL + seg * 64;
        float SL[8], B[8];
#pragma unroll
        for (int e = 0; e < 8; ++e) { SL[e] = 0.f; B[e] = 0.f; }
#pragma unroll 4
        for (int t = 0; t < 64; ++t) { const u32x4 lv = *(const u32x4*)(loga + (row0 + t) * 1024 + ch0), bv = *(const u32x4*)(beta + (row0 + t) * 1024 + ch0);
            const float l[8] = {bflo(lv.x), bfhi(lv.x), bflo(lv.y), bfhi(lv.y), bflo(lv.z), bfhi(lv.z), bflo(lv.w), bfhi(lv.w)};
            const float be[8] = {bflo(bv.x), bfhi(bv.x), bflo(bv.y), bfhi(bv.y), bflo(bv.z), bfhi(bv.z), bflo(bv.w), bfhi(bv.w)};
#pragma unroll
            for (int e = 0; e < 8; ++e) { B[e] = __expf(l[e]) * B[e] + be[e]; SL[e] += l[e]; } }
        __syncthreads();
#pragma unroll
        for (int e = 0; e < 8; ++e) { sA[tid * 8 + e] = __expf(SL[e]); sB[tid * 8 + e] = B[e]; }
        __syncthreads();
        float H[8];
#pragma unroll
        for (int e = 0; e < 8; ++e) H[e] = 0.f;
        for (int s = 0; s < seg; ++s) {
#pragma unroll
            for (int e = 0; e < 8; ++e) H[e] = sA[(s * 16 + o) * 8 + e] * H[e] + sB[(s * 16 + o) * 8 + e]; }
        for (int t0 = 0; t0 < 64; t0 += 4) { u32x4 lvv[4], bvv[4], gvv[4];
#pragma unroll
            for (int i = 0; i < 4; ++i) { lvv[i] = *(const u32x4*)(loga + (row0 + t0 + i) * 1024 + ch0); bvv[i] = *(const u32x4*)(beta + (row0 + t0 + i) * 1024 + ch0); gvv[i] = *(const u32x4*)(z + (row0 + t0 + i) * 2048 + ch0); }
#pragma unroll
            for (int i = 0; i < 4; ++i) { const u32x4 lv = lvv[i], bv = bvv[i], gv = gvv[i];
                const float l[8] = {bflo(lv.x), bfhi(lv.x), bflo(lv.y), bfhi(lv.y), bflo(lv.z), bfhi(lv.z), bflo(lv.w), bfhi(lv.w)};
                const float be[8] = {bflo(bv.x), bfhi(bv.x), bflo(bv.y), bfhi(bv.y), bflo(bv.z), bfhi(bv.z), bflo(bv.w), bfhi(bv.w)};
                const float gg[8] = {bflo(gv.x), bfhi(gv.x), bflo(gv.y), bfhi(gv.y), bflo(gv.z), bfhi(gv.z), bflo(gv.w), bfhi(gv.w)};
                float yv[8];
#pragma unroll
                for (int e = 0; e < 8; ++e) { H[e] = __expf(l[e]) * H[e] + be[e]; yv[e] = H[e] * gelu_tanh(gg[e]); }
                u32x4 ow; ow.x = pk2(yv[0], yv[1]); ow.y = pk2(yv[2], yv[3]); ow.z = pk2(yv[4], yv[5]); ow.w = pk2(yv[6], yv[7]);
                *(u32x4*)(y + (row0 + t0 + i) * 1024 + ch0) = ow; } }
    }
    __syncthreads();
}

constexpr int NPHASES = 39;
enum { T_PREP, T_GEMM, T_GEMMRG, T_ROW, T_MLSTM, T_HGRN, T_SPATIAL, T_CONV, T_SCAN };
__device__ __forceinline__ void decode(int ph, int& type, int& layer, int& sub) {
    if (ph == 0) { type = T_PREP; layer = 0; sub = 0; return; }
    int base, cbase;
    if (ph < 10) { layer = 0; base = 1; cbase = 4; } else if (ph < 19) { layer = 1; base = 10; cbase = 13; } else if (ph < 28) { layer = 2; base = 19; cbase = 22; } else { layer = 3; base = 28; cbase = 33; }
    if (ph >= cbase) { const int k = ph - cbase;
        if (k == 0) { type = T_ROW; sub = 1; } else if (k == 1) { type = T_GEMM; sub = 2; } else if (k == 2) { type = T_GEMM; sub = 3; } else if (k == 3) { type = T_ROW; sub = 2; } else if (k == 4) { type = T_GEMM; sub = 4; } else { type = T_ROW; sub = 3; }
        return; }
    const int k = ph - base;
    if (layer < 3) { if (k == 0) { type = T_GEMM; sub = 0; } else if (k == 1) { type = layer == 0 ? T_MLSTM : layer == 1 ? T_HGRN : T_SPATIAL; sub = 0; } else { type = T_GEMM; sub = 1; } }
    else { if (k == 0) { type = T_GEMM; sub = 0; } else if (k == 1) { type = T_CONV; sub = 0; } else if (k == 2) { type = T_GEMMRG; sub = 0; } else if (k == 3) { type = T_SCAN; sub = 0; } else { type = T_GEMM; sub = 1; } }
}

__global__ void __launch_bounds__(NTHREADS, 2) fwd_kernel(Params Pk) {
    extern __shared__ __attribute__((aligned(16))) unsigned char smem[];
    LAS unsigned char* lds = (LAS unsigned char*)smem;
    const int ph_lo = Pk.ph_lo, ph_hi = Pk.ph_hi;
    if (ph_lo < 0) cg::this_grid().sync();
    volatile LAS unsigned* bst = (volatile LAS unsigned*)(lds + (LDS_BYTES - 16));
    if (threadIdx.x == 0) { bst[0] = 0u; bst[1] = 0u; }
    __syncthreads();
    const XcdBarrier gbar = xcd_barrier_post((unsigned*)(Pk.ws + WS_BAR), bst);
    for (int ph = ph_lo; ph < ph_hi; ++ph) {
        KP P = (KP)__builtin_amdgcn_kernarg_segment_ptr();
        asm volatile("" : "+s"(P));
        unsigned char* ws = P->ws;
        bf16_t* W = (bf16_t*)(ws + WS_W); bf16_t* HN = (bf16_t*)(ws + WS_HN); bf16_t* Z = (bf16_t*)(ws + WS_Z); bf16_t* YP = (bf16_t*)(ws + WS_YP); bf16_t* PB = (bf16_t*)(ws + WS_PB);
        int type, layer, sub; decode(ph, type, layer, sub);
        if (type == T_PREP) prep_phase(P, lds);
        else if (type == T_GEMM) {
            const int njobs = (sub == 2) ? 2 : 1;
            for (int j = 0; j < njobs; ++j) {
                pg8::Gemm g; EpiGen e; e.gate = nullptr; e.gate_pn = -1; e.act = 0; g.M = MTOK;
                bf16_t* L = W + (size_t)layer * LW;
                if (sub == 0) { g.A = HN; g.lda = 1024; g.K = 1024; g.ldb = 1024; e.O = Z;
                    if (layer == 0) { g.Bt = W + OFF_A_IN; g.N = 3328; e.ldc = 3072; e.gate = (float*)(ws + WS_GATE); e.gate_pn = 12; }
                    else if (layer == 1) { g.Bt = W + OFF_B_IN; g.N = 4096; e.ldc = 4096; }
                    else if (layer == 2) { g.Bt = W + OFF_C_IN; g.N = 4096; e.ldc = 4096; e.act = 1; }
                    else { g.Bt = W + OFF_D_IN; g.N = 2048; e.ldc = 2048; } }
                else if (sub == 1) { g.N = 1024; e.O = (bf16_t*)P->out; e.ldc = 1024;
                    if (layer == 2) { g.A = Z; g.lda = 4096; g.K = 2048; g.ldb = 2048; g.Bt = W + OFF_C_OUT; }
                    else { g.A = YP; g.lda = 1024; g.K = 1024; g.ldb = 1024; g.Bt = W + (layer == 0 ? OFF_A_OUT : layer == 1 ? OFF_B_OUT : OFF_D_OUT); } }
                else if (sub == 2) {
                    if (j == 0) { g.A = HN; g.lda = 1024; g.K = 1024; g.ldb = 1024; g.Bt = L; g.N = 4096; e.O = Z; e.ldc = 4096; e.act = 2; }
                    else { g.A = PB; g.lda = 256; g.K = 256; g.ldb = 256; g.Bt = L + W_UP + W_DN + W_G; g.N = 1024; e.O = YP; e.ldc = 1024; } }
                else if (sub == 3) { g.A = Z; g.lda = 4096; g.K = 4096; g.ldb = 4096; g.Bt = L + W_UP; g.N = 1024; e.O = (bf16_t*)P->out; e.ldc = 1024; }
                else { g.A = HN; g.lda = 1024; g.K = 1024; g.ldb = 1024; g.Bt = L + W_UP + W_DN; g.N = 1024; e.O = YP; e.ldc = 1024; e.act = 3; }
                pg8::StaticOrder S; S.init(g.M, g.N, (int)gridDim.x, (int)blockIdx.x);
                pg8::gemm_phase<EpiGen>(lds, g, S, e);
            }
        }
        else if (type == T_GEMMRG) {
            for (int blk = 0; blk < 4; ++blk) {
                pg8::Gemm g; g.M = MTOK; g.N = 512; g.K = 256; g.A = YP + blk * 256; g.lda = 1024; g.Bt = W + OFF_D_G + (size_t)blk * 512 * 256; g.ldb = 256;
                EpiRg e; e.xc = YP; e.loga = Z + (size_t)MTOK * 2048; e.beta = e.loga + (size_t)MTOK * 1024; e.b_a = P->in[I_DBA]; e.b_x = P->in[I_DBX]; e.spt = (const float*)(ws + WS_LB) + 1024; e.blk = blk;
                pg8::StaticOrder S; S.init(g.M, g.N, (int)gridDim.x, (int)blockIdx.x);
                pg8::gemm_phase<EpiRg>(lds, g, S, e);
            }
        }
        else if (type == T_ROW) {
            const float* ng = P->in[I_NG] + (size_t)layer * 5 * 1024;
            bf16_t* HBuf = (bf16_t*)P->out;
            float* RS = (float*)(ws + WS_LB + 512 * 1024);
            if (sub == 1) rowpass(layer == 0 ? P->in[I_X] : nullptr, HN, HBuf, ng + 1024, nullptr, nullptr, ng + 2048, HN, 1, P->in[I_P] + (size_t)layer * MTOK * 256, PB, layer == 0 ? nullptr : RS, ng, RS);
            else if (sub == 2) rowpass(nullptr, HN, HBuf, ng + 3072, nullptr, nullptr, nullptr, HN, 0, nullptr, nullptr, RS, ng + 2048, nullptr);
            else if (layer < 3) rowpass(nullptr, HN, YP, ng + 4096, nullptr, nullptr, ng + 5120, HN, 1, nullptr, nullptr, nullptr, nullptr, RS);
            else rowpass(nullptr, HN, YP, ng + 4096, P->out, nullptr, nullptr, nullptr, 0, nullptr, nullptr);
        }
        else if (type == T_MLSTM) mlstm_core(P, lds);
        else if (type == T_HGRN) hgrn_core(P, lds);
        else if (type == T_SPATIAL) spatial_core(P, lds);
        else if (type == T_CONV) conv_pass(P);
        else if (type == T_SCAN) scan_pass(P, lds);
        if (ph + 1 < ph_hi) xcd_barrier(gbar);
    }
}

extern "C" void kernel_launch(void* const* d_in, const int* in_sizes, int n_in, void* d_out, int out_size, void* d_ws, size_t ws_size, hipStream_t stream) {
    static int grid = 0;
    if (grid == 0) {
        if (n_in != 31 || in_sizes[0] != MTOK * DM || out_size != MTOK * DM || ws_size < WS_END) { fprintf(stderr, "kernel_launch: unexpected shapes (n_in %d, ws %zu)\n", n_in, ws_size); grid = -1; return; }
        int dev = 0, cus = 0, per_cu = 0;
        hipGetDevice(&dev); hipDeviceGetAttribute(&cus, hipDeviceAttributeMultiprocessorCount, dev);
        hipFuncSetAttribute((const void*)fwd_kernel, hipFuncAttributeMaxDynamicSharedMemorySize, LDS_BYTES);
        hipOccupancyMaxActiveBlocksPerMultiprocessor(&per_cu, (const void*)fwd_kernel, NTHREADS, LDS_BYTES);
        if (per_cu < 1) per_cu = 1;
        grid = cus * per_cu;
        (void)hipGetLastError();
    }
    if (grid < 0) return;
    Params p{};
    for (int i = 0; i < 31; ++i) p.in[i] = (const float*)d_in[i];
    p.out = (float*)d_out; p.ws = (unsigned char*)d_ws;
    (void)hipMemsetAsync((unsigned char*)d_ws + WS_BAR, 0, XCD_BAR_WORDS * sizeof(unsigned), stream);
#if ONE_LAUNCH
    p.ph_lo = 0; p.ph_hi = NPHASES;
    void* args[] = {&p};
    hipError_t e = hipLaunchCooperativeKernel((const void*)fwd_kernel, dim3(grid), dim3(NTHREADS), args, LDS_BYTES, stream);
    if (e != hipSuccess) fprintf(stderr, "cooperative launch failed: %s (grid %d)\n", hipGetErrorString(e), grid);
#else
    for (int ph = 0; ph < NPHASES; ++ph) { p.ph_lo = ph; p.ph_hi = ph + 1; hipLaunchKernelGGL(fwd_kernel, dim3(grid), dim3(NTHREADS), LDS_BYTES, stream, p); }
#endif
}
```

```cpp
#include <hip/hip_runtime.h>
#include <hip/hip_cooperative_groups.h>
#include <cstdio>
namespace cg = cooperative_groups;

#ifndef ONE_LAUNCH
#define ONE_LAUNCH 1
#endif

#define LAS __attribute__((address_space(3)))
typedef unsigned short bf16_t;
typedef short bf16x8 __attribute__((ext_vector_type(8)));
typedef short s16x4 __attribute__((ext_vector_type(4)));
typedef float f32x4 __attribute__((ext_vector_type(4)));
typedef float f32x2 __attribute__((ext_vector_type(2)));
typedef unsigned u32x4 __attribute__((ext_vector_type(4)));
typedef unsigned u32x2 __attribute__((ext_vector_type(2)));

constexpr int MTOK = 65536, DM = 1024, SEQL = 2048;
constexpr float EPS = 1e-6f;
constexpr int NTHREADS = 512;
constexpr int LDS_BYTES = 147456;

constexpr size_t W_UP = 4096ull * 1024, W_DN = 1024ull * 4096, W_G = 1024ull * 1024, W_PU = 1024ull * 256;
constexpr size_t LW = W_UP + W_DN + W_G + W_PU;
constexpr size_t OFF_A_IN = 4 * LW;
constexpr size_t OFF_A_OUT = OFF_A_IN + 3328ull * 1024;
constexpr size_t OFF_B_IN = OFF_A_OUT + 1024ull * 1024;
constexpr size_t OFF_B_OUT = OFF_B_IN + 4096ull * 1024;
constexpr size_t OFF_C_IN = OFF_B_OUT + 1024ull * 1024;
constexpr size_t OFF_C_OUT = OFF_C_IN + 4096ull * 1024;
constexpr size_t OFF_C_WS = OFF_C_OUT + 1024ull * 2048;
constexpr size_t OFF_D_IN = OFF_C_WS + 8ull * 128 * 128;
constexpr size_t OFF_D_G = OFF_D_IN + 2048ull * 1024;
constexpr size_t OFF_D_OUT = OFF_D_G + 4ull * 512 * 256;
constexpr size_t W_TOTAL = OFF_D_OUT + 1024ull * 1024;
constexpr size_t MiB = 1024ull * 1024;
static_assert(W_TOTAL * 2 <= 112 * MiB, "weights region");
constexpr size_t WS_W = 0, WS_HN = 112 * MiB, WS_Z = 240 * MiB, WS_YP = 752 * MiB, WS_PB = 880 * MiB, WS_GATE = 912 * MiB, WS_LB = 916 * MiB, WS_BAR = 917 * MiB, WS_END = 918 * MiB;

struct Params {
    const float* in[31];
    float* out;
    unsigned char* ws;
    int ph_lo, ph_hi;
};
typedef const __attribute__((address_space(4))) Params* KP;
enum { I_X = 0, I_P, I_NG, I_WUP, I_WDN, I_PUP, I_PG, I_AIN, I_AIB, I_AFB, I_AHG, I_AOUT, I_BIN, I_BLB, I_BHG, I_BOUT, I_CIN, I_CLG, I_CLB, I_CSW, I_CSB, I_COUT,
       I_DIN, I_DCW, I_DCB, I_DWA, I_DBA, I_DWX, I_DBX, I_DLAM, I_DOUT };

__device__ __forceinline__ float bf2f(bf16_t b) { return __uint_as_float(((unsigned)b) << 16); }
__device__ __forceinline__ float bflo(unsigned u) { return __uint_as_float(u << 16); }
__device__ __forceinline__ float bfhi(unsigned u) { return __uint_as_float(u & 0xffff0000u); }
__device__ __forceinline__ unsigned pk2(float lo, float hi) { unsigned r; asm("v_cvt_pk_bf16_f32 %0, %1, %2" : "=v"(r) : "v"(lo), "v"(hi)); return r; }
__device__ __forceinline__ bf16_t f2bf(float f) { return (bf16_t)(pk2(f, 0.f) & 0xffffu); }
__device__ __forceinline__ float fast_rcp(float x) { return __builtin_amdgcn_rcpf(x); }
__device__ __forceinline__ float sigmoidf_(float x) { return fast_rcp(1.0f + __expf(-x)); }
__device__ __forceinline__ float gelu_tanh(float x) { const float t = 1.5957691216057308f * (x + 0.044715f * x * x * x); return x * fast_rcp(1.0f + __expf(-t)); }
__device__ __forceinline__ float wave_sum(float v) {
#pragma unroll
    for (int o = 32; o >= 1; o >>= 1) v += __shfl_xor(v, o);
    return v;
}
__device__ __forceinline__ bf16x8 as_bf16x8(u32x4 v) { union { u32x4 u; bf16x8 b; } x; x.u = v; return x.b; }
__device__ __forceinline__ u32x4 as_u32x4(bf16x8 v) { union { u32x4 u; bf16x8 b; } x; x.b = v; return x.u; }
__device__ __forceinline__ bf16x8 ldk(const LAS unsigned char* p) { return *(const LAS bf16x8*)p; }
__device__ __forceinline__ bf16x8 ldt(const LAS unsigned char* base, int pitch, int fr, int fq) {
    const LAS unsigned char* p = base + (fq * 8 + (fr >> 2)) * pitch + (fr & 3) * 8;
    s16x4 a = __builtin_amdgcn_ds_read_tr16_b64_v4i16((LAS s16x4*)p);
    s16x4 b = __builtin_amdgcn_ds_read_tr16_b64_v4i16((LAS s16x4*)(p + 4 * pitch));
    bf16x8 r = {a[0], a[1], a[2], a[3], b[0], b[1], b[2], b[3]};
    return r;
}
__device__ __forceinline__ int opaque_tid() { int t = threadIdx.x; asm volatile("" : "+v"(t)); return t; }
#define MFMA16(a, b, c) __builtin_amdgcn_mfma_f32_16x16x32_bf16((a), (b), (c), 0, 0, 0)


#define XB_TMO      128
#define XB_XCNT(j)  (256  + 64 * (j))
#define XB_XSUB(j)  (1280 + 64 * (j))
#define XB_XGEN(j)  (2304 + 64 * (j))
#define XB_TOP      3328
#define XB_TOPGEN   3392
#define XCD_BAR_WORDS 3456
#define XB_SPIN_CAP (1u << 20)
__device__ __forceinline__ unsigned xb_ld(unsigned* p)              { return __hip_atomic_load(p, __ATOMIC_RELAXED, __HIP_MEMORY_SCOPE_AGENT); }
__device__ __forceinline__ unsigned xb_add(unsigned* p, unsigned v) { return __hip_atomic_fetch_add(p, v, __ATOMIC_RELAXED, __HIP_MEMORY_SCOPE_AGENT); }
__device__ __forceinline__ unsigned xb_xcc_id() { return (unsigned)__builtin_amdgcn_s_getreg((3 << 11) | 20) & 0xFu; }
#define XB_SPIN(cond, bar) do { unsigned _sp = 0; while (cond) { __builtin_amdgcn_s_sleep(1); \
    if ((++_sp & 255u) == 0u) { if (xb_ld(&(bar)[XB_TMO])) break; if (_sp > XB_SPIN_CAP) { atomicAdd(&(bar)[XB_TMO], 1u); break; } } } } while (0)
struct XcdBarrier { unsigned* bar; unsigned x; volatile LAS unsigned* st; };
__device__ __forceinline__ XcdBarrier xcd_barrier_post(unsigned* bar, volatile LAS unsigned* st) {
    XcdBarrier b; b.bar = bar; b.x = xb_xcc_id(); b.st = st;
    if (threadIdx.x == 0) (void)xb_add(&bar[XB_XCNT(b.x)], 1u);
    return b;
}
__device__ __forceinline__ void xcd_barrier_complete(unsigned* bar, unsigned x, unsigned& nloc, unsigned& nx) {
    const unsigned G = gridDim.x * gridDim.y * gridDim.z;
    unsigned sum, cnt, mine, sp = 0u;
    for (;;) {
        sum = 0u; cnt = 0u; mine = 0u;
#pragma unroll
        for (unsigned j = 0; j < 16; ++j) { const unsigned c = xb_ld(&bar[XB_XCNT(j)]); sum += c; cnt += (c > 0u) ? 1u : 0u; mine = (j == x) ? c : mine; }
        if (sum == G) break;
        __builtin_amdgcn_s_sleep(1);
        if ((++sp & 255u) == 0u) { if (xb_ld(&bar[XB_TMO])) break; if (sp > XB_SPIN_CAP) { atomicAdd(&bar[XB_TMO], 1u); break; } }
    }
    nloc = mine > 0u ? mine : 1u; nx = cnt > 0u ? cnt : 1u;
}
__device__ __forceinline__ void xcd_barrier(const XcdBarrier& b) {
    asm volatile("s_waitcnt vmcnt(0)" ::: "memory");
    __syncthreads();
    if (threadIdx.x == 0) {
        unsigned* bar = b.bar;
        __builtin_amdgcn_s_waitcnt(0);
        unsigned nloc = b.st[0], nx = b.st[1];
        if (nloc == 0u) { xcd_barrier_complete(bar, b.x, nloc, nx); b.st[0] = nloc; b.st[1] = nx; }
        const unsigned old = xb_add(&bar[XB_XSUB(b.x)], 1u);
        const unsigned gen = old / nloc;
        if (old + 1u == (gen + 1u) * nloc) {
            __builtin_amdgcn_fence(__ATOMIC_RELEASE, "agent");
            asm volatile("s_waitcnt vmcnt(0)" ::: "memory");
            const unsigned og = xb_add(&bar[XB_TOP], 1u);
            const unsigned tg = og / nx;
            if (og + 1u == (tg + 1u) * nx) xb_add(&bar[XB_TOPGEN], 1u);
            else XB_SPIN(xb_ld(&bar[XB_TOPGEN]) == tg, bar);
            __builtin_amdgcn_fence(__ATOMIC_ACQUIRE, "agent");
            xb_add(&bar[XB_XGEN(b.x)], 1u);
            asm volatile("s_waitcnt vmcnt(0)" ::: "memory");
        } else {
            XB_SPIN(xb_ld(&bar[XB_XGEN(b.x)]) == gen, bar);
            __builtin_amdgcn_fence(__ATOMIC_ACQUIRE, "agent");
            asm volatile("s_waitcnt vmcnt(0)" ::: "memory");
        }
    }
    __syncthreads();
}

namespace pg8 {
constexpr int BM = 256, BK = 64, HALF = 128, HTB = HALF * BK * 2, STAGE_BYTES = 8 * HTB, NXCD = 8, WGM = 8;
__device__ __forceinline__ int lds_byte(int r, int c) { const int st = (r >> 4) * 2 + (c >> 5), rr = r & 15, cc = c & 31, ob = rr * 64 + cc * 2; return st * 1024 + (ob ^ (((ob >> 9) & 1) << 5)); }
__device__ __forceinline__ void stage_rc(int b, int& R, int& C) { const int st = b / 1024, sb = b % 1024, swz = sb ^ (((sb >> 9) & 1) << 5); R = (st >> 1) * 16 + swz / 64; C = (st & 1) * 32 + (swz % 64) / 2; }
__device__ __forceinline__ int perm32(int rho) { const int n = rho >> 4, i = rho & 15; return 8 * (i >> 2) + 4 * n + (i & 3); }
struct Unit { int pm, pn; };
struct Gemm { const bf16_t* A; const bf16_t* Bt; int M, N, K, lda, ldb; };
struct StaticOrder {
    int nM, nN, nwg, G, c;
    __device__ void init(int M, int N, int G_, int c_) { nM = M / BM; nN = N / BM; nwg = nM * nN; G = G_; c = c_; }
    __device__ bool next(int i, Unit& u) const {
        const long L = (long)i * G + c; if (L >= nwg) return false;
        int wgid = (int)L; { const int q = nwg / NXCD, r = nwg % NXCD, xcd = wgid % NXCD, off = wgid / NXCD; wgid = (xcd < r ? xcd * (q + 1) : r * (q + 1) + (xcd - r) * q) + off; }
        const int nig = WGM * nN, gid = wgid / nig, fm = gid * WGM, gsz = (nM - fm) < WGM ? (nM - fm) : WGM;
        u.pm = fm + ((wgid % nig) % gsz); u.pn = (wgid % nig) / gsz; return true;
    }
};
template <class Epi>
__device__ __forceinline__ void gemm_phase(LAS unsigned char* lds, const Gemm g, const StaticOrder& S, const Epi& E) {
    const int tid = opaque_tid(), wid = __builtin_amdgcn_readfirstlane(tid >> 6), lane = tid & 63, wr = wid >> 2, wc = wid & 3, fr = lane & 15, fq = lane >> 4;
    const int K = g.K, nt = K / BK;
    unsigned voffA[2], voffB[2];
#pragma unroll
    for (int i = 0; i < 2; ++i) { int R, C; stage_rc(tid * 16 + i * 8192, R, C); const int Rb = (R & ~31) + perm32(R & 31);
        voffA[i] = (unsigned)(R * g.lda + C) * 2u; voffB[i] = (unsigned)(Rb * g.ldb + C) * 2u; }
    const size_t kstep = (size_t)(BK * 2);
    const size_t hstepA = (size_t)HALF * g.lda * 2, hstepB = (size_t)HALF * g.ldb * 2;
    const size_t tstepA = 2 * hstepA, tstepB = 2 * hstepB;
    const unsigned ldsw = (unsigned)wid * 1024u;
    const int aoff = lds_byte(wr * 64 + fr, fq * 8), boff = lds_byte(wc * 32 + fr, fq * 8);
#define PG8_SA(b, h) (((b) * 2 + (h)) * HTB)
#define PG8_SB(b, h) ((4 + (b) * 2 + (h)) * HTB)
#define PG8_STAGE(bufoff, gbase, voff) do { _Pragma("unroll") for (int _i = 0; _i < 2; ++_i) \
        __builtin_amdgcn_global_load_lds((const unsigned*)((const char*)(gbase) + (voff)[_i]), (LAS unsigned*)(lds + (bufoff) + ldsw + _i * 8192), 16, 0, 0); } while (0)
#define PG8_LDA(dst, b, h) do { _Pragma("unroll") for (int m = 0; m < 4; ++m) _Pragma("unroll") for (int k = 0; k < 2; ++k) dst[m][k] = *(const LAS bf16x8*)(lds + PG8_SA(b, h) + aoff + m * 2048 + k * 1024); } while (0)
#define PG8_LDB(dst, b, h) do { _Pragma("unroll") for (int n = 0; n < 2; ++n) _Pragma("unroll") for (int k = 0; k < 2; ++k) dst[n][k] = *(const LAS bf16x8*)(lds + PG8_SB(b, h) + boff + n * 2048 + k * 1024); } while (0)
#define PG8_MMA(ai, bj, At, Bt) do { __builtin_amdgcn_s_setprio(1); _Pragma("unroll") for (int m = 0; m < 4; ++m) _Pragma("unroll") for (int n = 0; n < 2; ++n) _Pragma("unroll") for (int k = 0; k < 2; ++k) \
        acc[ai][bj][m][n] = __builtin_amdgcn_mfma_f32_16x16x32_bf16(Bt[n][k], At[m][k], acc[ai][bj][m][n], 0, 0, 0); __builtin_amdgcn_s_setprio(0); } while (0)
#define PG8_WAIT_V(n) asm volatile("s_waitcnt vmcnt(" #n ")" ::: "memory")
#define PG8_WAIT_L(n) asm volatile("s_waitcnt lgkmcnt(" #n ")" ::: "memory")
#define PG8_BAR __builtin_amdgcn_s_barrier()
#define PG8_SCHED __builtin_amdgcn_sched_barrier(0)
    Unit cur, nxt; int ui = 0;
    if (!S.next(0, cur)) return;
    f32x4 acc[2][2][4][2];
#pragma unroll
    for (int a = 0; a < 2; ++a)
#pragma unroll
        for (int b = 0; b < 2; ++b)
#pragma unroll
            for (int m = 0; m < 4; ++m)
#pragma unroll
                for (int n = 0; n < 2; ++n) acc[a][b][m][n] = (f32x4){0.f, 0.f, 0.f, 0.f};
    bf16x8 At[4][2], B0[2][2], B1[2][2];
    const char* cA = (const char*)g.A + (size_t)cur.pm * tstepA; const char* cB = (const char*)g.Bt + (size_t)cur.pn * tstepB;
    PG8_STAGE(PG8_SB(0, 0), cB, voffB); PG8_STAGE(PG8_SA(0, 0), cA, voffA); PG8_STAGE(PG8_SB(0, 1), cB + hstepB, voffB); PG8_STAGE(PG8_SA(0, 1), cA + hstepA, voffA);
    if (wr == 1) PG8_BAR;
    PG8_WAIT_V(4); PG8_BAR;
    PG8_STAGE(PG8_SB(1, 0), cB + kstep, voffB); PG8_STAGE(PG8_SA(1, 0), cA + kstep, voffA); PG8_STAGE(PG8_SB(1, 1), cB + hstepB + kstep, voffB);
    PG8_WAIT_V(6); PG8_BAR;
    for (;;) {
        const bool has_next = S.next(ui + 1, nxt);
        const char* nA = has_next ? (const char*)g.A + (size_t)nxt.pm * tstepA : cA; const char* nB = has_next ? (const char*)g.Bt + (size_t)nxt.pn * tstepB : cB;
        for (int t = 0; t < nt; t += 2) {
            const bool last = (t == nt - 2);
            const char* a1 = cA + (size_t)(t + 1) * kstep;
            const char* a2 = last ? nA : cA + (size_t)(t + 2) * kstep; const char* b2 = last ? nB : cB + (size_t)(t + 2) * kstep;
            const char* a3 = a2 + kstep; const char* b3 = b2 + kstep;
            PG8_LDB(B0, 0, 0); PG8_SCHED; PG8_LDA(At, 0, 0); PG8_STAGE(PG8_SA(1, 1), a1 + hstepA, voffA);
            PG8_WAIT_L(8); PG8_BAR; PG8_WAIT_L(0); PG8_MMA(0, 0, At, B0); PG8_BAR; PG8_SCHED;
            PG8_LDB(B1, 0, 1); PG8_STAGE(PG8_SB(0, 0), b2, voffB);
            PG8_BAR; PG8_WAIT_L(0); PG8_MMA(0, 1, At, B1); PG8_BAR;
            PG8_LDA(At, 0, 1); PG8_STAGE(PG8_SA(0, 0), a2, voffA);
            PG8_BAR; PG8_WAIT_L(0); PG8_MMA(1, 0, At, B0); PG8_BAR; PG8_SCHED;
            PG8_STAGE(PG8_SB(0, 1), b2 + hstepB, voffB);
            PG8_WAIT_V(6); PG8_BAR; PG8_MMA(1, 1, At, B1); PG8_BAR;
            PG8_LDB(B0, 1, 0); PG8_SCHED; PG8_LDA(At, 1, 0); PG8_STAGE(PG8_SA(0, 1), a2 + hstepA, voffA);
            PG8_WAIT_L(8); PG8_BAR; PG8_WAIT_L(0); PG8_MMA(0, 0, At, B0); PG8_BAR; PG8_SCHED;
            PG8_LDB(B1, 1, 1); PG8_STAGE(PG8_SB(1, 0), b3, voffB);
            PG8_BAR; PG8_WAIT_L(0); PG8_MMA(0, 1, At, B1); PG8_BAR;
            PG8_LDA(At, 1, 1); PG8_STAGE(PG8_SA(1, 0), a3, voffA);
            PG8_BAR; PG8_WAIT_L(0); PG8_MMA(1, 0, At, B0); PG8_BAR; PG8_SCHED;
            PG8_STAGE(PG8_SB(1, 1), b3 + hstepB, voffB);
            PG8_WAIT_V(6); PG8_BAR; PG8_MMA(1, 1, At, B1); PG8_BAR;
        }
        E(acc, cur, wr, wc, fr, fq);
        if (!has_next) break;
#pragma unroll
        for (int a = 0; a < 2; ++a)
#pragma unroll
            for (int b = 0; b < 2; ++b)
#pragma unroll
                for (int m = 0; m < 4; ++m)
#pragma unroll
                    for (int n = 0; n < 2; ++n) acc[a][b][m][n] = (f32x4){0.f, 0.f, 0.f, 0.f};
        cur = nxt; cA = nA; cB = nB; ++ui;
    }
    PG8_WAIT_V(0);
    if (wr == 0) PG8_BAR;
    PG8_BAR;
#undef PG8_SA
#undef PG8_SB
#undef PG8_STAGE
#undef PG8_LDA
#undef PG8_LDB
#undef PG8_MMA
#undef PG8_WAIT_V
#undef PG8_WAIT_L
#undef PG8_BAR
#undef PG8_SCHED
}
}

struct EpiGen {
    bf16_t* O; int ldc; int act;
    float* gate; int gate_pn;
    __device__ __forceinline__ void operator()(const f32x4 (&acc)[2][2][4][2], const pg8::Unit& u, int wr, int wc, int fr_, int fq_) const {
        int fr = fr_, fq = fq_; asm volatile("" : "+v"(fr), "+v"(fq));
        const int row0 = u.pm * 256 + wr * 64 + fr;
        if (act == 3) {
            const int col0 = u.pn * 256 + wc * 32 + 8 * fq;
#pragma unroll
            for (int q = 0; q < 4; ++q) { const int ai = q >> 1; u32x4 pv[2][2];
#pragma unroll
                for (int mm = 0; mm < 2; ++mm)
#pragma unroll
                    for (int bj = 0; bj < 2; ++bj) pv[mm][bj] = *(const u32x4*)(O + (size_t)(row0 + ai * 128 + ((q & 1) * 2 + mm) * 16) * ldc + col0 + bj * 128);
#pragma unroll
                for (int mm = 0; mm < 2; ++mm)
#pragma unroll
                    for (int bj = 0; bj < 2; ++bj) { const int m = (q & 1) * 2 + mm; const f32x4 v0 = acc[ai][bj][m][0], v1 = acc[ai][bj][m][1]; const u32x4 pu = pv[mm][bj]; u32x4 w;
                        w.x = pk2(sigmoidf_(v0[0]) * bflo(pu.x), sigmoidf_(v0[1]) * bfhi(pu.x)); w.y = pk2(sigmoidf_(v0[2]) * bflo(pu.y), sigmoidf_(v0[3]) * bfhi(pu.y));
                        w.z = pk2(sigmoidf_(v1[0]) * bflo(pu.z), sigmoidf_(v1[1]) * bfhi(pu.z)); w.w = pk2(sigmoidf_(v1[2]) * bflo(pu.w), sigmoidf_(v1[3]) * bfhi(pu.w));
                        *(u32x4*)(O + (size_t)(row0 + ai * 128 + m * 16) * ldc + col0 + bj * 128) = w; }
                asm volatile("" ::: "memory"); }
            return;
        }
        if (u.pn == gate_pn) {
            if (wc == 0 && fq < 2) {
#pragma unroll
                for (int ai = 0; ai < 2; ++ai)
#pragma unroll
                    for (int m = 0; m < 4; ++m) { float* gp = gate + (size_t)(row0 + ai * 128 + m * 16) * 16 + 8 * fq;
                        *(f32x4*)gp = acc[ai][0][m][0]; *(f32x4*)(gp + 4) = acc[ai][0][m][1]; }
            }
            return;
        }
        const int col0 = u.pn * 256 + wc * 32 + 8 * fq;
#pragma unroll
        for (int ai = 0; ai < 2; ++ai)
#pragma unroll
            for (int m = 0; m < 4; ++m) { bf16_t* rowp = O + (size_t)(row0 + ai * 128 + m * 16) * ldc + col0;
#pragma unroll
                for (int bj = 0; bj < 2; ++bj) { f32x4 v0 = acc[ai][bj][m][0], v1 = acc[ai][bj][m][1];
                    if (act == 1) {
#pragma unroll
                        for (int j = 0; j < 4; ++j) { v0[j] = gelu_tanh(v0[j]); v1[j] = gelu_tanh(v1[j]); }
                    } else if (act == 2) {
#pragma unroll
                        for (int j = 0; j < 4; ++j) { const float a = fmaxf(v0[j], 0.f), b = fmaxf(v1[j], 0.f); v0[j] = a * a; v1[j] = b * b; }
                    } else if (act == 3) {
                        const u32x4 pu = *(const u32x4*)(rowp + bj * 128);
                        v0[0] = sigmoidf_(v0[0]) * bflo(pu.x); v0[1] = sigmoidf_(v0[1]) * bfhi(pu.x); v0[2] = sigmoidf_(v0[2]) * bflo(pu.y); v0[3] = sigmoidf_(v0[3]) * bfhi(pu.y);
                        v1[0] = sigmoidf_(v1[0]) * bflo(pu.z); v1[1] = sigmoidf_(v1[1]) * bfhi(pu.z); v1[2] = sigmoidf_(v1[2]) * bflo(pu.w); v1[3] = sigmoidf_(v1[3]) * bfhi(pu.w);
                    }
                    u32x4 w; w.x = pk2(v0[0], v0[1]); w.y = pk2(v0[2], v0[3]); w.z = pk2(v1[0], v1[1]); w.w = pk2(v1[2], v1[3]);
                    *(u32x4*)(rowp + bj * 128) = w; }
                asm volatile("" ::: "memory"); }
    }
};
struct EpiRg {
    const bf16_t* xc; bf16_t* loga; bf16_t* beta; const float* b_a; const float* b_x; const float* spt; int blk;
    __device__ __forceinline__ void operator()(const f32x4 (&acc)[2][2][4][2], const pg8::Unit& u, int wr, int wc, int fr_, int fq_) const {
        int fr = fr_, fq = fq_; asm volatile("" : "+v"(fr), "+v"(fq));
        const int row0 = u.pm * 256 + wr * 64 + fr;
        const int ch0 = blk * 256 + u.pn * 128 + wc * 32 + 8 * fq;
#pragma unroll
        for (int q = 0; q < 4; ++q) { const int ai = q >> 1; u32x4 xq[2];
#pragma unroll
            for (int mm = 0; mm < 2; ++mm) xq[mm] = *(const u32x4*)(xc + (size_t)(row0 + ai * 128 + ((q & 1) * 2 + mm) * 16) * 1024 + ch0);
            f32x4 ba[2], bx[2], sp[2];
#pragma unroll
            for (int hh = 0; hh < 2; ++hh) { ba[hh] = *(const f32x4*)(b_a + ch0 + hh * 4); bx[hh] = *(const f32x4*)(b_x + ch0 + hh * 4); sp[hh] = *(const f32x4*)(spt + ch0 + hh * 4); }
#pragma unroll
            for (int mm = 0; mm < 2; ++mm) { const int m = (q & 1) * 2 + mm; const size_t off = (size_t)(row0 + ai * 128 + m * 16) * 1024 + ch0; const u32x4 xv = xq[mm];
                u32x4 wl, wb;
#pragma unroll
                for (int hh = 0; hh < 2; ++hh) {
                    const unsigned x01 = hh ? xv.z : xv.x, x23 = hh ? xv.w : xv.y;
                    const float x[4] = {bflo(x01), bfhi(x01), bflo(x23), bfhi(x23)};
                    float la[4], be[4];
#pragma unroll
                    for (int e = 0; e < 4; ++e) { const float rp = acc[ai][0][m][hh][e] + ba[hh][e], ip = acc[ai][1][m][hh][e] + bx[hh][e];
                        const float r = sigmoidf_(rp), ig = sigmoidf_(ip); const float l = sp[hh][e] * r; la[e] = l;
                        be[e] = __builtin_amdgcn_sqrtf(fmaxf(1.0f - __expf(2.0f * l), 0.f)) * ig * x[e]; }
                    if (hh == 0) { wl.x = pk2(la[0], la[1]); wl.y = pk2(la[2], la[3]); wb.x = pk2(be[0], be[1]); wb.y = pk2(be[2], be[3]); }
                    else { wl.z = pk2(la[0], la[1]); wl.w = pk2(la[2], la[3]); wb.z = pk2(be[0], be[1]); wb.w = pk2(be[2], be[3]); }
                }
                *(u32x4*)(loga + off) = wl; *(u32x4*)(beta + off) = wb; }
            asm volatile("" ::: "memory"); }
    }
};

__device__ __forceinline__ void rowpass(const float* hin, const bf16_t* hinb, const bf16_t* y, const float* gadd, float* hout, bf16_t* houtb, const float* gnext, bf16_t* hn, int normnext,
                                        const float* psrc, bf16_t* pdst, const float* rs_in = nullptr, const float* g_in = nullptr, float* rs_out = nullptr) {
    const int tid_ = opaque_tid(); const int lane = tid_ & 63, wave = tid_ >> 6;
    const int gw = blockIdx.x * 8 + wave, nw = gridDim.x * 8;
    f32x4 ga[4], gn[4], gi[4];
#pragma unroll
    for (int q = 0; q < 4; ++q) { gi[q] = (f32x4){1.f, 1.f, 1.f, 1.f}; if (rs_in) { const f32x4 t = *(const f32x4*)(g_in + q * 256 + lane * 4); gi[q] = (f32x4){fast_rcp(t[0]), fast_rcp(t[1]), fast_rcp(t[2]), fast_rcp(t[3])}; } }
#pragma unroll
    for (int q = 0; q < 4; ++q) { ga[q] = y ? *(const f32x4*)(gadd + q * 256 + lane * 4) : (f32x4){0.f, 0.f, 0.f, 0.f}; gn[q] = (hn && normnext) ? *(const f32x4*)(gnext + q * 256 + lane * 4) : (f32x4){1.f, 1.f, 1.f, 1.f}; }
    for (int row0_ = gw; row0_ < MTOK; row0_ += 4 * nw) {
        f32x4 h[4][4]; u32x2 yv[4][4]; f32x4 pv[4]; float rsi[4];
#pragma unroll
        for (int u = 0; u < 4; ++u) { const int row = row0_ + u * nw; rsi[u] = 1.0f; if (row < MTOK) { const size_t base = (size_t)row * DM + lane * 4;
            if (rs_in) rsi[u] = rs_in[row];
            if (hin) {
#pragma unroll
                for (int q = 0; q < 4; ++q) h[u][q] = __builtin_nontemporal_load((const f32x4*)(hin + base + q * 256));
            } else {
#pragma unroll
                for (int q = 0; q < 4; ++q) { const u32x2 hv = __builtin_nontemporal_load((const u32x2*)(hinb + base + q * 256)); h[u][q] = (f32x4){bflo(hv.x), bfhi(hv.x), bflo(hv.y), bfhi(hv.y)}; }
            }
            if (y) {
#pragma unroll
                for (int q = 0; q < 4; ++q) yv[u][q] = __builtin_nontemporal_load((const u32x2*)(y + base + q * 256));
            }
            if (psrc) pv[u] = __builtin_nontemporal_load((const f32x4*)(psrc + (size_t)row * 256 + lane * 4)); } }
#pragma unroll
        for (int u = 0; u < 4; ++u) { const int row = row0_ + u * nw; if (row < MTOK) { const size_t base = (size_t)row * DM + lane * 4;
            if (rs_in) { const float ir = fast_rcp(rsi[u]);
#pragma unroll
                for (int q = 0; q < 4; ++q) h[u][q] = h[u][q] * ir * gi[q]; }
            if (y) {
                f32x4 yf[4]; float ss = 0.f;
#pragma unroll
                for (int q = 0; q < 4; ++q) { yf[q] = (f32x4){bflo(yv[u][q].x), bfhi(yv[u][q].x), bflo(yv[u][q].y), bfhi(yv[u][q].y)}; ss += yf[q][0] * yf[q][0] + yf[q][1] * yf[q][1] + yf[q][2] * yf[q][2] + yf[q][3] * yf[q][3]; }
                ss = wave_sum(ss);
                const float rs = __builtin_amdgcn_rsqf(ss * (1.0f / DM) + EPS);
#pragma unroll
                for (int q = 0; q < 4; ++q) h[u][q] = h[u][q] + yf[q] * rs * ga[q];
            }
            if (hout) {
#pragma unroll
                for (int q = 0; q < 4; ++q) __builtin_nontemporal_store(h[u][q], (f32x4*)(hout + base + q * 256));
            }
            if (houtb) {
#pragma unroll
                for (int q = 0; q < 4; ++q) { u32x2 w; w.x = pk2(h[u][q][0], h[u][q][1]); w.y = pk2(h[u][q][2], h[u][q][3]); __builtin_nontemporal_store(w, (u32x2*)(houtb + base + q * 256)); }
            }
            if (hn) {
                float rs2 = 1.0f;
                if (normnext) { float ss = 0.f;
#pragma unroll
                    for (int q = 0; q < 4; ++q) ss += h[u][q][0] * h[u][q][0] + h[u][q][1] * h[u][q][1] + h[u][q][2] * h[u][q][2] + h[u][q][3] * h[u][q][3];
                    ss = wave_sum(ss); rs2 = __builtin_amdgcn_rsqf(ss * (1.0f / DM) + EPS); if (rs_out && lane == 0) rs_out[row] = rs2; }
#pragma unroll
                for (int q = 0; q < 4; ++q) { const f32x4 o = h[u][q] * rs2 * gn[q]; u32x2 w; w.x = pk2(o[0], o[1]); w.y = pk2(o[2], o[3]); __builtin_nontemporal_store(w, (u32x2*)(hn + base + q * 256)); }
            }
            if (psrc) { u32x2 w; w.x = pk2(pv[u][0], pv[u][1]); w.y = pk2(pv[u][2], pv[u][3]); __builtin_nontemporal_store(w, (u32x2*)(pdst + (size_t)row * 256 + lane * 4)); } } }
    }
}

struct TJob { const float* src; bf16_t* dst; int lds, ldd, K, nvalid, ntn, t0; };
__device__ __forceinline__ TJob make_tjob(KP P, int j) {
    TJob t; bf16_t* W = (bf16_t*)(P->ws + WS_W); int npad;
    if (j < 16) { const int i = j >> 2, k = j & 3; bf16_t* L = W + (size_t)i * LW;
        if (k == 0) { t.src = P->in[I_WUP] + (size_t)i * 1024 * 4096; t.lds = 4096; t.K = 1024; t.nvalid = 4096; t.dst = L; }
        else if (k == 1) { t.src = P->in[I_WDN] + (size_t)i * 4096 * 1024; t.lds = 1024; t.K = 4096; t.nvalid = 1024; t.dst = L + W_UP; }
        else if (k == 2) { t.src = P->in[I_PG] + (size_t)i * 1024 * 1024; t.lds = 1024; t.K = 1024; t.nvalid = 1024; t.dst = L + W_UP + W_DN; }
        else { t.src = P->in[I_PUP] + (size_t)i * 256 * 1024; t.lds = 1024; t.K = 256; t.nvalid = 1024; t.dst = L + W_UP + W_DN + W_G; }
        npad = t.nvalid; }
    else if (j == 16) { t.src = P->in[I_AIN]; t.lds = 3088; t.K = 1024; t.nvalid = 3088; npad = 3328; t.dst = W + OFF_A_IN; }
    else if (j == 17) { t.src = P->in[I_AOUT]; t.lds = 1024; t.K = 1024; t.nvalid = 1024; npad = 1024; t.dst = W + OFF_A_OUT; }
    else if (j == 18) { t.src = P->in[I_BIN]; t.lds = 4096; t.K = 1024; t.nvalid = 4096; npad = 4096; t.dst = W + OFF_B_IN; }
    else if (j == 19) { t.src = P->in[I_BOUT]; t.lds = 1024; t.K = 1024; t.nvalid = 1024; npad = 1024; t.dst = W + OFF_B_OUT; }
    else if (j == 20) { t.src = P->in[I_CIN]; t.lds = 4096; t.K = 1024; t.nvalid = 4096; npad = 4096; t.dst = W + OFF_C_IN; }
    else if (j == 21) { t.src = P->in[I_COUT]; t.lds = 1024; t.K = 2048; t.nvalid = 1024; npad = 1024; t.dst = W + OFF_C_OUT; }
    else if (j == 22) { t.src = P->in[I_DIN]; t.lds = 2048; t.K = 1024; t.nvalid = 2048; npad = 2048; t.dst = W + OFF_D_IN; }
    else if (j == 23) { t.src = P->in[I_DOUT]; t.lds = 1024; t.K = 1024; t.nvalid = 1024; npad = 1024; t.dst = W + OFF_D_OUT; }
    else { const int q = j - 24, blk = q >> 2, pn = (q >> 1) & 1, which = q & 1;
        t.src = (which ? P->in[I_DWX] : P->in[I_DWA]) + (size_t)blk * 65536 + pn * 128; t.lds = 256; t.K = 256; t.nvalid = 128; npad = 128;
        t.dst = W + OFF_D_G + (size_t)blk * 512 * 256 + (size_t)(pn * 256 + which * 128) * 256; }
    t.ldd = t.K; t.ntn = npad / 64; t.t0 = (t.K / 64) * t.ntn;
    return t;
}
constexpr int NTJOBS = 40;
__device__ __forceinline__ void prep_phase(KP P, LAS unsigned char* lds) {
    const int tid = opaque_tid();
    LAS int* tstart = (LAS int*)(lds + 32768);
    LAS float* tile = (LAS float*)lds;
    if (tid == 0) { int s = 0; for (int j = 0; j < NTJOBS; ++j) { tstart[j] = s; s += make_tjob(P, j).t0; } tstart[NTJOBS] = s; }
    __syncthreads();
    const int total = tstart[NTJOBS];
    for (int gt = blockIdx.x; gt < total; gt += gridDim.x) {
        int j = 0; while (tstart[j + 1] <= gt) ++j;
        const TJob t = make_tjob(P, j);
        const int lt = gt - tstart[j]; const int kt = lt / t.ntn, ntile = lt - kt * t.ntn; const int k0 = kt * 64, n0 = ntile * 64;
        { const int kk = tid >> 4, nn = (tid & 15) * 4;
#pragma unroll
            for (int i = 0; i < 2; ++i) { const int k = kk + 32 * i; f32x4 v = (f32x4){0.f, 0.f, 0.f, 0.f};
                if (n0 + nn < t.nvalid) v = *(const f32x4*)(t.src + (size_t)(k0 + k) * t.lds + n0 + nn);
                tile[k * 65 + nn] = v[0]; tile[k * 65 + nn + 1] = v[1]; tile[k * 65 + nn + 2] = v[2]; tile[k * 65 + nn + 3] = v[3]; } }
        __syncthreads();
        { const int n = tid >> 3, k8 = (tid & 7) * 8; float v[8];
#pragma unroll
            for (int e = 0; e < 8; ++e) v[e] = tile[(k8 + e) * 65 + n];
            u32x4 w; w.x = pk2(v[0], v[1]); w.y = pk2(v[2], v[3]); w.z = pk2(v[4], v[5]); w.w = pk2(v[6], v[7]);
            *(u32x4*)(t.dst + (size_t)(n0 + n) * t.ldd + k0 + k8) = w; }
        __syncthreads();
    }
    { bf16_t* Wsb = (bf16_t*)(P->ws + WS_W) + OFF_C_WS; const float* sw = P->in[I_CSW];
        for (int i = blockIdx.x * NTHREADS + tid; i < 8 * 128 * 128; i += gridDim.x * NTHREADS) { const int s = i & 127, t = (i >> 7) & 127; Wsb[i] = f2bf(s <= t ? sw[i] : 0.f); } }
    if (blockIdx.x == 0) { float* lb = (float*)(P->ws + WS_LB); const float* s = P->in[I_BLB];
        for (int c = tid; c < 1024; c += NTHREADS) { const float a0 = s[c], a1 = s[1024 + c], a2 = s[2048 + c], a3 = s[3072 + c]; const float mx = fmaxf(fmaxf(a0, a1), fmaxf(a2, a3));
            const float e0 = __expf(a0 - mx), e1 = __expf(a1 - mx), e2 = __expf(a2 - mx), e3 = __expf(a3 - mx); lb[c] = e1 * fast_rcp(e0 + e1 + e2 + e3);
            lb[1024 + c] = -8.0f * __logf(1.0f + __expf(-P->in[I_DLAM][c])); } }
    rowpass(P->in[I_X], nullptr, nullptr, nullptr, nullptr, nullptr, P->in[I_NG], (bf16_t*)(P->ws + WS_HN), 1, nullptr, nullptr, nullptr, nullptr, (float*)(P->ws + WS_LB + 512 * 1024));
}

__device__ __forceinline__ float incl_scan_sum(float v, int lane) {
#pragma unroll
    for (int d = 1; d < 64; d <<= 1) { const float t = __shfl_up(v, d); if (lane >= d) v += t; }
    return v;
}
__device__ __forceinline__ float incl_scan_max(float v, int lane) {
#pragma unroll
    for (int d = 1; d < 64; d <<= 1) { const float t = __shfl_up(v, d); if (lane >= d) v = fmaxf(v, t); }
    return v;
}
#define LDS_BARRIER() do { asm volatile("s_waitcnt lgkmcnt(0)" ::: "memory"); __builtin_amdgcn_s_barrier(); asm volatile("" ::: "memory"); } while (0)
__device__ __forceinline__ void mlstm_core(KP P, LAS unsigned char* lds) {
    const int tid = opaque_tid(), w = __builtin_amdgcn_readfirstlane(tid >> 6), lane = tid & 63, fr = lane & 15, fq = lane >> 4;
    const bf16_t* z = (const bf16_t*)(P->ws + WS_Z); const float* gate = (const float*)(P->ws + WS_GATE); bf16_t* yout = (bf16_t*)(P->ws + WS_YP);
    constexpr int PQ = 160, PV = 320, PP = 288, PC = 160;
    LAS unsigned char* Qs = lds; LAS unsigned char* Ks = lds + 20480; LAS unsigned char* Vs = lds + 40960; LAS unsigned char* Ps = lds + 81920; LAS unsigned char* Cb = lds + 118784;
    LAS float* fa = (LAS float*)(lds + 141824); LAS float* fM = fa + 128; LAS float* fb = fa + 256; LAS float* fwk = fa + 384;
    for (int unit = blockIdx.x; unit < 256; unit += gridDim.x) {
        const int b = unit >> 3, h = unit & 7;
        const float ib = P->in[I_AIB][h], fbias = P->in[I_AFB][h];
        __syncthreads();
        for (int i = tid; i < 144 * 80 / 2; i += NTHREADS) ((LAS unsigned*)Cb)[i] = 0u;
        if (tid < 128) { LAS unsigned* vp = (LAS unsigned*)(Vs + tid * PV + 256); unsigned zz, one; asm volatile("v_mov_b32 %0, 0" : "=v"(zz)); asm volatile("v_mov_b32 %0, 0x3f80" : "=v"(one)); vp[0] = one;
#pragma unroll
            for (int i = 1; i < 16; ++i) vp[i] = zz; }
        f32x4 st[5];
#pragma unroll
        for (int i = 0; i < 5; ++i) st[i] = (f32x4){0.f, 0.f, 0.f, 0.f};
        float m_state = 0.f;
        u32x4 nq[2], nk[2], nv[4]; float nig = 0.f, nfg = 0.f;
        { const size_t r0 = (size_t)b * SEQL;
#pragma unroll
            for (int i = 0; i < 2; ++i) { const int idx = tid + i * 512, row = idx >> 3, pc = idx & 7;
                nq[i] = *(const u32x4*)(z + (r0 + row) * 3072 + h * 64 + pc * 8); nk[i] = *(const u32x4*)(z + (r0 + row) * 3072 + 512 + h * 64 + pc * 8); }
#pragma unroll
            for (int i = 0; i < 4; ++i) { const int idx = tid + i * 512, row = idx >> 4, pc = idx & 15; nv[i] = *(const u32x4*)(z + (r0 + row) * 3072 + 1024 + h * 128 + pc * 8); }
            if (tid < 128) { nig = gate[(r0 + tid) * 16 + h]; nfg = gate[(r0 + tid) * 16 + 8 + h]; } }
        for (int chunk = 0; chunk < 16; ++chunk) {
            const size_t r0 = (size_t)b * SEQL + chunk * 128;
#pragma unroll
            for (int i = 0; i < 2; ++i) { const int idx = tid + i * 512, row = idx >> 3, pc = idx & 7;
                u32x4 q = nq[i];
                q.x = pk2(bflo(q.x) * 0.125f, bfhi(q.x) * 0.125f); q.y = pk2(bflo(q.y) * 0.125f, bfhi(q.y) * 0.125f); q.z = pk2(bflo(q.z) * 0.125f, bfhi(q.z) * 0.125f); q.w = pk2(bflo(q.w) * 0.125f, bfhi(q.w) * 0.125f);
                *(LAS u32x4*)(Qs + row * PQ + pc * 16) = q;
                *(LAS u32x4*)(Ks + row * PQ + pc * 16) = nk[i]; }
#pragma unroll
            for (int i = 0; i < 4; ++i) { const int idx = tid + i * 512, row = idx >> 4, pc = idx & 15;
                *(LAS u32x4*)(Vs + row * PV + pc * 16) = nv[i]; }
            if (tid < 128) { const float ig = nig, fg = nfg;
                const float xf = fg + fbias; const float lf = fminf(xf, 0.f) - __logf(1.0f + __expf(-fabsf(xf)));
                fa[tid] = ig + ib; fb[tid] = lf; }
            if (chunk + 1 < 16) { const size_t r1 = r0 + 128;
#pragma unroll
                for (int i = 0; i < 2; ++i) { const int idx = tid + i * 512, row = idx >> 3, pc = idx & 7;
                    nq[i] = *(const u32x4*)(z + (r1 + row) * 3072 + h * 64 + pc * 8); nk[i] = *(const u32x4*)(z + (r1 + row) * 3072 + 512 + h * 64 + pc * 8); }
#pragma unroll
                for (int i = 0; i < 4; ++i) { const int idx = tid + i * 512, row = idx >> 4, pc = idx & 15; nv[i] = *(const u32x4*)(z + (r1 + row) * 3072 + 1024 + h * 128 + pc * 8); }
                if (tid < 128) { nig = gate[(r1 + tid) * 16 + h]; nfg = gate[(r1 + tid) * 16 + 8 + h]; } }
            LDS_BARRIER();
            if (w == 0) {
                const float lf0 = fb[lane], lf1 = fb[64 + lane], li0 = fa[lane], li1 = fa[64 + lane];
                const float c0 = incl_scan_sum(lf0, lane); const float tot0 = __shfl(c0, 63); const float c1 = incl_scan_sum(lf1, lane) + tot0;
                const float a0 = li0 - c0, a1 = li1 - c1;
                const float p0 = incl_scan_max(a0, lane); const float pt = __shfl(p0, 63); const float p1 = fmaxf(incl_scan_max(a1, lane), pt);
                const float M0 = fmaxf(m_state, p0), M1 = fmaxf(m_state, p1);
                const float Ml = __shfl(M1, 63);
                fa[lane] = a0; fa[64 + lane] = a1; fM[lane] = M0; fM[64 + lane] = M1; fb[lane] = c0; fb[64 + lane] = c1;
                fwk[lane] = __expf(a0 - Ml); fwk[64 + lane] = __expf(a1 - Ml);
            }
            LDS_BARRIER();
            const float Mlast = fM[127], blast = fb[127];
            const int t = 16 * w + fr;
            const float Mt = fM[t], bt = fb[t];
            const float winter = __expf(m_state - Mt);
            u32x2 ogv[8];
#pragma unroll
            for (int n = 0; n < 8; ++n) ogv[n] = *(const u32x2*)(z + (r0 + t) * 3072 + 2048 + h * 128 + 16 * n + fq * 4);
            bf16x8 qf[2];
            qf[0] = ldk(Qs + t * PQ + fq * 16); qf[1] = ldk(Qs + t * PQ + 64 + fq * 16);
            for (int n = 0; n <= (w | 1); ++n) {
                f32x4 a = (f32x4){0.f, 0.f, 0.f, 0.f};
                if (n <= w) {
                    const bf16x8 k0 = ldk(Ks + (16 * n + fr) * PQ + fq * 16), k1 = ldk(Ks + (16 * n + fr) * PQ + 64 + fq * 16);
                    a = MFMA16(k0, qf[0], a); a = MFMA16(k1, qf[1], a);
                    const f32x4 as4 = *(const LAS f32x4*)(fa + 16 * n + fq * 4);
#pragma unroll
                    for (int j = 0; j < 4; ++j) { const int s = 16 * n + fq * 4 + j; a[j] = (s <= t) ? a[j] * __expf(as4[j] - Mt) : 0.f; }
                }
                u32x2 pw; pw.x = pk2(a[0], a[1]); pw.y = pk2(a[2], a[3]);
                *(LAS u32x2*)(Ps + t * PP + (16 * n + fq * 4) * 2) = pw;
            }
            asm volatile("s_waitcnt lgkmcnt(0)" ::: "memory");
            f32x4 o[9];
#pragma unroll
            for (int n = 0; n < 9; ++n) { f32x4 c = (f32x4){0.f, 0.f, 0.f, 0.f};
                c = MFMA16(ldk(Cb + (16 * n + fr) * PC + fq * 16), qf[0], c); c = MFMA16(ldk(Cb + (16 * n + fr) * PC + 64 + fq * 16), qf[1], c);
                o[n] = c * winter; }
            for (int ks = 0; ks <= (w >> 1); ++ks) {
                const bf16x8 pf = ldk(Ps + t * PP + ks * 64 + fq * 16);
#pragma unroll
                for (int n = 0; n < 9; ++n) o[n] = MFMA16(ldt(Vs + (ks * 32) * PV + (16 * n) * 2, PV, fr, fq), pf, o[n]);
            }
            {
                float den = __shfl(o[8][0], fr);
                const float dn = fast_rcp(fmaxf(fabsf(den), __expf(-(bt + Mt))));
                float ss = 0.f;
#pragma unroll
                for (int n = 0; n < 8; ++n) { o[n] = o[n] * dn; ss += o[n][0] * o[n][0] + o[n][1] * o[n][1] + o[n][2] * o[n][2] + o[n][3] * o[n][3]; }
                ss += __shfl_xor(ss, 16); ss += __shfl_xor(ss, 32);
                const float rs = __builtin_amdgcn_rsqf(ss * (1.0f / 128.0f) + EPS);
                const float* hg = P->in[I_AHG] + h * 128;
#pragma unroll
                for (int n = 0; n < 8; ++n) { const int v0 = 16 * n + fq * 4;
                    const u32x2 og = ogv[n];
                    const f32x4 g4 = *(const f32x4*)(hg + v0);
                    const float y0 = o[n][0] * rs * g4[0] * sigmoidf_(bflo(og.x)), y1 = o[n][1] * rs * g4[1] * sigmoidf_(bfhi(og.x));
                    const float y2 = o[n][2] * rs * g4[2] * sigmoidf_(bflo(og.y)), y3 = o[n][3] * rs * g4[3] * sigmoidf_(bfhi(og.y));
                    u32x2 yw; yw.x = pk2(y0, y1); yw.y = pk2(y2, y3);
                    *(u32x2*)(yout + (r0 + t) * 1024 + h * 128 + v0) = yw; }
            }
            {
                const float decay = __expf(m_state - Mlast);
#pragma unroll
                for (int i = 0; i < 5; ++i) st[i] = st[i] * decay;
                for (int ks = 0; ks < 4; ++ks) {
                    const f32x4 wa = *(const LAS f32x4*)(fwk + ks * 32 + fq * 8), wb = *(const LAS f32x4*)(fwk + ks * 32 + fq * 8 + 4);
                    const bf16x8 vf = ldt(Vs + (ks * 32) * PV + (16 * w) * 2, PV, fr, fq);
                    bf16x8 kf[4];
#pragma unroll
                    for (int dt = 0; dt < 4; ++dt) { const u32x4 kr = as_u32x4(ldt(Ks + (ks * 32) * PQ + (16 * dt) * 2, PQ, fr, fq)); u32x4 ksc;
                        ksc.x = pk2(bflo(kr.x) * wa[0], bfhi(kr.x) * wa[1]); ksc.y = pk2(bflo(kr.y) * wa[2], bfhi(kr.y) * wa[3]);
                        ksc.z = pk2(bflo(kr.z) * wb[0], bfhi(kr.z) * wb[1]); ksc.w = pk2(bflo(kr.w) * wb[2], bfhi(kr.w) * wb[3]);
                        kf[dt] = as_bf16x8(ksc); st[dt] = MFMA16(kf[dt], vf, st[dt]); }
                    if (w < 4) { const bf16x8 v8 = ldt(Vs + (ks * 32) * PV + 128 * 2, PV, fr, fq);
                        const bf16x8 kw = (w == 0) ? kf[0] : (w == 1) ? kf[1] : (w == 2) ? kf[2] : kf[3];
                        st[4] = MFMA16(kw, v8, st[4]); }
                }
            }
            m_state = blast + Mlast;
            LDS_BARRIER();
#pragma unroll
            for (int dt = 0; dt < 4; ++dt) { u32x2 cw; cw.x = pk2(st[dt][0], st[dt][1]); cw.y = pk2(st[dt][2], st[dt][3]);
                *(LAS u32x2*)(Cb + (16 * w + fr) * PC + (16 * dt + fq * 4) * 2) = cw; }
            if (w < 4) { u32x2 cw; cw.x = pk2(st[4][0], st[4][1]); cw.y = pk2(st[4][2], st[4][3]);
                *(LAS u32x2*)(Cb + (128 + fr) * PC + (16 * w + fq * 4) * 2) = cw; }
        }
    }
    __syncthreads();
}

__device__ __forceinline__ void hgrn_core(KP P, LAS unsigned char* lds) {
    const int tid = opaque_tid(), w = __builtin_amdgcn_readfirstlane(tid >> 6), lane = tid & 63, fr = lane & 15, fq = lane >> 4;
    const bf16_t* z = (const bf16_t*)(P->ws + WS_Z); const float* lbv = (const float*)(P->ws + WS_LB); bf16_t* yout = (bf16_t*)(P->ws + WS_YP);
    constexpr int PT = 288, PA = 96;
    LAS unsigned char* Qt = lds; LAS unsigned char* Qh = lds + 9216; LAS unsigned char* Kh = lds + 18432; LAS unsigned char* Vs = lds + 27648; LAS unsigned char* At = lds + 36864;
    LAS unsigned char* Sb = lds + 40960;
    LAS float* gl = (LAS float*)(lds + 77824);
    LAS float* seg = (LAS float*)(lds + 78336);
    LAS float* ssp = (LAS float*)(lds + 80384);
    const int c = tid & 127, tq = tid >> 7;
    for (int unit = blockIdx.x; unit < 256; unit += gridDim.x) {
        const int b = unit >> 3, h = unit & 7;
        const float lb = lbv[h * 128 + c];
        __syncthreads();
        for (int i = tid; i < 128 * 144 / 2; i += NTHREADS) ((LAS unsigned*)Sb)[i] = 0u;
        f32x4 S[8];
#pragma unroll
        for (int i = 0; i < 8; ++i) S[i] = (f32x4){0.f, 0.f, 0.f, 0.f};
        bf16_t nq[8], nf[8]; u32x4 nv; u32x2 ng2[2];
        { const size_t r0 = (size_t)b * SEQL;
#pragma unroll
            for (int i = 0; i < 8; ++i) { const size_t ro = (r0 + tq * 8 + i) * 4096 + h * 128 + c; nq[i] = z[ro]; nf[i] = z[ro + 1024]; }
            nv = *(const u32x4*)(z + (r0 + (tid >> 4)) * 4096 + 2048 + h * 128 + (tid & 15) * 8);
#pragma unroll
            for (int tt = 0; tt < 2; ++tt) ng2[tt] = *(const u32x2*)(z + (r0 + 16 * tt + fr) * 4096 + 3072 + h * 128 + 16 * w + fq * 4); }
        for (int chunk = 0; chunk < 64; ++chunk) {
            const size_t r0 = (size_t)b * SEQL + chunk * 32;
            float qv[8], kv[8], cs[8];
            const u32x2 cg0 = ng2[0], cg1 = ng2[1];
            { float run = 0.f;
#pragma unroll
                for (int i = 0; i < 8; ++i) {
                    qv[i] = bf2f(nq[i]); const float fz = bf2f(nf[i]);
                    const float f = lb + (1.0f - lb) * sigmoidf_(fz); kv[i] = 1.0f - f; run += __logf(f); cs[i] = run; }
                seg[tq * 128 + c] = run; }
            { const int row = tid >> 4, pc = tid & 15;
                *(LAS u32x4*)(Vs + row * PT + pc * 16) = nv; }
            if (chunk + 1 < 64) { const size_t r1 = r0 + 32;
#pragma unroll
                for (int i = 0; i < 8; ++i) { const size_t ro = (r1 + tq * 8 + i) * 4096 + h * 128 + c; nq[i] = z[ro]; nf[i] = z[ro + 1024]; }
                nv = *(const u32x4*)(z + (r1 + (tid >> 4)) * 4096 + 2048 + h * 128 + (tid & 15) * 8);
#pragma unroll
                for (int tt = 0; tt < 2; ++tt) ng2[tt] = *(const u32x2*)(z + (r1 + 16 * tt + fr) * 4096 + 3072 + h * 128 + 16 * w + fq * 4); }
            LDS_BARRIER();
            { const float s0 = seg[c], s1 = seg[128 + c], s2 = seg[256 + c], s3 = seg[384 + c];
                const float pre = (tq > 0 ? s0 : 0.f) + (tq > 1 ? s1 : 0.f) + (tq > 2 ? s2 : 0.f); const float glast = (s0 + s1) + (s2 + s3);
#pragma unroll
                for (int i = 0; i < 8; ++i) { const float g = pre + cs[i]; const int t = tq * 8 + i;
                    const float eg = __expf(g), er = __expf(g - glast);
                    *(LAS bf16_t*)(Qh + t * PT + c * 2) = f2bf(qv[i] * eg);
                    *(LAS bf16_t*)(Qt + t * PT + c * 2) = f2bf(qv[i] * er);
                    *(LAS bf16_t*)(Kh + t * PT + c * 2) = f2bf(kv[i] * fast_rcp(er)); }
                if (tq == 0) gl[c] = __expf(glast); }
            LDS_BARRIER();
            f32x4 o[2];
#pragma unroll
            for (int tt = 0; tt < 2; ++tt) { f32x4 a = (f32x4){0.f, 0.f, 0.f, 0.f};
#pragma unroll
                for (int ks = 0; ks < 4; ++ks) a = MFMA16(ldk(Sb + (16 * w + fr) * PT + ks * 64 + fq * 16), ldk(Qh + (16 * tt + fr) * PT + ks * 64 + fq * 16), a);
                o[tt] = a; }
            if (w < 4) { const int tt = w >> 1, stl = w & 1; f32x4 a = (f32x4){0.f, 0.f, 0.f, 0.f};
                if (!(tt == 0 && stl == 1)) {
#pragma unroll
                    for (int ks = 0; ks < 4; ++ks) a = MFMA16(ldk(Kh + (16 * stl + fr) * PT + ks * 64 + fq * 16), ldk(Qt + (16 * tt + fr) * PT + ks * 64 + fq * 16), a);
                    const int t = 16 * tt + fr;
#pragma unroll
                    for (int j = 0; j < 4; ++j) { const int s = 16 * stl + fq * 4 + j; if (s > t) a[j] = 0.f; }
                }
                u32x2 aw; aw.x = pk2(a[0], a[1]); aw.y = pk2(a[2], a[3]);
                *(LAS u32x2*)(At + (16 * tt + fr) * PA + (16 * stl + fq * 4) * 2) = aw; }
            LDS_BARRIER();
            { const bf16x8 vf = ldt(Vs + (16 * w) * 2, PT, fr, fq);
#pragma unroll
                for (int tt = 0; tt < 2; ++tt) { o[tt] = MFMA16(vf, ldk(At + (16 * tt + fr) * PA + fq * 16), o[tt]);
                    float ss = o[tt][0] * o[tt][0] + o[tt][1] * o[tt][1] + o[tt][2] * o[tt][2] + o[tt][3] * o[tt][3];
                    ss += __shfl_xor(ss, 16); ss += __shfl_xor(ss, 32);
                    if (fq == 0) ssp[(16 * tt + fr) * 8 + w] = ss; }
                const bf16x8 kf = ldt(Kh + (16 * w) * 2, PT, fr, fq);
                const f32x4 dc = *(const LAS f32x4*)(gl + 16 * w + fq * 4);
#pragma unroll
                for (int vt = 0; vt < 8; ++vt) { S[vt] = S[vt] * dc; S[vt] = MFMA16(kf, ldt(Vs + (16 * vt) * 2, PT, fr, fq), S[vt]); } }
            LDS_BARRIER();
#pragma unroll
            for (int vt = 0; vt < 8; ++vt) { u32x2 sw; sw.x = pk2(S[vt][0], S[vt][1]); sw.y = pk2(S[vt][2], S[vt][3]);
                *(LAS u32x2*)(Sb + (16 * vt + fr) * PT + (16 * w + fq * 4) * 2) = sw; }
            { const float* hg = P->in[I_BHG] + h * 128; const int v0 = 16 * w + fq * 4; const f32x4 g4 = *(const f32x4*)(hg + v0);
#pragma unroll
                for (int tt = 0; tt < 2; ++tt) { const int t = 16 * tt + fr;
                    const f32x4 sa = *(const LAS f32x4*)(ssp + t * 8), sb = *(const LAS f32x4*)(ssp + t * 8 + 4);
                    const float tot = ((sa[0] + sa[1]) + (sa[2] + sa[3])) + ((sb[0] + sb[1]) + (sb[2] + sb[3]));
                    const float rs = __builtin_amdgcn_rsqf(tot * (1.0f / 128.0f) + EPS);
                    const u32x2 gg = tt ? cg1 : cg0;
                    const float g0 = bflo(gg.x), g1 = bfhi(gg.x), g2 = bflo(gg.y), g3 = bfhi(gg.y);
                    const float y0 = o[tt][0] * rs * g4[0] * g0 * sigmoidf_(g0), y1 = o[tt][1] * rs * g4[1] * g1 * sigmoidf_(g1);
                    const float y2 = o[tt][2] * rs * g4[2] * g2 * sigmoidf_(g2), y3 = o[tt][3] * rs * g4[3] * g3 * sigmoidf_(g3);
                    u32x2 yw; yw.x = pk2(y0, y1); yw.y = pk2(y2, y3);
                    *(u32x2*)(yout + (r0 + t) * 1024 + h * 128 + v0) = yw; } }
        }
    }
    __syncthreads();
}

__device__ __forceinline__ void spatial_core(KP P, LAS unsigned char* lds) {
    const int tid = opaque_tid(), w = __builtin_amdgcn_readfirstlane(tid >> 6), lane = tid & 63, fr = lane & 15, fq = lane >> 4;
    bf16_t* z = (bf16_t*)(P->ws + WS_Z); const bf16_t* Wsb = (const bf16_t*)(P->ws + WS_W) + OFF_C_WS;
    constexpr int PVh = 544, PW = 288;
    LAS unsigned char* Vh = lds; LAS unsigned char* Wg = lds + 69632; LAS float* mu = (LAS float*)(lds + 106496); LAS float* rsd = mu + 128;
    for (int unit = blockIdx.x; unit < 512; unit += gridDim.x) {
        const size_t r0 = (size_t)unit * 128;
        __syncthreads();
        for (int rb = 0; rb < 4; ++rb) { u32x4 xr[4][4];
#pragma unroll
            for (int j = 0; j < 4; ++j)
#pragma unroll
                for (int q = 0; q < 4; ++q) xr[j][q] = *(const u32x4*)(z + (r0 + 16 * w + rb * 4 + j) * 4096 + 2048 + (q * 64 + lane) * 8);
#pragma unroll
            for (int j = 0; j < 4; ++j) { const int row = 16 * w + rb * 4 + j; float x[32]; float s = 0.f;
#pragma unroll
                for (int q = 0; q < 4; ++q) { const u32x4 v = xr[j][q];
                    x[q * 8 + 0] = bflo(v.x); x[q * 8 + 1] = bfhi(v.x); x[q * 8 + 2] = bflo(v.y); x[q * 8 + 3] = bfhi(v.y); x[q * 8 + 4] = bflo(v.z); x[q * 8 + 5] = bfhi(v.z); x[q * 8 + 6] = bflo(v.w); x[q * 8 + 7] = bfhi(v.w); }
#pragma unroll
                for (int e = 0; e < 32; ++e) s += x[e];
                s = wave_sum(s); const float mean = s * (1.0f / 2048.0f); float qd = 0.f;
#pragma unroll
                for (int e = 0; e < 32; ++e) { const float d = x[e] - mean; qd += d * d; }
                qd = wave_sum(qd);
                if (lane == 0) { mu[row] = mean; rsd[row] = __builtin_amdgcn_rsqf(qd * (1.0f / 2048.0f) + EPS); } } }
        __syncthreads();
        const int pc = tid & 31;
        u32x4 pvr[8], pwr[4];
#define SP_LOADG(gg) do { _Pragma("unroll") for (int i = 0; i < 8; ++i) pvr[i] = *(const u32x4*)(z + (r0 + (tid >> 5) + i * 16) * 4096 + 2048 + (gg) * 256 + pc * 8); \
            _Pragma("unroll") for (int i = 0; i < 4; ++i) { const int idx = tid + i * 512; pwr[i] = *(const u32x4*)(Wsb + (size_t)(gg) * 16384 + (idx >> 4) * 128 + (idx & 15) * 8); } } while (0)
        SP_LOADG(0);
        for (int g = 0; g < 8; ++g) {
            { float gn[8], bi[8];
#pragma unroll
                for (int e = 0; e < 8; ++e) { gn[e] = P->in[I_CLG][g * 256 + pc * 8 + e]; bi[e] = P->in[I_CLB][g * 256 + pc * 8 + e]; }
#pragma unroll
                for (int i = 0; i < 8; ++i) { const int row = (tid >> 5) + i * 16;
                    const u32x4 v = pvr[i]; const float m = mu[row], r = rsd[row];
                    u32x4 o; o.x = pk2((bflo(v.x) - m) * r * gn[0] + bi[0], (bfhi(v.x) - m) * r * gn[1] + bi[1]); o.y = pk2((bflo(v.y) - m) * r * gn[2] + bi[2], (bfhi(v.y) - m) * r * gn[3] + bi[3]);
                    o.z = pk2((bflo(v.z) - m) * r * gn[4] + bi[4], (bfhi(v.z) - m) * r * gn[5] + bi[5]); o.w = pk2((bflo(v.w) - m) * r * gn[6] + bi[6], (bfhi(v.w) - m) * r * gn[7] + bi[7]);
                    *(LAS u32x4*)(Vh + row * PVh + pc * 16) = o; }
#pragma unroll
                for (int i = 0; i < 4; ++i) { const int idx = tid + i * 512, row = idx >> 4, p2 = idx & 15;
                    *(LAS u32x4*)(Wg + row * PW + p2 * 16) = pwr[i]; } }
            u32x2 upre[8][2]; float bsv[8];
#pragma unroll
            for (int tt = 0; tt < 8; ++tt) { const int t = 16 * tt + fr; const bf16_t* up = z + (r0 + t) * 4096 + g * 256 + 32 * w + fq * 4;
                upre[tt][0] = *(const u32x2*)up; upre[tt][1] = *(const u32x2*)(up + 16); bsv[tt] = P->in[I_CSB][g * 128 + t]; }
            if (g + 1 < 8) SP_LOADG(g + 1);
            LDS_BARRIER();
            bf16x8 bf[2][4];
#pragma unroll
            for (int ci = 0; ci < 2; ++ci)
#pragma unroll
                for (int ks = 0; ks < 4; ++ks) bf[ci][ks] = ldt(Vh + (ks * 32) * PVh + (16 * (2 * w + ci)) * 2, PVh, fr, fq);
#pragma unroll
            for (int tt = 0; tt < 8; ++tt) { f32x4 a0 = (f32x4){0.f, 0.f, 0.f, 0.f}, a1 = a0;
#pragma unroll
                for (int ks = 0; ks < 4; ++ks) if (ks <= (tt >> 1)) { const bf16x8 af = ldk(Wg + (16 * tt + fr) * PW + ks * 64 + fq * 16); a0 = MFMA16(bf[0][ks], af, a0); a1 = MFMA16(bf[1][ks], af, a1); }
                const int t = 16 * tt + fr; const float bs = bsv[tt];
                bf16_t* up = z + (r0 + t) * 4096 + g * 256 + 32 * w + fq * 4;
                { const u32x2 uu = upre[tt][0]; u32x2 yw; yw.x = pk2(bflo(uu.x) * (a0[0] + bs), bfhi(uu.x) * (a0[1] + bs)); yw.y = pk2(bflo(uu.y) * (a0[2] + bs), bfhi(uu.y) * (a0[3] + bs)); *(u32x2*)up = yw; }
                { const u32x2 uu = upre[tt][1]; u32x2 yw; yw.x = pk2(bflo(uu.x) * (a1[0] + bs), bfhi(uu.x) * (a1[1] + bs)); yw.y = pk2(bflo(uu.y) * (a1[2] + bs), bfhi(uu.y) * (a1[3] + bs)); *(u32x2*)(up + 16) = yw; } }
            LDS_BARRIER();
        }
#undef SP_LOADG
    }
    __syncthreads();
}

__device__ __forceinline__ void conv_pass(KP P) {
    const bf16_t* z = (const bf16_t*)(P->ws + WS_Z); bf16_t* xc = (bf16_t*)(P->ws + WS_YP);
    const int gtid = blockIdx.x * NTHREADS + opaque_tid(), nth = gridDim.x * NTHREADS;
    const int oct = gtid & 127;
    float cw[4][8], cb[8];
#pragma unroll
    for (int e = 0; e < 8; ++e) { cb[e] = P->in[I_DCB][oct * 8 + e];
#pragma unroll
        for (int j = 0; j < 4; ++j) cw[j][e] = P->in[I_DCW][j * 1024 + oct * 8 + e]; }
    for (int idx = gtid; idx < (MTOK / 8) * 128; idx += nth) {
        const int r0 = (idx >> 7) * 8; const bool first = (r0 & (SEQL - 1)) == 0;
        u32x4 xr[11];
#pragma unroll
        for (int i = 0; i < 11; ++i) { xr[i] = (u32x4){0u, 0u, 0u, 0u}; if (i >= 3 || !first) xr[i] = *(const u32x4*)(z + (size_t)(r0 - 3 + i) * 2048 + 1024 + oct * 8); }
#pragma unroll
        for (int o = 0; o < 8; ++o) { float a[8];
#pragma unroll
            for (int e = 0; e < 8; ++e) a[e] = cb[e];
#pragma unroll
            for (int j = 0; j < 4; ++j) { const u32x4 v = xr[o + j];
                a[0] += cw[j][0] * bflo(v.x); a[1] += cw[j][1] * bfhi(v.x); a[2] += cw[j][2] * bflo(v.y); a[3] += cw[j][3] * bfhi(v.y);
                a[4] += cw[j][4] * bflo(v.z); a[5] += cw[j][5] * bfhi(v.z); a[6] += cw[j][6] * bflo(v.w); a[7] += cw[j][7] * bfhi(v.w); }
            u32x4 ow; ow.x = pk2(a[0], a[1]); ow.y = pk2(a[2], a[3]); ow.z = pk2(a[4], a[5]); ow.w = pk2(a[6], a[7]);
            *(u32x4*)(xc + (size_t)(r0 + o) * 1024 + oct * 8) = ow; }
    }
}
__device__ __forceinline__ void scan_pass(KP P, LAS unsigned char* lds) {
    const bf16_t* z = (const bf16_t*)(P->ws + WS_Z); const bf16_t* loga = z + (size_t)MTOK * 2048; const bf16_t* beta = loga + (size_t)MTOK * 1024; bf16_t* y = (bf16_t*)(P->ws + WS_YP);
    LAS float* sA = (LAS float*)lds; LAS float* sB = sA + 512 * 8;
    const int tid = opaque_tid(), seg = tid >> 4, o = tid & 15;
    for (int unit = blockIdx.x; unit < 256; unit += gridDim.x) {
        const int b = unit >> 3; const int ch0 = ((unit & 7) * 16 + o) * 8; const size_t row0 = (size_t)b * SEQL + seg * 64;
        float SL[8], B[8];
#pragma unroll
        for (int e = 0; e < 8; ++e) { SL[e] = 0.f; B[e] = 0.f; }
#pragma unroll 4
        for (int t = 0; t < 64; ++t) { const u32x4 lv = *(const u32x4*)(loga + (row0 + t) * 1024 + ch0), bv = *(const u32x4*)(beta + (row0 + t) * 1024 + ch0);
            const float l[8] = {bflo(lv.x), bfhi(lv.x), bflo(lv.y), bfhi(lv.y), bflo(lv.z), bfhi(lv.z), bflo(lv.w), bfhi(lv.w)};
            const float be[8] = {bflo(bv.x), bfhi(bv.x), bflo(bv.y), bfhi(bv.y), bflo(bv.z), bfhi(bv.z), bflo(bv.w), bfhi(bv.w)};
#pragma unroll
            for (int e = 0; e < 8; ++e) { B[e] = __expf(l[e]) * B[e] + be[e]; SL[e] += l[e]; } }
        __syncthreads();
#pragma unroll
        for (int e = 0; e < 8; ++e) { sA[tid * 8 + e] = __expf(SL[e]); sB[tid * 8 + e] = B[e]; }
        __syncthreads();
        float H[8];
#pragma unroll
        for (int e = 0; e < 8; ++e) H[e] = 0.f;
        for (int s = 0; s < seg; ++s) {
#pragma unroll
            for (int e = 0; e < 8; ++e) H[e] = sA[(s * 16 + o) * 8 + e] * H[e] + sB[(s * 16 + o) * 8 + e]; }
        for (int t0 = 0; t0 < 64; t0 += 4) { u32x4 lvv[4], bvv[4], gvv[4];
#pragma unroll
            for (int i = 0; i < 4; ++i) { lvv[i] = *(const u32x4*)(loga + (row0 + t0 + i) * 1024 + ch0); bvv[i] = *(const u32x4*)(beta + (row0 + t0 + i) * 1024 + ch0); gvv[i] = *(const u32x4*)(z + (row0 + t0 + i) * 2048 + ch0); }
#pragma unroll
            for (int i = 0; i < 4; ++i) { const u32x4 lv = lvv[i], bv = bvv[i], gv = gvv[i];
                const float l[8] = {bflo(lv.x), bfhi(lv.x), bflo(lv.y), bfhi(lv.y), bflo(lv.z), bfhi(lv.z), bflo(lv.w), bfhi(lv.w)};
                const float be[8] = {bflo(bv.x), bfhi(bv.x), bflo(bv.y), bfhi(bv.y), bflo(bv.z), bfhi(bv.z), bflo(bv.w), bfhi(bv.w)};
                const float gg[8] = {bflo(gv.x), bfhi(gv.x), bflo(gv.y), bfhi(gv.y), bflo(gv.z), bfhi(gv.z), bflo(gv.w), bfhi(gv.w)};
                float yv[8];
#pragma unroll
                for (int e = 0; e < 8; ++e) { H[e] = __expf(l[e]) * H[e] + be[e]; yv[e] = H[e] * gelu_tanh(gg[e]); }
                u32x4 ow; ow.x = pk2(yv[0], yv[1]); ow.y = pk2(yv[2], yv[3]); ow.z = pk2(yv[4], yv[5]); ow.w = pk2(yv[6], yv[7]);
                *(u32x4*)(y + (row0 + t0 + i) * 1024 + ch0) = ow; } }
    }
    __syncthreads();
}

constexpr int NPHASES = 39;
enum { T_PREP, T_GEMM, T_GEMMRG, T_ROW, T_MLSTM, T_HGRN, T_SPATIAL, T_CONV, T_SCAN };
__device__ __forceinline__ void decode(int ph, int& type, int& layer, int& sub) {
    if (ph == 0) { type = T_PREP; layer = 0; sub = 0; return; }
    int base, cbase;
    if (ph < 10) { layer = 0; base = 1; cbase = 4; } else if (ph < 19) { layer = 1; base = 10; cbase = 13; } else if (ph < 28) { layer = 2; base = 19; cbase = 22; } else { layer = 3; base = 28; cbase = 33; }
    if (ph >= cbase) { const int k = ph - cbase;
        if (k == 0) { type = T_ROW; sub = 1; } else if (k == 1) { type = T_GEMM; sub = 2; } else if (k == 2) { type = T_GEMM; sub = 3; } else if (k == 3) { type = T_ROW; sub = 2; } else if (k == 4) { type = T_GEMM; sub = 4; } else { type = T_ROW; sub = 3; }
        return; }
    const int k = ph - base;
    if (layer < 3) { if (k == 0) { type = T_GEMM; sub = 0; } else if (k == 1) { type = layer == 0 ? T_MLSTM : layer == 1 ? T_HGRN : T_SPATIAL; sub = 0; } else { type = T_GEMM; sub = 1; } }
    else { if (k == 0) { type = T_GEMM; sub = 0; } else if (k == 1) { type = T_CONV; sub = 0; } else if (k == 2) { type = T_GEMMRG; sub = 0; } else if (k == 3) { type = T_SCAN; sub = 0; } else { type = T_GEMM; sub = 1; } }
}

__global__ void __launch_bounds__(NTHREADS, 2) fwd_kernel(Params Pk) {
    extern __shared__ __attribute__((aligned(16))) unsigned char smem[];
    LAS unsigned char* lds = (LAS unsigned char*)smem;
    const int ph_lo = Pk.ph_lo, ph_hi = Pk.ph_hi;
    if (ph_lo < 0) cg::this_grid().sync();
    volatile LAS unsigned* bst = (volatile LAS unsigned*)(lds + (LDS_BYTES - 16));
    if (threadIdx.x == 0) { bst[0] = 0u; bst[1] = 0u; }
    __syncthreads();
    const XcdBarrier gbar = xcd_barrier_post((unsigned*)(Pk.ws + WS_BAR), bst);
    for (int ph = ph_lo; ph < ph_hi; ++ph) {
        KP P = (KP)__builtin_amdgcn_kernarg_segment_ptr();
        asm volatile("" : "+s"(P));
        unsigned char* ws = P->ws;
        bf16_t* W = (bf16_t*)(ws + WS_W); bf16_t* HN = (bf16_t*)(ws + WS_HN); bf16_t* Z = (bf16_t*)(ws + WS_Z); bf16_t* YP = (bf16_t*)(ws + WS_YP); bf16_t* PB = (bf16_t*)(ws + WS_PB);
        int type, layer, sub; decode(ph, type, layer, sub);
        if (type == T_PREP) prep_phase(P, lds);
        else if (type == T_GEMM) {
            const int njobs = (sub == 2) ? 2 : 1;
            for (int j = 0; j < njobs; ++j) {
                pg8::Gemm g; EpiGen e; e.gate = nullptr; e.gate_pn = -1; e.act = 0; g.M = MTOK;
                bf16_t* L = W + (size_t)layer * LW;
                if (sub == 0) { g.A = HN; g.lda = 1024; g.K = 1024; g.ldb = 1024; e.O = Z;
                    if (layer == 0) { g.Bt = W + OFF_A_IN; g.N = 3328; e.ldc = 3072; e.gate = (float*)(ws + WS_GATE); e.gate_pn = 12; }
                    else if (layer == 1) { g.Bt = W + OFF_B_IN; g.N = 4096; e.ldc = 4096; }
                    else if (layer == 2) { g.Bt = W + OFF_C_IN; g.N = 4096; e.ldc = 4096; e.act = 1; }
                    else { g.Bt = W + OFF_D_IN; g.N = 2048; e.ldc = 2048; } }
                else if (sub == 1) { g.N = 1024; e.O = (bf16_t*)P->out; e.ldc = 1024;
                    if (layer == 2) { g.A = Z; g.lda = 4096; g.K = 2048; g.ldb = 2048; g.Bt = W + OFF_C_OUT; }
                    else { g.A = YP; g.lda = 1024; g.K = 1024; g.ldb = 1024; g.Bt = W + (layer == 0 ? OFF_A_OUT : layer == 1 ? OFF_B_OUT : OFF_D_OUT); } }
                else if (sub == 2) {
                    if (j == 0) { g.A = HN; g.lda = 1024; g.K = 1024; g.ldb = 1024; g.Bt = L; g.N = 4096; e.O = Z; e.ldc = 4096; e.act = 2; }
                    else { g.A = PB; g.lda = 256; g.K = 256; g.ldb = 256; g.Bt = L + W_UP + W_DN + W_G; g.N = 1024; e.O = YP; e.ldc = 1024; } }
                else if (sub == 3) { g.A = Z; g.lda = 4096; g.K = 4096; g.ldb = 4096; g.Bt = L + W_UP; g.N = 1024; e.O = (bf16_t*)P->out; e.ldc = 1024; }
                else { g.A = HN; g.lda = 1024; g.K = 1024; g.ldb = 1024; g.Bt = L + W_UP + W_DN; g.N = 1024; e.O = YP; e.ldc = 1024; e.act = 3; }
                pg8::StaticOrder S; S.init(g.M, g.N, (int)gridDim.x, (int)blockIdx.x);
                pg8::gemm_phase<EpiGen>(lds, g, S, e);
            }
        }
        else if (type == T_GEMMRG) {
            for (int blk = 0; blk < 4; ++blk) {
                pg8::Gemm g; g.M = MTOK; g.N = 512; g.K = 256; g.A = YP + blk * 256; g.lda = 1024; g.Bt = W + OFF_D_G + (size_t)blk * 512 * 256; g.ldb = 256;
                EpiRg e; e.xc = YP; e.loga = Z + (size_t)MTOK * 2048; e.beta = e.loga + (size_t)MTOK * 1024; e.b_a = P->in[I_DBA]; e.b_x = P->in[I_DBX]; e.spt = (const float*)(ws + WS_LB) + 1024; e.blk = blk;
                pg8::StaticOrder S; S.init(g.M, g.N, (int)gridDim.x, (int)blockIdx.x);
                pg8::gemm_phase<EpiRg>(lds, g, S, e);
            }
        }
        else if (type == T_ROW) {
            const float* ng = P->in[I_NG] + (size_t)layer * 5 * 1024;
            bf16_t* HBuf = (bf16_t*)P->out;
            float* RS = (float*)(ws + WS_LB + 512 * 1024);
            if (sub == 1) rowpass(layer == 0 ? P->in[I_X] : nullptr, HN, HBuf, ng + 1024, nullptr, nullptr, ng + 2048, HN, 1, P->in[I_P] + (size_t)layer * MTOK * 256, PB, layer == 0 ? nullptr : RS, ng, RS);
            else if (sub == 2) rowpass(nullptr, HN, HBuf, ng + 3072, nullptr, nullptr, nullptr, HN, 0, nullptr, nullptr, RS, ng + 2048, nullptr);
            else if (layer < 3) rowpass(nullptr, HN, YP, ng + 4096, nullptr, nullptr, ng + 5120, HN, 1, nullptr, nullptr, nullptr, nullptr, RS);
            else rowpass(nullptr, HN, YP, ng + 4096, P->out, nullptr, nullptr, nullptr, 0, nullptr, nullptr);
        }
        else if (type == T_MLSTM) mlstm_core(P, lds);
        else if (type == T_HGRN) hgrn_core(P, lds);
        else if (type == T_SPATIAL) spatial_core(P, lds);
        else if (type == T_CONV) conv_pass(P);
        else if (type == T_SCAN) scan_pass(P, lds);
        if (ph + 1 < ph_hi) xcd_barrier(gbar);
    }
}

extern "C" void kernel_launch(void* const* d_in, const int* in_sizes, int n_in, void* d_out, int out_size, void* d_ws, size_t ws_size, hipStream_t stream) {
    static int grid = 0;
    if (grid == 0) {
        if (n_in != 31 || in_sizes[0] != MTOK * DM || out_size != MTOK * DM || ws_size < WS_END) { fprintf(stderr, "kernel_launch: unexpected shapes (n_in %d, ws %zu)\n", n_in, ws_size); grid = -1; return; }
        int dev = 0, cus = 0, per_cu = 0;
        hipGetDevice(&dev); hipDeviceGetAttribute(&cus, hipDeviceAttributeMultiprocessorCount, dev);
        hipFuncSetAttribute((const void*)fwd_kernel, hipFuncAttributeMaxDynamicSharedMemorySize, LDS_BYTES);
        hipOccupancyMaxActiveBlocksPerMultiprocessor(&per_cu, (const void*)fwd_kernel, NTHREADS, LDS_BYTES);
        if (per_cu < 1) per_cu = 1;
        grid = cus * per_cu;
        (void)hipGetLastError();
    }
    if (grid < 0) return;
    Params p{};
    for (int i = 0; i < 31; ++i) p.in[i] = (const float*)d_in[i];
    p.out = (float*)d_out; p.ws = (unsigned char*)d_ws;
    (void)hipMemsetAsync((unsigned char*)d_ws + WS_BAR, 0, XCD_BAR_WORDS * sizeof(unsigned), stream);
#if ONE_LAUNCH
    p.ph_lo = 0; p.ph_hi = NPHASES;
    void* args[] = {&p};
    hipError_t e = hipLaunchCooperativeKernel((const void*)fwd_kernel, dim3(grid), dim3(NTHREADS), args, LDS_BYTES, stream);
    if (e != hipSuccess) fprintf(stderr, "cooperative launch failed: %s (grid %d)\n", hipGetErrorString(e), grid);
#else
    for (int ph = 0; ph < NPHASES; ++ph) { p.ph_lo = ph; p.ph_hi = ph + 1; hipLaunchKernelGGL(fwd_kernel, dim3(grid), dim3(NTHREADS), LDS_BYTES, stream, p); }
#endif
}
```

```cpp
#include <hip/hip_runtime.h>
#include <hip/hip_cooperative_groups.h>
#include <cstdio>
namespace cg = cooperative_groups;

#ifndef ONE_LAUNCH
#define ONE_LAUNCH 1
#endif

#define LAS __attribute__((address_space(3)))
typedef unsigned short bf16_t;
typedef short bf16x8 __attribute__((ext_vector_type(8)));
typedef short s16x4 __attribute__((ext_vector_type(4)));
typedef float f32x4 __attribute__((ext_vector_type(4)));
typedef float f32x2 __attribute__((ext_vector_type(2)));
typedef unsigned u32x4 __attribute__((ext_vector_type(4)));
typedef unsigned u32x2 __attribute__((ext_vector_type(2)));

constexpr int MTOK = 65536, DM = 1024, SEQL = 2048;
constexpr float EPS = 1e-6f;
constexpr int NTHREADS = 512;
constexpr int LDS_BYTES = 147456;

constexpr size_t W_UP = 4096ull * 1024, W_DN = 1024ull * 4096, W_G = 1024ull * 1024, W_PU = 1024ull * 256;
constexpr size_t LW = W_UP + W_DN + W_G + W_PU;
constexpr size_t OFF_A_IN = 4 * LW;
constexpr size_t OFF_A_OUT = OFF_A_IN + 3328ull * 1024;
constexpr size_t OFF_B_IN = OFF_A_OUT + 1024ull * 1024;
constexpr size_t OFF_B_OUT = OFF_B_IN + 4096ull * 1024;
constexpr size_t OFF_C_IN = OFF_B_OUT + 1024ull * 1024;
constexpr size_t OFF_C_OUT = OFF_C_IN + 4096ull * 1024;
constexpr size_t OFF_C_WS = OFF_C_OUT + 1024ull * 2048;
constexpr size_t OFF_D_IN = OFF_C_WS + 8ull * 128 * 128;
constexpr size_t OFF_D_G = OFF_D_IN + 2048ull * 1024;
constexpr size_t OFF_D_OUT = OFF_D_G + 4ull * 512 * 256;
constexpr size_t W_TOTAL = OFF_D_OUT + 1024ull * 1024;
constexpr size_t MiB = 1024ull * 1024;
static_assert(W_TOTAL * 2 <= 112 * MiB, "weights region");
constexpr size_t WS_W = 0, WS_HN = 112 * MiB, WS_Z = 240 * MiB, WS_YP = 752 * MiB, WS_PB = 880 * MiB, WS_GATE = 912 * MiB, WS_LB = 916 * MiB, WS_BAR = 917 * MiB, WS_END = 918 * MiB;

struct Params {
    const float* in[31];
    float* out;
    unsigned char* ws;
    int ph_lo, ph_hi;
};
typedef const __attribute__((address_space(4))) Params* KP;
enum { I_X = 0, I_P, I_NG, I_WUP, I_WDN, I_PUP, I_PG, I_AIN, I_AIB, I_AFB, I_AHG, I_AOUT, I_BIN, I_BLB, I_BHG, I_BOUT, I_CIN, I_CLG, I_CLB, I_CSW, I_CSB, I_COUT,
       I_DIN, I_DCW, I_DCB, I_DWA, I_DBA, I_DWX, I_DBX, I_DLAM, I_DOUT };

__device__ __forceinline__ float bf2f(bf16_t b) { return __uint_as_float(((unsigned)b) << 16); }
__device__ __forceinline__ float bflo(unsigned u) { return __uint_as_float(u << 16); }
__device__ __forceinline__ float bfhi(unsigned u) { return __uint_as_float(u & 0xffff0000u); }
__device__ __forceinline__ unsigned pk2(float lo, float hi) { unsigned r; asm("v_cvt_pk_bf16_f32 %0, %1, %2" : "=v"(r) : "v"(lo), "v"(hi)); return r; }
__device__ __forceinline__ bf16_t f2bf(float f) { return (bf16_t)(pk2(f, 0.f) & 0xffffu); }
__device__ __forceinline__ float fast_rcp(float x) { return __builtin_amdgcn_rcpf(x); }
__device__ __forceinline__ float sigmoidf_(float x) { return fast_rcp(1.0f + __expf(-x)); }
__device__ __forceinline__ float gelu_tanh(float x) { const float t = 1.5957691216057308f * (x + 0.044715f * x * x * x); return x * fast_rcp(1.0f + __expf(-t)); }
__device__ __forceinline__ float wave_sum(float v) {
#pragma unroll
    for (int o = 32; o >= 1; o >>= 1) v += __shfl_xor(v, o);
    return v;
}
__device__ __forceinline__ bf16x8 as_bf16x8(u32x4 v) { union { u32x4 u; bf16x8 b; } x; x.u = v; return x.b; }
__device__ __forceinline__ u32x4 as_u32x4(bf16x8 v) { union { u32x4 u; bf16x8 b; } x; x.b = v; return x.u; }
__device__ __forceinline__ bf16x8 ldk(const LAS unsigned char* p) { return *(const LAS bf16x8*)p; }
__device__ __forceinline__ bf16x8 ldt(const LAS unsigned char* base, int pitch, int fr, int fq) {
    const LAS unsigned char* p = base + (fq * 8 + (fr >> 2)) * pitch + (fr & 3) * 8;
    s16x4 a = __builtin_amdgcn_ds_read_tr16_b64_v4i16((LAS s16x4*)p);
    s16x4 b = __builtin_amdgcn_ds_read_tr16_b64_v4i16((LAS s16x4*)(p + 4 * pitch));
    bf16x8 r = {a[0], a[1], a[2], a[3], b[0], b[1], b[2], b[3]};
    return r;
}
__device__ __forceinline__ int opaque_tid() { int t = threadIdx.x; asm volatile("" : "+v"(t)); return t; }
#define MFMA16(a, b, c) __builtin_amdgcn_mfma_f32_16x16x32_bf16((a), (b), (c), 0, 0, 0)


#define XB_TMO      128
#define XB_XCNT(j)  (256  + 64 * (j))
#define XB_XSUB(j)  (1280 + 64 * (j))
#define XB_XGEN(j)  (2304 + 64 * (j))
#define XB_TOP      3328
#define XB_TOPGEN   3392
#define XCD_BAR_WORDS 3456
#define XB_SPIN_CAP (1u << 20)
__device__ __forceinline__ unsigned xb_ld(unsigned* p)              { return __hip_atomic_load(p, __ATOMIC_RELAXED, __HIP_MEMORY_SCOPE_AGENT); }
__device__ __forceinline__ unsigned xb_add(unsigned* p, unsigned v) { return __hip_atomic_fetch_add(p, v, __ATOMIC_RELAXED, __HIP_MEMORY_SCOPE_AGENT); }
__device__ __forceinline__ unsigned xb_xcc_id() { return (unsigned)__builtin_amdgcn_s_getreg((3 << 11) | 20) & 0xFu; }
#define XB_SPIN(cond, bar) do { unsigned _sp = 0; while (cond) { __builtin_amdgcn_s_sleep(1); \
    if ((++_sp & 255u) == 0u) { if (xb_ld(&(bar)[XB_TMO])) break; if (_sp > XB_SPIN_CAP) { atomicAdd(&(bar)[XB_TMO], 1u); break; } } } } while (0)
struct XcdBarrier { unsigned* bar; unsigned x; volatile LAS unsigned* st; };
__device__ __forceinline__ XcdBarrier xcd_barrier_post(unsigned* bar, volatile LAS unsigned* st) {
    XcdBarrier b; b.bar = bar; b.x = xb_xcc_id(); b.st = st;
    if (threadIdx.x == 0) (void)xb_add(&bar[XB_XCNT(b.x)], 1u);
    return b;
}
__device__ __forceinline__ void xcd_barrier_complete(unsigned* bar, unsigned x, unsigned& nloc, unsigned& nx) {
    const unsigned G = gridDim.x * gridDim.y * gridDim.z;
    unsigned sum, cnt, mine, sp = 0u;
    for (;;) {
        sum = 0u; cnt = 0u; mine = 0u;
#pragma unroll
        for (unsigned j = 0; j < 16; ++j) { const unsigned c = xb_ld(&bar[XB_XCNT(j)]); sum += c; cnt += (c > 0u) ? 1u : 0u; mine = (j == x) ? c : mine; }
        if (sum == G) break;
        __builtin_amdgcn_s_sleep(1);
        if ((++sp & 255u) == 0u) { if (xb_ld(&bar[XB_TMO])) break; if (sp > XB_SPIN_CAP) { atomicAdd(&bar[XB_TMO], 1u); break; } }
    }
    nloc = mine > 0u ? mine : 1u; nx = cnt > 0u ? cnt : 1u;
}
__device__ __forceinline__ void xcd_barrier(const XcdBarrier& b) {
    asm volatile("s_waitcnt vmcnt(0)" ::: "memory");
    __syncthreads();
    if (threadIdx.x == 0) {
        unsigned* bar = b.bar;
        __builtin_amdgcn_s_waitcnt(0);
        unsigned nloc = b.st[0], nx = b.st[1];
        if (nloc == 0u) { xcd_barrier_complete(bar, b.x, nloc, nx); b.st[0] = nloc; b.st[1] = nx; }
        const unsigned old = xb_add(&bar[XB_XSUB(b.x)], 1u);
        const unsigned gen = old / nloc;
        if (old + 1u == (gen + 1u) * nloc) {
            __builtin_amdgcn_fence(__ATOMIC_RELEASE, "agent");
            asm volatile("s_waitcnt vmcnt(0)" ::: "memory");
            const unsigned og = xb_add(&bar[XB_TOP], 1u);
            const unsigned tg = og / nx;
            if (og + 1u == (tg + 1u) * nx) xb_add(&bar[XB_TOPGEN], 1u);
            else XB_SPIN(xb_ld(&bar[XB_TOPGEN]) == tg, bar);
            __builtin_amdgcn_fence(__ATOMIC_ACQUIRE, "agent");
            xb_add(&bar[XB_XGEN(b.x)], 1u);
            asm volatile("s_waitcnt vmcnt(0)" ::: "memory");
        } else {
            XB_SPIN(xb_ld(&bar[XB_XGEN(b.x)]) == gen, bar);
            __builtin_amdgcn_fence(__ATOMIC_ACQUIRE, "agent");
            asm volatile("s_waitcnt vmcnt(0)" ::: "memory");
        }
    }
    __syncthreads();
}

namespace pg8 {
constexpr int BM = 256, BK = 64, HALF = 128, HTB = HALF * BK * 2, STAGE_BYTES = 8 * HTB, NXCD = 8, WGM = 8;
__device__ __forceinline__ int lds_byte(int r, int c) { const int st = (r >> 4) * 2 + (c >> 5), rr = r & 15, cc = c & 31, ob = rr * 64 + cc * 2; return st * 1024 + (ob ^ (((ob >> 9) & 1) << 5)); }
__device__ __forceinline__ void stage_rc(int b, int& R, int& C) { const int st = b / 1024, sb = b % 1024, swz = sb ^ (((sb >> 9) & 1) << 5); R = (st >> 1) * 16 + swz / 64; C = (st & 1) * 32 + (swz % 64) / 2; }
__device__ __forceinline__ int perm32(int rho) { const int n = rho >> 4, i = rho & 15; return 8 * (i >> 2) + 4 * n + (i & 3); }
struct Unit { int pm, pn; };
struct Gemm { const bf16_t* A; const bf16_t* Bt; int M, N, K, lda, ldb; };
struct StaticOrder {
    int nM, nN, nwg, G, c;
    __device__ void init(int M, int N, int G_, int c_) { nM = M / BM; nN = N / BM; nwg = nM * nN; G = G_; c = c_; }
    __device__ bool next(int i, Unit& u) const {
        const long L = (long)i * G + c; if (L >= nwg) return false;
        int wgid = (int)L; { const int q = nwg / NXCD, r = nwg % NXCD, xcd = wgid % NXCD, off = wgid / NXCD; wgid = (xcd < r ? xcd * (q + 1) : r * (q + 1) + (xcd - r) * q) + off; }
        const int nig = WGM * nN, gid = wgid / nig, fm = gid * WGM, gsz = (nM - fm) < WGM ? (nM - fm) : WGM;
        u.pm = fm + ((wgid % nig) % gsz); u.pn = (wgid % nig) / gsz; return true;
    }
};
template <class Epi>
__device__ __forceinline__ void gemm_phase(LAS unsigned char* lds, const Gemm g, const StaticOrder& S, const Epi& E) {
    const int tid = opaque_tid(), wid = __builtin_amdgcn_readfirstlane(tid >> 6), lane = tid & 63, wr = wid >> 2, wc = wid & 3, fr = lane & 15, fq = lane >> 4;
    const int K = g.K, nt = K / BK;
    unsigned voffA[2], voffB[2];
#pragma unroll
    for (int i = 0; i < 2; ++i) { int R, C; stage_rc(tid * 16 + i * 8192, R, C); const int Rb = (R & ~31) + perm32(R & 31);
        voffA[i] = (unsigned)(R * g.lda + C) * 2u; voffB[i] = (unsigned)(Rb * g.ldb + C) * 2u; }
    const size_t kstep = (size_t)(BK * 2);
    const size_t hstepA = (size_t)HALF * g.lda * 2, hstepB = (size_t)HALF * g.ldb * 2;
    const size_t tstepA = 2 * hstepA, tstepB = 2 * hstepB;
    const unsigned ldsw = (unsigned)wid * 1024u;
    const int aoff = lds_byte(wr * 64 + fr, fq * 8), boff = lds_byte(wc * 32 + fr, fq * 8);
#define PG8_SA(b, h) (((b) * 2 + (h)) * HTB)
#define PG8_SB(b, h) ((4 + (b) * 2 + (h)) * HTB)
#define PG8_STAGE(bufoff, gbase, voff) do { _Pragma("unroll") for (int _i = 0; _i < 2; ++_i) \
        __builtin_amdgcn_global_load_lds((const unsigned*)((const char*)(gbase) + (voff)[_i]), (LAS unsigned*)(lds + (bufoff) + ldsw + _i * 8192), 16, 0, 0); } while (0)
#define PG8_LDA(dst, b, h) do { _Pragma("unroll") for (int m = 0; m < 4; ++m) _Pragma("unroll") for (int k = 0; k < 2; ++k) dst[m][k] = *(const LAS bf16x8*)(lds + PG8_SA(b, h) + aoff + m * 2048 + k * 1024); } while (0)
#define PG8_LDB(dst, b, h) do { _Pragma("unroll") for (int n = 0; n < 2; ++n) _Pragma("unroll") for (int k = 0; k < 2; ++k) dst[n][k] = *(const LAS bf16x8*)(lds + PG8_SB(b, h) + boff + n * 2048 + k * 1024); } while (0)
#define PG8_MMA(ai, bj, At, Bt) do { __builtin_amdgcn_s_setprio(1); _Pragma("unroll") for (int m = 0; m < 4; ++m) _Pragma("unroll") for (int n = 0; n < 2; ++n) _Pragma("unroll") for (int k = 0; k < 2; ++k) \
        acc[ai][bj][m][n] = __builtin_amdgcn_mfma_f32_16x16x32_bf16(Bt[n][k], At[m][k], acc[ai][bj][m][n], 0, 0, 0); __builtin_amdgcn_s_setprio(0); } while (0)
#define PG8_WAIT_V(n) asm volatile("s_waitcnt vmcnt(" #n ")" ::: "memory")
#define PG8_WAIT_L(n) asm volatile("s_waitcnt lgkmcnt(" #n ")" ::: "memory")
#define PG8_BAR __builtin_amdgcn_s_barrier()
#define PG8_SCHED __builtin_amdgcn_sched_barrier(0)
    Unit cur, nxt; int ui = 0;
    if (!S.next(0, cur)) return;
    f32x4 acc[2][2][4][2];
#pragma unroll
    for (int a = 0; a < 2; ++a)
#pragma unroll
        for (int b = 0; b < 2; ++b)
#pragma unroll
            for (int m = 0; m < 4; ++m)
#pragma unroll
                for (int n = 0; n < 2; ++n) acc[a][b][m][n] = (f32x4){0.f, 0.f, 0.f, 0.f};
    bf16x8 At[4][2], B0[2][2], B1[2][2];
    const char* cA = (const char*)g.A + (size_t)cur.pm * tstepA; const char* cB = (const char*)g.Bt + (size_t)cur.pn * tstepB;
    PG8_STAGE(PG8_SB(0, 0), cB, voffB); PG8_STAGE(PG8_SA(0, 0), cA, voffA); PG8_STAGE(PG8_SB(0, 1), cB + hstepB, voffB); PG8_STAGE(PG8_SA(0, 1), cA + hstepA, voffA);
    if (wr == 1) PG8_BAR;
    PG8_WAIT_V(4); PG8_BAR;
    PG8_STAGE(PG8_SB(1, 0), cB + kstep, voffB); PG8_STAGE(PG8_SA(1, 0), cA + kstep, voffA); PG8_STAGE(PG8_SB(1, 1), cB + hstepB + kstep, voffB);
    PG8_WAIT_V(6); PG8_BAR;
    for (;;) {
        const bool has_next = S.next(ui + 1, nxt);
        const char* nA = has_next ? (const char*)g.A + (size_t)nxt.pm * tstepA : cA; const char* nB = has_next ? (const char*)g.Bt + (size_t)nxt.pn * tstepB : cB;
        for (int t = 0; t < nt; t += 2) {
            const bool last = (t == nt - 2);
            const char* a1 = cA + (size_t)(t + 1) * kstep;
            const char* a2 = last ? nA : cA + (size_t)(t + 2) * kstep; const char* b2 = last ? nB : cB + (size_t)(t + 2) * kstep;
            const char* a3 = a2 + kstep; const char* b3 = b2 + kstep;
            PG8_LDB(B0, 0, 0); PG8_SCHED; PG8_LDA(At, 0, 0); PG8_STAGE(PG8_SA(1, 1), a1 + hstepA, voffA);
            PG8_WAIT_L(8); PG8_BAR; PG8_WAIT_L(0); PG8_MMA(0, 0, At, B0); PG8_BAR; PG8_SCHED;
            PG8_LDB(B1, 0, 1); PG8_STAGE(PG8_SB(0, 0), b2, voffB);
            PG8_BAR; PG8_WAIT_L(0); PG8_MMA(0, 1, At, B1); PG8_BAR;
            PG8_LDA(At, 0, 1); PG8_STAGE(PG8_SA(0, 0), a2, voffA);
            PG8_BAR; PG8_WAIT_L(0); PG8_MMA(1, 0, At, B0); PG8_BAR; PG8_SCHED;
            PG8_STAGE(PG8_SB(0, 1), b2 + hstepB, voffB);
            PG8_WAIT_V(6); PG8_BAR; PG8_MMA(1, 1, At, B1); PG8_BAR;
            PG8_LDB(B0, 1, 0); PG8_SCHED; PG8_LDA(At, 1, 0); PG8_STAGE(PG8_SA(0, 1), a2 + hstepA, voffA);
            PG8_WAIT_L(8); PG8_BAR; PG8_WAIT_L(0); PG8_MMA(0, 0, At, B0); PG8_BAR; PG8_SCHED;
            PG8_LDB(B1, 1, 1); PG8_STAGE(PG8_SB(1, 0), b3, voffB);
            PG8_BAR; PG8_WAIT_L(0); PG8_MMA(0, 1, At, B1); PG8_BAR;
            PG8_LDA(At, 1, 1); PG8_STAGE(PG8_SA(1, 0), a3, voffA);
            PG8_BAR; PG8_WAIT_L(0); PG8_MMA(1, 0, At, B0); PG8_BAR; PG8_SCHED;
            PG8_STAGE(PG8_SB(1, 1), b3 + hstepB, voffB);
            PG8_WAIT_V(6); PG8_BAR; PG8_MMA(1, 1, At, B1); PG8_BAR;
        }
        E(acc, cur, wr, wc, fr, fq);
        if (!has_next) break;
#pragma unroll
        for (int a = 0; a < 2; ++a)
#pragma unroll
            for (int b = 0; b < 2; ++b)
#pragma unroll
                for (int m = 0; m < 4; ++m)
#pragma unroll
                    for (int n = 0; n < 2; ++n) acc[a][b][m][n] = (f32x4){0.f, 0.f, 0.f, 0.f};
        cur = nxt; cA = nA; cB = nB; ++ui;
    }
    PG8_WAIT_V(0);
    if (wr == 0) PG8_BAR;
    PG8_BAR;
#undef PG8_SA
#undef PG8_SB
#undef PG8_STAGE
#undef PG8_LDA
#undef PG8_LDB
#undef PG8_MMA
#undef PG8_WAIT_V
#undef PG8_WAIT_L
#undef PG8_BAR
#undef PG8_SCHED
}
}

struct EpiGen {
    bf16_t* O; int ldc; int act;
    float* gate; int gate_pn;
    __device__ __forceinline__ void operator()(const f32x4 (&acc)[2][2][4][2], const pg8::Unit& u, int wr, int wc, int fr_, int fq_) const {
        int fr = fr_, fq = fq_; asm volatile("" : "+v"(fr), "+v"(fq));
        const int row0 = u.pm * 256 + wr * 64 + fr;
        if (act == 3) {
            const int col0 = u.pn * 256 + wc * 32 + 8 * fq;
#pragma unroll
            for (int q = 0; q < 4; ++q) { const int ai = q >> 1; u32x4 pv[2][2];
#pragma unroll
                for (int mm = 0; mm < 2; ++mm)
#pragma unroll
                    for (int bj = 0; bj < 2; ++bj) pv[mm][bj] = *(const u32x4*)(O + (size_t)(row0 + ai * 128 + ((q & 1) * 2 + mm) * 16) * ldc + col0 + bj * 128);
#pragma unroll
                for (int mm = 0; mm < 2; ++mm)
#pragma unroll
                    for (int bj = 0; bj < 2; ++bj) { const int m = (q & 1) * 2 + mm; const f32x4 v0 = acc[ai][bj][m][0], v1 = acc[ai][bj][m][1]; const u32x4 pu = pv[mm][bj]; u32x4 w;
                        w.x = pk2(sigmoidf_(v0[0]) * bflo(pu.x), sigmoidf_(v0[1]) * bfhi(pu.x)); w.y = pk2(sigmoidf_(v0[2]) * bflo(pu.y), sigmoidf_(v0[3]) * bfhi(pu.y));
                        w.z = pk2(sigmoidf_(v1[0]) * bflo(pu.z), sigmoidf_(v1[1]) * bfhi(pu.z)); w.w = pk2(sigmoidf_(v1[2]) * bflo(pu.w), sigmoidf_(v1[3]) * bfhi(pu.w));
                        *(u32x4*)(O + (size_t)(row0 + ai * 128 + m * 16) * ldc + col0 + bj * 128) = w; }
                asm volatile("" ::: "memory"); }
            return;
        }
        if (u.pn == gate_pn) {
            if (wc == 0 && fq < 2) {
#pragma unroll
                for (int ai = 0; ai < 2; ++ai)
#pragma unroll
                    for (int m = 0; m < 4; ++m) { float* gp = gate + (size_t)(row0 + ai * 128 + m * 16) * 16 + 8 * fq;
                        *(f32x4*)gp = acc[ai][0][m][0]; *(f32x4*)(gp + 4) = acc[ai][0][m][1]; }
            }
            return;
        }
        const int col0 = u.pn * 256 + wc * 32 + 8 * fq;
#pragma unroll
        for (int ai = 0; ai < 2; ++ai)
#pragma unroll
            for (int m = 0; m < 4; ++m) { bf16_t* rowp = O + (size_t)(row0 + ai * 128 + m * 16) * ldc + col0;
#pragma unroll
                for (int bj = 0; bj < 2; ++bj) { f32x4 v0 = acc[ai][bj][m][0], v1 = acc[ai][bj][m][1];
                    if (act == 1) {
#pragma unroll
                        for (int j = 0; j < 4; ++j) { v0[j] = gelu_tanh(v0[j]); v1[j] = gelu_tanh(v1[j]); }
                    } else if (act == 2) {
#pragma unroll
                        for (int j = 0; j < 4; ++j) { const float a = fmaxf(v0[j], 0.f), b = fmaxf(v1[j], 0.f); v0[j] = a * a; v1[j] = b * b; }
                    } else if (act == 3) {
                        const u32x4 pu = *(const u32x4*)(rowp + bj * 128);
                        v0[0] = sigmoidf_(v0[0]) * bflo(pu.x); v0[1] = sigmoidf_(v0[1]) * bfhi(pu.x); v0[2] = sigmoidf_(v0[2]) * bflo(pu.y); v0[3] = sigmoidf_(v0[3]) * bfhi(pu.y);
                        v1[0] = sigmoidf_(v1[0]) * bflo(pu.z); v1[1] = sigmoidf_(v1[1]) * bfhi(pu.z); v1[2] = sigmoidf_(v1[2]) * bflo(pu.w); v1[3] = sigmoidf_(v1[3]) * bfhi(pu.w);
                    }
                    u32x4 w; w.x = pk2(v0[0], v0[1]); w.y = pk2(v0[2], v0[3]); w.z = pk2(v1[0], v1[1]); w.w = pk2(v1[2], v1[3]);
                    *(u32x4*)(rowp + bj * 128) = w; }
                asm volatile("" ::: "memory"); }
    }
};
struct EpiRg {
    const bf16_t* xc; bf16_t* loga; bf16_t* beta; const float* b_a; const float* b_x; const float* spt; int blk;
    __device__ __forceinline__ void operator()(const f32x4 (&acc)[2][2][4][2], const pg8::Unit& u, int wr, int wc, int fr_, int fq_) const {
        int fr = fr_, fq = fq_; asm volatile("" : "+v"(fr), "+v"(fq));
        const int row0 = u.pm * 256 + wr * 64 + fr;
        const int ch0 = blk * 256 + u.pn * 128 + wc * 32 + 8 * fq;
#pragma unroll
        for (int q = 0; q < 4; ++q) { const int ai = q >> 1; u32x4 xq[2];
#pragma unroll
            for (int mm = 0; mm < 2; ++mm) xq[mm] = *(const u32x4*)(xc + (size_t)(row0 + ai * 128 + ((q & 1) * 2 + mm) * 16) * 1024 + ch0);
            f32x4 ba[2], bx[2], sp[2];
#pragma unroll
            for (int hh = 0; hh < 2; ++hh) { ba[hh] = *(const f32x4*)(b_a + ch0 + hh * 4); bx[hh] = *(const f32x4*)(b_x + ch0 + hh * 4); sp[hh] = *(const f32x4*)(spt + ch0 + hh * 4); }
#pragma unroll
            for (int mm = 0; mm < 2; ++mm) { const int m = (q & 1) * 2 + mm; const size_t off = (size_t)(row0 + ai * 128 + m * 16) * 1024 + ch0; const u32x4 xv = xq[mm];
                u32x4 wl, wb;
#pragma unroll
                for (int hh = 0; hh < 2; ++hh) {
                    const unsigned x01 = hh ? xv.z : xv.x, x23 = hh ? xv.w : xv.y;
                    const float x[4] = {bflo(x01), bfhi(x01), bflo(x23), bfhi(x23)};
                    float la[4], be[4];
#pragma unroll
                    for (int e = 0; e < 4; ++e) { const float rp = acc[ai][0][m][hh][e] + ba[hh][e], ip = acc[ai][1][m][hh][e] + bx[hh][e];
                        const float r = sigmoidf_(rp), ig = sigmoidf_(ip); const float l = sp[hh][e] * r; la[e] = l;
                        be[e] = __builtin_amdgcn_sqrtf(fmaxf(1.0f - __expf(2.0f * l), 0.f)) * ig * x[e]; }
                    if (hh == 0) { wl.x = pk2(la[0], la[1]); wl.y = pk2(la[2], la[3]); wb.x = pk2(be[0], be[1]); wb.y = pk2(be[2], be[3]); }
                    else { wl.z = pk2(la[0], la[1]); wl.w = pk2(la[2], la[3]); wb.z = pk2(be[0], be[1]); wb.w = pk2(be[2], be[3]); }
                }
                *(u32x4*)(loga + off) = wl; *(u32x4*)(beta + off) = wb; }
            asm volatile("" ::: "memory"); }
    }
};

__device__ __forceinline__ void rowpass(const float* hin, const bf16_t* hinb, const bf16_t* y, const float* gadd, float* hout, bf16_t* houtb, const float* gnext, bf16_t* hn, int normnext,
                                        const float* psrc, bf16_t* pdst, const float* rs_in = nullptr, const float* g_in = nullptr, float* rs_out = nullptr) {
    const int tid_ = opaque_tid(); const int lane = tid_ & 63, wave = tid_ >> 6;
    const int gw = blockIdx.x * 8 + wave, nw = gridDim.x * 8;
    f32x4 ga[4], gn[4], gi[4];
#pragma unroll
    for (int q = 0; q < 4; ++q) { gi[q] = (f32x4){1.f, 1.f, 1.f, 1.f}; if (rs_in) { const f32x4 t = *(const f32x4*)(g_in + q * 256 + lane * 4); gi[q] = (f32x4){fast_rcp(t[0]), fast_rcp(t[1]), fast_rcp(t[2]), fast_rcp(t[3])}; } }
#pragma unroll
    for (int q = 0; q < 4; ++q) { ga[q] = y ? *(const f32x4*)(gadd + q * 256 + lane * 4) : (f32x4){0.f, 0.f, 0.f, 0.f}; gn[q] = (hn && normnext) ? *(const f32x4*)(gnext + q * 256 + lane * 4) : (f32x4){1.f, 1.f, 1.f, 1.f}; }
    for (int row0_ = gw; row0_ < MTOK; row0_ += 4 * nw) {
        f32x4 h[4][4]; u32x2 yv[4][4]; f32x4 pv[4]; float rsi[4];
#pragma unroll
        for (int u = 0; u < 4; ++u) { const int row = row0_ + u * nw; rsi[u] = 1.0f; if (row < MTOK) { const size_t base = (size_t)row * DM + lane * 4;
            if (rs_in) rsi[u] = rs_in[row];
            if (hin) {
#pragma unroll
                for (int q = 0; q < 4; ++q) h[u][q] = __builtin_nontemporal_load((const f32x4*)(hin + base + q * 256));
            } else {
#pragma unroll
                for (int q = 0; q < 4; ++q) { const u32x2 hv = __builtin_nontemporal_load((const u32x2*)(hinb + base + q * 256)); h[u][q] = (f32x4){bflo(hv.x), bfhi(hv.x), bflo(hv.y), bfhi(hv.y)}; }
            }
            if (y) {
#pragma unroll
                for (int q = 0; q < 4; ++q) yv[u][q] = __builtin_nontemporal_load((const u32x2*)(y + base + q * 256));
            }
            if (psrc) pv[u] = __builtin_nontemporal_load((const f32x4*)(psrc + (size_t)row * 256 + lane * 4)); } }
#pragma unroll
        for (int u = 0; u < 4; ++u) { const int row = row0_ + u * nw; if (row < MTOK) { const size_t base = (size_t)row * DM + lane * 4;
            if (rs_in) { const float ir = fast_rcp(rsi[u]);
#pragma unroll
                for (int q = 0; q < 4; ++q) h[u][q] = h[u][q] * ir * gi[q]; }
            if (y) {
                f32x4 yf[4]; float ss = 0.f;
#pragma unroll
                for (int q = 0; q < 4; ++q) { yf[q] = (f32x4){bflo(yv[u][q].x), bfhi(yv[u][q].x), bflo(yv[u][q].y), bfhi(yv[u][q].y)}; ss += yf[q][0] * yf[q][0] + yf[q][1] * yf[q][1] + yf[q][2] * yf[q][2] + yf[q][3] * yf[q][3]; }
                ss = wave_sum(ss);
                const float rs = __builtin_amdgcn_rsqf(ss * (1.0f / DM) + EPS);
#pragma unroll
                for (int q = 0; q < 4; ++q) h[u][q] = h[u][q] + yf[q] * rs * ga[q];
            }
            if (hout) {
#pragma unroll
                for (int q = 0; q < 4; ++q) __builtin_nontemporal_store(h[u][q], (f32x4*)(hout + base + q * 256));
            }
            if (houtb) {
#pragma unroll
                for (int q = 0; q < 4; ++q) { u32x2 w; w.x = pk2(h[u][q][0], h[u][q][1]); w.y = pk2(h[u][q][2], h[u][q][3]); __builtin_nontemporal_store(w, (u32x2*)(houtb + base + q * 256)); }
            }
            if (hn) {
                float rs2 = 1.0f;
                if (normnext) { float ss = 0.f;
#pragma unroll
                    for (int q = 0; q < 4; ++q) ss += h[u][q][0] * h[u][q][0] + h[u][q][1] * h[u][q][1] + h[u][q][2] * h[u][q][2] + h[u][q][3] * h[u][q][3];
                    ss = wave_sum(ss); rs2 = __builtin_amdgcn_rsqf(ss * (1.0f / DM) + EPS); if (rs_out && lane == 0) rs_out[row] = rs2; }
#pragma unroll
                for (int q = 0; q < 4; ++q) { const f32x4 o = h[u][q] * rs2 * gn[q]; u32x2 w; w.x = pk2(o[0], o[1]); w.y = pk2(o[2], o[3]); __builtin_nontemporal_store(w, (u32x2*)(hn + base + q * 256)); }
            }
            if (psrc) { u32x2 w; w.x = pk2(pv[u][0], pv[u][1]); w.y = pk2(pv[u][2], pv[u][3]); __builtin_nontemporal_store(w, (u32x2*)(pdst + (size_t)row * 256 + lane * 4)); } } }
    }
}

struct TJob { const float* src; bf16_t* dst; int lds, ldd, K, nvalid, ntn, t0; };
__device__ __forceinline__ TJob make_tjob(KP P, int j) {
    TJob t; bf16_t* W = (bf16_t*)(P->ws + WS_W); int npad;
    if (j < 16) { const int i = j >> 2, k = j & 3; bf16_t* L = W + (size_t)i * LW;
        if (k == 0) { t.src = P->in[I_WUP] + (size_t)i * 1024 * 4096; t.lds = 4096; t.K = 1024; t.nvalid = 4096; t.dst = L; }
        else if (k == 1) { t.src = P->in[I_WDN] + (size_t)i * 4096 * 1024; t.lds = 1024; t.K = 4096; t.nvalid = 1024; t.dst = L + W_UP; }
        else if (k == 2) { t.src = P->in[I_PG] + (size_t)i * 1024 * 1024; t.lds = 1024; t.K = 1024; t.nvalid = 1024; t.dst = L + W_UP + W_DN; }
        else { t.src = P->in[I_PUP] + (size_t)i * 256 * 1024; t.lds = 1024; t.K = 256; t.nvalid = 1024; t.dst = L + W_UP + W_DN + W_G; }
        npad = t.nvalid; }
    else if (j == 16) { t.src = P->in[I_AIN]; t.lds = 3088; t.K = 1024; t.nvalid = 3088; npad = 3328; t.dst = W + OFF_A_IN; }
    else if (j == 17) { t.src = P->in[I_AOUT]; t.lds = 1024; t.K = 1024; t.nvalid = 1024; npad = 1024; t.dst = W + OFF_A_OUT; }
    else if (j == 18) { t.src = P->in[I_BIN]; t.lds = 4096; t.K = 1024; t.nvalid = 4096; npad = 4096; t.dst = W + OFF_B_IN; }
    else if (j == 19) { t.src = P->in[I_BOUT]; t.lds = 1024; t.K = 1024; t.nvalid = 1024; npad = 1024; t.dst = W + OFF_B_OUT; }
    else if (j == 20) { t.src = P->in[I_CIN]; t.lds = 4096; t.K = 1024; t.nvalid = 4096; npad = 4096; t.dst = W + OFF_C_IN; }
    else if (j == 21) { t.src = P->in[I_COUT]; t.lds = 1024; t.K = 2048; t.nvalid = 1024; npad = 1024; t.dst = W + OFF_C_OUT; }
    else if (j == 22) { t.src = P->in[I_DIN]; t.lds = 2048; t.K = 1024; t.nvalid = 2048; npad = 2048; t.dst = W + OFF_D_IN; }
    else if (j == 23) { t.src = P->in[I_DOUT]; t.lds = 1024; t.K = 1024; t.nvalid = 1024; npad = 1024; t.dst = W + OFF_D_OUT; }
    else { const int q = j - 24, blk = q >> 2, pn = (q >> 1) & 1, which = q & 1;
        t.src = (which ? P->in[I_DWX] : P->in[I_DWA]) + (size_t)blk * 65536 + pn * 128; t.lds = 256; t.K = 256; t.nvalid = 128; npad = 128;
        t.dst = W + OFF_D_G + (size_t)blk * 512 * 256 + (size_t)(pn * 256 + which * 128) * 256; }
    t.ldd = t.K; t.ntn = npad / 64; t.t0 = (t.K / 64) * t.ntn;
    return t;
}
constexpr int NTJOBS = 40;
__device__ __forceinline__ void prep_phase(KP P, LAS unsigned char* lds) {
    const int tid = opaque_tid();
    LAS int* tstart = (LAS int*)(lds + 32768);
    LAS float* tile = (LAS float*)lds;
    if (tid == 0) { int s = 0; for (int j = 0; j < NTJOBS; ++j) { tstart[j] = s; s += make_tjob(P, j).t0; } tstart[NTJOBS] = s; }
    __syncthreads();
    const int total = tstart[NTJOBS];
    for (int gt = blockIdx.x; gt < total; gt += gridDim.x) {
        int j = 0; while (tstart[j + 1] <= gt) ++j;
        const TJob t = make_tjob(P, j);
        const int lt = gt - tstart[j]; const int kt = lt / t.ntn, ntile = lt - kt * t.ntn; const int k0 = kt * 64, n0 = ntile * 64;
        { const int kk = tid >> 4, nn = (tid & 15) * 4;
#pragma unroll
            for (int i = 0; i < 2; ++i) { const int k = kk + 32 * i; f32x4 v = (f32x4){0.f, 0.f, 0.f, 0.f};
                if (n0 + nn < t.nvalid) v = *(const f32x4*)(t.src + (size_t)(k0 + k) * t.lds + n0 + nn);
                tile[k * 65 + nn] = v[0]; tile[k * 65 + nn + 1] = v[1]; tile[k * 65 + nn + 2] = v[2]; tile[k * 65 + nn + 3] = v[3]; } }
        __syncthreads();
        { const int n = tid >> 3, k8 = (tid & 7) * 8; float v[8];
#pragma unroll
            for (int e = 0; e < 8; ++e) v[e] = tile[(k8 + e) * 65 + n];
            u32x4 w; w.x = pk2(v[0], v[1]); w.y = pk2(v[2], v[3]); w.z = pk2(v[4], v[5]); w.w = pk2(v[6], v[7]);
            *(u32x4*)(t.dst + (size_t)(n0 + n) * t.ldd + k0 + k8) = w; }
        __syncthreads();
    }
    { bf16_t* Wsb = (bf16_t*)(P->ws + WS_W) + OFF_C_WS; const float* sw = P->in[I_CSW];
        for (int i = blockIdx.x * NTHREADS + tid; i < 8 * 128 * 128; i += gridDim.x * NTHREADS) { const int s = i & 127, t = (i >> 7) & 127; Wsb[i] = f2bf(s <= t ? sw[i] : 0.f); } }
    if (blockIdx.x == 0) { float* lb = (float*)(P->ws + WS_LB); const float* s = P->in[I_BLB];
        for (int c = tid; c < 1024; c += NTHREADS) { const float a0 = s[c], a1 = s[1024 + c], a2 = s[2048 + c], a3 = s[3072 + c]; const float mx = fmaxf(fmaxf(a0, a1), fmaxf(a2, a3));
            const float e0 = __expf(a0 - mx), e1 = __expf(a1 - mx), e2 = __expf(a2 - mx), e3 = __expf(a3 - mx); lb[c] = e1 * fast_rcp(e0 + e1 + e2 + e3);
            lb[1024 + c] = -8.0f * __logf(1.0f + __expf(-P->in[I_DLAM][c])); } }
    rowpass(P->in[I_X], nullptr, nullptr, nullptr, nullptr, nullptr, P->in[I_NG], (bf16_t*)(P->ws + WS_HN), 1, nullptr, nullptr, nullptr, nullptr, (float*)(P->ws + WS_LB + 512 * 1024));
}

__device__ __forceinline__ float incl_scan_sum(float v, int lane) {
#pragma unroll
    for (int d = 1; d < 64; d <<= 1) { const float t = __shfl_up(v, d); if (lane >= d) v += t; }
    return v;
}
__device__ __forceinline__ float incl_scan_max(float v, int lane) {
#pragma unroll
    for (int d = 1; d < 64; d <<= 1) { const float t = __shfl_up(v, d); if (lane >= d) v = fmaxf(v, t); }
    return v;
}
#define LDS_BARRIER() do { asm volatile("s_waitcnt lgkmcnt(0)" ::: "memory"); __builtin_amdgcn_s_barrier(); asm volatile("" ::: "memory"); } while (0)
__device__ __forceinline__ void mlstm_core(KP P, LAS unsigned char* lds) {
    const int tid = opaque_tid(), w = __builtin_amdgcn_readfirstlane(tid >> 6), lane = tid & 63, fr = lane & 15, fq = lane >> 4;
    const bf16_t* z = (const bf16_t*)(P->ws + WS_Z); const float* gate = (const float*)(P->ws + WS_GATE); bf16_t* yout = (bf16_t*)(P->ws + WS_YP);
    constexpr int PQ = 160, PV = 320, PP = 288, PC = 160;
    LAS unsigned char* Qs = lds; LAS unsigned char* Ks = lds + 20480; LAS unsigned char* Vs = lds + 40960; LAS unsigned char* Ps = lds + 81920; LAS unsigned char* Cb = lds + 118784;
    LAS float* fa = (LAS float*)(lds + 141824); LAS float* fM = fa + 128; LAS float* fb = fa + 256; LAS float* fwk = fa + 384;
    for (int unit = blockIdx.x; unit < 256; unit += gridDim.x) {
        const int b = unit >> 3, h = unit & 7;
        const float ib = P->in[I_AIB][h], fbias = P->in[I_AFB][h];
        __syncthreads();
        for (int i = tid; i < 144 * 80 / 2; i += NTHREADS) ((LAS unsigned*)Cb)[i] = 0u;
        if (tid < 128) { LAS unsigned* vp = (LAS unsigned*)(Vs + tid * PV + 256); unsigned zz, one; asm volatile("v_mov_b32 %0, 0" : "=v"(zz)); asm volatile("v_mov_b32 %0, 0x3f80" : "=v"(one)); vp[0] = one;
#pragma unroll
            for (int i = 1; i < 16; ++i) vp[i] = zz; }
        f32x4 st[5];
#pragma unroll
        for (int i = 0; i < 5; ++i) st[i] = (f32x4){0.f, 0.f, 0.f, 0.f};
        float m_state = 0.f;
        u32x4 nq[2], nk[2], nv[4]; float nig = 0.f, nfg = 0.f;
        { const size_t r0 = (size_t)b * SEQL;
#pragma unroll
            for (int i = 0; i < 2; ++i) { const int idx = tid + i * 512, row = idx >> 3, pc = idx & 7;
                nq[i] = *(const u32x4*)(z + (r0 + row) * 3072 + h * 64 + pc * 8); nk[i] = *(const u32x4*)(z + (r0 + row) * 3072 + 512 + h * 64 + pc * 8); }
#pragma unroll
            for (int i = 0; i < 4; ++i) { const int idx = tid + i * 512, row = idx >> 4, pc = idx & 15; nv[i] = *(const u32x4*)(z + (r0 + row) * 3072 + 1024 + h * 128 + pc * 8); }
            if (tid < 128) { nig = gate[(r0 + tid) * 16 + h]; nfg = gate[(r0 + tid) * 16 + 8 + h]; } }
        for (int chunk = 0; chunk < 16; ++chunk) {
            const size_t r0 = (size_t)b * SEQL + chunk * 128;
#pragma unroll
            for (int i = 0; i < 2; ++i) { const int idx = tid + i * 512, row = idx >> 3, pc = idx & 7;
                u32x4 q = nq[i];
                q.x = pk2(bflo(q.x) * 0.125f, bfhi(q.x) * 0.125f); q.y = pk2(bflo(q.y) * 0.125f, bfhi(q.y) * 0.125f); q.z = pk2(bflo(q.z) * 0.125f, bfhi(q.z) * 0.125f); q.w = pk2(bflo(q.w) * 0.125f, bfhi(q.w) * 0.125f);
                *(LAS u32x4*)(Qs + row * PQ + pc * 16) = q;
                *(LAS u32x4*)(Ks + row * PQ + pc * 16) = nk[i]; }
#pragma unroll
            for (int i = 0; i < 4; ++i) { const int idx = tid + i * 512, row = idx >> 4, pc = idx & 15;
                *(LAS u32x4*)(Vs + row * PV + pc * 16) = nv[i]; }
            if (tid < 128) { const float ig = nig, fg = nfg;
                const float xf = fg + fbias; const float lf = fminf(xf, 0.f) - __logf(1.0f + __expf(-fabsf(xf)));
                fa[tid] = ig + ib; fb[tid] = lf; }
            if (chunk + 1 < 16) { const size_t r1 = r0 + 128;
#pragma unroll
                for (int i = 0; i < 2; ++i) { const int idx = tid + i * 512, row = idx >> 3, pc = idx & 7;
                    nq[i] = *(const u32x4*)(z + (r1 + row) * 3072 + h * 64 + pc * 8); nk[i] = *(const u32x4*)(z + (r1 + row) * 3072 + 512 + h * 64 + pc * 8); }
#pragma unroll
                for (int i = 0; i < 4; ++i) { const int idx = tid + i * 512, row = idx >> 4, pc = idx & 15; nv[i] = *(const u32x4*)(z + (r1 + row) * 3072 + 1024 + h * 128 + pc * 8); }
                if (tid < 128) { nig = gate[(r1 + tid) * 16 + h]; nfg = gate[(r1 + tid) * 16 + 8 + h]; } }
            LDS_BARRIER();
            if (w == 0) {
                const float lf0 = fb[lane], lf1 = fb[64 + lane], li0 = fa[lane], li1 = fa[64 + lane];
                const float c0 = incl_scan_sum(lf0, lane); const float tot0 = __shfl(c0, 63); const float c1 = incl_scan_sum(lf1, lane) + tot0;
                const float a0 = li0 - c0, a1 = li1 - c1;
                const float p0 = incl_scan_max(a0, lane); const float pt = __shfl(p0, 63); const float p1 = fmaxf(incl_scan_max(a1, lane), pt);
                const float M0 = fmaxf(m_state, p0), M1 = fmaxf(m_state, p1);
                const float Ml = __shfl(M1, 63);
                fa[lane] = a0; fa[64 + lane] = a1; fM[lane] = M0; fM[64 + lane] = M1; fb[lane] = c0; fb[64 + lane] = c1;
                fwk[lane] = __expf(a0 - Ml); fwk[64 + lane] = __expf(a1 - Ml);
            }
            LDS_BARRIER();
            const float Mlast = fM[127], blast = fb[127];
            const int t = 16 * w + fr;
            const float Mt = fM[t], bt = fb[t];
            const float winter = __expf(m_state - Mt);
            u32x2 ogv[8];
#pragma unroll
            for (int n = 0; n < 8; ++n) ogv[n] = *(const u32x2*)(z + (r0 + t) * 3072 + 2048 + h * 128 + 16 * n + fq * 4);
            bf16x8 qf[2];
            qf[0] = ldk(Qs + t * PQ + fq * 16); qf[1] = ldk(Qs + t * PQ + 64 + fq * 16);
            for (int n = 0; n <= (w | 1); ++n) {
                f32x4 a = (f32x4){0.f, 0.f, 0.f, 0.f};
                if (n <= w) {
                    const bf16x8 k0 = ldk(Ks + (16 * n + fr) * PQ + fq * 16), k1 = ldk(Ks + (16 * n + fr) * PQ + 64 + fq * 16);
                    a = MFMA16(k0, qf[0], a); a = MFMA16(k1, qf[1], a);
                    const f32x4 as4 = *(const LAS f32x4*)(fa + 16 * n + fq * 4);
#pragma unroll
                    for (int j = 0; j < 4; ++j) { const int s = 16 * n + fq * 4 + j; a[j] = (s <= t) ? a[j] * __expf(as4[j] - Mt) : 0.f; }
                }
                u32x2 pw; pw.x = pk2(a[0], a[1]); pw.y = pk2(a[2], a[3]);
                *(LAS u32x2*)(Ps + t * PP + (16 * n + fq * 4) * 2) = pw;
            }
            asm volatile("s_waitcnt lgkmcnt(0)" ::: "memory");
            f32x4 o[9];
#pragma unroll
            for (int n = 0; n < 9; ++n) { f32x4 c = (f32x4){0.f, 0.f, 0.f, 0.f};
                c = MFMA16(ldk(Cb + (16 * n + fr) * PC + fq * 16), qf[0], c); c = MFMA16(ldk(Cb + (16 * n + fr) * PC + 64 + fq * 16), qf[1], c);
                o[n] = c * winter; }
            for (int ks = 0; ks <= (w >> 1); ++ks) {
                const bf16x8 pf = ldk(Ps + t * PP + ks * 64 + fq * 16);
#pragma unroll
                for (int n = 0; n < 9; ++n) o[n] = MFMA16(ldt(Vs + (ks * 32) * PV + (16 * n) * 2, PV, fr, fq), pf, o[n]);
            }
            {
                float den = __shfl(o[8][0], fr);
                const float dn = fast_rcp(fmaxf(fabsf(den), __expf(-(bt + Mt))));
                float ss = 0.f;
#pragma unroll
                for (int n = 0; n < 8; ++n) { o[n] = o[n] * dn; ss += o[n][0] * o[n][0] + o[n][1] * o[n][1] + o[n][2] * o[n][2] + o[n][3] * o[n][3]; }
                ss += __shfl_xor(ss, 16); ss += __shfl_xor(ss, 32);
                const float rs = __builtin_amdgcn_rsqf(ss * (1.0f / 128.0f) + EPS);
                const float* hg = P->in[I_AHG] + h * 128;
#pragma unroll
                for (int n = 0; n < 8; ++n) { const int v0 = 16 * n + fq * 4;
                    const u32x2 og = ogv[n];
                    const f32x4 g4 = *(const f32x4*)(hg + v0);
                    const float y0 = o[n][0] * rs * g4[0] * sigmoidf_(bflo(og.x)), y1 = o[n][1] * rs * g4[1] * sigmoidf_(bfhi(og.x));
                    const float y2 = o[n][2] * rs * g4[2] * sigmoidf_(bflo(og.y)), y3 = o[n][3] * rs * g4[3] * sigmoidf_(bfhi(og.y));
                    u32x2 yw; yw.x = pk2(y0, y1); yw.y = pk2(y2, y3);
                    *(u32x2*)(yout + (r0 + t) * 1024 + h * 128 + v0) = yw; }
            }
            {
                const float decay = __expf(m_state - Mlast);
#pragma unroll
                for (int i = 0; i < 5; ++i) st[i] = st[i] * decay;
                for (int ks = 0; ks < 4; ++ks) {
                    const f32x4 wa = *(const LAS f32x4*)(fwk + ks * 32 + fq * 8), wb = *(const LAS f32x4*)(fwk + ks * 32 + fq * 8 + 4);
                    const bf16x8 vf = ldt(Vs + (ks * 32) * PV + (16 * w) * 2, PV, fr, fq);
                    bf16x8 kf[4];
#pragma unroll
                    for (int dt = 0; dt < 4; ++dt) { const u32x4 kr = as_u32x4(ldt(Ks + (ks * 32) * PQ + (16 * dt) * 2, PQ, fr, fq)); u32x4 ksc;
                        ksc.x = pk2(bflo(kr.x) * wa[0], bfhi(kr.x) * wa[1]); ksc.y = pk2(bflo(kr.y) * wa[2], bfhi(kr.y) * wa[3]);
                        ksc.z = pk2(bflo(kr.z) * wb[0], bfhi(kr.z) * wb[1]); ksc.w = pk2(bflo(kr.w) * wb[2], bfhi(kr.w) * wb[3]);
                        kf[dt] = as_bf16x8(ksc); st[dt] = MFMA16(kf[dt], vf, st[dt]); }
                    if (w < 4) { const bf16x8 v8 = ldt(Vs + (ks * 32) * PV + 128 * 2, PV, fr, fq);
                        const bf16x8 kw = (w == 0) ? kf[0] : (w == 1) ? kf[1] : (w == 2) ? kf[2] : kf[3];
                        st[4] = MFMA16(kw, v8, st[4]); }
                }
            }
            m_state = blast + Mlast;
            LDS_BARRIER();
#pragma unroll
            for (int dt = 0; dt < 4; ++dt) { u32x2 cw; cw.x = pk2(st[dt][0], st[dt][1]); cw.y = pk2(st[dt][2], st[dt][3]);
                *(LAS u32x2*)(Cb + (16 * w + fr) * PC + (16 * dt + fq * 4) * 2) = cw; }
            if (w < 4) { u32x2 cw; cw.x = pk2(st[4][0], st[4][1]); cw.y = pk2(st[4][2], st[4][3]);
                *(LAS u32x2*)(Cb + (128 + fr) * PC + (16 * w + fq * 4) * 2) = cw; }
        }
    }
    __syncthreads();
}

__device__ __forceinline__ void hgrn_core(KP P, LAS unsigned char* lds) {
    const int tid = opaque_tid(), w = __builtin_amdgcn_readfirstlane(tid >> 6), lane = tid & 63, fr = lane & 15, fq = lane >> 4;
    const bf16_t* z = (const bf16_t*)(P->ws + WS_Z); const float* lbv = (const float*)(P->ws + WS_LB); bf16_t* yout = (bf16_t*)(P->ws + WS_YP);
    constexpr int PT = 288, PA = 96;
    LAS unsigned char* Qt = lds; LAS unsigned char* Qh = lds + 9216; LAS unsigned char* Kh = lds + 18432; LAS unsigned char* Vs = lds + 27648; LAS unsigned char* At = lds + 36864;
    LAS unsigned char* Sb = lds + 40960;
    LAS float* gl = (LAS float*)(lds + 77824);
    LAS float* seg = (LAS float*)(lds + 78336);
    LAS float* ssp = (LAS float*)(lds + 80384);
    const int c = tid & 127, tq = tid >> 7;
    for (int unit = blockIdx.x; unit < 256; unit += gridDim.x) {
        const int b = unit >> 3, h = unit & 7;
        const float lb = lbv[h * 128 + c];
        __syncthreads();
        for (int i = tid; i < 128 * 144 / 2; i += NTHREADS) ((LAS unsigned*)Sb)[i] = 0u;
        f32x4 S[8];
#pragma unroll
        for (int i = 0; i < 8; ++i) S[i] = (f32x4){0.f, 0.f, 0.f, 0.f};
        bf16_t nq[8], nf[8]; u32x4 nv; u32x2 ng2[2];
        { const size_t r0 = (size_t)b * SEQL;
#pragma unroll
            for (int i = 0; i < 8; ++i) { const size_t ro = (r0 + tq * 8 + i) * 4096 + h * 128 + c; nq[i] = z[ro]; nf[i] = z[ro + 1024]; }
            nv = *(const u32x4*)(z + (r0 + (tid >> 4)) * 4096 + 2048 + h * 128 + (tid & 15) * 8);
#pragma unroll
            for (int tt = 0; tt < 2; ++tt) ng2[tt] = *(const u32x2*)(z + (r0 + 16 * tt + fr) * 4096 + 3072 + h * 128 + 16 * w + fq * 4); }
        for (int chunk = 0; chunk < 64; ++chunk) {
            const size_t r0 = (size_t)b * SEQL + chunk * 32;
            float qv[8], kv[8], cs[8];
            const u32x2 cg0 = ng2[0], cg1 = ng2[1];
            { float run = 0.f;
#pragma unroll
                for (int i = 0; i < 8; ++i) {
                    qv[i] = bf2f(nq[i]); const float fz = bf2f(nf[i]);
                    const float f = lb + (1.0f - lb) * sigmoidf_(fz); kv[i] = 1.0f - f; run += __logf(f); cs[i] = run; }
                seg[tq * 128 + c] = run; }
            { const int row = tid >> 4, pc = tid & 15;
                *(LAS u32x4*)(Vs + row * PT + pc * 16) = nv; }
            if (chunk + 1 < 64) { const size_t r1 = r0 + 32;
#pragma unroll
                for (int i = 0; i < 8; ++i) { const size_t ro = (r1 + tq * 8 + i) * 4096 + h * 128 + c; nq[i] = z[ro]; nf[i] = z[ro + 1024]; }
                nv = *(const u32x4*)(z + (r1 + (tid >> 4)) * 4096 + 2048 + h * 128 + (tid & 15) * 8);
#pragma unroll
                for (int tt = 0; tt < 2; ++tt) ng2[tt] = *(const u32x2*)(z + (r1 + 16 * tt + fr) * 4096 + 3072 + h * 128 + 16 * w + fq * 4); }
            LDS_BARRIER();
            { const float s0 = seg[c], s1 = seg[128 + c], s2 = seg[256 + c], s3 = seg[384 + c];
                const float pre = (tq > 0 ? s0 : 0.f) + (tq > 1 ? s1 : 0.f) + (tq > 2 ? s2 : 0.f); const float glast = (s0 + s1) + (s2 + s3);
#pragma unroll
                for (int i = 0; i < 8; ++i) { const float g = pre + cs[i]; const int t = tq * 8 + i;
                    const float eg = __expf(g), er = __expf(g - glast);
                    *(LAS bf16_t*)(Qh + t * PT + c * 2) = f2bf(qv[i] * eg);
                    *(LAS bf16_t*)(Qt + t * PT + c * 2) = f2bf(qv[i] * er);
                    *(LAS bf16_t*)(Kh + t * PT + c * 2) = f2bf(kv[i] * fast_rcp(er)); }
                if (tq == 0) gl[c] = __expf(glast); }
            LDS_BARRIER();
            f32x4 o[2];
#pragma unroll
            for (int tt = 0; tt < 2; ++tt) { f32x4 a = (f32x4){0.f, 0.f, 0.f, 0.f};
#pragma unroll
                for (int ks = 0; ks < 4; ++ks) a = MFMA16(ldk(Sb + (16 * w + fr) * PT + ks * 64 + fq * 16), ldk(Qh + (16 * tt + fr) * PT + ks * 64 + fq * 16), a);
                o[tt] = a; }
            if (w < 4) { const int tt = w >> 1, stl = w & 1; f32x4 a = (f32x4){0.f, 0.f, 0.f, 0.f};
                if (!(tt == 0 && stl == 1)) {
#pragma unroll
                    for (int ks = 0; ks < 4; ++ks) a = MFMA16(ldk(Kh + (16 * stl + fr) * PT + ks * 64 + fq * 16), ldk(Qt + (16 * tt + fr) * PT + ks * 64 + fq * 16), a);
                    const int t = 16 * tt + fr;
#pragma unroll
                    for (int j = 0; j < 4; ++j) { const int s = 16 * stl + fq * 4 + j; if (s > t) a[j] = 0.f; }
                }
                u32x2 aw; aw.x = pk2(a[0], a[1]); aw.y = pk2(a[2], a[3]);
                *(LAS u32x2*)(At + (16 * tt + fr) * PA + (16 * stl + fq * 4) * 2) = aw; }
            LDS_BARRIER();
            { const bf16x8 vf = ldt(Vs + (16 * w) * 2, PT, fr, fq);
#pragma unroll
                for (int tt = 0; tt < 2; ++tt) { o[tt] = MFMA16(vf, ldk(At + (16 * tt + fr) * PA + fq * 16), o[tt]);
                    float ss = o[tt][0] * o[tt][0] + o[tt][1] * o[tt][1] + o[tt][2] * o[tt][2] + o[tt][3] * o[tt][3];
                    ss += __shfl_xor(ss, 16); ss += __shfl_xor(ss, 32);
                    if (fq == 0) ssp[(16 * tt + fr) * 8 + w] = ss; }
                const bf16x8 kf = ldt(Kh + (16 * w) * 2, PT, fr, fq);
                const f32x4 dc = *(const LAS f32x4*)(gl + 16 * w + fq * 4);
#pragma unroll
                for (int vt = 0; vt < 8; ++vt) { S[vt] = S[vt] * dc; S[vt] = MFMA16(kf, ldt(Vs + (16 * vt) * 2, PT, fr, fq), S[vt]); } }
            LDS_BARRIER();
#pragma unroll
            for (int vt = 0; vt < 8; ++vt) { u32x2 sw; sw.x = pk2(S[vt][0], S[vt][1]); sw.y = pk2(S[vt][2], S[vt][3]);
                *(LAS u32x2*)(Sb + (16 * vt + fr) * PT + (16 * w + fq * 4) * 2) = sw; }
            { const float* hg = P->in[I_BHG] + h * 128; const int v0 = 16 * w + fq * 4; const f32x4 g4 = *(const f32x4*)(hg + v0);
#pragma unroll
                for (int tt = 0; tt < 2; ++tt) { const int t = 16 * tt + fr;
                    const f32x4 sa = *(const LAS f32x4*)(ssp + t * 8), sb = *(const LAS f32x4*)(ssp + t * 8 + 4);
                    const float tot = ((sa[0] + sa[1]) + (sa[2] + sa[3])) + ((sb[0] + sb[1]) + (sb[2] + sb[3]));
                    const float rs = __builtin_amdgcn_rsqf(tot * (1.0f / 128.0f) + EPS);
                    const u32x2 gg = tt ? cg1 : cg0;
                    const float g0 = bflo(gg.x), g1 = bfhi(gg.x), g2 = bflo(gg.y), g3 = bfhi(gg.y);
                    const float y0 = o[tt][0] * rs * g4[0] * g0 * sigmoidf_(g0), y1 = o[tt][1] * rs * g4[1] * g1 * sigmoidf_(g1);
                    const float y2 = o[tt][2] * rs * g4[2] * g2 * sigmoidf_(g2), y3 = o[tt][3] * rs * g4[3] * g3 * sigmoidf_(g3);
                    u32x2 yw; yw.x = pk2(y0, y1); yw.y = pk2(y2, y3);
                    *(u32x2*)(yout + (r0 + t) * 1024 + h * 128 + v0) = yw; } }
        }
    }
    __syncthreads();
}

__device__ __forceinline__ void spatial_core(KP P, LAS unsigned char* lds) {
    const int tid = opaque_tid(), w = __builtin_amdgcn_readfirstlane(tid >> 6), lane = tid & 63, fr = lane & 15, fq = lane >> 4;
    bf16_t* z = (bf16_t*)(P->ws + WS_Z); const bf16_t* Wsb = (const bf16_t*)(P->ws + WS_W) + OFF_C_WS;
    constexpr int PVh = 544, PW = 288;
    LAS unsigned char* Vh = lds; LAS unsigned char* Wg = lds + 69632; LAS float* mu = (LAS float*)(lds + 106496); LAS float* rsd = mu + 128;
    for (int unit = blockIdx.x; unit < 512; unit += gridDim.x) {
        const size_t r0 = (size_t)unit * 128;
        __syncthreads();
        for (int rb = 0; rb < 4; ++rb) { u32x4 xr[4][4];
#pragma unroll
            for (int j = 0; j < 4; ++j)
#pragma unroll
                for (int q = 0; q < 4; ++q) xr[j][q] = *(const u32x4*)(z + (r0 + 16 * w + rb * 4 + j) * 4096 + 2048 + (q * 64 + lane) * 8);
#pragma unroll
            for (int j = 0; j < 4; ++j) { const int row = 16 * w + rb * 4 + j; float x[32]; float s = 0.f;
#pragma unroll
                for (int q = 0; q < 4; ++q) { const u32x4 v = xr[j][q];
                    x[q * 8 + 0] = bflo(v.x); x[q * 8 + 1] = bfhi(v.x); x[q * 8 + 2] = bflo(v.y); x[q * 8 + 3] = bfhi(v.y); x[q * 8 + 4] = bflo(v.z); x[q * 8 + 5] = bfhi(v.z); x[q * 8 + 6] = bflo(v.w); x[q * 8 + 7] = bfhi(v.w); }
#pragma unroll
                for (int e = 0; e < 32; ++e) s += x[e];
                s = wave_sum(s); const float mean = s * (1.0f / 2048.0f); float qd = 0.f;
#pragma unroll
                for (int e = 0; e < 32; ++e) { const float d = x[e] - mean; qd += d * d; }
                qd = wave_sum(qd);
                if (lane == 0) { mu[row] = mean; rsd[row] = __builtin_amdgcn_rsqf(qd * (1.0f / 2048.0f) + EPS); } } }
        __syncthreads();
        const int pc = tid & 31;
        u32x4 pvr[8], pwr[4];
#define SP_LOADG(gg) do { _Pragma("unroll") for (int i = 0; i < 8; ++i) pvr[i] = *(const u32x4*)(z + (r0 + (tid >> 5) + i * 16) * 4096 + 2048 + (gg) * 256 + pc * 8); \
            _Pragma("unroll") for (int i = 0; i < 4; ++i) { const int idx = tid + i * 512; pwr[i] = *(const u32x4*)(Wsb + (size_t)(gg) * 16384 + (idx >> 4) * 128 + (idx & 15) * 8); } } while (0)
        SP_LOADG(0);
        for (int g = 0; g < 8; ++g) {
            { float gn[8], bi[8];
#pragma unroll
                for (int e = 0; e < 8; ++e) { gn[e] = P->in[I_CLG][g * 256 + pc * 8 + e]; bi[e] = P->in[I_CLB][g * 256 + pc * 8 + e]; }
#pragma unroll
                for (int i = 0; i < 8; ++i) { const int row = (tid >> 5) + i * 16;
                    const u32x4 v = pvr[i]; const float m = mu[row], r = rsd[row];
                    u32x4 o; o.x = pk2((bflo(v.x) - m) * r * gn[0] + bi[0], (bfhi(v.x) - m) * r * gn[1] + bi[1]); o.y = pk2((bflo(v.y) - m) * r * gn[2] + bi[2], (bfhi(v.y) - m) * r * gn[3] + bi[3]);
                    o.z = pk2((bflo(v.z) - m) * r * gn[4] + bi[4], (bfhi(v.z) - m) * r * gn[5] + bi[5]); o.w = pk2((bflo(v.w) - m) * r * gn[6] + bi[6], (bfhi(v.w) - m) * r * gn[7] + bi[7]);
                    *(LAS u32x4*)(Vh + row * PVh + pc * 16) = o; }
#pragma unroll
                for (int i = 0; i < 4; ++i) { const int idx = tid + i * 512, row = idx >> 4, p2 = idx & 15;
                    *(LAS u32x4*)(Wg + row * PW + p2 * 16) = pwr[i]; } }
            u32x2 upre[8][2]; float bsv[8];
#pragma unroll
            for (int tt = 0; tt < 8; ++tt) { const int t = 16 * tt + fr; const bf16_t* up = z + (r0 + t) * 4096 + g * 256 + 32 * w + fq * 4;
                upre[tt][0] = *(const u32x2*)up; upre[tt][1] = *(const u32x2*)(up + 16); bsv[tt] = P->in[I_CSB][g * 128 + t]; }
            if (g + 1 < 8) SP_LOADG(g + 1);
            LDS_BARRIER();
            bf16x8 bf[2][4];
#pragma unroll
            for (int ci = 0; ci < 2; ++ci)
#pragma unroll
                for (int ks = 0; ks < 4; ++ks) bf[ci][ks] = ldt(Vh + (ks * 32) * PVh + (16 * (2 * w + ci)) * 2, PVh, fr, fq);
#pragma unroll
            for (int tt = 0; tt < 8; ++tt) { f32x4 a0 = (f32x4){0.f, 0.f, 0.f, 0.f}, a1 = a0;
#pragma unroll
                for (int ks = 0; ks < 4; ++ks) if (ks <= (tt >> 1)) { const bf16x8 af = ldk(Wg + (16 * tt + fr) * PW + ks * 64 + fq * 16); a0 = MFMA16(bf[0][ks], af, a0); a1 = MFMA16(bf[1][ks], af, a1); }
                const int t = 16 * tt + fr; const float bs = bsv[tt];
                bf16_t* up = z + (r0 + t) * 4096 + g * 256 + 32 * w + fq * 4;
                { const u32x2 uu = upre[tt][0]; u32x2 yw; yw.x = pk2(bflo(uu.x) * (a0[0] + bs), bfhi(uu.x) * (a0[1] + bs)); yw.y = pk2(bflo(uu.y) * (a0[2] + bs), bfhi(uu.y) * (a0[3] + bs)); *(u32x2*)up = yw; }
                { const u32x2 uu = upre[tt][1]; u32x2 yw; yw.x = pk2(bflo(uu.x) * (a1[0] + bs), bfhi(uu.x) * (a1[1] + bs)); yw.y = pk2(bflo(uu.y) * (a1[2] + bs), bfhi(uu.y) * (a1[3] + bs)); *(u32x2*)(up + 16) = yw; } }
            LDS_BARRIER();
        }
#undef SP_LOADG
    }
    __syncthreads();
}

__device__ __forceinline__ void conv_pass(KP P) {
    const bf16_t* z = (const bf16_t*)(P->ws + WS_Z); bf16_t* xc = (bf16_t*)(P->ws + WS_YP);
    const int gtid = blockIdx.x * NTHREADS + opaque_tid(), nth = gridDim.x * NTHREADS;
    const int oct = gtid & 127;
    float cw[4][8], cb[8];
#pragma unroll
    for (int e = 0; e < 8; ++e) { cb[e] = P->in[I_DCB][oct * 8 + e];
#pragma unroll
        for (int j = 0; j < 4; ++j) cw[j][e] = P->in[I_DCW][j * 1024 + oct * 8 + e]; }
    for (int idx = gtid; idx < (MTOK / 8) * 128; idx += nth) {
        const int r0 = (idx >> 7) * 8; const bool first = (r0 & (SEQL - 1)) == 0;
        u32x4 xr[11];
#pragma unroll
        for (int i = 0; i < 11; ++i) { xr[i] = (u32x4){0u, 0u, 0u, 0u}; if (i >= 3 || !first) xr[i] = *(const u32x4*)(z + (size_t)(r0 - 3 + i) * 2048 + 1024 + oct * 8); }
#pragma unroll
        for (int o = 0; o < 8; ++o) { float a[8];
#pragma unroll
            for (int e = 0; e < 8; ++e) a[e] = cb[e];
#pragma unroll
            for (int j = 0; j < 4; ++j) { const u32x4 v = xr[o + j];
                a[0] += cw[j][0] * bflo(v.x); a[1] += cw[j][1] * bfhi(v.x); a[2] += cw[j][2] * bflo(v.y); a[3] += cw[j][3] * bfhi(v.y);
                a[4] += cw[j][4] * bflo(v.z); a[5] += cw[j][5] * bfhi(v.z); a[6] += cw[j][6] * bflo(v.w); a[7] += cw[j][7] * bfhi(v.w); }
            u32x4 ow; ow.x = pk2(a[0], a[1]); ow.y = pk2(a[2], a[3]); ow.z = pk2(a[4], a[5]); ow.w = pk2(a[6], a[7]);
            *(u32x4*)(xc + (size_t)(r0 + o) * 1024 + oct * 8) = ow; }
    }
}
__device__ __forceinline__ void scan_pass(KP P, LAS unsigned char* lds) {
    const bf16_t* z = (const bf16_t*)(P->ws + WS_Z); const bf16_t* loga = z + (size_t)MTOK * 2048; const bf16_t* beta = loga + (size_t)MTOK * 1024; bf16_t* y = (bf16_t*)(P->ws + WS_YP);
    LAS float* sA = (LAS float*)lds; LAS float* sB = sA + 512 * 8;
    const int tid = opaque_tid(), seg = tid >> 4, o = tid & 15;
    for (int unit = blockIdx.x; unit < 256; unit += gridDim.x) {
        const int b = unit >> 3; const int ch0 = ((unit & 7) * 16 + o) * 8; const size_t row0 = (size_t)b * SEQL + seg * 64;
        float SL[8], B[8];
#pragma unroll
        for (int e = 0; e < 8; ++e) { SL[e] = 0.f; B[e] = 0.f; }
#pragma unroll 4
        for (int t = 0; t < 64; ++t) { const u32x4 lv = *(const u32x4*)(loga + (row0 + t) * 1024 + ch0), bv = *(const u32x4*)(beta + (row0 + t) * 1024 + ch0);
            const float l[8] = {bflo(lv.x), bfhi(lv.x), bflo(lv.y), bfhi(lv.y), bflo(lv.z), bfhi(lv.z), bflo(lv.w), bfhi(lv.w)};
            const float be[8] = {bflo(bv.x), bfhi(bv.x), bflo(bv.y), bfhi(bv.y), bflo(bv.z), bfhi(bv.z), bflo(bv.w), bfhi(bv.w)};
#pragma unroll
            for (int e = 0; e < 8; ++e) { B[e] = __expf(l[e]) * B[e] + be[e]; SL[e] += l[e]; } }
        __syncthreads();
#pragma unroll
        for (int e = 0; e < 8; ++e) { sA[tid * 8 + e] = __expf(SL[e]); sB[tid * 8 + e] = B[e]; }
        __syncthreads();
        float H[8];
#pragma unroll
        for (int e = 0; e < 8; ++e) H[e] = 0.f;
        for (int s = 0; s < seg; ++s) {
#pragma unroll
            for (int e = 0; e < 8; ++e) H[e] = sA[(s * 16 + o) * 8 + e] * H[e] + sB[(s * 16 + o) * 8 + e]; }
        for (int t0 = 0; t0 < 64; t0 += 4) { u32x4 lvv[4], bvv[4], gvv[4];
#pragma unroll
            for (int i = 0; i < 4; ++i) { lvv[i] = *(const u32x4*)(loga + (row0 + t0 + i) * 1024 + ch0); bvv[i] = *(const u32x4*)(beta + (row0 + t0 + i) * 1024 + ch0); gvv[i] = *(const u32x4*)(z + (row0 + t0 + i) * 2048 + ch0); }
#pragma unroll
            for (int i = 0; i < 4; ++i) { const u32x4 lv = lvv[i], bv = bvv[i], gv = gvv[i];
                const float l[8] = {bflo(lv.x), bfhi(lv.x), bflo(lv.y), bfhi(lv.y), bflo(lv.z), bfhi(lv.z), bflo(lv.w), bfhi(lv.w)};
                const float be[8] = {bflo(bv.x), bfhi(bv.x), bflo(bv.y), bfhi(bv.y), bflo(bv.z), bfhi(bv.z), bflo(bv.w), bfhi(bv.w)};
                const float gg[8] = {bflo(gv.x), bfhi(gv.x), bflo(gv.y), bfhi(gv.y), bflo(gv.z), bfhi(gv.z), bflo(gv.w), bfhi(gv.w)};
                float yv[8];
#pragma unroll
                for (int e = 0; e < 8; ++e) { H[e] = __expf(l[e]) * H[e] + be[e]; yv[e] = H[e] * gelu_tanh(gg[e]); }
                u32x4 ow; ow.x = pk2(yv[0], yv[1]); ow.y = pk2(yv[2], yv[3]); ow.z = pk2(yv[4], yv[5]); ow.w = pk2(yv[6], yv[7]);
                *(u32x4*)(y + (row0 + t0 + i) * 1024 + ch0) = ow; } }
    }
    __syncthreads();
}

constexpr int NPHASES = 39;
enum { T_PREP, T_GEMM, T_GEMMRG, T_ROW, T_MLSTM, T_HGRN, T_SPATIAL, T_CONV, T_SCAN };
__device__ __forceinline__ void decode(int ph, int& type, int& layer, int& sub) {
    if (ph == 0) { type = T_PREP; layer = 0; sub = 0; return; }
    int base, cbase;
    if (ph < 10) { layer = 0; base = 1; cbase = 4; } else if (ph < 19) { layer = 1; base = 10; cbase = 13; } else if (ph < 28) { layer = 2; base = 19; cbase = 22; } else { layer = 3; base = 28; cbase = 33; }
    if (ph >= cbase) { const int k = ph - cbase;
        if (k == 0) { type = T_ROW; sub = 1; } else if (k == 1) { type = T_GEMM; sub = 2; } else if (k == 2) { type = T_GEMM; sub = 3; } else if (k == 3) { type = T_ROW; sub = 2; } else if (k == 4) { type = T_GEMM; sub = 4; } else { type = T_ROW; sub = 3; }
        return; }
    const int k = ph - base;
    if (layer < 3) { if (k == 0) { type = T_GEMM; sub = 0; } else if (k == 1) { type = layer == 0 ? T_MLSTM : layer == 1 ? T_HGRN : T_SPATIAL; sub = 0; } else { type = T_GEMM; sub = 1; } }
    else { if (k == 0) { type = T_GEMM; sub = 0; } else if (k == 1) { type = T_CONV; sub = 0; } else if (k == 2) { type = T_GEMMRG; sub = 0; } else if (k == 3) { type = T_SCAN; sub = 0; } else { type = T_GEMM; sub = 1; } }
}

__global__ void __launch_bounds__(NTHREADS, 2) fwd_kernel(Params Pk) {
    extern __shared__ __attribute__((aligned(16))) unsigned char smem[];
    LAS unsigned char* lds = (LAS unsigned char*)smem;
    const int ph_lo = Pk.ph_lo, ph_hi = Pk.ph_hi;
    if (ph_lo < 0) cg::this_grid().sync();
    volatile LAS unsigned* bst = (volatile LAS unsigned*)(lds + (LDS_BYTES - 16));
    if (threadIdx.x == 0) { bst[0] = 0u; bst[1] = 0u; }
    __syncthreads();
    const XcdBarrier gbar = xcd_barrier_post((unsigned*)(Pk.ws + WS_BAR), bst);
    for (int ph = ph_lo; ph < ph_hi; ++ph) {
        KP P = (KP)__builtin_amdgcn_kernarg_segment_ptr();
        asm volatile("" : "+s"(P));
        unsigned char* ws = P->ws;
        bf16_t* W = (bf16_t*)(ws + WS_W); bf16_t* HN = (bf16_t*)(ws + WS_HN); bf16_t* Z = (bf16_t*)(ws + WS_Z); bf16_t* YP = (bf16_t*)(ws + WS_YP); bf16_t* PB = (bf16_t*)(ws + WS_PB);
        int type, layer, sub; decode(ph, type, layer, sub);
        if (type == T_PREP) prep_phase(P, lds);
        else if (type == T_GEMM) {
            const int njobs = (sub == 2) ? 2 : 1;
            for (int j = 0; j < njobs; ++j) {
                pg8::Gemm g; EpiGen e; e.gate = nullptr; e.gate_pn = -1; e.act = 0; g.M = MTOK;
                bf16_t* L = W + (size_t)layer * LW;
                if (sub == 0) { g.A = HN; g.lda = 1024; g.K = 1024; g.ldb = 1024; e.O = Z;
                    if (layer == 0) { g.Bt = W + OFF_A_IN; g.N = 3328; e.ldc = 3072; e.gate = (float*)(ws + WS_GATE); e.gate_pn = 12; }
                    else if (layer == 1) { g.Bt = W + OFF_B_IN; g.N = 4096; e.ldc = 4096; }
                    else if (layer == 2) { g.Bt = W + OFF_C_IN; g.N = 4096; e.ldc = 4096; e.act = 1; }
                    else { g.Bt = W + OFF_D_IN; g.N = 2048; e.ldc = 2048; } }
                else if (sub == 1) { g.N = 1024; e.O = (bf16_t*)P->out; e.ldc = 1024;
                    if (layer == 2) { g.A = Z; g.lda = 4096; g.K = 2048; g.ldb = 2048; g.Bt = W + OFF_C_OUT; }
                    else { g.A = YP; g.lda = 1024; g.K = 1024; g.ldb = 1024; g.Bt = W + (layer == 0 ? OFF_A_OUT : layer == 1 ? OFF_B_OUT : OFF_D_OUT); } }
                else if (sub == 2) {
                    if (j == 0) { g.A = HN; g.lda = 1024; g.K = 1024; g.ldb = 1024; g.Bt = L; g.N = 4096; e.O = Z; e.ldc = 4096; e.act = 2; }
                    else { g.A = PB; g.lda = 256; g.K = 256; g.ldb = 256; g.Bt = L + W_UP + W_DN + W_G; g.N = 1024; e.O = YP; e.ldc = 1024; } }
                else if (sub == 3) { g.A = Z; g.lda = 4096; g.K = 4096; g.ldb = 4096; g.Bt = L + W_UP; g.N = 1024; e.O = (bf16_t*)P->out; e.ldc = 1024; }
                else { g.A = HN; g.lda = 1024; g.K = 1024; g.ldb = 1024; g.Bt = L + W_UP + W_DN; g.N = 1024; e.O = YP; e.ldc = 1024; e.act = 3; }
                pg8::StaticOrder S; S.init(g.M, g.N, (int)gridDim.x, (int)blockIdx.x);
                pg8::gemm_phase<EpiGen>(lds, g, S, e);
            }
        }
        else if (type == T_GEMMRG) {
            for (int blk = 0; blk < 4; ++blk) {
                pg8::Gemm g; g.M = MTOK; g.N = 512; g.K = 256; g.A = YP + blk * 256; g.lda = 1024; g.Bt = W + OFF_D_G + (size_t)blk * 512 * 256; g.ldb = 256;
                EpiRg e; e.xc = YP; e.loga = Z + (size_t)MTOK * 2048; e.beta = e.loga + (size_t)MTOK * 1024; e.b_a = P->in[I_DBA]; e.b_x = P->in[I_DBX]; e.spt = (const float*)(ws + WS_LB) + 1024; e.blk = blk;
                pg8::StaticOrder S; S.init(g.M, g.N, (int)gridDim.x, (int)blockIdx.x);
                pg8::gemm_phase<EpiRg>(lds, g, S, e);
            }
        }
        else if (type == T_ROW) {
            const float* ng = P->in[I_NG] + (size_t)layer * 5 * 1024;
            bf16_t* HBuf = (bf16_t*)P->out;
            float* RS = (float*)(ws + WS_LB + 512 * 1024);
            if (sub == 1) rowpass(nullptr, HN, HBuf, ng + 1024, nullptr, nullptr, ng + 2048, HN, 1, P->in[I_P] + (size_t)layer * MTOK * 256, PB, RS, ng, RS);
            else if (sub == 2) rowpass(nullptr, HN, HBuf, ng + 3072, nullptr, nullptr, nullptr, HN, 0, nullptr, nullptr, RS, ng + 2048, nullptr);
            else if (layer < 3) rowpass(nullptr, HN, YP, ng + 4096, nullptr, nullptr, ng + 5120, HN, 1, nullptr, nullptr, nullptr, nullptr, RS);
            else rowpass(nullptr, HN, YP, ng + 4096, P->out, nullptr, nullptr, nullptr, 0, nullptr, nullptr);
        }
        else if (type == T_MLSTM) mlstm_core(P, lds);
        else if (type == T_HGRN) hgrn_core(P, lds);
        else if (type == T_SPATIAL) spatial_core(P, lds);
        else if (type == T_CONV) conv_pass(P);
        else if (type == T_SCAN) scan_pass(P, lds);
        if (ph + 1 < ph_hi) xcd_barrier(gbar);
    }
}

extern "C" void kernel_launch(void* const* d_in, const int* in_sizes, int n_in, void* d_out, int out_size, void* d_ws, size_t ws_size, hipStream_t stream) {
    static int grid = 0;
    if (grid == 0) {
        if (n_in != 31 || in_sizes[0] != MTOK * DM || out_size != MTOK * DM || ws_size < WS_END) { fprintf(stderr, "kernel_launch: unexpected shapes (n_in %d, ws %zu)\n", n_in, ws_size); grid = -1; return; }
        int dev = 0, cus = 0, per_cu = 0;
        hipGetDevice(&dev); hipDeviceGetAttribute(&cus, hipDeviceAttributeMultiprocessorCount, dev);
        hipFuncSetAttribute((const void*)fwd_kernel, hipFuncAttributeMaxDynamicSharedMemorySize, LDS_BYTES);
        hipOccupancyMaxActiveBlocksPerMultiprocessor(&per_cu, (const void*)fwd_kernel, NTHREADS, LDS_BYTES);
        if (per_cu < 1) per_cu = 1;
        grid = cus * per_cu;
        (void)hipGetLastError();
    }
    if (grid < 0) return;
    Params p{};
    for (int i = 0; i < 31; ++i) p.in[i] = (const float*)d_in[i];
    p.out = (float*)d_out; p.ws = (unsigned char*)d_ws;
    (void)hipMemsetAsync((unsigned char*)d_ws + WS_BAR, 0, XCD_BAR_WORDS * sizeof(unsigned), stream);
#if ONE_LAUNCH
    p.ph_lo = 0; p.ph_hi = NPHASES;
    void* args[] = {&p};
    hipError_t e = hipLaunchCooperativeKernel((const void*)fwd_kernel, dim3(grid), dim3(NTHREADS), args, LDS_BYTES, stream);
    if (e != hipSuccess) fprintf(stderr, "cooperative launch failed: %s (grid %d)\n", hipGetErrorString(e), grid);
#else
    for (int ph = 0; ph < NPHASES; ++ph) { p.ph_lo = ph; p.ph_hi = ph + 1; hipLaunchKernelGGL(fwd_kernel, dim3(grid), dim3(NTHREADS), LDS_BYTES, stream, p); }
#endif
}
```

```cpp
#include <hip/hip_runtime.h>
#include <hip/hip_cooperative_groups.h>
#include <cstdio>
namespace cg = cooperative_groups;

#ifndef ONE_LAUNCH
#define ONE_LAUNCH 1
#endif

#define LAS __attribute__((address_space(3)))
typedef unsigned short bf16_t;
typedef short bf16x8 __attribute__((ext_vector_type(8)));
typedef short s16x4 __attribute__((ext_vector_type(4)));
typedef float f32x4 __attribute__((ext_vector_type(4)));
typedef float f32x2 __attribute__((ext_vector_type(2)));
typedef unsigned u32x4 __attribute__((ext_vector_type(4)));
typedef unsigned u32x2 __attribute__((ext_vector_type(2)));

constexpr int MTOK = 65536, DM = 1024, SEQL = 2048;
constexpr float EPS = 1e-6f;
constexpr int NTHREADS = 512;
constexpr int LDS_BYTES = 147456;

constexpr size_t W_UP = 4096ull * 1024, W_DN = 1024ull * 4096, W_G = 1024ull * 1024, W_PU = 1024ull * 256;
constexpr size_t LW = W_UP + W_DN + W_G + W_PU;
constexpr size_t OFF_A_IN = 4 * LW;
constexpr size_t OFF_A_OUT = OFF_A_IN + 3328ull * 1024;
constexpr size_t OFF_B_IN = OFF_A_OUT + 1024ull * 1024;
constexpr size_t OFF_B_OUT = OFF_B_IN + 4096ull * 1024;
constexpr size_t OFF_C_IN = OFF_B_OUT + 1024ull * 1024;
constexpr size_t OFF_C_OUT = OFF_C_IN + 4096ull * 1024;
constexpr size_t OFF_C_WS = OFF_C_OUT + 1024ull * 2048;
constexpr size_t OFF_D_IN = OFF_C_WS + 8ull * 128 * 128;
constexpr size_t OFF_D_G = OFF_D_IN + 2048ull * 1024;
constexpr size_t OFF_D_OUT = OFF_D_G + 4ull * 512 * 256;
constexpr size_t W_TOTAL = OFF_D_OUT + 1024ull * 1024;
constexpr size_t MiB = 1024ull * 1024;
static_assert(W_TOTAL * 2 <= 112 * MiB, "weights region");
constexpr size_t WS_W = 0, WS_HN = 112 * MiB, WS_Z = 240 * MiB, WS_YP = 752 * MiB, WS_PB = 880 * MiB, WS_GATE = 912 * MiB, WS_LB = 916 * MiB, WS_BAR = 917 * MiB, WS_END = 918 * MiB;

struct Params {
    const float* in[31];
    float* out;
    unsigned char* ws;
    int ph_lo, ph_hi;
};
typedef const __attribute__((address_space(4))) Params* KP;
enum { I_X = 0, I_P, I_NG, I_WUP, I_WDN, I_PUP, I_PG, I_AIN, I_AIB, I_AFB, I_AHG, I_AOUT, I_BIN, I_BLB, I_BHG, I_BOUT, I_CIN, I_CLG, I_CLB, I_CSW, I_CSB, I_COUT,
       I_DIN, I_DCW, I_DCB, I_DWA, I_DBA, I_DWX, I_DBX, I_DLAM, I_DOUT };

__device__ __forceinline__ float bf2f(bf16_t b) { return __uint_as_float(((unsigned)b) << 16); }
__device__ __forceinline__ float bflo(unsigned u) { return __uint_as_float(u << 16); }
__device__ __forceinline__ float bfhi(unsigned u) { return __uint_as_float(u & 0xffff0000u); }
__device__ __forceinline__ unsigned pk2(float lo, float hi) { unsigned r; asm("v_cvt_pk_bf16_f32 %0, %1, %2" : "=v"(r) : "v"(lo), "v"(hi)); return r; }
__device__ __forceinline__ bf16_t f2bf(float f) { return (bf16_t)(pk2(f, 0.f) & 0xffffu); }
__device__ __forceinline__ float fast_rcp(float x) { return __builtin_amdgcn_rcpf(x); }
__device__ __forceinline__ float sigmoidf_(float x) { return fast_rcp(1.0f + __expf(-x)); }
__device__ __forceinline__ float gelu_tanh(float x) { const float t = 1.5957691216057308f * (x + 0.044715f * x * x * x); return x * fast_rcp(1.0f + __expf(-t)); }
__device__ __forceinline__ float wave_sum(float v) {
#pragma unroll
    for (int o = 32; o >= 1; o >>= 1) v += __shfl_xor(v, o);
    return v;
}
__device__ __forceinline__ bf16x8 as_bf16x8(u32x4 v) { union { u32x4 u; bf16x8 b; } x; x.u = v; return x.b; }
__device__ __forceinline__ u32x4 as_u32x4(bf16x8 v) { union { u32x4 u; bf16x8 b; } x; x.b = v; return x.u; }
__device__ __forceinline__ bf16x8 ldk(const LAS unsigned char* p) { return *(const LAS bf16x8*)p; }
__device__ __forceinline__ bf16x8 ldt(const LAS unsigned char* base, int pitch, int fr, int fq) {
    const LAS unsigned char* p = base + (fq * 8 + (fr >> 2)) * pitch + (fr & 3) * 8;
    s16x4 a = __builtin_amdgcn_ds_read_tr16_b64_v4i16((LAS s16x4*)p);
    s16x4 b = __builtin_amdgcn_ds_read_tr16_b64_v4i16((LAS s16x4*)(p + 4 * pitch));
    bf16x8 r = {a[0], a[1], a[2], a[3], b[0], b[1], b[2], b[3]};
    return r;
}
__device__ __forceinline__ int opaque_tid(int wv) { int l; asm volatile("v_mbcnt_lo_u32_b32 %0, -1, 0\n\tv_mbcnt_hi_u32_b32 %0, -1, %0" : "=v"(l)); return (wv << 6) | l; }
#define MFMA16(a, b, c) __builtin_amdgcn_mfma_f32_16x16x32_bf16((a), (b), (c), 0, 0, 0)


#define XB_TMO      128
#define XB_XCNT(j)  (256  + 64 * (j))
#define XB_XSUB(j)  (1280 + 64 * (j))
#define XB_XGEN(j)  (2304 + 64 * (j))
#define XB_TOP      3328
#define XB_TOPGEN   3392
#define XCD_BAR_WORDS 3456
#define XB_SPIN_CAP (1u << 20)
__device__ __forceinline__ unsigned xb_ld(unsigned* p)              { return __hip_atomic_load(p, __ATOMIC_RELAXED, __HIP_MEMORY_SCOPE_AGENT); }
__device__ __forceinline__ unsigned xb_add(unsigned* p, unsigned v) { return __hip_atomic_fetch_add(p, v, __ATOMIC_RELAXED, __HIP_MEMORY_SCOPE_AGENT); }
__device__ __forceinline__ unsigned xb_xcc_id() { return (unsigned)__builtin_amdgcn_s_getreg((3 << 11) | 20) & 0xFu; }
#define XB_SPIN(cond, bar) do { unsigned _sp = 0; while (cond) { __builtin_amdgcn_s_sleep(1); \
    if ((++_sp & 255u) == 0u) { if (xb_ld(&(bar)[XB_TMO])) break; if (_sp > XB_SPIN_CAP) { atomicAdd(&(bar)[XB_TMO], 1u); break; } } } } while (0)
struct XcdBarrier { unsigned* bar; unsigned x; volatile LAS unsigned* st; };
__device__ __forceinline__ bool xb_leader(int wv) { return wv == 0 && __builtin_amdgcn_mbcnt_hi(~0u, __builtin_amdgcn_mbcnt_lo(~0u, 0u)) == 0u; }
__device__ __forceinline__ XcdBarrier xcd_barrier_post(unsigned* bar, volatile LAS unsigned* st, int wv) {
    XcdBarrier b; b.bar = bar; b.x = xb_xcc_id(); b.st = st;
    if (xb_leader(wv)) (void)xb_add(&bar[XB_XCNT(b.x)], 1u);
    return b;
}
__device__ __forceinline__ void xcd_barrier_complete(unsigned* bar, unsigned x, unsigned& nloc, unsigned& nx) {
    const unsigned G = gridDim.x * gridDim.y * gridDim.z;
    unsigned sum, cnt, mine, sp = 0u;
    for (;;) {
        sum = 0u; cnt = 0u; mine = 0u;
#pragma unroll
        for (unsigned j = 0; j < 16; ++j) { const unsigned c = xb_ld(&bar[XB_XCNT(j)]); sum += c; cnt += (c > 0u) ? 1u : 0u; mine = (j == x) ? c : mine; }
        if (sum == G) break;
        __builtin_amdgcn_s_sleep(1);
        if ((++sp & 255u) == 0u) { if (xb_ld(&bar[XB_TMO])) break; if (sp > XB_SPIN_CAP) { atomicAdd(&bar[XB_TMO], 1u); break; } }
    }
    nloc = mine > 0u ? mine : 1u; nx = cnt > 0u ? cnt : 1u;
}
__device__ __forceinline__ void xcd_barrier(const XcdBarrier& b, int wv) {
    asm volatile("s_waitcnt vmcnt(0)" ::: "memory");
    __syncthreads();
    if (xb_leader(wv)) {
        unsigned* bar = b.bar;
        __builtin_amdgcn_s_waitcnt(0);
        unsigned nloc = b.st[0], nx = b.st[1];
        if (nloc == 0u) { xcd_barrier_complete(bar, b.x, nloc, nx); b.st[0] = nloc; b.st[1] = nx; }
        const unsigned old = xb_add(&bar[XB_XSUB(b.x)], 1u);
        const unsigned gen = old / nloc;
        if (old + 1u == (gen + 1u) * nloc) {
            __builtin_amdgcn_fence(__ATOMIC_RELEASE, "agent");
            asm volatile("s_waitcnt vmcnt(0)" ::: "memory");
            const unsigned og = xb_add(&bar[XB_TOP], 1u);
            const unsigned tg = og / nx;
            if (og + 1u == (tg + 1u) * nx) xb_add(&bar[XB_TOPGEN], 1u);
            else XB_SPIN(xb_ld(&bar[XB_TOPGEN]) == tg, bar);
            __builtin_amdgcn_fence(__ATOMIC_ACQUIRE, "agent");
            xb_add(&bar[XB_XGEN(b.x)], 1u);
            asm volatile("s_waitcnt vmcnt(0)" ::: "memory");
        } else {
            XB_SPIN(xb_ld(&bar[XB_XGEN(b.x)]) == gen, bar);
            __builtin_amdgcn_fence(__ATOMIC_ACQUIRE, "agent");
            asm volatile("s_waitcnt vmcnt(0)" ::: "memory");
        }
    }
    __syncthreads();
}

namespace pg8 {
constexpr int BM = 256, BK = 64, HALF = 128, HTB = HALF * BK * 2, STAGE_BYTES = 8 * HTB, NXCD = 8, WGM = 8;
__device__ __forceinline__ int lds_byte(int r, int c) { const int st = (r >> 4) * 2 + (c >> 5), rr = r & 15, cc = c & 31, ob = rr * 64 + cc * 2; return st * 1024 + (ob ^ (((ob >> 9) & 1) << 5)); }
__device__ __forceinline__ void stage_rc(int b, int& R, int& C) { const int st = b / 1024, sb = b % 1024, swz = sb ^ (((sb >> 9) & 1) << 5); R = (st >> 1) * 16 + swz / 64; C = (st & 1) * 32 + (swz % 64) / 2; }
__device__ __forceinline__ int perm32(int rho) { const int n = rho >> 4, i = rho & 15; return 8 * (i >> 2) + 4 * n + (i & 3); }
struct Unit { int pm, pn; };
struct Gemm { const bf16_t* A; const bf16_t* Bt; int M, N, K, lda, ldb; };
struct StaticOrder {
    int nM, nN, nwg, G, c;
    __device__ void init(int M, int N, int G_, int c_) { nM = M / BM; nN = N / BM; nwg = nM * nN; G = G_; c = c_; }
    __device__ bool next(int i, Unit& u) const {
        const long L = (long)i * G + c; if (L >= nwg) return false;
        int wgid = (int)L; { const int q = nwg / NXCD, r = nwg % NXCD, xcd = wgid % NXCD, off = wgid / NXCD; wgid = (xcd < r ? xcd * (q + 1) : r * (q + 1) + (xcd - r) * q) + off; }
        const int nig = WGM * nN, gid = wgid / nig, fm = gid * WGM, gsz = (nM - fm) < WGM ? (nM - fm) : WGM;
        u.pm = fm + ((wgid % nig) % gsz); u.pn = (wgid % nig) / gsz; return true;
    }
};
template <class Epi>
__device__ __forceinline__ void gemm_phase(LAS unsigned char* lds, const Gemm g, const StaticOrder& S, const Epi& E, int wv) {
    const int tid = opaque_tid(wv), wid = __builtin_amdgcn_readfirstlane(tid >> 6), lane = tid & 63, wr = wid >> 2, wc = wid & 3, fr = lane & 15, fq = lane >> 4;
    const int K = g.K, nt = K / BK;
    unsigned voffA[2], voffB[2];
#pragma unroll
    for (int i = 0; i < 2; ++i) { int R, C; stage_rc(tid * 16 + i * 8192, R, C); const int Rb = (R & ~31) + perm32(R & 31);
        voffA[i] = (unsigned)(R * g.lda + C) * 2u; voffB[i] = (unsigned)(Rb * g.ldb + C) * 2u; }
    const size_t kstep = (size_t)(BK * 2);
    const size_t hstepA = (size_t)HALF * g.lda * 2, hstepB = (size_t)HALF * g.ldb * 2;
    const size_t tstepA = 2 * hstepA, tstepB = 2 * hstepB;
    const unsigned ldsw = (unsigned)wid * 1024u;
    const int aoff = lds_byte(wr * 64 + fr, fq * 8), boff = lds_byte(wc * 32 + fr, fq * 8);
#define PG8_SA(b, h) (((b) * 2 + (h)) * HTB)
#define PG8_SB(b, h) ((4 + (b) * 2 + (h)) * HTB)
#define PG8_STAGE(bufoff, gbase, voff) do { _Pragma("unroll") for (int _i = 0; _i < 2; ++_i) \
        __builtin_amdgcn_global_load_lds((const unsigned*)((const char*)(gbase) + (voff)[_i]), (LAS unsigned*)(lds + (bufoff) + ldsw + _i * 8192), 16, 0, 0); } while (0)
#define PG8_LDA(dst, b, h) do { _Pragma("unroll") for (int m = 0; m < 4; ++m) _Pragma("unroll") for (int k = 0; k < 2; ++k) dst[m][k] = *(const LAS bf16x8*)(lds + PG8_SA(b, h) + aoff + m * 2048 + k * 1024); } while (0)
#define PG8_LDB(dst, b, h) do { _Pragma("unroll") for (int n = 0; n < 2; ++n) _Pragma("unroll") for (int k = 0; k < 2; ++k) dst[n][k] = *(const LAS bf16x8*)(lds + PG8_SB(b, h) + boff + n * 2048 + k * 1024); } while (0)
#define PG8_MMA(ai, bj, At, Bt) do { __builtin_amdgcn_s_setprio(1); _Pragma("unroll") for (int m = 0; m < 4; ++m) _Pragma("unroll") for (int n = 0; n < 2; ++n) _Pragma("unroll") for (int k = 0; k < 2; ++k) \
        acc[ai][bj][m][n] = __builtin_amdgcn_mfma_f32_16x16x32_bf16(Bt[n][k], At[m][k], acc[ai][bj][m][n], 0, 0, 0); __builtin_amdgcn_s_setprio(0); } while (0)
#define PG8_WAIT_V(n) asm volatile("s_waitcnt vmcnt(" #n ")" ::: "memory")
#define PG8_WAIT_L(n) asm volatile("s_waitcnt lgkmcnt(" #n ")" ::: "memory")
#define PG8_BAR __builtin_amdgcn_s_barrier()
#define PG8_SCHED __builtin_amdgcn_sched_barrier(0)
    Unit cur, nxt; int ui = 0;
    if (!S.next(0, cur)) return;
    f32x4 acc[2][2][4][2];
#pragma unroll
    for (int a = 0; a < 2; ++a)
#pragma unroll
        for (int b = 0; b < 2; ++b)
#pragma unroll
            for (int m = 0; m < 4; ++m)
#pragma unroll
                for (int n = 0; n < 2; ++n) acc[a][b][m][n] = (f32x4){0.f, 0.f, 0.f, 0.f};
    bf16x8 At[4][2], B0[2][2], B1[2][2];
    const char* cA = (const char*)g.A + (size_t)cur.pm * tstepA; const char* cB = (const char*)g.Bt + (size_t)cur.pn * tstepB;
    PG8_STAGE(PG8_SB(0, 0), cB, voffB); PG8_STAGE(PG8_SA(0, 0), cA, voffA); PG8_STAGE(PG8_SB(0, 1), cB + hstepB, voffB); PG8_STAGE(PG8_SA(0, 1), cA + hstepA, voffA);
    if (wr == 1) PG8_BAR;
    PG8_WAIT_V(4); PG8_BAR;
    PG8_STAGE(PG8_SB(1, 0), cB + kstep, voffB); PG8_STAGE(PG8_SA(1, 0), cA + kstep, voffA); PG8_STAGE(PG8_SB(1, 1), cB + hstepB + kstep, voffB);
    PG8_WAIT_V(6); PG8_BAR;
    for (;;) {
        const bool has_next = S.next(ui + 1, nxt);
        const char* nA = has_next ? (const char*)g.A + (size_t)nxt.pm * tstepA : cA; const char* nB = has_next ? (const char*)g.Bt + (size_t)nxt.pn * tstepB : cB;
        for (int t = 0; t < nt; t += 2) {
            const bool last = (t == nt - 2);
            const char* a1 = cA + (size_t)(t + 1) * kstep;
            const char* a2 = last ? nA : cA + (size_t)(t + 2) * kstep; const char* b2 = last ? nB : cB + (size_t)(t + 2) * kstep;
            const char* a3 = a2 + kstep; const char* b3 = b2 + kstep;
            PG8_LDB(B0, 0, 0); PG8_SCHED; PG8_LDA(At, 0, 0); PG8_STAGE(PG8_SA(1, 1), a1 + hstepA, voffA);
            PG8_WAIT_L(8); PG8_BAR; PG8_WAIT_L(0); PG8_MMA(0, 0, At, B0); PG8_BAR; PG8_SCHED;
            PG8_LDB(B1, 0, 1); PG8_STAGE(PG8_SB(0, 0), b2, voffB);
            PG8_BAR; PG8_WAIT_L(0); PG8_MMA(0, 1, At, B1); PG8_BAR;
            PG8_LDA(At, 0, 1); PG8_STAGE(PG8_SA(0, 0), a2, voffA);
            PG8_BAR; PG8_WAIT_L(0); PG8_MMA(1, 0, At, B0); PG8_BAR; PG8_SCHED;
            PG8_STAGE(PG8_SB(0, 1), b2 + hstepB, voffB);
            PG8_WAIT_V(6); PG8_BAR; PG8_MMA(1, 1, At, B1); PG8_BAR;
            PG8_LDB(B0, 1, 0); PG8_SCHED; PG8_LDA(At, 1, 0); PG8_STAGE(PG8_SA(0, 1), a2 + hstepA, voffA);
            PG8_WAIT_L(8); PG8_BAR; PG8_WAIT_L(0); PG8_MMA(0, 0, At, B0); PG8_BAR; PG8_SCHED;
            PG8_LDB(B1, 1, 1); PG8_STAGE(PG8_SB(1, 0), b3, voffB);
            PG8_BAR; PG8_WAIT_L(0); PG8_MMA(0, 1, At, B1); PG8_BAR;
            PG8_LDA(At, 1, 1); PG8_STAGE(PG8_SA(1, 0), a3, voffA);
            PG8_BAR; PG8_WAIT_L(0); PG8_MMA(1, 0, At, B0); PG8_BAR; PG8_SCHED;
            PG8_STAGE(PG8_SB(1, 1), b3 + hstepB, voffB);
            PG8_WAIT_V(6); PG8_BAR; PG8_MMA(1, 1, At, B1); PG8_BAR;
        }
        E(acc, cur, wr, wc, fr, fq);
        if (!has_next) break;
#pragma unroll
        for (int a = 0; a < 2; ++a)
#pragma unroll
            for (int b = 0; b < 2; ++b)
#pragma unroll
                for (int m = 0; m < 4; ++m)
#pragma unroll
                    for (int n = 0; n < 2; ++n) acc[a][b][m][n] = (f32x4){0.f, 0.f, 0.f, 0.f};
        cur = nxt; cA = nA; cB = nB; ++ui;
    }
    PG8_WAIT_V(0);
    if (wr == 0) PG8_BAR;
    PG8_BAR;
#undef PG8_SA
#undef PG8_SB
#undef PG8_STAGE
#undef PG8_LDA
#undef PG8_LDB
#undef PG8_MMA
#undef PG8_WAIT_V
#undef PG8_WAIT_L
#undef PG8_BAR
#undef PG8_SCHED
}
}

struct EpiGen {
    bf16_t* O; int ldc; int act;
    float* gate; int gate_pn;
    __device__ __forceinline__ void operator()(const f32x4 (&acc)[2][2][4][2], const pg8::Unit& u, int wr, int wc, int fr_, int fq_) const {
        int fr = fr_, fq = fq_; asm volatile("" : "+v"(fr), "+v"(fq));
        const int row0 = u.pm * 256 + wr * 64 + fr;
        if (act == 3) {
            const int col0 = u.pn * 256 + wc * 32 + 8 * fq;
#pragma unroll
            for (int q = 0; q < 4; ++q) { const int ai = q >> 1; u32x4 pv[2][2];
#pragma unroll
                for (int mm = 0; mm < 2; ++mm)
#pragma unroll
                    for (int bj = 0; bj < 2; ++bj) pv[mm][bj] = *(const u32x4*)(O + (size_t)(row0 + ai * 128 + ((q & 1) * 2 + mm) * 16) * ldc + col0 + bj * 128);
#pragma unroll
                for (int mm = 0; mm < 2; ++mm)
#pragma unroll
                    for (int bj = 0; bj < 2; ++bj) { const int m = (q & 1) * 2 + mm; const f32x4 v0 = acc[ai][bj][m][0], v1 = acc[ai][bj][m][1]; const u32x4 pu = pv[mm][bj]; u32x4 w;
                        w.x = pk2(sigmoidf_(v0[0]) * bflo(pu.x), sigmoidf_(v0[1]) * bfhi(pu.x)); w.y = pk2(sigmoidf_(v0[2]) * bflo(pu.y), sigmoidf_(v0[3]) * bfhi(pu.y));
                        w.z = pk2(sigmoidf_(v1[0]) * bflo(pu.z), sigmoidf_(v1[1]) * bfhi(pu.z)); w.w = pk2(sigmoidf_(v1[2]) * bflo(pu.w), sigmoidf_(v1[3]) * bfhi(pu.w));
                        *(u32x4*)(O + (size_t)(row0 + ai * 128 + m * 16) * ldc + col0 + bj * 128) = w; }
                asm volatile("" ::: "memory"); }
            return;
        }
        if (u.pn == gate_pn) {
            if (wc == 0 && fq < 2) {
#pragma unroll
                for (int ai = 0; ai < 2; ++ai)
#pragma unroll
                    for (int m = 0; m < 4; ++m) { float* gp = gate + (size_t)(row0 + ai * 128 + m * 16) * 16 + 8 * fq;
                        *(f32x4*)gp = acc[ai][0][m][0]; *(f32x4*)(gp + 4) = acc[ai][0][m][1]; }
            }
            return;
        }
        const int col0 = u.pn * 256 + wc * 32 + 8 * fq;
#pragma unroll
        for (int ai = 0; ai < 2; ++ai)
#pragma unroll
            for (int m = 0; m < 4; ++m) { bf16_t* rowp = O + (size_t)(row0 + ai * 128 + m * 16) * ldc + col0;
#pragma unroll
                for (int bj = 0; bj < 2; ++bj) { f32x4 v0 = acc[ai][bj][m][0], v1 = acc[ai][bj][m][1];
                    if (act == 1) {
#pragma unroll
                        for (int j = 0; j < 4; ++j) { v0[j] = gelu_tanh(v0[j]); v1[j] = gelu_tanh(v1[j]); }
                    } else if (act == 2) {
#pragma unroll
                        for (int j = 0; j < 4; ++j) { const float a = fmaxf(v0[j], 0.f), b = fmaxf(v1[j], 0.f); v0[j] = a * a; v1[j] = b * b; }
                    } else if (act == 3) {
                        const u32x4 pu = *(const u32x4*)(rowp + bj * 128);
                        v0[0] = sigmoidf_(v0[0]) * bflo(pu.x); v0[1] = sigmoidf_(v0[1]) * bfhi(pu.x); v0[2] = sigmoidf_(v0[2]) * bflo(pu.y); v0[3] = sigmoidf_(v0[3]) * bfhi(pu.y);
                        v1[0] = sigmoidf_(v1[0]) * bflo(pu.z); v1[1] = sigmoidf_(v1[1]) * bfhi(pu.z); v1[2] = sigmoidf_(v1[2]) * bflo(pu.w); v1[3] = sigmoidf_(v1[3]) * bfhi(pu.w);
                    }
                    u32x4 w; w.x = pk2(v0[0], v0[1]); w.y = pk2(v0[2], v0[3]); w.z = pk2(v1[0], v1[1]); w.w = pk2(v1[2], v1[3]);
                    *(u32x4*)(rowp + bj * 128) = w; }
                asm volatile("" ::: "memory"); }
    }
};
struct EpiRg {
    const bf16_t* xc; bf16_t* loga; bf16_t* beta; const float* b_a; const float* b_x; const float* spt; int blk;
    __device__ __forceinline__ void operator()(const f32x4 (&acc)[2][2][4][2], const pg8::Unit& u, int wr, int wc, int fr_, int fq_) const {
        int fr = fr_, fq = fq_; asm volatile("" : "+v"(fr), "+v"(fq));
        const int row0 = u.pm * 256 + wr * 64 + fr;
        const int ch0 = blk * 256 + u.pn * 128 + wc * 32 + 8 * fq;
#pragma unroll
        for (int q = 0; q < 4; ++q) { const int ai = q >> 1; u32x4 xq[2];
#pragma unroll
            for (int mm = 0; mm < 2; ++mm) xq[mm] = *(const u32x4*)(xc + (size_t)(row0 + ai * 128 + ((q & 1) * 2 + mm) * 16) * 1024 + ch0);
            f32x4 ba[2], bx[2], sp[2];
#pragma unroll
            for (int hh = 0; hh < 2; ++hh) { ba[hh] = *(const f32x4*)(b_a + ch0 + hh * 4); bx[hh] = *(const f32x4*)(b_x + ch0 + hh * 4); sp[hh] = *(const f32x4*)(spt + ch0 + hh * 4); }
#pragma unroll
            for (int mm = 0; mm < 2; ++mm) { const int m = (q & 1) * 2 + mm; const size_t off = (size_t)(row0 + ai * 128 + m * 16) * 1024 + ch0; const u32x4 xv = xq[mm];
                u32x4 wl, wb;
#pragma unroll
                for (int hh = 0; hh < 2; ++hh) {
                    const unsigned x01 = hh ? xv.z : xv.x, x23 = hh ? xv.w : xv.y;
                    const float x[4] = {bflo(x01), bfhi(x01), bflo(x23), bfhi(x23)};
                    float la[4], be[4];
#pragma unroll
                    for (int e = 0; e < 4; ++e) { const float rp = acc[ai][0][m][hh][e] + ba[hh][e], ip = acc[ai][1][m][hh][e] + bx[hh][e];
                        const float r = sigmoidf_(rp), ig = sigmoidf_(ip); const float l = sp[hh][e] * r; la[e] = l;
                        be[e] = __builtin_amdgcn_sqrtf(fmaxf(1.0f - __expf(2.0f * l), 0.f)) * ig * x[e]; }
                    if (hh == 0) { wl.x = pk2(la[0], la[1]); wl.y = pk2(la[2], la[3]); wb.x = pk2(be[0], be[1]); wb.y = pk2(be[2], be[3]); }
                    else { wl.z = pk2(la[0], la[1]); wl.w = pk2(la[2], la[3]); wb.z = pk2(be[0], be[1]); wb.w = pk2(be[2], be[3]); }
                }
                *(u32x4*)(loga + off) = wl; *(u32x4*)(beta + off) = wb; }
            asm volatile("" ::: "memory"); }
    }
};

__device__ __forceinline__ void rowpass(const float* hin, const bf16_t* hinb, const bf16_t* y, const float* gadd, float* hout, bf16_t* houtb, const float* gnext, bf16_t* hn, int normnext,
                                        const float* psrc, bf16_t* pdst, const float* rs_in, const float* g_in, float* rs_out, int wv) {
    const int tid_ = opaque_tid(wv); const int lane = tid_ & 63, wave = tid_ >> 6;
    const int gw = blockIdx.x * 8 + wave, nw = gridDim.x * 8;
    f32x4 ga[4], gn[4], gi[4];
#pragma unroll
    for (int q = 0; q < 4; ++q) { gi[q] = (f32x4){1.f, 1.f, 1.f, 1.f}; if (rs_in) { const f32x4 t = *(const f32x4*)(g_in + q * 256 + lane * 4); gi[q] = (f32x4){fast_rcp(t[0]), fast_rcp(t[1]), fast_rcp(t[2]), fast_rcp(t[3])}; } }
#pragma unroll
    for (int q = 0; q < 4; ++q) { ga[q] = y ? *(const f32x4*)(gadd + q * 256 + lane * 4) : (f32x4){0.f, 0.f, 0.f, 0.f}; gn[q] = (hn && normnext) ? *(const f32x4*)(gnext + q * 256 + lane * 4) : (f32x4){1.f, 1.f, 1.f, 1.f}; }
    for (int row0_ = 4 * gw; row0_ < MTOK; row0_ += 4 * nw) {
        f32x4 h[4][4]; u32x2 yv[4][4]; f32x4 pv[4]; float rsi[4];
#pragma unroll
        for (int u = 0; u < 4; ++u) { const int row = row0_ + u; rsi[u] = 1.0f; if (row < MTOK) { const size_t base = (size_t)row * DM + lane * 4;
            if (rs_in) rsi[u] = rs_in[row];
            if (hin) {
#pragma unroll
                for (int q = 0; q < 4; ++q) h[u][q] = __builtin_nontemporal_load((const f32x4*)(hin + base + q * 256));
            } else {
#pragma unroll
                for (int q = 0; q < 4; ++q) { const u32x2 hv = __builtin_nontemporal_load((const u32x2*)(hinb + base + q * 256)); h[u][q] = (f32x4){bflo(hv.x), bfhi(hv.x), bflo(hv.y), bfhi(hv.y)}; }
            }
            if (y) {
#pragma unroll
                for (int q = 0; q < 4; ++q) yv[u][q] = __builtin_nontemporal_load((const u32x2*)(y + base + q * 256));
            }
            if (psrc) pv[u] = __builtin_nontemporal_load((const f32x4*)(psrc + (size_t)row * 256 + lane * 4)); } }
#pragma unroll
        for (int u = 0; u < 4; ++u) { const int row = row0_ + u; if (row < MTOK) { const size_t base = (size_t)row * DM + lane * 4;
            if (rs_in) { const float ir = fast_rcp(rsi[u]);
#pragma unroll
                for (int q = 0; q < 4; ++q) h[u][q] = h[u][q] * ir * gi[q]; }
            if (y) {
                f32x4 yf[4]; float ss = 0.f;
#pragma unroll
                for (int q = 0; q < 4; ++q) { yf[q] = (f32x4){bflo(yv[u][q].x), bfhi(yv[u][q].x), bflo(yv[u][q].y), bfhi(yv[u][q].y)}; ss += yf[q][0] * yf[q][0] + yf[q][1] * yf[q][1] + yf[q][2] * yf[q][2] + yf[q][3] * yf[q][3]; }
                ss = wave_sum(ss);
                const float rs = __builtin_amdgcn_rsqf(ss * (1.0f / DM) + EPS);
#pragma unroll
                for (int q = 0; q < 4; ++q) h[u][q] = h[u][q] + yf[q] * rs * ga[q];
            }
            if (hout) {
#pragma unroll
                for (int q = 0; q < 4; ++q) __builtin_nontemporal_store(h[u][q], (f32x4*)(hout + base + q * 256));
            }
            if (houtb) {
#pragma unroll
                for (int q = 0; q < 4; ++q) { u32x2 w; w.x = pk2(h[u][q][0], h[u][q][1]); w.y = pk2(h[u][q][2], h[u][q][3]); __builtin_nontemporal_store(w, (u32x2*)(houtb + base + q * 256)); }
            }
            if (hn) {
                float rs2 = 1.0f;
                if (normnext) { float ss = 0.f;
#pragma unroll
                    for (int q = 0; q < 4; ++q) ss += h[u][q][0] * h[u][q][0] + h[u][q][1] * h[u][q][1] + h[u][q][2] * h[u][q][2] + h[u][q][3] * h[u][q][3];
                    ss = wave_sum(ss); rs2 = __builtin_amdgcn_rsqf(ss * (1.0f / DM) + EPS); if (rs_out && lane == 0) rs_out[row] = rs2; }
#pragma unroll
                for (int q = 0; q < 4; ++q) { const f32x4 o = h[u][q] * rs2 * gn[q]; u32x2 w; w.x = pk2(o[0], o[1]); w.y = pk2(o[2], o[3]); __builtin_nontemporal_store(w, (u32x2*)(hn + base + q * 256)); }
            }
            if (psrc) { u32x2 w; w.x = pk2(pv[u][0], pv[u][1]); w.y = pk2(pv[u][2], pv[u][3]); __builtin_nontemporal_store(w, (u32x2*)(pdst + (size_t)row * 256 + lane * 4)); } } }
    }
}

struct TJob { const float* src; bf16_t* dst; int lds, ldd, K, nvalid, ntn, t0; };
__device__ __forceinline__ TJob make_tjob(KP P, int j) {
    TJob t; bf16_t* W = (bf16_t*)(P->ws + WS_W); int npad;
    if (j < 16) { const int i = j >> 2, k = j & 3; bf16_t* L = W + (size_t)i * LW;
        if (k == 0) { t.src = P->in[I_WUP] + (size_t)i * 1024 * 4096; t.lds = 4096; t.K = 1024; t.nvalid = 4096; t.dst = L; }
        else if (k == 1) { t.src = P->in[I_WDN] + (size_t)i * 4096 * 1024; t.lds = 1024; t.K = 4096; t.nvalid = 1024; t.dst = L + W_UP; }
        else if (k == 2) { t.src = P->in[I_PG] + (size_t)i * 1024 * 1024; t.lds = 1024; t.K = 1024; t.nvalid = 1024; t.dst = L + W_UP + W_DN; }
        else { t.src = P->in[I_PUP] + (size_t)i * 256 * 1024; t.lds = 1024; t.K = 256; t.nvalid = 1024; t.dst = L + W_UP + W_DN + W_G; }
        npad = t.nvalid; }
    else if (j == 16) { t.src = P->in[I_AIN]; t.lds = 3088; t.K = 1024; t.nvalid = 3088; npad = 3328; t.dst = W + OFF_A_IN; }
    else if (j == 17) { t.src = P->in[I_AOUT]; t.lds = 1024; t.K = 1024; t.nvalid = 1024; npad = 1024; t.dst = W + OFF_A_OUT; }
    else if (j == 18) { t.src = P->in[I_BIN]; t.lds = 4096; t.K = 1024; t.nvalid = 4096; npad = 4096; t.dst = W + OFF_B_IN; }
    else if (j == 19) { t.src = P->in[I_BOUT]; t.lds = 1024; t.K = 1024; t.nvalid = 1024; npad = 1024; t.dst = W + OFF_B_OUT; }
    else if (j == 20) { t.src = P->in[I_CIN]; t.lds = 4096; t.K = 1024; t.nvalid = 4096; npad = 4096; t.dst = W + OFF_C_IN; }
    else if (j == 21) { t.src = P->in[I_COUT]; t.lds = 1024; t.K = 2048; t.nvalid = 1024; npad = 1024; t.dst = W + OFF_C_OUT; }
    else if (j == 22) { t.src = P->in[I_DIN]; t.lds = 2048; t.K = 1024; t.nvalid = 2048; npad = 2048; t.dst = W + OFF_D_IN; }
    else if (j == 23) { t.src = P->in[I_DOUT]; t.lds = 1024; t.K = 1024; t.nvalid = 1024; npad = 1024; t.dst = W + OFF_D_OUT; }
    else { const int q = j - 24, blk = q >> 2, pn = (q >> 1) & 1, which = q & 1;
        t.src = (which ? P->in[I_DWX] : P->in[I_DWA]) + (size_t)blk * 65536 + pn * 128; t.lds = 256; t.K = 256; t.nvalid = 128; npad = 128;
        t.dst = W + OFF_D_G + (size_t)blk * 512 * 256 + (size_t)(pn * 256 + which * 128) * 256; }
    t.ldd = t.K; t.ntn = npad / 64; t.t0 = (t.K / 64) * t.ntn;
    return t;
}
constexpr int NTJOBS = 40;
__device__ __forceinline__ void prep_phase(KP P, LAS unsigned char* lds, int wv) {
    const int tid = opaque_tid(wv);
    LAS int* tstart = (LAS int*)(lds + 32768);
    LAS float* tile = (LAS float*)lds;
    if (tid == 0) { int s = 0; for (int j = 0; j < NTJOBS; ++j) { tstart[j] = s; s += make_tjob(P, j).t0; } tstart[NTJOBS] = s; }
    __syncthreads();
    const int total = tstart[NTJOBS];
    for (int gt = blockIdx.x; gt < total; gt += gridDim.x) {
        int j = 0; while (tstart[j + 1] <= gt) ++j;
        const TJob t = make_tjob(P, j);
        const int lt = gt - tstart[j]; const int kt = lt / t.ntn, ntile = lt - kt * t.ntn; const int k0 = kt * 64, n0 = ntile * 64;
        { const int kk = tid >> 4, nn = (tid & 15) * 4;
#pragma unroll
            for (int i = 0; i < 2; ++i) { const int k = kk + 32 * i; f32x4 v = (f32x4){0.f, 0.f, 0.f, 0.f};
                if (n0 + nn < t.nvalid) v = *(const f32x4*)(t.src + (size_t)(k0 + k) * t.lds + n0 + nn);
                tile[k * 65 + nn] = v[0]; tile[k * 65 + nn + 1] = v[1]; tile[k * 65 + nn + 2] = v[2]; tile[k * 65 + nn + 3] = v[3]; } }
        __syncthreads();
        { const int n = tid >> 3, k8 = (tid & 7) * 8; float v[8];
#pragma unroll
            for (int e = 0; e < 8; ++e) v[e] = tile[(k8 + e) * 65 + n];
            u32x4 w; w.x = pk2(v[0], v[1]); w.y = pk2(v[2], v[3]); w.z = pk2(v[4], v[5]); w.w = pk2(v[6], v[7]);
            *(u32x4*)(t.dst + (size_t)(n0 + n) * t.ldd + k0 + k8) = w; }
        __syncthreads();
    }
    { bf16_t* Wsb = (bf16_t*)(P->ws + WS_W) + OFF_C_WS; const float* sw = P->in[I_CSW];
        for (int i = blockIdx.x * NTHREADS + tid; i < 8 * 128 * 128; i += gridDim.x * NTHREADS) { const int s = i & 127, t = (i >> 7) & 127; Wsb[i] = f2bf(s <= t ? sw[i] : 0.f); } }
    if (blockIdx.x == 0) { float* lb = (float*)(P->ws + WS_LB); const float* s = P->in[I_BLB];
        for (int c = tid; c < 1024; c += NTHREADS) { const float a0 = s[c], a1 = s[1024 + c], a2 = s[2048 + c], a3 = s[3072 + c]; const float mx = fmaxf(fmaxf(a0, a1), fmaxf(a2, a3));
            const float e0 = __expf(a0 - mx), e1 = __expf(a1 - mx), e2 = __expf(a2 - mx), e3 = __expf(a3 - mx); lb[c] = e1 * fast_rcp(e0 + e1 + e2 + e3);
            lb[1024 + c] = -8.0f * __logf(1.0f + __expf(-P->in[I_DLAM][c])); } }
    rowpass(P->in[I_X], nullptr, nullptr, nullptr, nullptr, nullptr, P->in[I_NG], (bf16_t*)(P->ws + WS_HN), 1, nullptr, nullptr, nullptr, nullptr, (float*)(P->ws + WS_LB + 512 * 1024), wv);
}

__device__ __forceinline__ float incl_scan_sum(float v, int lane) {
#pragma unroll
    for (int d = 1; d < 64; d <<= 1) { const float t = __shfl_up(v, d); if (lane >= d) v += t; }
    return v;
}
__device__ __forceinline__ float incl_scan_max(float v, int lane) {
#pragma unroll
    for (int d = 1; d < 64; d <<= 1) { const float t = __shfl_up(v, d); if (lane >= d) v = fmaxf(v, t); }
    return v;
}
#define LDS_BARRIER() do { asm volatile("s_waitcnt lgkmcnt(0)" ::: "memory"); __builtin_amdgcn_s_barrier(); asm volatile("" ::: "memory"); } while (0)
__device__ __forceinline__ void mlstm_core(KP P, LAS unsigned char* lds, int wv) {
    const int tid = opaque_tid(wv), w = __builtin_amdgcn_readfirstlane(tid >> 6), lane = tid & 63, fr = lane & 15, fq = lane >> 4;
    const bf16_t* z = (const bf16_t*)(P->ws + WS_Z); const float* gate = (const float*)(P->ws + WS_GATE); bf16_t* yout = (bf16_t*)(P->ws + WS_YP);
    constexpr int PQ = 160, PV = 320, PP = 288, PC = 160;
    LAS unsigned char* Qs = lds; LAS unsigned char* Ks = lds + 20480; LAS unsigned char* Vs = lds + 40960; LAS unsigned char* Ps = lds + 81920; LAS unsigned char* Cb = lds + 118784;
    LAS float* fa = (LAS float*)(lds + 141824); LAS float* fM = fa + 128; LAS float* fb = fa + 256; LAS float* fwk = fa + 384;
    for (int unit = blockIdx.x; unit < 256; unit += gridDim.x) {
        const int b = unit >> 3, h = unit & 7;
        const float ib = P->in[I_AIB][h], fbias = P->in[I_AFB][h];
        __syncthreads();
        for (int i = tid; i < 144 * 80 / 2; i += NTHREADS) ((LAS unsigned*)Cb)[i] = 0u;
        if (tid < 128) { LAS unsigned* vp = (LAS unsigned*)(Vs + tid * PV + 256); unsigned zz, one; asm volatile("v_mov_b32 %0, 0" : "=v"(zz)); asm volatile("v_mov_b32 %0, 0x3f80" : "=v"(one)); vp[0] = one;
#pragma unroll
            for (int i = 1; i < 16; ++i) vp[i] = zz; }
        f32x4 st[5];
#pragma unroll
        for (int i = 0; i < 5; ++i) st[i] = (f32x4){0.f, 0.f, 0.f, 0.f};
        float m_state = 0.f;
        u32x4 nq[2], nk[2], nv[4]; float nig = 0.f, nfg = 0.f;
        { const size_t r0 = (size_t)b * SEQL;
#pragma unroll
            for (int i = 0; i < 2; ++i) { const int idx = tid + i * 512, row = idx >> 3, pc = idx & 7;
                nq[i] = *(const u32x4*)(z + (r0 + row) * 3072 + h * 64 + pc * 8); nk[i] = *(const u32x4*)(z + (r0 + row) * 3072 + 512 + h * 64 + pc * 8); }
#pragma unroll
            for (int i = 0; i < 4; ++i) { const int idx = tid + i * 512, row = idx >> 4, pc = idx & 15; nv[i] = *(const u32x4*)(z + (r0 + row) * 3072 + 1024 + h * 128 + pc * 8); }
            if (tid < 128) { nig = gate[(r0 + tid) * 16 + h]; nfg = gate[(r0 + tid) * 16 + 8 + h]; } }
        for (int chunk = 0; chunk < 16; ++chunk) {
            const size_t r0 = (size_t)b * SEQL + chunk * 128;
#pragma unroll
            for (int i = 0; i < 2; ++i) { const int idx = tid + i * 512, row = idx >> 3, pc = idx & 7;
                u32x4 q = nq[i];
                q.x = pk2(bflo(q.x) * 0.125f, bfhi(q.x) * 0.125f); q.y = pk2(bflo(q.y) * 0.125f, bfhi(q.y) * 0.125f); q.z = pk2(bflo(q.z) * 0.125f, bfhi(q.z) * 0.125f); q.w = pk2(bflo(q.w) * 0.125f, bfhi(q.w) * 0.125f);
                *(LAS u32x4*)(Qs + row * PQ + pc * 16) = q;
                *(LAS u32x4*)(Ks + row * PQ + pc * 16) = nk[i]; }
#pragma unroll
            for (int i = 0; i < 4; ++i) { const int idx = tid + i * 512, row = idx >> 4, pc = idx & 15;
                *(LAS u32x4*)(Vs + row * PV + pc * 16) = nv[i]; }
            if (tid < 128) { const float ig = nig, fg = nfg;
                const float xf = fg + fbias; const float lf = fminf(xf, 0.f) - __logf(1.0f + __expf(-fabsf(xf)));
                fa[tid] = ig + ib; fb[tid] = lf; }
            if (chunk + 1 < 16) { const size_t r1 = r0 + 128;
#pragma unroll
                for (int i = 0; i < 2; ++i) { const int idx = tid + i * 512, row = idx >> 3, pc = idx & 7;
                    nq[i] = *(const u32x4*)(z + (r1 + row) * 3072 + h * 64 + pc * 8); nk[i] = *(const u32x4*)(z + (r1 + row) * 3072 + 512 + h * 64 + pc * 8); }
#pragma unroll
                for (int i = 0; i < 4; ++i) { const int idx = tid + i * 512, row = idx >> 4, pc = idx & 15; nv[i] = *(const u32x4*)(z + (r1 + row) * 3072 + 1024 + h * 128 + pc * 8); }
                if (tid < 128) { nig = gate[(r1 + tid) * 16 + h]; nfg = gate[(r1 + tid) * 16 + 8 + h]; } }
            LDS_BARRIER();
            if (w == 0) {
                const float lf0 = fb[lane], lf1 = fb[64 + lane], li0 = fa[lane], li1 = fa[64 + lane];
                const float c0 = incl_scan_sum(lf0, lane); const float tot0 = __int_as_float(__builtin_amdgcn_readlane(__float_as_int(c0), 63)); const float c1 = incl_scan_sum(lf1, lane) + tot0;
                const float a0 = li0 - c0, a1 = li1 - c1;
                const float p0 = incl_scan_max(a0, lane); const float pt = __int_as_float(__builtin_amdgcn_readlane(__float_as_int(p0), 63)); const float p1 = fmaxf(incl_scan_max(a1, lane), pt);
                const float M0 = fmaxf(m_state, p0), M1 = fmaxf(m_state, p1);
                const float Ml = __int_as_float(__builtin_amdgcn_readlane(__float_as_int(M1), 63));
                fa[lane] = a0; fa[64 + lane] = a1; fM[lane] = M0; fM[64 + lane] = M1; fb[lane] = c0; fb[64 + lane] = c1;
                fwk[lane] = __expf(a0 - Ml); fwk[64 + lane] = __expf(a1 - Ml);
            }
            LDS_BARRIER();
            const float Mlast = fM[127], blast = fb[127];
            const int t = 16 * w + fr;
            const float Mt = fM[t], bt = fb[t];
            const float winter = __expf(m_state - Mt);
            u32x2 ogv[8];
#pragma unroll
            for (int n = 0; n < 8; ++n) ogv[n] = *(const u32x2*)(z + (r0 + t) * 3072 + 2048 + h * 128 + 16 * n + fq * 4);
            bf16x8 qf[2];
            qf[0] = ldk(Qs + t * PQ + fq * 16); qf[1] = ldk(Qs + t * PQ + 64 + fq * 16);
            for (int n = 0; n <= (w | 1); ++n) {
                f32x4 a = (f32x4){0.f, 0.f, 0.f, 0.f};
                if (n <= w) {
                    const bf16x8 k0 = ldk(Ks + (16 * n + fr) * PQ + fq * 16), k1 = ldk(Ks + (16 * n + fr) * PQ + 64 + fq * 16);
                    a = MFMA16(k0, qf[0], a); a = MFMA16(k1, qf[1], a);
                    const f32x4 as4 = *(const LAS f32x4*)(fa + 16 * n + fq * 4);
#pragma unroll
                    for (int j = 0; j < 4; ++j) { const int s = 16 * n + fq * 4 + j; a[j] = (s <= t) ? a[j] * __expf(as4[j] - Mt) : 0.f; }
                }
                u32x2 pw; pw.x = pk2(a[0], a[1]); pw.y = pk2(a[2], a[3]);
                *(LAS u32x2*)(Ps + t * PP + (16 * n + fq * 4) * 2) = pw;
            }
            asm volatile("s_waitcnt lgkmcnt(0)" ::: "memory");
            f32x4 o[9];
#pragma unroll
            for (int n = 0; n < 9; ++n) { f32x4 c = (f32x4){0.f, 0.f, 0.f, 0.f};
                c = MFMA16(ldk(Cb + (16 * n + fr) * PC + fq * 16), qf[0], c); c = MFMA16(ldk(Cb + (16 * n + fr) * PC + 64 + fq * 16), qf[1], c);
                o[n] = c * winter; }
            for (int ks = 0; ks <= (w >> 1); ++ks) {
                const bf16x8 pf = ldk(Ps + t * PP + ks * 64 + fq * 16);
#pragma unroll
                for (int n = 0; n < 9; ++n) o[n] = MFMA16(ldt(Vs + (ks * 32) * PV + (16 * n) * 2, PV, fr, fq), pf, o[n]);
            }
            {
                float den = __shfl(o[8][0], fr);
                const float dn = fast_rcp(fmaxf(fabsf(den), __expf(-(bt + Mt))));
                float ss = 0.f;
#pragma unroll
                for (int n = 0; n < 8; ++n) { o[n] = o[n] * dn; ss += o[n][0] * o[n][0] + o[n][1] * o[n][1] + o[n][2] * o[n][2] + o[n][3] * o[n][3]; }
                ss += __shfl_xor(ss, 16); ss += __shfl_xor(ss, 32);
                const float rs = __builtin_amdgcn_rsqf(ss * (1.0f / 128.0f) + EPS);
                const float* hg = P->in[I_AHG] + h * 128;
#pragma unroll
                for (int n = 0; n < 8; ++n) { const int v0 = 16 * n + fq * 4;
                    const u32x2 og = ogv[n];
                    const f32x4 g4 = *(const f32x4*)(hg + v0);
                    const float y0 = o[n][0] * rs * g4[0] * sigmoidf_(bflo(og.x)), y1 = o[n][1] * rs * g4[1] * sigmoidf_(bfhi(og.x));
                    const float y2 = o[n][2] * rs * g4[2] * sigmoidf_(bflo(og.y)), y3 = o[n][3] * rs * g4[3] * sigmoidf_(bfhi(og.y));
                    u32x2 yw; yw.x = pk2(y0, y1); yw.y = pk2(y2, y3);
                    *(u32x2*)(yout + (r0 + t) * 1024 + h * 128 + v0) = yw; }
            }
            {
                const float decay = __expf(m_state - Mlast);
#pragma unroll
                for (int i = 0; i < 5; ++i) st[i] = st[i] * decay;
                for (int ks = 0; ks < 4; ++ks) {
                    const f32x4 wa = *(const LAS f32x4*)(fwk + ks * 32 + fq * 8), wb = *(const LAS f32x4*)(fwk + ks * 32 + fq * 8 + 4);
                    const bf16x8 vf = ldt(Vs + (ks * 32) * PV + (16 * w) * 2, PV, fr, fq);
                    bf16x8 kf[4];
#pragma unroll
                    for (int dt = 0; dt < 4; ++dt) { const u32x4 kr = as_u32x4(ldt(Ks + (ks * 32) * PQ + (16 * dt) * 2, PQ, fr, fq)); u32x4 ksc;
                        ksc.x = pk2(bflo(kr.x) * wa[0], bfhi(kr.x) * wa[1]); ksc.y = pk2(bflo(kr.y) * wa[2], bfhi(kr.y) * wa[3]);
                        ksc.z = pk2(bflo(kr.z) * wb[0], bfhi(kr.z) * wb[1]); ksc.w = pk2(bflo(kr.w) * wb[2], bfhi(kr.w) * wb[3]);
                        kf[dt] = as_bf16x8(ksc); st[dt] = MFMA16(kf[dt], vf, st[dt]); }
                    if (w < 4) { const bf16x8 v8 = ldt(Vs + (ks * 32) * PV + 128 * 2, PV, fr, fq);
                        const bf16x8 kw = (w == 0) ? kf[0] : (w == 1) ? kf[1] : (w == 2) ? kf[2] : kf[3];
                        st[4] = MFMA16(kw, v8, st[4]); }
                }
            }
            m_state = blast + Mlast;
            LDS_BARRIER();
#pragma unroll
            for (int dt = 0; dt < 4; ++dt) { u32x2 cw; cw.x = pk2(st[dt][0], st[dt][1]); cw.y = pk2(st[dt][2], st[dt][3]);
                *(LAS u32x2*)(Cb + (16 * w + fr) * PC + (16 * dt + fq * 4) * 2) = cw; }
            if (w < 4) { u32x2 cw; cw.x = pk2(st[4][0], st[4][1]); cw.y = pk2(st[4][2], st[4][3]);
                *(LAS u32x2*)(Cb + (128 + fr) * PC + (16 * w + fq * 4) * 2) = cw; }
        }
    }
    __syncthreads();
}

__device__ __forceinline__ void hgrn_core(KP P, LAS unsigned char* lds, int wv) {
    const int tid = opaque_tid(wv), w = __builtin_amdgcn_readfirstlane(tid >> 6), lane = tid & 63, fr = lane & 15, fq = lane >> 4;
    const bf16_t* z = (const bf16_t*)(P->ws + WS_Z); const float* lbv = (const float*)(P->ws + WS_LB); bf16_t* yout = (bf16_t*)(P->ws + WS_YP);
    constexpr int PT = 288, PA = 96;
    LAS unsigned char* Qt = lds; LAS unsigned char* Qh = lds + 9216; LAS unsigned char* Kh = lds + 18432; LAS unsigned char* Vs = lds + 27648; LAS unsigned char* At = lds + 36864;
    LAS unsigned char* Sb = lds + 40960;
    LAS float* gl = (LAS float*)(lds + 77824);
    LAS float* seg = (LAS float*)(lds + 78336);
    LAS float* ssp = (LAS float*)(lds + 80384);
    const int c = tid & 127, tq = tid >> 7;
    for (int unit = blockIdx.x; unit < 256; unit += gridDim.x) {
        const int b = unit >> 3, h = unit & 7;
        const float lb = lbv[h * 128 + c];
        __syncthreads();
        for (int i = tid; i < 128 * 144 / 2; i += NTHREADS) ((LAS unsigned*)Sb)[i] = 0u;
        f32x4 S[8];
#pragma unroll
        for (int i = 0; i < 8; ++i) S[i] = (f32x4){0.f, 0.f, 0.f, 0.f};
        bf16_t nq[8], nf[8]; u32x4 nv; u32x2 ng2[2];
        { const size_t r0 = (size_t)b * SEQL;
#pragma unroll
            for (int i = 0; i < 8; ++i) { const size_t ro = (r0 + tq * 8 + i) * 4096 + h * 128 + c; nq[i] = z[ro]; nf[i] = z[ro + 1024]; }
            nv = *(const u32x4*)(z + (r0 + (tid >> 4)) * 4096 + 2048 + h * 128 + (tid & 15) * 8);
#pragma unroll
            for (int tt = 0; tt < 2; ++tt) ng2[tt] = *(const u32x2*)(z + (r0 + 16 * tt + fr) * 4096 + 3072 + h * 128 + 16 * w + fq * 4); }
        for (int chunk = 0; chunk < 64; ++chunk) {
            const size_t r0 = (size_t)b * SEQL + chunk * 32;
            float qv[8], kv[8], cs[8];
            const u32x2 cg0 = ng2[0], cg1 = ng2[1];
            { float run = 0.f;
#pragma unroll
                for (int i = 0; i < 8; ++i) {
                    qv[i] = bf2f(nq[i]); const float fz = bf2f(nf[i]);
                    const float f = lb + (1.0f - lb) * sigmoidf_(fz); kv[i] = 1.0f - f; run += __logf(f); cs[i] = run; }
                seg[tq * 128 + c] = run; }
            { const int row = tid >> 4, pc = tid & 15;
                *(LAS u32x4*)(Vs + row * PT + pc * 16) = nv; }
            if (chunk + 1 < 64) { const size_t r1 = r0 + 32;
#pragma unroll
                for (int i = 0; i < 8; ++i) { const size_t ro = (r1 + tq * 8 + i) * 4096 + h * 128 + c; nq[i] = z[ro]; nf[i] = z[ro + 1024]; }
                nv = *(const u32x4*)(z + (r1 + (tid >> 4)) * 4096 + 2048 + h * 128 + (tid & 15) * 8);
#pragma unroll
                for (int tt = 0; tt < 2; ++tt) ng2[tt] = *(const u32x2*)(z + (r1 + 16 * tt + fr) * 4096 + 3072 + h * 128 + 16 * w + fq * 4); }
            LDS_BARRIER();
            { const float s0 = seg[c], s1 = seg[128 + c], s2 = seg[256 + c], s3 = seg[384 + c];
                const float pre = (tq > 0 ? s0 : 0.f) + (tq > 1 ? s1 : 0.f) + (tq > 2 ? s2 : 0.f); const float glast = (s0 + s1) + (s2 + s3);
#pragma unroll
                for (int i = 0; i < 8; ++i) { const float g = pre + cs[i]; const int t = tq * 8 + i;
                    const float eg = __expf(g), er = __expf(g - glast);
                    *(LAS bf16_t*)(Qh + t * PT + c * 2) = f2bf(qv[i] * eg);
                    *(LAS bf16_t*)(Qt + t * PT + c * 2) = f2bf(qv[i] * er);
                    *(LAS bf16_t*)(Kh + t * PT + c * 2) = f2bf(kv[i] * fast_rcp(er)); }
                if (tq == 0) gl[c] = __expf(glast); }
            LDS_BARRIER();
            f32x4 o[2];
#pragma unroll
            for (int tt = 0; tt < 2; ++tt) { f32x4 a = (f32x4){0.f, 0.f, 0.f, 0.f};
#pragma unroll
                for (int ks = 0; ks < 4; ++ks) a = MFMA16(ldk(Sb + (16 * w + fr) * PT + ks * 64 + fq * 16), ldk(Qh + (16 * tt + fr) * PT + ks * 64 + fq * 16), a);
                o[tt] = a; }
            if (w < 4) { const int tt = w >> 1, stl = w & 1; f32x4 a = (f32x4){0.f, 0.f, 0.f, 0.f};
                if (!(tt == 0 && stl == 1)) {
#pragma unroll
                    for (int ks = 0; ks < 4; ++ks) a = MFMA16(ldk(Kh + (16 * stl + fr) * PT + ks * 64 + fq * 16), ldk(Qt + (16 * tt + fr) * PT + ks * 64 + fq * 16), a);
                    const int t = 16 * tt + fr;
#pragma unroll
                    for (int j = 0; j < 4; ++j) { const int s = 16 * stl + fq * 4 + j; if (s > t) a[j] = 0.f; }
                }
                u32x2 aw; aw.x = pk2(a[0], a[1]); aw.y = pk2(a[2], a[3]);
                *(LAS u32x2*)(At + (16 * tt + fr) * PA + (16 * stl + fq * 4) * 2) = aw; }
            LDS_BARRIER();
            { const bf16x8 vf = ldt(Vs + (16 * w) * 2, PT, fr, fq);
#pragma unroll
                for (int tt = 0; tt < 2; ++tt) { o[tt] = MFMA16(vf, ldk(At + (16 * tt + fr) * PA + fq * 16), o[tt]);
                    float ss = o[tt][0] * o[tt][0] + o[tt][1] * o[tt][1] + o[tt][2] * o[tt][2] + o[tt][3] * o[tt][3];
                    ss += __shfl_xor(ss, 16); ss += __shfl_xor(ss, 32);
                    if (fq == 0) ssp[(16 * tt + fr) * 8 + w] = ss; }
                const bf16x8 kf = ldt(Kh + (16 * w) * 2, PT, fr, fq);
                const f32x4 dc = *(const LAS f32x4*)(gl + 16 * w + fq * 4);
#pragma unroll
                for (int vt = 0; vt < 8; ++vt) { S[vt] = S[vt] * dc; S[vt] = MFMA16(kf, ldt(Vs + (16 * vt) * 2, PT, fr, fq), S[vt]); } }
            LDS_BARRIER();
#pragma unroll
            for (int vt = 0; vt < 8; ++vt) { u32x2 sw; sw.x = pk2(S[vt][0], S[vt][1]); sw.y = pk2(S[vt][2], S[vt][3]);
                *(LAS u32x2*)(Sb + (16 * vt + fr) * PT + (16 * w + fq * 4) * 2) = sw; }
            { const float* hg = P->in[I_BHG] + h * 128; const int v0 = 16 * w + fq * 4; const f32x4 g4 = *(const f32x4*)(hg + v0);
#pragma unroll
                for (int tt = 0; tt < 2; ++tt) { const int t = 16 * tt + fr;
                    const f32x4 sa = *(const LAS f32x4*)(ssp + t * 8), sb = *(const LAS f32x4*)(ssp + t * 8 + 4);
                    const float tot = ((sa[0] + sa[1]) + (sa[2] + sa[3])) + ((sb[0] + sb[1]) + (sb[2] + sb[3]));
                    const float rs = __builtin_amdgcn_rsqf(tot * (1.0f / 128.0f) + EPS);
                    const u32x2 gg = tt ? cg1 : cg0;
                    const float g0 = bflo(gg.x), g1 = bfhi(gg.x), g2 = bflo(gg.y), g3 = bfhi(gg.y);
                    const float y0 = o[tt][0] * rs * g4[0] * g0 * sigmoidf_(g0), y1 = o[tt][1] * rs * g4[1] * g1 * sigmoidf_(g1);
                    const float y2 = o[tt][2] * rs * g4[2] * g2 * sigmoidf_(g2), y3 = o[tt][3] * rs * g4[3] * g3 * sigmoidf_(g3);
                    u32x2 yw; yw.x = pk2(y0, y1); yw.y = pk2(y2, y3);
                    *(u32x2*)(yout + (r0 + t) * 1024 + h * 128 + v0) = yw; } }
        }
    }
    __syncthreads();
}

__device__ __forceinline__ void spatial_core(KP P, LAS unsigned char* lds, int wv) {
    const int tid = opaque_tid(wv), w = __builtin_amdgcn_readfirstlane(tid >> 6), lane = tid & 63, fr = lane & 15, fq = lane >> 4;
    bf16_t* z = (bf16_t*)(P->ws + WS_Z); const bf16_t* Wsb = (const bf16_t*)(P->ws + WS_W) + OFF_C_WS;
    constexpr int PVh = 544, PW = 288;
    LAS unsigned char* Vh = lds; LAS unsigned char* Wg = lds + 69632; LAS float* mu = (LAS float*)(lds + 106496); LAS float* rsd = mu + 128;
    for (int unit = blockIdx.x; unit < 512; unit += gridDim.x) {
        const size_t r0 = (size_t)unit * 128;
        __syncthreads();
        for (int rb = 0; rb < 4; ++rb) { u32x4 xr[4][4];
#pragma unroll
            for (int j = 0; j < 4; ++j)
#pragma unroll
                for (int q = 0; q < 4; ++q) xr[j][q] = *(const u32x4*)(z + (r0 + 16 * w + rb * 4 + j) * 4096 + 2048 + (q * 64 + lane) * 8);
#pragma unroll
            for (int j = 0; j < 4; ++j) { const int row = 16 * w + rb * 4 + j; float x[32]; float s = 0.f;
#pragma unroll
                for (int q = 0; q < 4; ++q) { const u32x4 v = xr[j][q];
                    x[q * 8 + 0] = bflo(v.x); x[q * 8 + 1] = bfhi(v.x); x[q * 8 + 2] = bflo(v.y); x[q * 8 + 3] = bfhi(v.y); x[q * 8 + 4] = bflo(v.z); x[q * 8 + 5] = bfhi(v.z); x[q * 8 + 6] = bflo(v.w); x[q * 8 + 7] = bfhi(v.w); }
#pragma unroll
                for (int e = 0; e < 32; ++e) s += x[e];
                s = wave_sum(s); const float mean = s * (1.0f / 2048.0f); float qd = 0.f;
#pragma unroll
                for (int e = 0; e < 32; ++e) { const float d = x[e] - mean; qd += d * d; }
                qd = wave_sum(qd);
                if (lane == 0) { mu[row] = mean; rsd[row] = __builtin_amdgcn_rsqf(qd * (1.0f / 2048.0f) + EPS); } } }
        __syncthreads();
        const int pc = tid & 31;
        u32x4 pvr[8], pwr[4];
#define SP_LOADG(gg) do { _Pragma("unroll") for (int i = 0; i < 8; ++i) pvr[i] = *(const u32x4*)(z + (r0 + (tid >> 5) + i * 16) * 4096 + 2048 + (gg) * 256 + pc * 8); \
            _Pragma("unroll") for (int i = 0; i < 4; ++i) { const int idx = tid + i * 512; pwr[i] = *(const u32x4*)(Wsb + (size_t)(gg) * 16384 + (idx >> 4) * 128 + (idx & 15) * 8); } } while (0)
        SP_LOADG(0);
        for (int g = 0; g < 8; ++g) {
            { float gn[8], bi[8];
#pragma unroll
                for (int e = 0; e < 8; ++e) { gn[e] = P->in[I_CLG][g * 256 + pc * 8 + e]; bi[e] = P->in[I_CLB][g * 256 + pc * 8 + e]; }
#pragma unroll
                for (int i = 0; i < 8; ++i) { const int row = (tid >> 5) + i * 16;
                    const u32x4 v = pvr[i]; const float m = mu[row], r = rsd[row];
                    u32x4 o; o.x = pk2((bflo(v.x) - m) * r * gn[0] + bi[0], (bfhi(v.x) - m) * r * gn[1] + bi[1]); o.y = pk2((bflo(v.y) - m) * r * gn[2] + bi[2], (bfhi(v.y) - m) * r * gn[3] + bi[3]);
                    o.z = pk2((bflo(v.z) - m) * r * gn[4] + bi[4], (bfhi(v.z) - m) * r * gn[5] + bi[5]); o.w = pk2((bflo(v.w) - m) * r * gn[6] + bi[6], (bfhi(v.w) - m) * r * gn[7] + bi[7]);
                    *(LAS u32x4*)(Vh + row * PVh + pc * 16) = o; }
#pragma unroll
                for (int i = 0; i < 4; ++i) { const int idx = tid + i * 512, row = idx >> 4, p2 = idx & 15;
                    *(LAS u32x4*)(Wg + row * PW + p2 * 16) = pwr[i]; } }
            u32x2 upre[8][2]; float bsv[8];
#pragma unroll
            for (int tt = 0; tt < 8; ++tt) { const int t = 16 * tt + fr; const bf16_t* up = z + (r0 + t) * 4096 + g * 256 + 32 * w + fq * 4;
                upre[tt][0] = *(const u32x2*)up; upre[tt][1] = *(const u32x2*)(up + 16); bsv[tt] = P->in[I_CSB][g * 128 + t]; }
            if (g + 1 < 8) SP_LOADG(g + 1);
            LDS_BARRIER();
            bf16x8 bf[2][4];
#pragma unroll
            for (int ci = 0; ci < 2; ++ci)
#pragma unroll
                for (int ks = 0; ks < 4; ++ks) bf[ci][ks] = ldt(Vh + (ks * 32) * PVh + (16 * (2 * w + ci)) * 2, PVh, fr, fq);
#pragma unroll
            for (int tt = 0; tt < 8; ++tt) { f32x4 a0 = (f32x4){0.f, 0.f, 0.f, 0.f}, a1 = a0;
#pragma unroll
                for (int ks = 0; ks < 4; ++ks) if (ks <= (tt >> 1)) { const bf16x8 af = ldk(Wg + (16 * tt + fr) * PW + ks * 64 + fq * 16); a0 = MFMA16(bf[0][ks], af, a0); a1 = MFMA16(bf[1][ks], af, a1); }
                const int t = 16 * tt + fr; const float bs = bsv[tt];
                bf16_t* up = z + (r0 + t) * 4096 + g * 256 + 32 * w + fq * 4;
                { const u32x2 uu = upre[tt][0]; u32x2 yw; yw.x = pk2(bflo(uu.x) * (a0[0] + bs), bfhi(uu.x) * (a0[1] + bs)); yw.y = pk2(bflo(uu.y) * (a0[2] + bs), bfhi(uu.y) * (a0[3] + bs)); *(u32x2*)up = yw; }
                { const u32x2 uu = upre[tt][1]; u32x2 yw; yw.x = pk2(bflo(uu.x) * (a1[0] + bs), bfhi(uu.x) * (a1[1] + bs)); yw.y = pk2(bflo(uu.y) * (a1[2] + bs), bfhi(uu.y) * (a1[3] + bs)); *(u32x2*)(up + 16) = yw; } }
            LDS_BARRIER();
        }
#undef SP_LOADG
    }
    __syncthreads();
}

__device__ __forceinline__ void conv_pass(KP P, int wv) {
    const bf16_t* z = (const bf16_t*)(P->ws + WS_Z); bf16_t* xc = (bf16_t*)(P->ws + WS_YP);
    const int gtid = blockIdx.x * NTHREADS + opaque_tid(wv), nth = gridDim.x * NTHREADS;
    const int oct = gtid & 127;
    float cw[4][8], cb[8];
#pragma unroll
    for (int e = 0; e < 8; ++e) { cb[e] = P->in[I_DCB][oct * 8 + e];
#pragma unroll
        for (int j = 0; j < 4; ++j) cw[j][e] = P->in[I_DCW][j * 1024 + oct * 8 + e]; }
    for (int idx = gtid; idx < (MTOK / 8) * 128; idx += nth) {
        const int r0 = (idx >> 7) * 8; const bool first = (r0 & (SEQL - 1)) == 0;
        u32x4 xr[11];
#pragma unroll
        for (int i = 0; i < 11; ++i) { xr[i] = (u32x4){0u, 0u, 0u, 0u}; if (i >= 3 || !first) xr[i] = *(const u32x4*)(z + (size_t)(r0 - 3 + i) * 2048 + 1024 + oct * 8); }
#pragma unroll
        for (int o = 0; o < 8; ++o) { float a[8];
#pragma unroll
            for (int e = 0; e < 8; ++e) a[e] = cb[e];
#pragma unroll
            for (int j = 0; j < 4; ++j) { const u32x4 v = xr[o + j];
                a[0] += cw[j][0] * bflo(v.x); a[1] += cw[j][1] * bfhi(v.x); a[2] += cw[j][2] * bflo(v.y); a[3] += cw[j][3] * bfhi(v.y);
                a[4] += cw[j][4] * bflo(v.z); a[5] += cw[j][5] * bfhi(v.z); a[6] += cw[j][6] * bflo(v.w); a[7] += cw[j][7] * bfhi(v.w); }
            u32x4 ow; ow.x = pk2(a[0], a[1]); ow.y = pk2(a[2], a[3]); ow.z = pk2(a[4], a[5]); ow.w = pk2(a[6], a[7]);
            *(u32x4*)(xc + (size_t)(r0 + o) * 1024 + oct * 8) = ow; }
    }
}
__device__ __forceinline__ void scan_pass(KP P, LAS unsigned char* lds, int wv) {
    const bf16_t* z = (const bf16_t*)(P->ws + WS_Z); const bf16_t* loga = z + (size_t)MTOK * 2048; const bf16_t* beta = loga + (size_t)MTOK * 1024; bf16_t* y = (bf16_t*)(P->ws + WS_YP);
    LAS float* sA = (LAS float*)lds; LAS float* sB = sA + 512 * 8;
    const int tid = opaque_tid(wv), seg = tid >> 4, o = tid & 15;
    for (int unit = blockIdx.x; unit < 256; unit += gridDim.x) {
        const int b = unit >> 3; const int ch0 = ((unit & 7) * 16 + o) * 8; const size_t row0 = (size_t)b * SEQL + seg * 64;
        float SL[8], B[8];
#pragma unroll
        for (int e = 0; e < 8; ++e) { SL[e] = 0.f; B[e] = 0.f; }
#pragma unroll 4
        for (int t = 0; t < 64; ++t) { const u32x4 lv = *(const u32x4*)(loga + (row0 + t) * 1024 + ch0), bv = *(const u32x4*)(beta + (row0 + t) * 1024 + ch0);
            const float l[8] = {bflo(lv.x), bfhi(lv.x), bflo(lv.y), bfhi(lv.y), bflo(lv.z), bfhi(lv.z), bflo(lv.w), bfhi(lv.w)};
            const float be[8] = {bflo(bv.x), bfhi(bv.x), bflo(bv.y), bfhi(bv.y), bflo(bv.z), bfhi(bv.z), bflo(bv.w), bfhi(bv.w)};
#pragma unroll
            for (int e = 0; e < 8; ++e) { B[e] = __expf(l[e]) * B[e] + be[e]; SL[e] += l[e]; } }
        __syncthreads();
#pragma unroll
        for (int e = 0; e < 8; ++e) { sA[tid * 8 + e] = __expf(SL[e]); sB[tid * 8 + e] = B[e]; }
        __syncthreads();
        float H[8];
#pragma unroll
        for (int e = 0; e < 8; ++e) H[e] = 0.f;
        for (int s = 0; s < seg; ++s) {
#pragma unroll
            for (int e = 0; e < 8; ++e) H[e] = sA[(s * 16 + o) * 8 + e] * H[e] + sB[(s * 16 + o) * 8 + e]; }
        for (int t0 = 0; t0 < 64; t0 += 4) { u32x4 lvv[4], bvv[4], gvv[4];
#pragma unroll
            for (int i = 0; i < 4; ++i) { lvv[i] = *(const u32x4*)(loga + (row0 + t0 + i) * 1024 + ch0); bvv[i] = *(const u32x4*)(beta + (row0 + t0 + i) * 1024 + ch0); gvv[i] = *(const u32x4*)(z + (row0 + t0 + i) * 2048 + ch0); }
#pragma unroll
            for (int i = 0; i < 4; ++i) { const u32x4 lv = lvv[i], bv = bvv[i], gv = gvv[i];
                const float l[8] = {bflo(lv.x), bfhi(lv.x), bflo(lv.y), bfhi(lv.y), bflo(lv.z), bfhi(lv.z), bflo(lv.w), bfhi(lv.w)};
                const float be[8] = {bflo(bv.x), bfhi(bv.x), bflo(bv.y), bfhi(bv.y), bflo(bv.z), bfhi(bv.z), bflo(bv.w), bfhi(bv.w)};
                const float gg[8] = {bflo(gv.x), bfhi(gv.x), bflo(gv.y), bfhi(gv.y), bflo(gv.z), bfhi(gv.z), bflo(gv.w), bfhi(gv.w)};
                float yv[8];
#pragma unroll
                for (int e = 0; e < 8; ++e) { H[e] = __expf(l[e]) * H[e] + be[e]; yv[e] = H[e] * gelu_tanh(gg[e]); }
                u32x4 ow; ow.x = pk2(yv[0], yv[1]); ow.y = pk2(yv[2], yv[3]); ow.z = pk2(yv[4], yv[5]); ow.w = pk2(yv[6], yv[7]);
                *(u32x4*)(y + (row0 + t0 + i) * 1024 + ch0) = ow; } }
    }
    __syncthreads();
}

constexpr int NPHASES = 39;
enum { T_PREP, T_GEMM, T_GEMMRG, T_ROW, T_MLSTM, T_HGRN, T_SPATIAL, T_CONV, T_SCAN };
__device__ __forceinline__ void decode(int ph, int& type, int& layer, int& sub) {
    if (ph == 0) { type = T_PREP; layer = 0; sub = 0; return; }
    int base, cbase;
    if (ph < 10) { layer = 0; base = 1; cbase = 4; } else if (ph < 19) { layer = 1; base = 10; cbase = 13; } else if (ph < 28) { layer = 2; base = 19; cbase = 22; } else { layer = 3; base = 28; cbase = 33; }
    if (ph >= cbase) { const int k = ph - cbase;
        if (k == 0) { type = T_ROW; sub = 1; } else if (k == 1) { type = T_GEMM; sub = 2; } else if (k == 2) { type = T_GEMM; sub = 3; } else if (k == 3) { type = T_ROW; sub = 2; } else if (k == 4) { type = T_GEMM; sub = 4; } else { type = T_ROW; sub = 3; }
        return; }
    const int k = ph - base;
    if (layer < 3) { if (k == 0) { type = T_GEMM; sub = 0; } else if (k == 1) { type = layer == 0 ? T_MLSTM : layer == 1 ? T_HGRN : T_SPATIAL; sub = 0; } else { type = T_GEMM; sub = 1; } }
    else { if (k == 0) { type = T_GEMM; sub = 0; } else if (k == 1) { type = T_CONV; sub = 0; } else if (k == 2) { type = T_GEMMRG; sub = 0; } else if (k == 3) { type = T_SCAN; sub = 0; } else { type = T_GEMM; sub = 1; } }
}

__global__ void __launch_bounds__(NTHREADS, 2) fwd_kernel(Params Pk) {
    extern __shared__ __attribute__((aligned(16))) unsigned char smem[];
    LAS unsigned char* lds = (LAS unsigned char*)smem;
    const int ph_lo = Pk.ph_lo, ph_hi = Pk.ph_hi;
    if (ph_lo < 0) cg::this_grid().sync();
    volatile LAS unsigned* bst = (volatile LAS unsigned*)(lds + (LDS_BYTES - 16));
    const int wv = __builtin_amdgcn_readfirstlane((int)threadIdx.x >> 6);
    if (xb_leader(wv)) { bst[0] = 0u; bst[1] = 0u; }
    __syncthreads();
    const XcdBarrier gbar = xcd_barrier_post((unsigned*)(Pk.ws + WS_BAR), bst, wv);
    for (int ph = ph_lo; ph < ph_hi; ++ph) {
        KP P = (KP)__builtin_amdgcn_kernarg_segment_ptr();
        asm volatile("" : "+s"(P));
        unsigned char* ws = P->ws;
        bf16_t* W = (bf16_t*)(ws + WS_W); bf16_t* HN = (bf16_t*)(ws + WS_HN); bf16_t* Z = (bf16_t*)(ws + WS_Z); bf16_t* YP = (bf16_t*)(ws + WS_YP); bf16_t* PB = (bf16_t*)(ws + WS_PB);
        int type, layer, sub; decode(ph, type, layer, sub);
        if (type == T_PREP) prep_phase(P, lds, wv);
        else if (type == T_GEMM) {
            const int njobs = (sub == 2) ? 2 : 1;
            for (int j = 0; j < njobs; ++j) {
                pg8::Gemm g; EpiGen e; e.gate = nullptr; e.gate_pn = -1; e.act = 0; g.M = MTOK;
                bf16_t* L = W + (size_t)layer * LW;
                if (sub == 0) { g.A = HN; g.lda = 1024; g.K = 1024; g.ldb = 1024; e.O = Z;
                    if (layer == 0) { g.Bt = W + OFF_A_IN; g.N = 3328; e.ldc = 3072; e.gate = (float*)(ws + WS_GATE); e.gate_pn = 12; }
                    else if (layer == 1) { g.Bt = W + OFF_B_IN; g.N = 4096; e.ldc = 4096; }
                    else if (layer == 2) { g.Bt = W + OFF_C_IN; g.N = 4096; e.ldc = 4096; e.act = 1; }
                    else { g.Bt = W + OFF_D_IN; g.N = 2048; e.ldc = 2048; } }
                else if (sub == 1) { g.N = 1024; e.O = (bf16_t*)P->out; e.ldc = 1024;
                    if (layer == 2) { g.A = Z; g.lda = 4096; g.K = 2048; g.ldb = 2048; g.Bt = W + OFF_C_OUT; }
                    else { g.A = YP; g.lda = 1024; g.K = 1024; g.ldb = 1024; g.Bt = W + (layer == 0 ? OFF_A_OUT : layer == 1 ? OFF_B_OUT : OFF_D_OUT); } }
                else if (sub == 2) {
                    if (j == 0) { g.A = HN; g.lda = 1024; g.K = 1024; g.ldb = 1024; g.Bt = L; g.N = 4096; e.O = Z; e.ldc = 4096; e.act = 2; }
                    else { g.A = PB; g.lda = 256; g.K = 256; g.ldb = 256; g.Bt = L + W_UP + W_DN + W_G; g.N = 1024; e.O = YP; e.ldc = 1024; } }
                else if (sub == 3) { g.A = Z; g.lda = 4096; g.K = 4096; g.ldb = 4096; g.Bt = L + W_UP; g.N = 1024; e.O = (bf16_t*)P->out; e.ldc = 1024; }
                else { g.A = HN; g.lda = 1024; g.K = 1024; g.ldb = 1024; g.Bt = L + W_UP + W_DN; g.N = 1024; e.O = YP; e.ldc = 1024; e.act = 3; }
                pg8::StaticOrder S; S.init(g.M, g.N, (int)gridDim.x, (int)blockIdx.x);
                pg8::gemm_phase<EpiGen>(lds, g, S, e, wv);
            }
        }
        else if (type == T_GEMMRG) {
            for (int blk = 0; blk < 4; ++blk) {
                pg8::Gemm g; g.M = MTOK; g.N = 512; g.K = 256; g.A = YP + blk * 256; g.lda = 1024; g.Bt = W + OFF_D_G + (size_t)blk * 512 * 256; g.ldb = 256;
                EpiRg e; e.xc = YP; e.loga = Z + (size_t)MTOK * 2048; e.beta = e.loga + (size_t)MTOK * 1024; e.b_a = P->in[I_DBA]; e.b_x = P->in[I_DBX]; e.spt = (const float*)(ws + WS_LB) + 1024; e.blk = blk;
                pg8::StaticOrder S; S.init(g.M, g.N, (int)gridDim.x, (int)blockIdx.x);
                pg8::gemm_phase<EpiRg>(lds, g, S, e, wv);
            }
        }
        else if (type == T_ROW) {
            const float* ng = P->in[I_NG] + (size_t)layer * 5 * 1024;
            bf16_t* HBuf = (bf16_t*)P->out;
            float* RS = (float*)(ws + WS_LB + 512 * 1024);
            if (sub == 1) rowpass(nullptr, HN, HBuf, ng + 1024, nullptr, nullptr, ng + 2048, HN, 1, P->in[I_P] + (size_t)layer * MTOK * 256, PB, RS, ng, RS, wv);
            else if (sub == 2) rowpass(nullptr, HN, HBuf, ng + 3072, nullptr, nullptr, nullptr, HN, 0, nullptr, nullptr, RS, ng + 2048, nullptr, wv);
            else if (layer < 3) rowpass(nullptr, HN, YP, ng + 4096, nullptr, nullptr, ng + 5120, HN, 1, nullptr, nullptr, nullptr, nullptr, RS, wv);
            else rowpass(nullptr, HN, YP, ng + 4096, P->out, nullptr, nullptr, nullptr, 0, nullptr, nullptr, nullptr, nullptr, nullptr, wv);
        }
        else if (type == T_MLSTM) mlstm_core(P, lds, wv);
        else if (type == T_HGRN) hgrn_core(P, lds, wv);
        else if (type == T_SPATIAL) spatial_core(P, lds, wv);
        else if (type == T_CONV) conv_pass(P, wv);
        else if (type == T_SCAN) scan_pass(P, lds, wv);
        if (ph + 1 < ph_hi) xcd_barrier(gbar, wv);
    }
}

extern "C" void kernel_launch(void* const* d_in, const int* in_sizes, int n_in, void* d_out, int out_size, void* d_ws, size_t ws_size, hipStream_t stream) {
    static int grid = 0;
    if (grid == 0) {
        if (n_in != 31 || in_sizes[0] != MTOK * DM || out_size != MTOK * DM || ws_size < WS_END) { fprintf(stderr, "kernel_launch: unexpected shapes (n_in %d, ws %zu)\n", n_in, ws_size); grid = -1; return; }
        int dev = 0, cus = 0, per_cu = 0;
        hipGetDevice(&dev); hipDeviceGetAttribute(&cus, hipDeviceAttributeMultiprocessorCount, dev);
        hipFuncSetAttribute((const void*)fwd_kernel, hipFuncAttributeMaxDynamicSharedMemorySize, LDS_BYTES);
        hipOccupancyMaxActiveBlocksPerMultiprocessor(&per_cu, (const void*)fwd_kernel, NTHREADS, LDS_BYTES);
        if (per_cu < 1) per_cu = 1;
        grid = cus * per_cu;
        (void)hipGetLastError();
    }
    if (grid < 0) return;
    Params p{};
    for (int i = 0; i < 31; ++i) p.in[i] = (const float*)d_in[i];
    p.out = (float*)d_out; p.ws = (unsigned char*)d_ws;
    (void)hipMemsetAsync((unsigned char*)d_ws + WS_BAR, 0, XCD_BAR_WORDS * sizeof(unsigned), stream);
#if ONE_LAUNCH
    p.ph_lo = 0; p.ph_hi = NPHASES;
    void* args[] = {&p};
    hipError_t e = hipLaunchCooperativeKernel((const void*)fwd_kernel, dim3(grid), dim3(NTHREADS), args, LDS_BYTES, stream);
    if (e != hipSuccess) fprintf(stderr, "cooperative launch failed: %s (grid %d)\n", hipGetErrorString(e), grid);
#else
    for (int ph = 0; ph < NPHASES; ++ph) { p.ph_lo = ph; p.ph_hi = ph + 1; hipLaunchKernelGGL(fwd_kernel, dim3(grid), dim3(NTHREADS), LDS_BYTES, stream, p); }
#endif
}
```

```cpp
#include <hip/hip_runtime.h>
#include <hip/hip_cooperative_groups.h>
#include <cstdio>
namespace cg = cooperative_groups;

#ifndef ONE_LAUNCH
#define ONE_LAUNCH 1
#endif

#define LAS __attribute__((address_space(3)))
typedef unsigned short bf16_t;
typedef short bf16x8 __attribute__((ext_vector_type(8)));
typedef short s16x4 __attribute__((ext_vector_type(4)));
typedef float f32x4 __attribute__((ext_vector_type(4)));
typedef float f32x2 __attribute__((ext_vector_type(2)));
typedef unsigned u32x4 __attribute__((ext_vector_type(4)));
typedef unsigned u32x2 __attribute__((ext_vector_type(2)));

constexpr int MTOK = 65536, DM = 1024, SEQL = 2048;
constexpr float EPS = 1e-6f;
constexpr int NTHREADS = 512;
constexpr int LDS_BYTES = 155648;

constexpr size_t W_UP = 4096ull * 1024, W_DN = 1024ull * 4096, W_G = 1024ull * 1024, W_PU = 1024ull * 256;
constexpr size_t LW = W_UP + W_DN + W_G + W_PU;
constexpr size_t OFF_A_IN = 4 * LW;
constexpr size_t OFF_A_OUT = OFF_A_IN + 3328ull * 1024;
constexpr size_t OFF_B_IN = OFF_A_OUT + 1024ull * 1024;
constexpr size_t OFF_B_OUT = OFF_B_IN + 4096ull * 1024;
constexpr size_t OFF_C_IN = OFF_B_OUT + 1024ull * 1024;
constexpr size_t OFF_C_OUT = OFF_C_IN + 4096ull * 1024;
constexpr size_t OFF_C_WS = OFF_C_OUT + 1024ull * 2048;
constexpr size_t OFF_D_IN = OFF_C_WS + 8ull * 128 * 128;
constexpr size_t OFF_D_G = OFF_D_IN + 2048ull * 1024;
constexpr size_t OFF_D_OUT = OFF_D_G + 4ull * 512 * 256;
constexpr size_t W_TOTAL = OFF_D_OUT + 1024ull * 1024;
constexpr size_t MiB = 1024ull * 1024;
static_assert(W_TOTAL * 2 <= 112 * MiB, "weights region");
constexpr size_t WS_W = 0, WS_HN = 112 * MiB, WS_Z = 240 * MiB, WS_YP = 752 * MiB, WS_PB = 880 * MiB, WS_GATE = 912 * MiB, WS_LB = 916 * MiB, WS_BAR = 917 * MiB, WS_END = 918 * MiB;

struct Params {
    const float* in[31];
    float* out;
    unsigned char* ws;
    int ph_lo, ph_hi;
};
typedef const __attribute__((address_space(4))) Params* KP;
enum { I_X = 0, I_P, I_NG, I_WUP, I_WDN, I_PUP, I_PG, I_AIN, I_AIB, I_AFB, I_AHG, I_AOUT, I_BIN, I_BLB, I_BHG, I_BOUT, I_CIN, I_CLG, I_CLB, I_CSW, I_CSB, I_COUT,
       I_DIN, I_DCW, I_DCB, I_DWA, I_DBA, I_DWX, I_DBX, I_DLAM, I_DOUT };

__device__ __forceinline__ float bf2f(bf16_t b) { return __uint_as_float(((unsigned)b) << 16); }
__device__ __forceinline__ float bflo(unsigned u) { return __uint_as_float(u << 16); }
__device__ __forceinline__ float bfhi(unsigned u) { return __uint_as_float(u & 0xffff0000u); }
__device__ __forceinline__ unsigned pk2(float lo, float hi) { unsigned r; asm("v_cvt_pk_bf16_f32 %0, %1, %2" : "=v"(r) : "v"(lo), "v"(hi)); return r; }
__device__ __forceinline__ bf16_t f2bf(float f) { return (bf16_t)(pk2(f, 0.f) & 0xffffu); }
__device__ __forceinline__ float fast_rcp(float x) { return __builtin_amdgcn_rcpf(x); }
__device__ __forceinline__ float sigmoidf_(float x) { return fast_rcp(1.0f + __expf(-x)); }
__device__ __forceinline__ float gelu_tanh(float x) { const float t = 1.5957691216057308f * (x + 0.044715f * x * x * x); return x * fast_rcp(1.0f + __expf(-t)); }
__device__ __forceinline__ float wave_sum(float v) {
#pragma unroll
    for (int o = 32; o >= 1; o >>= 1) v += __shfl_xor(v, o);
    return v;
}
__device__ __forceinline__ bf16x8 as_bf16x8(u32x4 v) { union { u32x4 u; bf16x8 b; } x; x.u = v; return x.b; }
__device__ __forceinline__ u32x4 as_u32x4(bf16x8 v) { union { u32x4 u; bf16x8 b; } x; x.b = v; return x.u; }
__device__ __forceinline__ bf16x8 ldk(const LAS unsigned char* p) { return *(const LAS bf16x8*)p; }
__device__ __forceinline__ bf16x8 ldt(const LAS unsigned char* base, int pitch, int fr, int fq) {
    const LAS unsigned char* p = base + (fq * 8 + (fr >> 2)) * pitch + (fr & 3) * 8;
    s16x4 a = __builtin_amdgcn_ds_read_tr16_b64_v4i16((LAS s16x4*)p);
    s16x4 b = __builtin_amdgcn_ds_read_tr16_b64_v4i16((LAS s16x4*)(p + 4 * pitch));
    bf16x8 r = {a[0], a[1], a[2], a[3], b[0], b[1], b[2], b[3]};
    return r;
}
__device__ __forceinline__ int opaque_tid(int wv) { int l; asm volatile("v_mbcnt_lo_u32_b32 %0, -1, 0\n\tv_mbcnt_hi_u32_b32 %0, -1, %0" : "=v"(l)); return (wv << 6) | l; }
#define MFMA16(a, b, c) __builtin_amdgcn_mfma_f32_16x16x32_bf16((a), (b), (c), 0, 0, 0)


#define XB_TMO      128
#define XB_XCNT(j)  (256  + 64 * (j))
#define XB_XSUB(j)  (1280 + 64 * (j))
#define XB_XGEN(j)  (2304 + 64 * (j))
#define XB_TOP      3328
#define XB_TOPGEN   3392
#define XCD_BAR_WORDS 3456
#define XB_SPIN_CAP (1u << 20)
__device__ __forceinline__ unsigned xb_ld(unsigned* p)              { return __hip_atomic_load(p, __ATOMIC_RELAXED, __HIP_MEMORY_SCOPE_AGENT); }
__device__ __forceinline__ unsigned xb_add(unsigned* p, unsigned v) { return __hip_atomic_fetch_add(p, v, __ATOMIC_RELAXED, __HIP_MEMORY_SCOPE_AGENT); }
__device__ __forceinline__ unsigned xb_xcc_id() { return (unsigned)__builtin_amdgcn_s_getreg((3 << 11) | 20) & 0xFu; }
#define XB_SPIN(cond, bar) do { unsigned _sp = 0; while (cond) { __builtin_amdgcn_s_sleep(1); \
    if ((++_sp & 255u) == 0u) { if (xb_ld(&(bar)[XB_TMO])) break; if (_sp > XB_SPIN_CAP) { atomicAdd(&(bar)[XB_TMO], 1u); break; } } } } while (0)
struct XcdBarrier { unsigned* bar; unsigned x; volatile LAS unsigned* st; };
__device__ __forceinline__ bool xb_leader(int wv) { return wv == 0 && __builtin_amdgcn_mbcnt_hi(~0u, __builtin_amdgcn_mbcnt_lo(~0u, 0u)) == 0u; }
__device__ __forceinline__ XcdBarrier xcd_barrier_post(unsigned* bar, volatile LAS unsigned* st, int wv) {
    XcdBarrier b; b.bar = bar; b.x = xb_xcc_id(); b.st = st;
    if (xb_leader(wv)) (void)xb_add(&bar[XB_XCNT(b.x)], 1u);
    return b;
}
__device__ __forceinline__ void xcd_barrier_complete(unsigned* bar, unsigned x, unsigned& nloc, unsigned& nx) {
    const unsigned G = gridDim.x * gridDim.y * gridDim.z;
    unsigned sum, cnt, mine, sp = 0u;
    for (;;) {
        sum = 0u; cnt = 0u; mine = 0u;
#pragma unroll
        for (unsigned j = 0; j < 16; ++j) { const unsigned c = xb_ld(&bar[XB_XCNT(j)]); sum += c; cnt += (c > 0u) ? 1u : 0u; mine = (j == x) ? c : mine; }
        if (sum == G) break;
        __builtin_amdgcn_s_sleep(1);
        if ((++sp & 255u) == 0u) { if (xb_ld(&bar[XB_TMO])) break; if (sp > XB_SPIN_CAP) { atomicAdd(&bar[XB_TMO], 1u); break; } }
    }
    nloc = mine > 0u ? mine : 1u; nx = cnt > 0u ? cnt : 1u;
}
__device__ __forceinline__ void xcd_barrier(const XcdBarrier& b, int wv) {
    asm volatile("s_waitcnt vmcnt(0)" ::: "memory");
    __syncthreads();
    if (xb_leader(wv)) {
        unsigned* bar = b.bar;
        __builtin_amdgcn_s_waitcnt(0);
        unsigned nloc = b.st[0], nx = b.st[1];
        if (nloc == 0u) { xcd_barrier_complete(bar, b.x, nloc, nx); b.st[0] = nloc; b.st[1] = nx; }
        const unsigned old = xb_add(&bar[XB_XSUB(b.x)], 1u);
        const unsigned gen = old / nloc;
        if (old + 1u == (gen + 1u) * nloc) {
            __builtin_amdgcn_fence(__ATOMIC_RELEASE, "agent");
            asm volatile("s_waitcnt vmcnt(0)" ::: "memory");
            const unsigned og = xb_add(&bar[XB_TOP], 1u);
            const unsigned tg = og / nx;
            if (og + 1u == (tg + 1u) * nx) xb_add(&bar[XB_TOPGEN], 1u);
            else XB_SPIN(xb_ld(&bar[XB_TOPGEN]) == tg, bar);
            __builtin_amdgcn_fence(__ATOMIC_ACQUIRE, "agent");
            xb_add(&bar[XB_XGEN(b.x)], 1u);
            asm volatile("s_waitcnt vmcnt(0)" ::: "memory");
        } else {
            XB_SPIN(xb_ld(&bar[XB_XGEN(b.x)]) == gen, bar);
            __builtin_amdgcn_fence(__ATOMIC_ACQUIRE, "agent");
            asm volatile("s_waitcnt vmcnt(0)" ::: "memory");
        }
    }
    __syncthreads();
}

namespace pg8 {
constexpr int BM = 256, BK = 64, HALF = 128, HTB = HALF * BK * 2, STAGE_BYTES = 8 * HTB, NXCD = 8, WGM = 8;
__device__ __forceinline__ int lds_byte(int r, int c) { const int st = (r >> 4) * 2 + (c >> 5), rr = r & 15, cc = c & 31, ob = rr * 64 + cc * 2; return st * 1024 + (ob ^ (((ob >> 9) & 1) << 5)); }
__device__ __forceinline__ void stage_rc(int b, int& R, int& C) { const int st = b / 1024, sb = b % 1024, swz = sb ^ (((sb >> 9) & 1) << 5); R = (st >> 1) * 16 + swz / 64; C = (st & 1) * 32 + (swz % 64) / 2; }
__device__ __forceinline__ int perm32(int rho) { const int n = rho >> 4, i = rho & 15; return 8 * (i >> 2) + 4 * n + (i & 3); }
struct Unit { int pm, pn; };
struct Gemm { const bf16_t* A; const bf16_t* Bt; int M, N, K, lda, ldb; };
struct StaticOrder {
    int nM, nN, nwg, G, c;
    __device__ void init(int M, int N, int G_, int c_) { nM = M / BM; nN = N / BM; nwg = nM * nN; G = G_; c = c_; }
    __device__ bool next(int i, Unit& u) const {
        const long L = (long)i * G + c; if (L >= nwg) return false;
        int wgid = (int)L; { const int q = nwg / NXCD, r = nwg % NXCD, xcd = wgid % NXCD, off = wgid / NXCD; wgid = (xcd < r ? xcd * (q + 1) : r * (q + 1) + (xcd - r) * q) + off; }
        const int nig = WGM * nN, gid = wgid / nig, fm = gid * WGM, gsz = (nM - fm) < WGM ? (nM - fm) : WGM;
        u.pm = fm + ((wgid % nig) % gsz); u.pn = (wgid % nig) / gsz; return true;
    }
};
template <class Epi>
__device__ __forceinline__ void gemm_phase(LAS unsigned char* lds, const Gemm g, const StaticOrder& S, const Epi& E, int wv) {
    const int tid = opaque_tid(wv), wid = __builtin_amdgcn_readfirstlane(tid >> 6), lane = tid & 63, wr = wid >> 2, wc = wid & 3, fr = lane & 15, fq = lane >> 4;
    const int K = g.K, nt = K / BK;
    unsigned voffA[2], voffB[2];
#pragma unroll
    for (int i = 0; i < 2; ++i) { int R, C; stage_rc(tid * 16 + i * 8192, R, C); const int Rb = (R & ~31) + perm32(R & 31);
        voffA[i] = (unsigned)(R * g.lda + C) * 2u; voffB[i] = (unsigned)(Rb * g.ldb + C) * 2u; }
    const size_t kstep = (size_t)(BK * 2);
    const size_t hstepA = (size_t)HALF * g.lda * 2, hstepB = (size_t)HALF * g.ldb * 2;
    const size_t tstepA = 2 * hstepA, tstepB = 2 * hstepB;
    const unsigned ldsw = (unsigned)wid * 1024u;
    const int aoff = lds_byte(wr * 64 + fr, fq * 8), boff = lds_byte(wc * 32 + fr, fq * 8);
#define PG8_SA(b, h) (((b) * 2 + (h)) * HTB)
#define PG8_SB(b, h) ((4 + (b) * 2 + (h)) * HTB)
#define PG8_STAGE(bufoff, gbase, voff) do { _Pragma("unroll") for (int _i = 0; _i < 2; ++_i) \
        __builtin_amdgcn_global_load_lds((const unsigned*)((const char*)(gbase) + (voff)[_i]), (LAS unsigned*)(lds + (bufoff) + ldsw + _i * 8192), 16, 0, 0); } while (0)
#define PG8_LDA(dst, b, h) do { _Pragma("unroll") for (int m = 0; m < 4; ++m) _Pragma("unroll") for (int k = 0; k < 2; ++k) dst[m][k] = *(const LAS bf16x8*)(lds + PG8_SA(b, h) + aoff + m * 2048 + k * 1024); } while (0)
#define PG8_LDB(dst, b, h) do { _Pragma("unroll") for (int n = 0; n < 2; ++n) _Pragma("unroll") for (int k = 0; k < 2; ++k) dst[n][k] = *(const LAS bf16x8*)(lds + PG8_SB(b, h) + boff + n * 2048 + k * 1024); } while (0)
#define PG8_MMA(ai, bj, At, Bt) do { __builtin_amdgcn_s_setprio(1); _Pragma("unroll") for (int m = 0; m < 4; ++m) _Pragma("unroll") for (int n = 0; n < 2; ++n) _Pragma("unroll") for (int k = 0; k < 2; ++k) \
        acc[ai][bj][m][n] = __builtin_amdgcn_mfma_f32_16x16x32_bf16(Bt[n][k], At[m][k], acc[ai][bj][m][n], 0, 0, 0); __builtin_amdgcn_s_setprio(0); } while (0)
#define PG8_WAIT_V(n) asm volatile("s_waitcnt vmcnt(" #n ")" ::: "memory")
#define PG8_WAIT_L(n) asm volatile("s_waitcnt lgkmcnt(" #n ")" ::: "memory")
#define PG8_BAR __builtin_amdgcn_s_barrier()
#define PG8_SCHED __builtin_amdgcn_sched_barrier(0)
    Unit cur, nxt; int ui = 0;
    if (!S.next(0, cur)) return;
    f32x4 acc[2][2][4][2];
#pragma unroll
    for (int a = 0; a < 2; ++a)
#pragma unroll
        for (int b = 0; b < 2; ++b)
#pragma unroll
            for (int m = 0; m < 4; ++m)
#pragma unroll
                for (int n = 0; n < 2; ++n) acc[a][b][m][n] = (f32x4){0.f, 0.f, 0.f, 0.f};
    bf16x8 At[4][2], B0[2][2], B1[2][2];
    const char* cA = (const char*)g.A + (size_t)cur.pm * tstepA; const char* cB = (const char*)g.Bt + (size_t)cur.pn * tstepB;
    PG8_STAGE(PG8_SB(0, 0), cB, voffB); PG8_STAGE(PG8_SA(0, 0), cA, voffA); PG8_STAGE(PG8_SB(0, 1), cB + hstepB, voffB); PG8_STAGE(PG8_SA(0, 1), cA + hstepA, voffA);
    if (wr == 1) PG8_BAR;
    PG8_WAIT_V(4); PG8_BAR;
    PG8_STAGE(PG8_SB(1, 0), cB + kstep, voffB); PG8_STAGE(PG8_SA(1, 0), cA + kstep, voffA); PG8_STAGE(PG8_SB(1, 1), cB + hstepB + kstep, voffB);
    PG8_WAIT_V(6); PG8_BAR;
    for (;;) {
        const bool has_next = S.next(ui + 1, nxt);
        const char* nA = has_next ? (const char*)g.A + (size_t)nxt.pm * tstepA : cA; const char* nB = has_next ? (const char*)g.Bt + (size_t)nxt.pn * tstepB : cB;
        for (int t = 0; t < nt; t += 2) {
            const bool last = (t == nt - 2);
            const char* a1 = cA + (size_t)(t + 1) * kstep;
            const char* a2 = last ? nA : cA + (size_t)(t + 2) * kstep; const char* b2 = last ? nB : cB + (size_t)(t + 2) * kstep;
            const char* a3 = a2 + kstep; const char* b3 = b2 + kstep;
            PG8_LDB(B0, 0, 0); PG8_SCHED; PG8_LDA(At, 0, 0); PG8_STAGE(PG8_SA(1, 1), a1 + hstepA, voffA);
            PG8_WAIT_L(8); PG8_BAR; PG8_WAIT_L(0); PG8_MMA(0, 0, At, B0); PG8_BAR; PG8_SCHED;
            PG8_LDB(B1, 0, 1); PG8_STAGE(PG8_SB(0, 0), b2, voffB);
            PG8_BAR; PG8_WAIT_L(0); PG8_MMA(0, 1, At, B1); PG8_BAR;
            PG8_LDA(At, 0, 1); PG8_STAGE(PG8_SA(0, 0), a2, voffA);
            PG8_BAR; PG8_WAIT_L(0); PG8_MMA(1, 0, At, B0); PG8_BAR; PG8_SCHED;
            PG8_STAGE(PG8_SB(0, 1), b2 + hstepB, voffB);
            PG8_WAIT_V(6); PG8_BAR; PG8_MMA(1, 1, At, B1); PG8_BAR;
            PG8_LDB(B0, 1, 0); PG8_SCHED; PG8_LDA(At, 1, 0); PG8_STAGE(PG8_SA(0, 1), a2 + hstepA, voffA);
            PG8_WAIT_L(8); PG8_BAR; PG8_WAIT_L(0); PG8_MMA(0, 0, At, B0); PG8_BAR; PG8_SCHED;
            PG8_LDB(B1, 1, 1); PG8_STAGE(PG8_SB(1, 0), b3, voffB);
            PG8_BAR; PG8_WAIT_L(0); PG8_MMA(0, 1, At, B1); PG8_BAR;
            PG8_LDA(At, 1, 1); PG8_STAGE(PG8_SA(1, 0), a3, voffA);
            PG8_BAR; PG8_WAIT_L(0); PG8_MMA(1, 0, At, B0); PG8_BAR; PG8_SCHED;
            PG8_STAGE(PG8_SB(1, 1), b3 + hstepB, voffB);
            PG8_WAIT_V(6); PG8_BAR; PG8_MMA(1, 1, At, B1); PG8_BAR;
        }
        E(acc, cur, wr, wc, fr, fq);
        if (!has_next) break;
#pragma unroll
        for (int a = 0; a < 2; ++a)
#pragma unroll
            for (int b = 0; b < 2; ++b)
#pragma unroll
                for (int m = 0; m < 4; ++m)
#pragma unroll
                    for (int n = 0; n < 2; ++n) acc[a][b][m][n] = (f32x4){0.f, 0.f, 0.f, 0.f};
        cur = nxt; cA = nA; cB = nB; ++ui;
    }
    PG8_WAIT_V(0);
    if (wr == 0) PG8_BAR;
    PG8_BAR;
#undef PG8_SA
#undef PG8_SB
#undef PG8_STAGE
#undef PG8_LDA
#undef PG8_LDB
#undef PG8_MMA
#undef PG8_WAIT_V
#undef PG8_WAIT_L
#undef PG8_BAR
#undef PG8_SCHED
}
}

struct EpiGen {
    bf16_t* O; int ldc; int act;
    float* gate; int gate_pn;
    __device__ __forceinline__ void operator()(const f32x4 (&acc)[2][2][4][2], const pg8::Unit& u, int wr, int wc, int fr_, int fq_) const {
        int fr = fr_, fq = fq_; asm volatile("" : "+v"(fr), "+v"(fq));
        const int row0 = u.pm * 256 + wr * 64 + fr;
        if (act == 3) {
            const int col0 = u.pn * 256 + wc * 32 + 8 * fq;
#pragma unroll
            for (int q = 0; q < 4; ++q) { const int ai = q >> 1; u32x4 pv[2][2];
#pragma unroll
                for (int mm = 0; mm < 2; ++mm)
#pragma unroll
                    for (int bj = 0; bj < 2; ++bj) pv[mm][bj] = *(const u32x4*)(O + (size_t)(row0 + ai * 128 + ((q & 1) * 2 + mm) * 16) * ldc + col0 + bj * 128);
#pragma unroll
                for (int mm = 0; mm < 2; ++mm)
#pragma unroll
                    for (int bj = 0; bj < 2; ++bj) { const int m = (q & 1) * 2 + mm; const f32x4 v0 = acc[ai][bj][m][0], v1 = acc[ai][bj][m][1]; const u32x4 pu = pv[mm][bj]; u32x4 w;
                        w.x = pk2(sigmoidf_(v0[0]) * bflo(pu.x), sigmoidf_(v0[1]) * bfhi(pu.x)); w.y = pk2(sigmoidf_(v0[2]) * bflo(pu.y), sigmoidf_(v0[3]) * bfhi(pu.y));
                        w.z = pk2(sigmoidf_(v1[0]) * bflo(pu.z), sigmoidf_(v1[1]) * bfhi(pu.z)); w.w = pk2(sigmoidf_(v1[2]) * bflo(pu.w), sigmoidf_(v1[3]) * bfhi(pu.w));
                        *(u32x4*)(O + (size_t)(row0 + ai * 128 + m * 16) * ldc + col0 + bj * 128) = w; }
                asm volatile("" ::: "memory"); }
            return;
        }
        if (u.pn == gate_pn) {
            if (wc == 0 && fq < 2) {
#pragma unroll
                for (int ai = 0; ai < 2; ++ai)
#pragma unroll
                    for (int m = 0; m < 4; ++m) { float* gp = gate + (size_t)(row0 + ai * 128 + m * 16) * 16 + 8 * fq;
                        *(f32x4*)gp = acc[ai][0][m][0]; *(f32x4*)(gp + 4) = acc[ai][0][m][1]; }
            }
            return;
        }
        const int col0 = u.pn * 256 + wc * 32 + 8 * fq;
#pragma unroll
        for (int ai = 0; ai < 2; ++ai)
#pragma unroll
            for (int m = 0; m < 4; ++m) { bf16_t* rowp = O + (size_t)(row0 + ai * 128 + m * 16) * ldc + col0;
#pragma unroll
                for (int bj = 0; bj < 2; ++bj) { f32x4 v0 = acc[ai][bj][m][0], v1 = acc[ai][bj][m][1];
                    if (act == 1) {
#pragma unroll
                        for (int j = 0; j < 4; ++j) { v0[j] = gelu_tanh(v0[j]); v1[j] = gelu_tanh(v1[j]); }
                    } else if (act == 2) {
#pragma unroll
                        for (int j = 0; j < 4; ++j) { const float a = fmaxf(v0[j], 0.f), b = fmaxf(v1[j], 0.f); v0[j] = a * a; v1[j] = b * b; }
                    } else if (act == 3) {
                        const u32x4 pu = *(const u32x4*)(rowp + bj * 128);
                        v0[0] = sigmoidf_(v0[0]) * bflo(pu.x); v0[1] = sigmoidf_(v0[1]) * bfhi(pu.x); v0[2] = sigmoidf_(v0[2]) * bflo(pu.y); v0[3] = sigmoidf_(v0[3]) * bfhi(pu.y);
                        v1[0] = sigmoidf_(v1[0]) * bflo(pu.z); v1[1] = sigmoidf_(v1[1]) * bfhi(pu.z); v1[2] = sigmoidf_(v1[2]) * bflo(pu.w); v1[3] = sigmoidf_(v1[3]) * bfhi(pu.w);
                    }
                    u32x4 w; w.x = pk2(v0[0], v0[1]); w.y = pk2(v0[2], v0[3]); w.z = pk2(v1[0], v1[1]); w.w = pk2(v1[2], v1[3]);
                    *(u32x4*)(rowp + bj * 128) = w; }
                asm volatile("" ::: "memory"); }
    }
};
struct EpiRg {
    const bf16_t* xc; bf16_t* loga; bf16_t* beta; const float* b_a; const float* b_x; const float* spt; int blk;
    __device__ __forceinline__ void operator()(const f32x4 (&acc)[2][2][4][2], const pg8::Unit& u, int wr, int wc, int fr_, int fq_) const {
        int fr = fr_, fq = fq_; asm volatile("" : "+v"(fr), "+v"(fq));
        const int row0 = u.pm * 256 + wr * 64 + fr;
        const int ch0 = blk * 256 + u.pn * 128 + wc * 32 + 8 * fq;
#pragma unroll
        for (int q = 0; q < 4; ++q) { const int ai = q >> 1; u32x4 xq[2];
#pragma unroll
            for (int mm = 0; mm < 2; ++mm) xq[mm] = *(const u32x4*)(xc + (size_t)(row0 + ai * 128 + ((q & 1) * 2 + mm) * 16) * 1024 + ch0);
            f32x4 ba[2], bx[2], sp[2];
#pragma unroll
            for (int hh = 0; hh < 2; ++hh) { ba[hh] = *(const f32x4*)(b_a + ch0 + hh * 4); bx[hh] = *(const f32x4*)(b_x + ch0 + hh * 4); sp[hh] = *(const f32x4*)(spt + ch0 + hh * 4); }
#pragma unroll
            for (int mm = 0; mm < 2; ++mm) { const int m = (q & 1) * 2 + mm; const size_t off = (size_t)(row0 + ai * 128 + m * 16) * 1024 + ch0; const u32x4 xv = xq[mm];
                u32x4 wl, wb;
#pragma unroll
                for (int hh = 0; hh < 2; ++hh) {
                    const unsigned x01 = hh ? xv.z : xv.x, x23 = hh ? xv.w : xv.y;
                    const float x[4] = {bflo(x01), bfhi(x01), bflo(x23), bfhi(x23)};
                    float la[4], be[4];
#pragma unroll
                    for (int e = 0; e < 4; ++e) { const float rp = acc[ai][0][m][hh][e] + ba[hh][e], ip = acc[ai][1][m][hh][e] + bx[hh][e];
                        const float r = sigmoidf_(rp), ig = sigmoidf_(ip); const float l = sp[hh][e] * r; la[e] = l;
                        be[e] = __builtin_amdgcn_sqrtf(fmaxf(1.0f - __expf(2.0f * l), 0.f)) * ig * x[e]; }
                    if (hh == 0) { wl.x = pk2(la[0], la[1]); wl.y = pk2(la[2], la[3]); wb.x = pk2(be[0], be[1]); wb.y = pk2(be[2], be[3]); }
                    else { wl.z = pk2(la[0], la[1]); wl.w = pk2(la[2], la[3]); wb.z = pk2(be[0], be[1]); wb.w = pk2(be[2], be[3]); }
                }
                *(u32x4*)(loga + off) = wl; *(u32x4*)(beta + off) = wb; }
            asm volatile("" ::: "memory"); }
    }
};

__device__ __forceinline__ void rowpass(const float* hin, const bf16_t* hinb, const bf16_t* y, const float* gadd, float* hout, bf16_t* houtb, const float* gnext, bf16_t* hn, int normnext,
                                        const float* psrc, bf16_t* pdst, const float* rs_in, const float* g_in, float* rs_out, int wv) {
    const int tid_ = opaque_tid(wv); const int lane = tid_ & 63, wave = tid_ >> 6;
    const int gw = blockIdx.x * 8 + wave, nw = gridDim.x * 8;
    f32x4 ga[4], gn[4], gi[4];
#pragma unroll
    for (int q = 0; q < 4; ++q) { gi[q] = (f32x4){1.f, 1.f, 1.f, 1.f}; if (rs_in) { const f32x4 t = *(const f32x4*)(g_in + q * 256 + lane * 4); gi[q] = (f32x4){fast_rcp(t[0]), fast_rcp(t[1]), fast_rcp(t[2]), fast_rcp(t[3])}; } }
#pragma unroll
    for (int q = 0; q < 4; ++q) { ga[q] = y ? *(const f32x4*)(gadd + q * 256 + lane * 4) : (f32x4){0.f, 0.f, 0.f, 0.f}; gn[q] = (hn && normnext) ? *(const f32x4*)(gnext + q * 256 + lane * 4) : (f32x4){1.f, 1.f, 1.f, 1.f}; }
    for (int row0_ = 4 * gw; row0_ < MTOK; row0_ += 4 * nw) {
        f32x4 h[4][4]; u32x2 yv[4][4]; f32x4 pv[4]; float rsi[4];
#pragma unroll
        for (int u = 0; u < 4; ++u) { const int row = row0_ + u; rsi[u] = 1.0f; if (row < MTOK) { const size_t base = (size_t)row * DM + lane * 4;
            if (rs_in) rsi[u] = rs_in[row];
            if (hin) {
#pragma unroll
                for (int q = 0; q < 4; ++q) h[u][q] = __builtin_nontemporal_load((const f32x4*)(hin + base + q * 256));
            } else {
#pragma unroll
                for (int q = 0; q < 4; ++q) { const u32x2 hv = __builtin_nontemporal_load((const u32x2*)(hinb + base + q * 256)); h[u][q] = (f32x4){bflo(hv.x), bfhi(hv.x), bflo(hv.y), bfhi(hv.y)}; }
            }
            if (y) {
#pragma unroll
                for (int q = 0; q < 4; ++q) yv[u][q] = __builtin_nontemporal_load((const u32x2*)(y + base + q * 256));
            }
            if (psrc) pv[u] = __builtin_nontemporal_load((const f32x4*)(psrc + (size_t)row * 256 + lane * 4)); } }
#pragma unroll
        for (int u = 0; u < 4; ++u) { const int row = row0_ + u; if (row < MTOK) { const size_t base = (size_t)row * DM + lane * 4;
            if (rs_in) { const float ir = fast_rcp(rsi[u]);
#pragma unroll
                for (int q = 0; q < 4; ++q) h[u][q] = h[u][q] * ir * gi[q]; }
            if (y) {
                f32x4 yf[4]; float ss = 0.f;
#pragma unroll
                for (int q = 0; q < 4; ++q) { yf[q] = (f32x4){bflo(yv[u][q].x), bfhi(yv[u][q].x), bflo(yv[u][q].y), bfhi(yv[u][q].y)}; ss += yf[q][0] * yf[q][0] + yf[q][1] * yf[q][1] + yf[q][2] * yf[q][2] + yf[q][3] * yf[q][3]; }
                ss = wave_sum(ss);
                const float rs = __builtin_amdgcn_rsqf(ss * (1.0f / DM) + EPS);
#pragma unroll
                for (int q = 0; q < 4; ++q) h[u][q] = h[u][q] + yf[q] * rs * ga[q];
            }
            if (hout) {
#pragma unroll
                for (int q = 0; q < 4; ++q) __builtin_nontemporal_store(h[u][q], (f32x4*)(hout + base + q * 256));
            }
            if (houtb) {
#pragma unroll
                for (int q = 0; q < 4; ++q) { u32x2 w; w.x = pk2(h[u][q][0], h[u][q][1]); w.y = pk2(h[u][q][2], h[u][q][3]); __builtin_nontemporal_store(w, (u32x2*)(houtb + base + q * 256)); }
            }
            if (hn) {
                float rs2 = 1.0f;
                if (normnext) { float ss = 0.f;
#pragma unroll
                    for (int q = 0; q < 4; ++q) ss += h[u][q][0] * h[u][q][0] + h[u][q][1] * h[u][q][1] + h[u][q][2] * h[u][q][2] + h[u][q][3] * h[u][q][3];
                    ss = wave_sum(ss); rs2 = __builtin_amdgcn_rsqf(ss * (1.0f / DM) + EPS); if (rs_out && lane == 0) rs_out[row] = rs2; }
#pragma unroll
                for (int q = 0; q < 4; ++q) { const f32x4 o = h[u][q] * rs2 * gn[q]; u32x2 w; w.x = pk2(o[0], o[1]); w.y = pk2(o[2], o[3]); __builtin_nontemporal_store(w, (u32x2*)(hn + base + q * 256)); }
            }
            if (psrc) { u32x2 w; w.x = pk2(pv[u][0], pv[u][1]); w.y = pk2(pv[u][2], pv[u][3]); __builtin_nontemporal_store(w, (u32x2*)(pdst + (size_t)row * 256 + lane * 4)); } } }
    }
}

struct TJob { const float* src; bf16_t* dst; int lds, ldd, K, nvalid, ntn, t0; };
__device__ __forceinline__ TJob make_tjob(KP P, int j) {
    TJob t; bf16_t* W = (bf16_t*)(P->ws + WS_W); int npad;
    if (j < 16) { const int i = j >> 2, k = j & 3; bf16_t* L = W + (size_t)i * LW;
        if (k == 0) { t.src = P->in[I_WUP] + (size_t)i * 1024 * 4096; t.lds = 4096; t.K = 1024; t.nvalid = 4096; t.dst = L; }
        else if (k == 1) { t.src = P->in[I_WDN] + (size_t)i * 4096 * 1024; t.lds = 1024; t.K = 4096; t.nvalid = 1024; t.dst = L + W_UP; }
        else if (k == 2) { t.src = P->in[I_PG] + (size_t)i * 1024 * 1024; t.lds = 1024; t.K = 1024; t.nvalid = 1024; t.dst = L + W_UP + W_DN; }
        else { t.src = P->in[I_PUP] + (size_t)i * 256 * 1024; t.lds = 1024; t.K = 256; t.nvalid = 1024; t.dst = L + W_UP + W_DN + W_G; }
        npad = t.nvalid; }
    else if (j == 16) { t.src = P->in[I_AIN]; t.lds = 3088; t.K = 1024; t.nvalid = 3088; npad = 3328; t.dst = W + OFF_A_IN; }
    else if (j == 17) { t.src = P->in[I_AOUT]; t.lds = 1024; t.K = 1024; t.nvalid = 1024; npad = 1024; t.dst = W + OFF_A_OUT; }
    else if (j == 18) { t.src = P->in[I_BIN]; t.lds = 4096; t.K = 1024; t.nvalid = 4096; npad = 4096; t.dst = W + OFF_B_IN; }
    else if (j == 19) { t.src = P->in[I_BOUT]; t.lds = 1024; t.K = 1024; t.nvalid = 1024; npad = 1024; t.dst = W + OFF_B_OUT; }
    else if (j == 20) { t.src = P->in[I_CIN]; t.lds = 4096; t.K = 1024; t.nvalid = 4096; npad = 4096; t.dst = W + OFF_C_IN; }
    else if (j == 21) { t.src = P->in[I_COUT]; t.lds = 1024; t.K = 2048; t.nvalid = 1024; npad = 1024; t.dst = W + OFF_C_OUT; }
    else if (j == 22) { t.src = P->in[I_DIN]; t.lds = 2048; t.K = 1024; t.nvalid = 2048; npad = 2048; t.dst = W + OFF_D_IN; }
    else if (j == 23) { t.src = P->in[I_DOUT]; t.lds = 1024; t.K = 1024; t.nvalid = 1024; npad = 1024; t.dst = W + OFF_D_OUT; }
    else { const int q = j - 24, blk = q >> 2, pn = (q >> 1) & 1, which = q & 1;
        t.src = (which ? P->in[I_DWX] : P->in[I_DWA]) + (size_t)blk * 65536 + pn * 128; t.lds = 256; t.K = 256; t.nvalid = 128; npad = 128;
        t.dst = W + OFF_D_G + (size_t)blk * 512 * 256 + (size_t)(pn * 256 + which * 128) * 256; }
    t.ldd = t.K; t.ntn = npad / 64; t.t0 = (t.K / 64) * t.ntn;
    return t;
}
constexpr int NTJOBS = 40;
__device__ __forceinline__ void prep_phase(KP P, LAS unsigned char* lds, int wv) {
    const int tid = opaque_tid(wv);
    LAS int* tstart = (LAS int*)(lds + 32768);
    LAS float* tile = (LAS float*)lds;
    if (tid == 0) { int s = 0; for (int j = 0; j < NTJOBS; ++j) { tstart[j] = s; s += make_tjob(P, j).t0; } tstart[NTJOBS] = s; }
    __syncthreads();
    const int total = tstart[NTJOBS];
    for (int gt = blockIdx.x; gt < total; gt += gridDim.x) {
        int j = 0; while (tstart[j + 1] <= gt) ++j;
        const TJob t = make_tjob(P, j);
        const int lt = gt - tstart[j]; const int kt = lt / t.ntn, ntile = lt - kt * t.ntn; const int k0 = kt * 64, n0 = ntile * 64;
        { const int kk = tid >> 4, nn = (tid & 15) * 4;
#pragma unroll
            for (int i = 0; i < 2; ++i) { const int k = kk + 32 * i; f32x4 v = (f32x4){0.f, 0.f, 0.f, 0.f};
                if (n0 + nn < t.nvalid) v = *(const f32x4*)(t.src + (size_t)(k0 + k) * t.lds + n0 + nn);
                tile[k * 65 + nn] = v[0]; tile[k * 65 + nn + 1] = v[1]; tile[k * 65 + nn + 2] = v[2]; tile[k * 65 + nn + 3] = v[3]; } }
        __syncthreads();
        { const int n = tid >> 3, k8 = (tid & 7) * 8; float v[8];
#pragma unroll
            for (int e = 0; e < 8; ++e) v[e] = tile[(k8 + e) * 65 + n];
            u32x4 w; w.x = pk2(v[0], v[1]); w.y = pk2(v[2], v[3]); w.z = pk2(v[4], v[5]); w.w = pk2(v[6], v[7]);
            *(u32x4*)(t.dst + (size_t)(n0 + n) * t.ldd + k0 + k8) = w; }
        __syncthreads();
    }
    { bf16_t* Wsb = (bf16_t*)(P->ws + WS_W) + OFF_C_WS; const float* sw = P->in[I_CSW];
        for (int i = blockIdx.x * NTHREADS + tid; i < 8 * 128 * 128; i += gridDim.x * NTHREADS) { const int s = i & 127, t = (i >> 7) & 127; Wsb[i] = f2bf(s <= t ? sw[i] : 0.f); } }
    if (blockIdx.x == 0) { float* lb = (float*)(P->ws + WS_LB); const float* s = P->in[I_BLB];
        for (int c = tid; c < 1024; c += NTHREADS) { const float a0 = s[c], a1 = s[1024 + c], a2 = s[2048 + c], a3 = s[3072 + c]; const float mx = fmaxf(fmaxf(a0, a1), fmaxf(a2, a3));
            const float e0 = __expf(a0 - mx), e1 = __expf(a1 - mx), e2 = __expf(a2 - mx), e3 = __expf(a3 - mx); lb[c] = e1 * fast_rcp(e0 + e1 + e2 + e3);
            lb[1024 + c] = -8.0f * __logf(1.0f + __expf(-P->in[I_DLAM][c])); } }
    rowpass(P->in[I_X], nullptr, nullptr, nullptr, nullptr, nullptr, P->in[I_NG], (bf16_t*)(P->ws + WS_HN), 1, nullptr, nullptr, nullptr, nullptr, (float*)(P->ws + WS_LB + 512 * 1024), wv);
}

__device__ __forceinline__ float incl_scan_sum(float v, int lane) {
#pragma unroll
    for (int d = 1; d < 64; d <<= 1) { const float t = __shfl_up(v, d); if (lane >= d) v += t; }
    return v;
}
__device__ __forceinline__ float incl_scan_max(float v, int lane) {
#pragma unroll
    for (int d = 1; d < 64; d <<= 1) { const float t = __shfl_up(v, d); if (lane >= d) v = fmaxf(v, t); }
    return v;
}
#define LDS_BARRIER() do { asm volatile("s_waitcnt lgkmcnt(0)" ::: "memory"); __builtin_amdgcn_s_barrier(); asm volatile("" ::: "memory"); } while (0)
__device__ __forceinline__ void mlstm_core(KP P, LAS unsigned char* lds, int wv) {
    const int tid = opaque_tid(wv), w = __builtin_amdgcn_readfirstlane(tid >> 6), lane = tid & 63, fr = lane & 15, fq = lane >> 4;
    const bf16_t* z = (const bf16_t*)(P->ws + WS_Z); const float* gate = (const float*)(P->ws + WS_GATE); bf16_t* yout = (bf16_t*)(P->ws + WS_YP);
    constexpr int PQ = 160, PV = 352, PP = 288, PC = 160;
    LAS unsigned char* Qs = lds; LAS unsigned char* Ks = lds + 20480; LAS unsigned char* Vs = lds + 40960; LAS unsigned char* Ps = lds + 86016; LAS unsigned char* Cb = lds + 122880;
    LAS float* fa = (LAS float*)(lds + 145920); LAS float* fM = fa + 128; LAS float* fb = fa + 256; LAS float* fwk = fa + 384;
    for (int unit = blockIdx.x; unit < 256; unit += gridDim.x) {
        const int b = unit >> 3, h = unit & 7;
        const float ib = P->in[I_AIB][h], fbias = P->in[I_AFB][h];
        __syncthreads();
        for (int i = tid; i < 144 * 80 / 2; i += NTHREADS) ((LAS unsigned*)Cb)[i] = 0u;
        if (tid < 128) { LAS unsigned* vp = (LAS unsigned*)(Vs + tid * PV + 256); unsigned zz, one; asm volatile("v_mov_b32 %0, 0" : "=v"(zz)); asm volatile("v_mov_b32 %0, 0x3f80" : "=v"(one)); vp[0] = one;
#pragma unroll
            for (int i = 1; i < 16; ++i) vp[i] = zz; }
        f32x4 st[5];
#pragma unroll
        for (int i = 0; i < 5; ++i) st[i] = (f32x4){0.f, 0.f, 0.f, 0.f};
        float m_state = 0.f;
        u32x4 nq[2], nk[2], nv[4]; float nig = 0.f, nfg = 0.f;
        { const size_t r0 = (size_t)b * SEQL;
#pragma unroll
            for (int i = 0; i < 2; ++i) { const int idx = tid + i * 512, row = idx >> 3, pc = idx & 7;
                nq[i] = *(const u32x4*)(z + (r0 + row) * 3072 + h * 64 + pc * 8); nk[i] = *(const u32x4*)(z + (r0 + row) * 3072 + 512 + h * 64 + pc * 8); }
#pragma unroll
            for (int i = 0; i < 4; ++i) { const int idx = tid + i * 512, row = idx >> 4, pc = idx & 15; nv[i] = *(const u32x4*)(z + (r0 + row) * 3072 + 1024 + h * 128 + pc * 8); }
            if (tid < 128) { nig = gate[(r0 + tid) * 16 + h]; nfg = gate[(r0 + tid) * 16 + 8 + h]; } }
        for (int chunk = 0; chunk < 16; ++chunk) {
            const size_t r0 = (size_t)b * SEQL + chunk * 128;
#pragma unroll
            for (int i = 0; i < 2; ++i) { const int idx = tid + i * 512, row = idx >> 3, pc = idx & 7;
                u32x4 q = nq[i];
                q.x = pk2(bflo(q.x) * 0.125f, bfhi(q.x) * 0.125f); q.y = pk2(bflo(q.y) * 0.125f, bfhi(q.y) * 0.125f); q.z = pk2(bflo(q.z) * 0.125f, bfhi(q.z) * 0.125f); q.w = pk2(bflo(q.w) * 0.125f, bfhi(q.w) * 0.125f);
                *(LAS u32x4*)(Qs + row * PQ + pc * 16) = q;
                *(LAS u32x4*)(Ks + row * PQ + pc * 16) = nk[i]; }
#pragma unroll
            for (int i = 0; i < 4; ++i) { const int idx = tid + i * 512, row = idx >> 4, pc = idx & 15;
                *(LAS u32x4*)(Vs + row * PV + pc * 16) = nv[i]; }
            if (tid < 128) { const float ig = nig, fg = nfg;
                const float xf = fg + fbias; const float lf = fminf(xf, 0.f) - __logf(1.0f + __expf(-fabsf(xf)));
                fa[tid] = ig + ib; fb[tid] = lf; }
            if (chunk + 1 < 16) { const size_t r1 = r0 + 128;
#pragma unroll
                for (int i = 0; i < 2; ++i) { const int idx = tid + i * 512, row = idx >> 3, pc = idx & 7;
                    nq[i] = *(const u32x4*)(z + (r1 + row) * 3072 + h * 64 + pc * 8); nk[i] = *(const u32x4*)(z + (r1 + row) * 3072 + 512 + h * 64 + pc * 8); }
#pragma unroll
                for (int i = 0; i < 4; ++i) { const int idx = tid + i * 512, row = idx >> 4, pc = idx & 15; nv[i] = *(const u32x4*)(z + (r1 + row) * 3072 + 1024 + h * 128 + pc * 8); }
                if (tid < 128) { nig = gate[(r1 + tid) * 16 + h]; nfg = gate[(r1 + tid) * 16 + 8 + h]; } }
            LDS_BARRIER();
            if (w == 0) {
                const float lf0 = fb[lane], lf1 = fb[64 + lane], li0 = fa[lane], li1 = fa[64 + lane];
                const float c0 = incl_scan_sum(lf0, lane); const float tot0 = __int_as_float(__builtin_amdgcn_readlane(__float_as_int(c0), 63)); const float c1 = incl_scan_sum(lf1, lane) + tot0;
                const float a0 = li0 - c0, a1 = li1 - c1;
                const float p0 = incl_scan_max(a0, lane); const float pt = __int_as_float(__builtin_amdgcn_readlane(__float_as_int(p0), 63)); const float p1 = fmaxf(incl_scan_max(a1, lane), pt);
                const float M0 = fmaxf(m_state, p0), M1 = fmaxf(m_state, p1);
                const float Ml = __int_as_float(__builtin_amdgcn_readlane(__float_as_int(M1), 63));
                fa[lane] = a0; fa[64 + lane] = a1; fM[lane] = M0; fM[64 + lane] = M1; fb[lane] = c0; fb[64 + lane] = c1;
                fwk[lane] = __expf(a0 - Ml); fwk[64 + lane] = __expf(a1 - Ml);
            }
            LDS_BARRIER();
            const float Mlast = fM[127], blast = fb[127];
            const int t = 16 * w + fr;
            const float Mt = fM[t], bt = fb[t];
            const float winter = __expf(m_state - Mt);
            u32x2 ogv[8];
#pragma unroll
            for (int n = 0; n < 8; ++n) ogv[n] = *(const u32x2*)(z + (r0 + t) * 3072 + 2048 + h * 128 + 16 * n + fq * 4);
            bf16x8 qf[2];
            qf[0] = ldk(Qs + t * PQ + fq * 16); qf[1] = ldk(Qs + t * PQ + 64 + fq * 16);
            for (int n = 0; n <= (w | 1); ++n) {
                f32x4 a = (f32x4){0.f, 0.f, 0.f, 0.f};
                if (n <= w) {
                    const bf16x8 k0 = ldk(Ks + (16 * n + fr) * PQ + fq * 16), k1 = ldk(Ks + (16 * n + fr) * PQ + 64 + fq * 16);
                    a = MFMA16(k0, qf[0], a); a = MFMA16(k1, qf[1], a);
                    const f32x4 as4 = *(const LAS f32x4*)(fa + 16 * n + fq * 4);
#pragma unroll
                    for (int j = 0; j < 4; ++j) { const int s = 16 * n + fq * 4 + j; a[j] = (s <= t) ? a[j] * __expf(as4[j] - Mt) : 0.f; }
                }
                u32x2 pw; pw.x = pk2(a[0], a[1]); pw.y = pk2(a[2], a[3]);
                *(LAS u32x2*)(Ps + t * PP + (16 * n + fq * 4) * 2) = pw;
            }
            asm volatile("s_waitcnt lgkmcnt(0)" ::: "memory");
            f32x4 o[9];
#pragma unroll
            for (int n = 0; n < 9; ++n) { f32x4 c = (f32x4){0.f, 0.f, 0.f, 0.f};
                c = MFMA16(ldk(Cb + (16 * n + fr) * PC + fq * 16), qf[0], c); c = MFMA16(ldk(Cb + (16 * n + fr) * PC + 64 + fq * 16), qf[1], c);
                o[n] = c * winter; }
            for (int ks = 0; ks <= (w >> 1); ++ks) {
                const bf16x8 pf = ldk(Ps + t * PP + ks * 64 + fq * 16);
#pragma unroll
                for (int n = 0; n < 9; ++n) o[n] = MFMA16(ldt(Vs + (ks * 32) * PV + (16 * n) * 2, PV, fr, fq), pf, o[n]);
            }
            {
                float den = __shfl(o[8][0], fr);
                const float dn = fast_rcp(fmaxf(fabsf(den), __expf(-(bt + Mt))));
                float ss = 0.f;
#pragma unroll
                for (int n = 0; n < 8; ++n) { o[n] = o[n] * dn; ss += o[n][0] * o[n][0] + o[n][1] * o[n][1] + o[n][2] * o[n][2] + o[n][3] * o[n][3]; }
                ss += __shfl_xor(ss, 16); ss += __shfl_xor(ss, 32);
                const float rs = __builtin_amdgcn_rsqf(ss * (1.0f / 128.0f) + EPS);
                const float* hg = P->in[I_AHG] + h * 128;
#pragma unroll
                for (int n = 0; n < 8; ++n) { const int v0 = 16 * n + fq * 4;
                    const u32x2 og = ogv[n];
                    const f32x4 g4 = *(const f32x4*)(hg + v0);
                    const float y0 = o[n][0] * rs * g4[0] * sigmoidf_(bflo(og.x)), y1 = o[n][1] * rs * g4[1] * sigmoidf_(bfhi(og.x));
                    const float y2 = o[n][2] * rs * g4[2] * sigmoidf_(bflo(og.y)), y3 = o[n][3] * rs * g4[3] * sigmoidf_(bfhi(og.y));
                    u32x2 yw; yw.x = pk2(y0, y1); yw.y = pk2(y2, y3);
                    *(u32x2*)(yout + (r0 + t) * 1024 + h * 128 + v0) = yw; }
            }
            {
                const float decay = __expf(m_state - Mlast);
#pragma unroll
                for (int i = 0; i < 5; ++i) st[i] = st[i] * decay;
                for (int ks = 0; ks < 4; ++ks) {
                    const f32x4 wa = *(const LAS f32x4*)(fwk + ks * 32 + fq * 8), wb = *(const LAS f32x4*)(fwk + ks * 32 + fq * 8 + 4);
                    const bf16x8 vf = ldt(Vs + (ks * 32) * PV + (16 * w) * 2, PV, fr, fq);
                    bf16x8 kf[4];
#pragma unroll
                    for (int dt = 0; dt < 4; ++dt) { const u32x4 kr = as_u32x4(ldt(Ks + (ks * 32) * PQ + (16 * dt) * 2, PQ, fr, fq)); u32x4 ksc;
                        ksc.x = pk2(bflo(kr.x) * wa[0], bfhi(kr.x) * wa[1]); ksc.y = pk2(bflo(kr.y) * wa[2], bfhi(kr.y) * wa[3]);
                        ksc.z = pk2(bflo(kr.z) * wb[0], bfhi(kr.z) * wb[1]); ksc.w = pk2(bflo(kr.w) * wb[2], bfhi(kr.w) * wb[3]);
                        kf[dt] = as_bf16x8(ksc); st[dt] = MFMA16(kf[dt], vf, st[dt]); }
                    if (w < 4) { const bf16x8 v8 = ldt(Vs + (ks * 32) * PV + 128 * 2, PV, fr, fq);
                        const bf16x8 kw = (w == 0) ? kf[0] : (w == 1) ? kf[1] : (w == 2) ? kf[2] : kf[3];
                        st[4] = MFMA16(kw, v8, st[4]); }
                }
            }
            m_state = blast + Mlast;
            LDS_BARRIER();
#pragma unroll
            for (int dt = 0; dt < 4; ++dt) { u32x2 cw; cw.x = pk2(st[dt][0], st[dt][1]); cw.y = pk2(st[dt][2], st[dt][3]);
                *(LAS u32x2*)(Cb + (16 * w + fr) * PC + (16 * dt + fq * 4) * 2) = cw; }
            if (w < 4) { u32x2 cw; cw.x = pk2(st[4][0], st[4][1]); cw.y = pk2(st[4][2], st[4][3]);
                *(LAS u32x2*)(Cb + (128 + fr) * PC + (16 * w + fq * 4) * 2) = cw; }
        }
    }
    __syncthreads();
}

__device__ __forceinline__ void hgrn_core(KP P, LAS unsigned char* lds, int wv) {
    const int tid = opaque_tid(wv), w = __builtin_amdgcn_readfirstlane(tid >> 6), lane = tid & 63, fr = lane & 15, fq = lane >> 4;
    const bf16_t* z = (const bf16_t*)(P->ws + WS_Z); const float* lbv = (const float*)(P->ws + WS_LB); bf16_t* yout = (bf16_t*)(P->ws + WS_YP);
    constexpr int PT = 288, PA = 96;
    LAS unsigned char* Qt = lds; LAS unsigned char* Qh = lds + 9216; LAS unsigned char* Kh = lds + 18432; LAS unsigned char* Vs = lds + 27648; LAS unsigned char* At = lds + 36864;
    LAS unsigned char* Sb = lds + 40960;
    LAS float* gl = (LAS float*)(lds + 77824);
    LAS float* seg = (LAS float*)(lds + 78336);
    LAS float* ssp = (LAS float*)(lds + 80384);
    const int c = tid & 127, tq = tid >> 7;
    for (int unit = blockIdx.x; unit < 256; unit += gridDim.x) {
        const int b = unit >> 3, h = unit & 7;
        const float lb = lbv[h * 128 + c];
        __syncthreads();
        for (int i = tid; i < 128 * 144 / 2; i += NTHREADS) ((LAS unsigned*)Sb)[i] = 0u;
        f32x4 S[8];
#pragma unroll
        for (int i = 0; i < 8; ++i) S[i] = (f32x4){0.f, 0.f, 0.f, 0.f};
        bf16_t nq[8], nf[8]; u32x4 nv; u32x2 ng2[2];
        { const size_t r0 = (size_t)b * SEQL;
#pragma unroll
            for (int i = 0; i < 8; ++i) { const size_t ro = (r0 + tq * 8 + i) * 4096 + h * 128 + c; nq[i] = z[ro]; nf[i] = z[ro + 1024]; }
            nv = *(const u32x4*)(z + (r0 + (tid >> 4)) * 4096 + 2048 + h * 128 + (tid & 15) * 8);
#pragma unroll
            for (int tt = 0; tt < 2; ++tt) ng2[tt] = *(const u32x2*)(z + (r0 + 16 * tt + fr) * 4096 + 3072 + h * 128 + 16 * w + fq * 4); }
        for (int chunk = 0; chunk < 64; ++chunk) {
            const size_t r0 = (size_t)b * SEQL + chunk * 32;
            float qv[8], kv[8], cs[8];
            const u32x2 cg0 = ng2[0], cg1 = ng2[1];
            { float run = 0.f;
#pragma unroll
                for (int i = 0; i < 8; ++i) {
                    qv[i] = bf2f(nq[i]); const float fz = bf2f(nf[i]);
                    const float f = lb + (1.0f - lb) * sigmoidf_(fz); kv[i] = 1.0f - f; run += __logf(f); cs[i] = run; }
                seg[tq * 128 + c] = run; }
            { const int row = tid >> 4, pc = tid & 15;
                *(LAS u32x4*)(Vs + row * PT + pc * 16) = nv; }
            if (chunk + 1 < 64) { const size_t r1 = r0 + 32;
#pragma unroll
                for (int i = 0; i < 8; ++i) { const size_t ro = (r1 + tq * 8 + i) * 4096 + h * 128 + c; nq[i] = z[ro]; nf[i] = z[ro + 1024]; }
                nv = *(const u32x4*)(z + (r1 + (tid >> 4)) * 4096 + 2048 + h * 128 + (tid & 15) * 8);
#pragma unroll
                for (int tt = 0; tt < 2; ++tt) ng2[tt] = *(const u32x2*)(z + (r1 + 16 * tt + fr) * 4096 + 3072 + h * 128 + 16 * w + fq * 4); }
            LDS_BARRIER();
            { const float s0 = seg[c], s1 = seg[128 + c], s2 = seg[256 + c], s3 = seg[384 + c];
                const float pre = (tq > 0 ? s0 : 0.f) + (tq > 1 ? s1 : 0.f) + (tq > 2 ? s2 : 0.f); const float glast = (s0 + s1) + (s2 + s3);
#pragma unroll
                for (int i = 0; i < 8; ++i) { const float g = pre + cs[i]; const int t = tq * 8 + i;
                    const float eg = __expf(g), er = __expf(g - glast);
                    *(LAS bf16_t*)(Qh + t * PT + c * 2) = f2bf(qv[i] * eg);
                    *(LAS bf16_t*)(Qt + t * PT + c * 2) = f2bf(qv[i] * er);
                    *(LAS bf16_t*)(Kh + t * PT + c * 2) = f2bf(kv[i] * fast_rcp(er)); }
                if (tq == 0) gl[c] = __expf(glast); }
            LDS_BARRIER();
            f32x4 o[2];
#pragma unroll
            for (int tt = 0; tt < 2; ++tt) { f32x4 a = (f32x4){0.f, 0.f, 0.f, 0.f};
#pragma unroll
                for (int ks = 0; ks < 4; ++ks) a = MFMA16(ldk(Sb + (16 * w + fr) * PT + ks * 64 + fq * 16), ldk(Qh + (16 * tt + fr) * PT + ks * 64 + fq * 16), a);
                o[tt] = a; }
            if (w < 4) { const int tt = w >> 1, stl = w & 1; f32x4 a = (f32x4){0.f, 0.f, 0.f, 0.f};
                if (!(tt == 0 && stl == 1)) {
#pragma unroll
                    for (int ks = 0; ks < 4; ++ks) a = MFMA16(ldk(Kh + (16 * stl + fr) * PT + ks * 64 + fq * 16), ldk(Qt + (16 * tt + fr) * PT + ks * 64 + fq * 16), a);
                    const int t = 16 * tt + fr;
#pragma unroll
                    for (int j = 0; j < 4; ++j) { const int s = 16 * stl + fq * 4 + j; if (s > t) a[j] = 0.f; }
                }
                u32x2 aw; aw.x = pk2(a[0], a[1]); aw.y = pk2(a[2], a[3]);
                *(LAS u32x2*)(At + (16 * tt + fr) * PA + (16 * stl + fq * 4) * 2) = aw; }
            LDS_BARRIER();
            { const bf16x8 vf = ldt(Vs + (16 * w) * 2, PT, fr, fq);
#pragma unroll
                for (int tt = 0; tt < 2; ++tt) { o[tt] = MFMA16(vf, ldk(At + (16 * tt + fr) * PA + fq * 16), o[tt]);
                    float ss = o[tt][0] * o[tt][0] + o[tt][1] * o[tt][1] + o[tt][2] * o[tt][2] + o[tt][3] * o[tt][3];
                    ss += __shfl_xor(ss, 16); ss += __shfl_xor(ss, 32);
                    if (fq == 0) ssp[(16 * tt + fr) * 8 + w] = ss; }
                const bf16x8 kf = ldt(Kh + (16 * w) * 2, PT, fr, fq);
                const f32x4 dc = *(const LAS f32x4*)(gl + 16 * w + fq * 4);
#pragma unroll
                for (int vt = 0; vt < 8; ++vt) { S[vt] = S[vt] * dc; S[vt] = MFMA16(kf, ldt(Vs + (16 * vt) * 2, PT, fr, fq), S[vt]); } }
            LDS_BARRIER();
#pragma unroll
            for (int vt = 0; vt < 8; ++vt) { u32x2 sw; sw.x = pk2(S[vt][0], S[vt][1]); sw.y = pk2(S[vt][2], S[vt][3]);
                *(LAS u32x2*)(Sb + (16 * vt + fr) * PT + (16 * w + fq * 4) * 2) = sw; }
            { const float* hg = P->in[I_BHG] + h * 128; const int v0 = 16 * w + fq * 4; const f32x4 g4 = *(const f32x4*)(hg + v0);
#pragma unroll
                for (int tt = 0; tt < 2; ++tt) { const int t = 16 * tt + fr;
                    const f32x4 sa = *(const LAS f32x4*)(ssp + t * 8), sb = *(const LAS f32x4*)(ssp + t * 8 + 4);
                    const float tot = ((sa[0] + sa[1]) + (sa[2] + sa[3])) + ((sb[0] + sb[1]) + (sb[2] + sb[3]));
                    const float rs = __builtin_amdgcn_rsqf(tot * (1.0f / 128.0f) + EPS);
                    const u32x2 gg = tt ? cg1 : cg0;
                    const float g0 = bflo(gg.x), g1 = bfhi(gg.x), g2 = bflo(gg.y), g3 = bfhi(gg.y);
                    const float y0 = o[tt][0] * rs * g4[0] * g0 * sigmoidf_(g0), y1 = o[tt][1] * rs * g4[1] * g1 * sigmoidf_(g1);
                    const float y2 = o[tt][2] * rs * g4[2] * g2 * sigmoidf_(g2), y3 = o[tt][3] * rs * g4[3] * g3 * sigmoidf_(g3);
                    u32x2 yw; yw.x = pk2(y0, y1); yw.y = pk2(y2, y3);
                    *(u32x2*)(yout + (r0 + t) * 1024 + h * 128 + v0) = yw; } }
        }
    }
    __syncthreads();
}

__device__ __forceinline__ void spatial_core(KP P, LAS unsigned char* lds, int wv) {
    const int tid = opaque_tid(wv), w = __builtin_amdgcn_readfirstlane(tid >> 6), lane = tid & 63, fr = lane & 15, fq = lane >> 4;
    bf16_t* z = (bf16_t*)(P->ws + WS_Z); const bf16_t* Wsb = (const bf16_t*)(P->ws + WS_W) + OFF_C_WS;
    constexpr int PVh = 544, PW = 288;
    LAS unsigned char* Vh = lds; LAS unsigned char* Wg = lds + 69632; LAS float* mu = (LAS float*)(lds + 106496); LAS float* rsd = mu + 128;
    for (int unit = blockIdx.x; unit < 512; unit += gridDim.x) {
        const size_t r0 = (size_t)unit * 128;
        __syncthreads();
        for (int rb = 0; rb < 4; ++rb) { u32x4 xr[4][4];
#pragma unroll
            for (int j = 0; j < 4; ++j)
#pragma unroll
                for (int q = 0; q < 4; ++q) xr[j][q] = *(const u32x4*)(z + (r0 + 16 * w + rb * 4 + j) * 4096 + 2048 + (q * 64 + lane) * 8);
#pragma unroll
            for (int j = 0; j < 4; ++j) { const int row = 16 * w + rb * 4 + j; float x[32]; float s = 0.f;
#pragma unroll
                for (int q = 0; q < 4; ++q) { const u32x4 v = xr[j][q];
                    x[q * 8 + 0] = bflo(v.x); x[q * 8 + 1] = bfhi(v.x); x[q * 8 + 2] = bflo(v.y); x[q * 8 + 3] = bfhi(v.y); x[q * 8 + 4] = bflo(v.z); x[q * 8 + 5] = bfhi(v.z); x[q * 8 + 6] = bflo(v.w); x[q * 8 + 7] = bfhi(v.w); }
#pragma unroll
                for (int e = 0; e < 32; ++e) s += x[e];
                s = wave_sum(s); const float mean = s * (1.0f / 2048.0f); float qd = 0.f;
#pragma unroll
                for (int e = 0; e < 32; ++e) { const float d = x[e] - mean; qd += d * d; }
                qd = wave_sum(qd);
                if (lane == 0) { mu[row] = mean; rsd[row] = __builtin_amdgcn_rsqf(qd * (1.0f / 2048.0f) + EPS); } } }
        __syncthreads();
        const int pc = tid & 31;
        u32x4 pvr[8], pwr[4];
#define SP_LOADG(gg) do { _Pragma("unroll") for (int i = 0; i < 8; ++i) pvr[i] = *(const u32x4*)(z + (r0 + (tid >> 5) + i * 16) * 4096 + 2048 + (gg) * 256 + pc * 8); \
            _Pragma("unroll") for (int i = 0; i < 4; ++i) { const int idx = tid + i * 512; pwr[i] = *(const u32x4*)(Wsb + (size_t)(gg) * 16384 + (idx >> 4) * 128 + (idx & 15) * 8); } } while (0)
        SP_LOADG(0);
        for (int g = 0; g < 8; ++g) {
            { float gn[8], bi[8];
#pragma unroll
                for (int e = 0; e < 8; ++e) { gn[e] = P->in[I_CLG][g * 256 + pc * 8 + e]; bi[e] = P->in[I_CLB][g * 256 + pc * 8 + e]; }
#pragma unroll
                for (int i = 0; i < 8; ++i) { const int row = (tid >> 5) + i * 16;
                    const u32x4 v = pvr[i]; const float m = mu[row], r = rsd[row];
                    u32x4 o; o.x = pk2((bflo(v.x) - m) * r * gn[0] + bi[0], (bfhi(v.x) - m) * r * gn[1] + bi[1]); o.y = pk2((bflo(v.y) - m) * r * gn[2] + bi[2], (bfhi(v.y) - m) * r * gn[3] + bi[3]);
                    o.z = pk2((bflo(v.z) - m) * r * gn[4] + bi[4], (bfhi(v.z) - m) * r * gn[5] + bi[5]); o.w = pk2((bflo(v.w) - m) * r * gn[6] + bi[6], (bfhi(v.w) - m) * r * gn[7] + bi[7]);
                    *(LAS u32x4*)(Vh + row * PVh + pc * 16) = o; }
#pragma unroll
                for (int i = 0; i < 4; ++i) { const int idx = tid + i * 512, row = idx >> 4, p2 = idx & 15;
                    *(LAS u32x4*)(Wg + row * PW + p2 * 16) = pwr[i]; } }
            u32x2 upre[8][2]; float bsv[8];
#pragma unroll
            for (int tt = 0; tt < 8; ++tt) { const int t = 16 * tt + fr; const bf16_t* up = z + (r0 + t) * 4096 + g * 256 + 32 * w + fq * 4;
                upre[tt][0] = *(const u32x2*)up; upre[tt][1] = *(const u32x2*)(up + 16); bsv[tt] = P->in[I_CSB][g * 128 + t]; }
            if (g + 1 < 8) SP_LOADG(g + 1);
            LDS_BARRIER();
            bf16x8 bf[2][4];
#pragma unroll
            for (int ci = 0; ci < 2; ++ci)
#pragma unroll
                for (int ks = 0; ks < 4; ++ks) bf[ci][ks] = ldt(Vh + (ks * 32) * PVh + (16 * (2 * w + ci)) * 2, PVh, fr, fq);
#pragma unroll
            for (int tt = 0; tt < 8; ++tt) { f32x4 a0 = (f32x4){0.f, 0.f, 0.f, 0.f}, a1 = a0;
#pragma unroll
                for (int ks = 0; ks < 4; ++ks) if (ks <= (tt >> 1)) { const bf16x8 af = ldk(Wg + (16 * tt + fr) * PW + ks * 64 + fq * 16); a0 = MFMA16(bf[0][ks], af, a0); a1 = MFMA16(bf[1][ks], af, a1); }
                const int t = 16 * tt + fr; const float bs = bsv[tt];
                bf16_t* up = z + (r0 + t) * 4096 + g * 256 + 32 * w + fq * 4;
                { const u32x2 uu = upre[tt][0]; u32x2 yw; yw.x = pk2(bflo(uu.x) * (a0[0] + bs), bfhi(uu.x) * (a0[1] + bs)); yw.y = pk2(bflo(uu.y) * (a0[2] + bs), bfhi(uu.y) * (a0[3] + bs)); *(u32x2*)up = yw; }
                { const u32x2 uu = upre[tt][1]; u32x2 yw; yw.x = pk2(bflo(uu.x) * (a1[0] + bs), bfhi(uu.x) * (a1[1] + bs)); yw.y = pk2(bflo(uu.y) * (a1[2] + bs), bfhi(uu.y) * (a1[3] + bs)); *(u32x2*)(up + 16) = yw; } }
            LDS_BARRIER();
        }
#undef SP_LOADG
    }
    __syncthreads();
}

__device__ __forceinline__ void conv_pass(KP P, int wv) {
    const bf16_t* z = (const bf16_t*)(P->ws + WS_Z); bf16_t* xc = (bf16_t*)(P->ws + WS_YP);
    const int gtid = blockIdx.x * NTHREADS + opaque_tid(wv), nth = gridDim.x * NTHREADS;
    const int oct = gtid & 127;
    float cw[4][8], cb[8];
#pragma unroll
    for (int e = 0; e < 8; ++e) { cb[e] = P->in[I_DCB][oct * 8 + e];
#pragma unroll
        for (int j = 0; j < 4; ++j) cw[j][e] = P->in[I_DCW][j * 1024 + oct * 8 + e]; }
    for (int idx = gtid; idx < (MTOK / 8) * 128; idx += nth) {
        const int r0 = (idx >> 7) * 8; const bool first = (r0 & (SEQL - 1)) == 0;
        u32x4 xr[11];
#pragma unroll
        for (int i = 0; i < 11; ++i) { xr[i] = (u32x4){0u, 0u, 0u, 0u}; if (i >= 3 || !first) xr[i] = *(const u32x4*)(z + (size_t)(r0 - 3 + i) * 2048 + 1024 + oct * 8); }
#pragma unroll
        for (int o = 0; o < 8; ++o) { float a[8];
#pragma unroll
            for (int e = 0; e < 8; ++e) a[e] = cb[e];
#pragma unroll
            for (int j = 0; j < 4; ++j) { const u32x4 v = xr[o + j];
                a[0] += cw[j][0] * bflo(v.x); a[1] += cw[j][1] * bfhi(v.x); a[2] += cw[j][2] * bflo(v.y); a[3] += cw[j][3] * bfhi(v.y);
                a[4] += cw[j][4] * bflo(v.z); a[5] += cw[j][5] * bfhi(v.z); a[6] += cw[j][6] * bflo(v.w); a[7] += cw[j][7] * bfhi(v.w); }
            u32x4 ow; ow.x = pk2(a[0], a[1]); ow.y = pk2(a[2], a[3]); ow.z = pk2(a[4], a[5]); ow.w = pk2(a[6], a[7]);
            *(u32x4*)(xc + (size_t)(r0 + o) * 1024 + oct * 8) = ow; }
    }
}
__device__ __forceinline__ void scan_pass(KP P, LAS unsigned char* lds, int wv) {
    const bf16_t* z = (const bf16_t*)(P->ws + WS_Z); const bf16_t* loga = z + (size_t)MTOK * 2048; const bf16_t* beta = loga + (size_t)MTOK * 1024; bf16_t* y = (bf16_t*)(P->ws + WS_YP);
    LAS float* sA = (LAS float*)lds; LAS float* sB = sA + 512 * 8;
    const int tid = opaque_tid(wv), seg = tid >> 4, o = tid & 15;
    for (int unit = blockIdx.x; unit < 256; unit += gridDim.x) {
        const int b = unit >> 3; const int ch0 = ((unit & 7) * 16 + o) * 8; const size_t row0 = (size_t)b * SEQL + seg * 64;
        float SL[8], B[8];
#pragma unroll
        for (int e = 0; e < 8; ++e) { SL[e] = 0.f; B[e] = 0.f; }
#pragma unroll 4
        for (int t = 0; t < 64; ++t) { const u32x4 lv = *(const u32x4*)(loga + (row0 + t) * 1024 + ch0), bv = *(const u32x4*)(beta + (row0 + t) * 1024 + ch0);
            const float l[8] = {bflo(lv.x), bfhi(lv.x), bflo(lv.y), bfhi(lv.y), bflo(lv.z), bfhi(lv.z), bflo(lv.w), bfhi(lv.w)};
            const float be[8] = {bflo(bv.x), bfhi(bv.x), bflo(bv.y), bfhi(bv.y), bflo(bv.z), bfhi(bv.z), bflo(bv.w), bfhi(bv.w)};
#pragma unroll
            for (int e = 0; e < 8; ++e) { B[e] = __expf(l[e]) * B[e] + be[e]; SL[e] += l[e]; } }
        __syncthreads();
#pragma unroll
        for (int e = 0; e < 8; ++e) { sA[tid * 8 + e] = __expf(SL[e]); sB[tid * 8 + e] = B[e]; }
        __syncthreads();
        float H[8];
#pragma unroll
        for (int e = 0; e < 8; ++e) H[e] = 0.f;
        for (int s = 0; s < seg; ++s) {
#pragma unroll
            for (int e = 0; e < 8; ++e) H[e] = sA[(s * 16 + o) * 8 + e] * H[e] + sB[(s * 16 + o) * 8 + e]; }
        for (int t0 = 0; t0 < 64; t0 += 4) { u32x4 lvv[4], bvv[4], gvv[4];
#pragma unroll
            for (int i = 0; i < 4; ++i) { lvv[i] = *(const u32x4*)(loga + (row0 + t0 + i) * 1024 + ch0); bvv[i] = *(const u32x4*)(beta + (row0 + t0 + i) * 1024 + ch0); gvv[i] = *(const u32x4*)(z + (row0 + t0 + i) * 2048 + ch0); }
#pragma unroll
            for (int i = 0; i < 4; ++i) { const u32x4 lv = lvv[i], bv = bvv[i], gv = gvv[i];
                const float l[8] = {bflo(lv.x), bfhi(lv.x), bflo(lv.y), bfhi(lv.y), bflo(lv.z), bfhi(lv.z), bflo(lv.w), bfhi(lv.w)};
                const float be[8] = {bflo(bv.x), bfhi(bv.x), bflo(bv.y), bfhi(bv.y), bflo(bv.z), bfhi(bv.z), bflo(bv.w), bfhi(bv.w)};
                const float gg[8] = {bflo(gv.x), bfhi(gv.x), bflo(gv.y), bfhi(gv.y), bflo(gv.z), bfhi(gv.z), bflo(gv.w), bfhi(gv.w)};
                float yv[8];
#pragma unroll
                for (int e = 0; e < 8; ++e) { H[e] = __expf(l[e]) * H[e] + be[e]; yv[e] = H[e] * gelu_tanh(gg[e]); }
                u32x4 ow; ow.x = pk2(yv[0], yv[1]); ow.y = pk2(yv[2], yv[3]); ow.z = pk2(yv[4], yv[5]); ow.w = pk2(yv[6], yv[7]);
                *(u32x4*)(y + (row0 + t0 + i) * 1024 + ch0) = ow; } }
    }
    __syncthreads();
}

constexpr int NPHASES = 39;
enum { T_PREP, T_GEMM, T_GEMMRG, T_ROW, T_MLSTM, T_HGRN, T_SPATIAL, T_CONV, T_SCAN };
__device__ __forceinline__ void decode(int ph, int& type, int& layer, int& sub) {
    if (ph == 0) { type = T_PREP; layer = 0; sub = 0; return; }
    int base, cbase;
    if (ph < 10) { layer = 0; base = 1; cbase = 4; } else if (ph < 19) { layer = 1; base = 10; cbase = 13; } else if (ph < 28) { layer = 2; base = 19; cbase = 22; } else { layer = 3; base = 28; cbase = 33; }
    if (ph >= cbase) { const int k = ph - cbase;
        if (k == 0) { type = T_ROW; sub = 1; } else if (k == 1) { type = T_GEMM; sub = 2; } else if (k == 2) { type = T_GEMM; sub = 3; } else if (k == 3) { type = T_ROW; sub = 2; } else if (k == 4) { type = T_GEMM; sub = 4; } else { type = T_ROW; sub = 3; }
        return; }
    const int k = ph - base;
    if (layer < 3) { if (k == 0) { type = T_GEMM; sub = 0; } else if (k == 1) { type = layer == 0 ? T_MLSTM : layer == 1 ? T_HGRN : T_SPATIAL; sub = 0; } else { type = T_GEMM; sub = 1; } }
    else { if (k == 0) { type = T_GEMM; sub = 0; } else if (k == 1) { type = T_CONV; sub = 0; } else if (k == 2) { type = T_GEMMRG; sub = 0; } else if (k == 3) { type = T_SCAN; sub = 0; } else { type = T_GEMM; sub = 1; } }
}

__global__ void __launch_bounds__(NTHREADS, 2) fwd_kernel(Params Pk) {
    extern __shared__ __attribute__((aligned(16))) unsigned char smem[];
    LAS unsigned char* lds = (LAS unsigned char*)smem;
    const int ph_lo = Pk.ph_lo, ph_hi = Pk.ph_hi;
    if (ph_lo < 0) cg::this_grid().sync();
    volatile LAS unsigned* bst = (volatile LAS unsigned*)(lds + (LDS_BYTES - 16));
    const int wv = __builtin_amdgcn_readfirstlane((int)threadIdx.x >> 6);
    if (xb_leader(wv)) { bst[0] = 0u; bst[1] = 0u; }
    __syncthreads();
    const XcdBarrier gbar = xcd_barrier_post((unsigned*)(Pk.ws + WS_BAR), bst, wv);
    for (int ph = ph_lo; ph < ph_hi; ++ph) {
        KP P = (KP)__builtin_amdgcn_kernarg_segment_ptr();
        asm volatile("" : "+s"(P));
        unsigned char* ws = P->ws;
        bf16_t* W = (bf16_t*)(ws + WS_W); bf16_t* HN = (bf16_t*)(ws + WS_HN); bf16_t* Z = (bf16_t*)(ws + WS_Z); bf16_t* YP = (bf16_t*)(ws + WS_YP); bf16_t* PB = (bf16_t*)(ws + WS_PB);
        int type, layer, sub; decode(ph, type, layer, sub);
        if (type == T_PREP) prep_phase(P, lds, wv);
        else if (type == T_GEMM) {
            const int njobs = (sub == 2) ? 2 : 1;
            for (int j = 0; j < njobs; ++j) {
                pg8::Gemm g; EpiGen e; e.gate = nullptr; e.gate_pn = -1; e.act = 0; g.M = MTOK;
                bf16_t* L = W + (size_t)layer * LW;
                if (sub == 0) { g.A = HN; g.lda = 1024; g.K = 1024; g.ldb = 1024; e.O = Z;
                    if (layer == 0) { g.Bt = W + OFF_A_IN; g.N = 3328; e.ldc = 3072; e.gate = (float*)(ws + WS_GATE); e.gate_pn = 12; }
                    else if (layer == 1) { g.Bt = W + OFF_B_IN; g.N = 4096; e.ldc = 4096; }
                    else if (layer == 2) { g.Bt = W + OFF_C_IN; g.N = 4096; e.ldc = 4096; e.act = 1; }
                    else { g.Bt = W + OFF_D_IN; g.N = 2048; e.ldc = 2048; } }
                else if (sub == 1) { g.N = 1024; e.O = (bf16_t*)P->out; e.ldc = 1024;
                    if (layer == 2) { g.A = Z; g.lda = 4096; g.K = 2048; g.ldb = 2048; g.Bt = W + OFF_C_OUT; }
                    else { g.A = YP; g.lda = 1024; g.K = 1024; g.ldb = 1024; g.Bt = W + (layer == 0 ? OFF_A_OUT : layer == 1 ? OFF_B_OUT : OFF_D_OUT); } }
                else if (sub == 2) {
                    if (j == 0) { g.A = HN; g.lda = 1024; g.K = 1024; g.ldb = 1024; g.Bt = L; g.N = 4096; e.O = Z; e.ldc = 4096; e.act = 2; }
                    else { g.A = PB; g.lda = 256; g.K = 256; g.ldb = 256; g.Bt = L + W_UP + W_DN + W_G; g.N = 1024; e.O = YP; e.ldc = 1024; } }
                else if (sub == 3) { g.A = Z; g.lda = 4096; g.K = 4096; g.ldb = 4096; g.Bt = L + W_UP; g.N = 1024; e.O = (bf16_t*)P->out; e.ldc = 1024; }
                else { g.A = HN; g.lda = 1024; g.K = 1024; g.ldb = 1024; g.Bt = L + W_UP + W_DN; g.N = 1024; e.O = YP; e.ldc = 1024; e.act = 3; }
                pg8::StaticOrder S; S.init(g.M, g.N, (int)gridDim.x, (int)blockIdx.x);
                pg8::gemm_phase<EpiGen>(lds, g, S, e, wv);
            }
        }
        else if (type == T_GEMMRG) {
            for (int blk = 0; blk < 4; ++blk) {
                pg8::Gemm g; g.M = MTOK; g.N = 512; g.K = 256; g.A = YP + blk * 256; g.lda = 1024; g.Bt = W + OFF_D_G + (size_t)blk * 512 * 256; g.ldb = 256;
                EpiRg e; e.xc = YP; e.loga = Z + (size_t)MTOK * 2048; e.beta = e.loga + (size_t)MTOK * 1024; e.b_a = P->in[I_DBA]; e.b_x = P->in[I_DBX]; e.spt = (const float*)(ws + WS_LB) + 1024; e.blk = blk;
                pg8::StaticOrder S; S.init(g.M, g.N, (int)gridDim.x, (int)blockIdx.x);
                pg8::gemm_phase<EpiRg>(lds, g, S, e, wv);
            }
        }
        else if (type == T_ROW) {
            const float* ng = P->in[I_NG] + (size_t)layer * 5 * 1024;
            bf16_t* HBuf = (bf16_t*)P->out;
            float* RS = (float*)(ws + WS_LB + 512 * 1024);
            if (sub == 1) rowpass(nullptr, HN, HBuf, ng + 1024, nullptr, nullptr, ng + 2048, HN, 1, P->in[I_P] + (size_t)layer * MTOK * 256, PB, RS, ng, RS, wv);
            else if (sub == 2) rowpass(nullptr, HN, HBuf, ng + 3072, nullptr, nullptr, nullptr, HN, 0, nullptr, nullptr, RS, ng + 2048, nullptr, wv);
            else if (layer < 3) rowpass(nullptr, HN, YP, ng + 4096, nullptr, nullptr, ng + 5120, HN, 1, nullptr, nullptr, nullptr, nullptr, RS, wv);
            else rowpass(nullptr, HN, YP, ng + 4096, P->out, nullptr, nullptr, nullptr, 0, nullptr, nullptr, nullptr, nullptr, nullptr, wv);
        }
        else if (type == T_MLSTM) mlstm_core(P, lds, wv);
        else if (type == T_HGRN) hgrn_core(P, lds, wv);
        else if (type == T_SPATIAL) spatial_core(P, lds, wv);
        else if (type == T_CONV) conv_pass(P, wv);
        else if (type == T_SCAN) scan_pass(P, lds, wv);
        if (ph + 1 < ph_hi) xcd_barrier(gbar, wv);
    }
}

extern "C" void kernel_launch(void* const* d_in, const int* in_sizes, int n_in, void* d_out, int out_size, void* d_ws, size_t ws_size, hipStream_t stream) {
    static int grid = 0;
    if (grid == 0) {
        if (n_in != 31 || in_sizes[0] != MTOK * DM || out_size != MTOK * DM || ws_size < WS_END) { fprintf(stderr, "kernel_launch: unexpected shapes (n_in %d, ws %zu)\n", n_in, ws_size); grid = -1; return; }
        int dev = 0, cus = 0, per_cu = 0;
        hipGetDevice(&dev); hipDeviceGetAttribute(&cus, hipDeviceAttributeMultiprocessorCount, dev);
        hipFuncSetAttribute((const void*)fwd_kernel, hipFuncAttributeMaxDynamicSharedMemorySize, LDS_BYTES);
        hipOccupancyMaxActiveBlocksPerMultiprocessor(&per_cu, (const void*)fwd_kernel, NTHREADS, LDS_BYTES);
        if (per_cu < 1) per_cu = 1;
        grid = cus * per_cu;
        (void)hipGetLastError();
    }
    if (grid < 0) return;
    Params p{};
    for (int i = 0; i < 31; ++i) p.in[i] = (const float*)d_in[i];
    p.out = (float*)d_out; p.ws = (unsigned char*)d_ws;
    (void)hipMemsetAsync((unsigned char*)d_ws + WS_BAR, 0, XCD_BAR_WORDS * sizeof(unsigned), stream);
#if ONE_LAUNCH
    p.ph_lo = 0; p.ph_hi = NPHASES;
    void* args[] = {&p};
    hipError_t e = hipLaunchCooperativeKernel((const void*)fwd_kernel, dim3(grid), dim3(NTHREADS), args, LDS_BYTES, stream);
    if (e != hipSuccess) fprintf(stderr, "cooperative launch failed: %s (grid %d)\n", hipGetErrorString(e), grid);
#else
    for (int ph = 0; ph < NPHASES; ++ph) { p.ph_lo = ph; p.ph_hi = ph + 1; hipLaunchKernelGGL(fwd_kernel, dim3(grid), dim3(NTHREADS), LDS_BYTES, stream, p); }
#endif
}
```
